# Optimizing an MI355X kernel written in HIP

```python
import math
import jax, jax.numpy as jnp
from jax import lax
import numpy as np

D_MODEL = 1024
BATCH = 2
SEQ = 16384
DEPTH = 2

A_HEADS = 4
A_QK_DIM = 64
A_V_DIM = 2 * A_QK_DIM
B_HEADS = 4
B_DIM = 128
CONV_K = 4
CHUNK = 64
C_HEADS = 8
C_HEAD_DIM = 64
C_Q_LORA = 256
C_KV_LORA = 128
IDX_HEADS = 8
IDX_DIM = 64
INDEX_TOPK = 256
N_BRANCH = 3
D_FF = 4 * D_MODEL
Q_BLOCK = 128
DN_ALPHA = (2 * DEPTH) ** 0.25
DN_BETA = (8 * DEPTH) ** -0.25
NORM_EPS = 1e-6

A_QK_COLS = A_HEADS * 2 * A_QK_DIM
A_V_COLS = A_HEADS * A_V_DIM
B_COLS = B_HEADS * B_DIM
C_OUT = C_HEADS * C_HEAD_DIM
SPLIT_SIZES = (A_QK_COLS, A_QK_COLS, A_V_COLS,
               B_COLS, B_COLS, B_COLS, B_COLS, B_HEADS, B_HEADS,
               C_Q_LORA, C_KV_LORA, IDX_DIM, IDX_HEADS,
               N_BRANCH * D_MODEL)
SPLIT_POINTS = tuple(int(v) for v in np.cumsum(SPLIT_SIZES)[:-1])
IN_COLS = int(sum(SPLIT_SIZES))

kernel_name = 'hybrid_diffattn_gdn_dsa_deepnorm'


def layer_norm(x, g, b):
    xf = x.astype(jnp.float32)
    mu = jnp.mean(xf, -1, keepdims=True)
    var = jnp.mean(jnp.square(xf - mu), -1, keepdims=True)
    return ((xf - mu) * lax.rsqrt(var + NORM_EPS) * g + b).astype(x.dtype)


def rms_norm(x, g):
    xf = x.astype(jnp.float32)
    y = xf * lax.rsqrt(jnp.mean(xf * xf, -1, keepdims=True) + NORM_EPS)
    return (y * g).astype(x.dtype)


def l2_norm(x):
    xf = x.astype(jnp.float32)
    return (xf * lax.rsqrt(jnp.sum(xf * xf, -1, keepdims=True) + NORM_EPS)).astype(x.dtype)


def causal_depthwise_conv(x, w):
    k = w.shape[0]
    return lax.conv_general_dilated(x, w[:, None, :].astype(x.dtype), window_strides=(1,),
                                    padding=[(k - 1, 0)], dimension_numbers=('NWC', 'WIO', 'NWC'),
                                    feature_group_count=x.shape[-1])


def to_blocks(z, nb):
    return z.reshape(z.shape[0], nb, Q_BLOCK, *z.shape[2:]).swapaxes(0, 1)


def diff_attention(q, k, v, lam, subln_g, lam_init):
    bsz, t, h = q.shape[:3]
    nb = t // Q_BLOCK
    scale = A_QK_DIM ** -0.5
    key_pos = jnp.arange(t)

    def block(args):
        qi, start = args
        s = jnp.einsum('bqhcd,bshcd->bhcqs', qi, k).astype(jnp.float32) * scale
        qpos = start + jnp.arange(Q_BLOCK)
        s = jnp.where(key_pos[None, :] <= qpos[:, None], s, -jnp.inf)
        p = jax.nn.softmax(s, axis=-1)
        a = p[:, :, 0] - lam * p[:, :, 1]
        return jnp.einsum('bhqs,bshd->bqhd', a.astype(v.dtype), v)

    o = lax.map(block, (to_blocks(q, nb), jnp.arange(nb) * Q_BLOCK))
    o = o.swapaxes(0, 1).reshape(bsz, t, h, v.shape[-1])
    o = rms_norm(o, subln_g) * (1.0 - lam_init)
    return o.reshape(bsz, t, h * v.shape[-1])


def gated_delta_rule(q, k, v, g, beta):
    bsz, t, h, dk = q.shape
    dv = v.shape[-1]
    n = t // CHUNK
    f32 = jnp.float32

    def chunks(z):
        z = z.astype(f32).reshape(bsz, n, CHUNK, h, *z.shape[3:])
        return jnp.moveaxis(z, 3, 1)

    q, k, v, g, beta = (chunks(z) for z in (q, k, v, g, beta))
    q = q * dk ** -0.5
    g = jnp.cumsum(g, axis=-1)
    idx = jnp.arange(CHUNK)
    lower_incl = idx[:, None] >= idx[None, :]
    strict_lower = idx[:, None] > idx[None, :]
    diff = g[..., :, None] - g[..., None, :]
    decay = jnp.where(lower_incl, jnp.exp(jnp.where(lower_incl, diff, 0.0)), 0.0)
    k_beta = k * beta[..., None]
    low = jnp.where(strict_lower, jnp.einsum('bhncd,bhnsd->bhncs', k_beta, k) * decay, 0.0)
    rhs = jnp.concatenate([v * beta[..., None], k_beta * jnp.exp(g)[..., None]], axis=-1)
    sol = lax.linalg.triangular_solve(low + jnp.eye(CHUNK, dtype=f32), rhs,
                                      left_side=True, lower=True, unit_diagonal=True)
    u, w = sol[..., :dv], sol[..., dv:]
    attn_intra = jnp.einsum('bhncd,bhnsd->bhncs', q, k) * decay
    q_dec = q * jnp.exp(g)[..., None]
    k_dec = k * jnp.exp(g[..., -1:] - g)[..., None]
    g_last = jnp.exp(g[..., -1])

    def step(S, xs):
        q_i, k_i, u_i, w_i, a_i, gl_i = xs
        v_new = u_i - jnp.einsum('bhcd,bhde->bhce', w_i, S)
        o = jnp.einsum('bhcd,bhde->bhce', q_i, S) + jnp.einsum('bhcs,bhse->bhce', a_i, v_new)
        S = S * gl_i[..., None, None] + jnp.einsum('bhcd,bhce->bhde', k_i, v_new)
        return S, o

    xs = tuple(jnp.moveaxis(z, 2, 0) for z in (q_dec, k_dec, u, w, attn_intra, g_last))
    _, o = lax.scan(step, jnp.zeros((bsz, h, dk, dv), f32), xs)
    return jnp.transpose(o, (1, 0, 3, 2, 4)).reshape(bsz, t, h, dv)


def gated_deltanet(q, k, v, z, a, b, conv_w, a_log, dt_bias, norm_g):
    bsz, t, _ = q.shape
    qkv = jax.nn.silu(causal_depthwise_conv(jnp.concatenate([q, k, v], axis=-1), conv_w))
    q, k, v = jnp.split(qkv, 3, axis=-1)
    heads = lambda y: y.reshape(bsz, t, B_HEADS, B_DIM)
    q, k, v = l2_norm(heads(q)), l2_norm(heads(k)), heads(v)
    g = -jnp.exp(a_log.astype(jnp.float32)) * jax.nn.softplus(a.astype(jnp.float32) + dt_bias.astype(jnp.float32))
    beta = jax.nn.sigmoid(b.astype(jnp.float32))
    o = gated_delta_rule(q, k, v, g, beta)
    o = rms_norm(o, norm_g) * jax.nn.silu(heads(z).astype(jnp.float32))
    return o.reshape(bsz, t, B_COLS).astype(z.dtype)


def dsa_attention(q_lat, kv_lat, k_idx, w_idx, q_norm_g, kv_norm_g, kidx_g, kidx_b,
                  w_uq, w_qidx, w_uk, w_uv):
    bsz, t, _ = q_lat.shape
    q_lat = rms_norm(q_lat, q_norm_g)
    c_kv = rms_norm(kv_lat, kv_norm_g)
    q = jnp.einsum('btr,rhd->bthd', q_lat, w_uq)
    q_abs = jnp.einsum('bthd,rhd->bthr', q, w_uk)
    q_idx = jnp.einsum('btr,rhd->bthd', q_lat, w_qidx)
    k_idx = layer_norm(k_idx, kidx_g, kidx_b)
    w_idx = w_idx * (IDX_HEADS ** -0.5 * IDX_DIM ** -0.5)
    n_sel = min(INDEX_TOPK, t // 4)
    nb = t // Q_BLOCK
    key_pos = jnp.arange(t)
    scale = C_HEAD_DIM ** -0.5

    def block(args):
        qa, qi, wi, start = args
        qpos = start + jnp.arange(Q_BLOCK)
        s = jax.nn.relu(jnp.einsum('bqhd,bsd->bqhs', qi, k_idx).astype(jnp.float32))
        score = jnp.einsum('bqhs,bqh->bqs', s, wi.astype(jnp.float32))
        score = jnp.where(key_pos[None, :] <= qpos[:, None], score, -jnp.inf)
        _, sel = lax.top_k(score, n_sel)
        valid = sel <= qpos[None, :, None]
        c_sel = jax.vmap(lambda c, i: c[i])(c_kv, sel)
        logits = jnp.einsum('bqhr,bqkr->bqhk', qa, c_sel).astype(jnp.float32) * scale
        logits = jnp.where(valid[:, :, None, :], logits, -jnp.inf)
        p = jax.nn.softmax(logits, axis=-1).astype(c_sel.dtype)
        return jnp.einsum('bqhk,bqkr->bqhr', p, c_sel)

    o_lat = lax.map(block, (to_blocks(q_abs, nb), to_blocks(q_idx, nb), to_blocks(w_idx, nb),
                            jnp.arange(nb) * Q_BLOCK))
    o_lat = o_lat.swapaxes(0, 1).reshape(bsz, t, C_HEADS, C_KV_LORA)
    o = jnp.einsum('bthr,rhd->bthd', o_lat, w_uv)
    return o.reshape(bsz, t, C_OUT)


def setup_inputs(seed: int = 0) -> dict:
    key = jax.random.key(seed)
    ks = iter(jax.random.split(key, 40))
    nrm = lambda shape, s: jax.random.normal(next(ks), shape, jnp.float32) * s
    gain = lambda shape: 1.0 + nrm(shape, 0.02)
    dt = jnp.exp(jax.random.uniform(next(ks), (DEPTH, B_HEADS), jnp.float32,
                                    math.log(1e-3), math.log(1e-1)))
    return {
        'x': nrm((BATCH, SEQ, D_MODEL), 1.0),
        'w_in': nrm((DEPTH, D_MODEL, IN_COLS), D_MODEL ** -0.5),
        'b_gate': nrm((DEPTH, N_BRANCH * D_MODEL), 0.1),
        'a_lambda': nrm((DEPTH, 4, A_QK_DIM), 0.1),
        'a_subln_g': gain((DEPTH, A_V_DIM)),
        'b_conv_w': nrm((DEPTH, CONV_K, 3 * B_COLS), CONV_K ** -0.5),
        'b_a_log': jnp.log(jax.random.uniform(next(ks), (DEPTH, B_HEADS), jnp.float32, 1.0, 16.0)),
        'b_dt_bias': dt + jnp.log(-jnp.expm1(-dt)),
        'b_norm_g': gain((DEPTH, B_DIM)),
        'c_q_norm_g': gain((DEPTH, C_Q_LORA)),
        'c_kv_norm_g': gain((DEPTH, C_KV_LORA)),
        'c_kidx_g': gain((DEPTH, IDX_DIM)),
        'c_kidx_b': nrm((DEPTH, IDX_DIM), 0.02),
        'c_w_uq': nrm((DEPTH, C_Q_LORA, C_HEADS, C_HEAD_DIM), C_Q_LORA ** -0.5),
        'c_w_qidx': nrm((DEPTH, C_Q_LORA, IDX_HEADS, IDX_DIM), C_Q_LORA ** -0.5),
        'c_w_uk': nrm((DEPTH, C_KV_LORA, C_HEADS, C_HEAD_DIM), C_KV_LORA ** -0.5),
        'c_w_uv': nrm((DEPTH, C_KV_LORA, C_HEADS, C_HEAD_DIM), C_KV_LORA ** -0.5),
        'w_branch_a': nrm((DEPTH, A_V_COLS, D_MODEL), A_V_COLS ** -0.5),
        'w_branch_b': nrm((DEPTH, B_COLS, D_MODEL), B_COLS ** -0.5),
        'w_branch_c': nrm((DEPTH, C_OUT, D_MODEL), C_OUT ** -0.5),
        'w_o': nrm((DEPTH, D_MODEL, D_MODEL), D_MODEL ** -0.5 * DN_BETA),
        'ln1_g': gain((DEPTH, D_MODEL)),
        'ln1_b': nrm((DEPTH, D_MODEL), 0.02),
        'w_ff1': nrm((DEPTH, D_MODEL, D_FF), D_MODEL ** -0.5),
        'w_ff2': nrm((DEPTH, D_FF, D_MODEL), D_FF ** -0.5 * DN_BETA),
        'ln2_g': gain((DEPTH, D_MODEL)),
        'ln2_b': nrm((DEPTH, D_MODEL), 0.02),
    }


def reference(x, w_in, b_gate, a_lambda, a_subln_g, b_conv_w, b_a_log, b_dt_bias, b_norm_g,
              c_q_norm_g, c_kv_norm_g, c_kidx_g, c_kidx_b, c_w_uq, c_w_qidx, c_w_uk, c_w_uv,
              w_branch_a, w_branch_b, w_branch_c, w_o, ln1_g, ln1_b, w_ff1, w_ff2, ln2_g, ln2_b):
    bsz, t, _ = x.shape
    for l in range(DEPTH):
        lam_init = 0.8 - 0.6 * math.exp(-0.3 * l)
        lam_p = a_lambda[l].astype(jnp.float32)
        lam = jnp.exp(jnp.sum(lam_p[0] * lam_p[1])) - jnp.exp(jnp.sum(lam_p[2] * lam_p[3])) + lam_init

        proj = x @ w_in[l]
        (aq, ak, av, bq, bk, bv, bz, ba, bb,
         cq, ckv, cki, cwi, gates) = jnp.split(proj, SPLIT_POINTS, axis=-1)

        y_a = diff_attention(aq.reshape(bsz, t, A_HEADS, 2, A_QK_DIM),
                             ak.reshape(bsz, t, A_HEADS, 2, A_QK_DIM),
                             av.reshape(bsz, t, A_HEADS, A_V_DIM),
                             lam, a_subln_g[l], lam_init)
        y_b = gated_deltanet(bq, bk, bv, bz, ba, bb, b_conv_w[l], b_a_log[l], b_dt_bias[l], b_norm_g[l])
        y_c = dsa_attention(cq, ckv, cki, cwi, c_q_norm_g[l], c_kv_norm_g[l], c_kidx_g[l], c_kidx_b[l],
                            c_w_uq[l], c_w_uqidx[l] if False else c_w_qidx[l], c_w_uk[l], c_w_uv[l])

        g = jax.nn.sigmoid(gates + b_gate[l]).reshape(bsz, t, N_BRANCH, D_MODEL)
        merged = (g[:, :, 0] * (y_a @ w_branch_a[l])
                  + g[:, :, 1] * (y_b @ w_branch_b[l])
                  + g[:, :, 2] * (y_c @ w_branch_c[l]))
        x = layer_norm(DN_ALPHA * x + merged @ w_o[l], ln1_g[l], ln1_b[l])

        hdn = jnp.square(jax.nn.relu(x @ w_ff1[l]))
        x = layer_norm(DN_ALPHA * x + hdn @ w_ff2[l], ln2_g[l], ln2_b[l])
    return x
```

```cpp
#include <hip/hip_runtime.h>
#include <hip/hip_cooperative_groups.h>
#include <cstdio>
namespace cg = cooperative_groups;

#ifndef COOP
#define COOP 1
#endif
#ifndef EN_A
#define EN_A 1
#endif
#ifndef EN_B
#define EN_B 1
#endif
#ifndef EN_C
#define EN_C 1
#endif

typedef unsigned short u16;
typedef unsigned int u32;
typedef unsigned long long u64;
using bf16x8 = __attribute__((ext_vector_type(8))) short;
using s16x4 = __attribute__((ext_vector_type(4))) short;
using f32x4 = __attribute__((ext_vector_type(4))) float;
using f32x16 = __attribute__((ext_vector_type(16))) float;
#define DI __device__ __forceinline__

constexpr int NT = 32768, T = 16384, PC = 4048;
constexpr int AQ = 0, AK = 512, AV = 1024, BQ = 1536, BK_ = 2048, BV = 2560, BZ = 3072, BA = 3584, BB = 3588,
              CQ = 3592, CKVc = 3848, CKI = 3976, CWI = 4040, GATES = 4048;
constexpr float EPS = 1e-6f;
constexpr float DN_ALPHA = 1.41421356237f;
constexpr int SMEM_BYTES = 73728 + 1024;

constexpr size_t al256(size_t x) { return (x + 255) & ~(size_t)255; }
constexpr size_t SZ_WIN = al256((size_t)7120 * 1024 * 2), SZ_WQX = al256((size_t)1536 * 256 * 2), SZ_WBR = al256((size_t)1024 * 512 * 2),
                 SZ_WBRC = al256((size_t)1024 * 1024 * 2), SZ_WO = al256((size_t)1024 * 1024 * 2), SZ_WF = al256((size_t)4096 * 1024 * 2);
constexpr size_t O_WIN = 0, O_WQX = O_WIN + SZ_WIN, O_WBRA = O_WQX + SZ_WQX, O_WBRB = O_WBRA + SZ_WBR, O_WBRC = O_WBRB + SZ_WBR,
                 O_WO = O_WBRC + SZ_WBRC, O_WF1 = O_WO + SZ_WO, O_WF2 = O_WF1 + SZ_WF, LAYER_W = O_WF2 + SZ_WF;
constexpr size_t O_P = 2 * LAYER_W, O_XB = O_P + (size_t)NT * 4096 * 2, O_M = O_XB + (size_t)NT * 1024 * 2;
constexpr size_t O_KDT = O_M, O_ATT = O_KDT + 33554432, O_HALO = O_ATT + 16777216, O_KIDX = O_HALO + 4718592, O_CKV = O_KIDX + 4194304,
                 O_MEND = O_CKV + 8388608;
constexpr size_t O_WIDX = O_MEND, O_GL = O_WIDX + (size_t)NT * 8 * 4, O_LAM = O_GL + 8192, O_CNT = O_LAM + 256, WS_NEED = O_CNT + 256;
static_assert(O_MEND - O_M >= (size_t)NT * 1024 * 2, "merged alias");

struct Params {
  const float *x, *w_in, *b_gate, *a_lambda, *a_subln_g, *b_conv_w, *b_a_log, *b_dt_bias, *b_norm_g,
      *c_q_norm_g, *c_kv_norm_g, *c_kidx_g, *c_kidx_b, *c_w_uq, *c_w_qidx, *c_w_uk, *c_w_uv,
      *w_branch_a, *w_branch_b, *w_branch_c, *w_o, *ln1_g, *ln1_b, *w_ff1, *w_ff2, *ln2_g, *ln2_b;
  float* out;
  char* ws;
  __device__ __forceinline__ u16* win(int l) const { return (u16*)(ws + l * LAYER_W + O_WIN); }
  __device__ __forceinline__ u16* wqx(int l) const { return (u16*)(ws + l * LAYER_W + O_WQX); }
  __device__ __forceinline__ u16* wbra(int l) const { return (u16*)(ws + l * LAYER_W + O_WBRA); }
  __device__ __forceinline__ u16* wbrb(int l) const { return (u16*)(ws + l * LAYER_W + O_WBRB); }
  __device__ __forceinline__ u16* wbrc(int l) const { return (u16*)(ws + l * LAYER_W + O_WBRC); }
  __device__ __forceinline__ u16* wo(int l) const { return (u16*)(ws + l * LAYER_W + O_WO); }
  __device__ __forceinline__ u16* wf1(int l) const { return (u16*)(ws + l * LAYER_W + O_WF1); }
  __device__ __forceinline__ u16* wf2(int l) const { return (u16*)(ws + l * LAYER_W + O_WF2); }
  __device__ __forceinline__ u16* P() const { return (u16*)(ws + O_P); }
  __device__ __forceinline__ u16* XB() const { return (u16*)(ws + O_XB); }
  __device__ __forceinline__ u16* KDT() const { return (u16*)(ws + O_KDT); }
  __device__ __forceinline__ u16* ATT() const { return (u16*)(ws + O_ATT); }
  __device__ __forceinline__ u16* HALO() const { return (u16*)(ws + O_HALO); }
  __device__ __forceinline__ u16* KIDX() const { return (u16*)(ws + O_KIDX); }
  __device__ __forceinline__ u16* CKV() const { return (u16*)(ws + O_CKV); }
  __device__ __forceinline__ u16* MERGED() const { return (u16*)(ws + O_M); }
  __device__ __forceinline__ float* WIDX() const { return (float*)(ws + O_WIDX); }
  __device__ __forceinline__ float* GL() const { return (float*)(ws + O_GL); }
  __device__ __forceinline__ float* LAM() const { return (float*)(ws + O_LAM); }
  __device__ __forceinline__ u32* CNT() const { return (u32*)(ws + O_CNT); }
};

DI int lbid() { int b = blockIdx.x; asm volatile("" : "+s"(b)); return b; }
DI int lgdim() { int b = gridDim.x; asm volatile("" : "+s"(b)); return b; }
DI int ltid() { int t = threadIdx.x; asm volatile("" : "+v"(t)); return t; }
DI u16 f2bf(float x) { u32 u = __float_as_uint(x); u += 0x7fffu + ((u >> 16) & 1u); return (u16)(u >> 16); }
DI float bf2f(u16 h) { return __uint_as_float(((u32)h) << 16); }
DI u32 pack2(float a, float b) { return (u32)f2bf(a) | ((u32)f2bf(b) << 16); }
DI float bflo(u32 v) { return __uint_as_float(v << 16); }
DI float bfhi(u32 v) { return __uint_as_float(v & 0xffff0000u); }
DI f32x4 mfma16(bf16x8 a, bf16x8 b, f32x4 c) { return __builtin_amdgcn_mfma_f32_16x16x32_bf16(a, b, c, 0, 0, 0); }
DI f32x16 mfma32(bf16x8 a, bf16x8 b, f32x16 c) { return __builtin_amdgcn_mfma_f32_32x32x16_bf16(a, b, c, 0, 0, 0); }
DI int crow(int i, int hh) { return (i & 3) + 8 * (i >> 2) + 4 * hh; }
DI float sigmoidf_(float x) { return 1.f / (1.f + __expf(-x)); }
DI float siluf_(float x) { return x / (1.f + __expf(-x)); }
DI u32 lane_lt_cnt(u64 m) { return __builtin_amdgcn_mbcnt_hi((u32)(m >> 32), __builtin_amdgcn_mbcnt_lo((u32)m, 0)); }

DI bf16x8 pack8(const f32x16& x, int s) {
  u32 p0, p1, p2, p3;
  if (s == 0) {
    asm volatile("v_cvt_pk_bf16_f32 %0, %4, %5\n\tv_cvt_pk_bf16_f32 %1, %6, %7\n\tv_cvt_pk_bf16_f32 %2, %8, %9\n\tv_cvt_pk_bf16_f32 %3, %10, %11\n\ts_nop 1"
                 : "=&v"(p0), "=&v"(p1), "=&v"(p2), "=&v"(p3)
                 : "v"(x[0]), "v"(x[1]), "v"(x[2]), "v"(x[3]), "v"(x[4]), "v"(x[5]), "v"(x[6]), "v"(x[7]));
  } else {
    asm volatile("v_cvt_pk_bf16_f32 %0, %4, %5\n\tv_cvt_pk_bf16_f32 %1, %6, %7\n\tv_cvt_pk_bf16_f32 %2, %8, %9\n\tv_cvt_pk_bf16_f32 %3, %10, %11\n\ts_nop 1"
                 : "=&v"(p0), "=&v"(p1), "=&v"(p2), "=&v"(p3)
                 : "v"(x[8]), "v"(x[9]), "v"(x[10]), "v"(x[11]), "v"(x[12]), "v"(x[13]), "v"(x[14]), "v"(x[15]));
  }
  typedef u32 u32x4 __attribute__((ext_vector_type(4)));
  u32x4 v = {p0, p1, p2, p3};
  return __builtin_bit_cast(bf16x8, v);
}
DI bf16x8 afrag_perm(const char* base, int row, int stride, int kbase, int hh) {
  const char* pr = base + row * stride + (kbase + 4 * hh) * 2;
  s16x4 lo = *(const s16x4*)pr;
  s16x4 hi = *(const s16x4*)(pr + 16);
  return __builtin_shufflevector(lo, hi, 0, 1, 2, 3, 4, 5, 6, 7);
}
DI bf16x8 trfrag(const char* img, int stride, int krow0, int col0, int ln) {
  const int hh = ln >> 5, chalf = (ln >> 4) & 1, q4 = (ln & 15) >> 2, p4 = ln & 3;
  u32 a = (u32)(size_t)(img + (krow0 + 4 * hh + q4) * stride + (col0 + 16 * chalf + 4 * p4) * 2);
  s16x4 lo, hi;
  asm volatile("ds_read_b64_tr_b16 %0, %2\n\tds_read_b64_tr_b16 %1, %3\n\ts_waitcnt lgkmcnt(0)"
               : "=&v"(lo), "=&v"(hi) : "v"(a), "v"(a + 8 * stride) : "memory");
  return __builtin_shufflevector(lo, hi, 0, 1, 2, 3, 4, 5, 6, 7);
}

template <int MT>
DI void gemm_core(const u16* __restrict__ A, int lda, const u16* __restrict__ B, int ldb, int K,
                  f32x4 (&acc)[MT][4], char* smem) {
  constexpr int BM = 32 * MT;
  constexpr int ASZ = BM * 144, BSZ = 128 * 144, BUF = ASZ + BSZ;
  const int tid = ltid(), l = tid & 63, w = tid >> 6, wm = w >> 1, wn = w & 1;
  const int fr = l & 15, fq = l >> 4;
  uint4 ra[MT], rb[4];
  const int nk = K >> 6;
  const int srow = tid >> 3, sch = tid & 7;
#define GLOAD(kt)                                                                                          \
  {                                                                                                        \
    _Pragma("unroll") for (int i = 0; i < MT; ++i)                                                         \
        ra[i] = *(const uint4*)(A + (size_t)(srow + 32 * i) * lda + (kt) * 64 + sch * 8);                  \
    _Pragma("unroll") for (int i = 0; i < 4; ++i)                                                          \
        rb[i] = *(const uint4*)(B + (size_t)(srow + 32 * i) * ldb + (kt) * 64 + sch * 8);                  \
  }
#define SSTORE(buf)                                                                                        \
  {                                                                                                        \
    char* as_ = smem + (buf) * BUF;                                                                        \
    char* bs_ = as_ + ASZ;                                                                                 \
    _Pragma("unroll") for (int i = 0; i < MT; ++i) *(uint4*)(as_ + (srow + 32 * i) * 144 + sch * 16) = ra[i]; \
    _Pragma("unroll") for (int i = 0; i < 4; ++i) *(uint4*)(bs_ + (srow + 32 * i) * 144 + sch * 16) = rb[i];  \
  }
  GLOAD(0);
  SSTORE(0);
  __syncthreads();
  for (int kt = 0; kt < nk; ++kt) {
    if (kt + 1 < nk) GLOAD(kt + 1);
    const char* as = smem + (kt & 1) * BUF;
    const char* bs = as + ASZ;
#pragma unroll
    for (int kk = 0; kk < 2; ++kk) {
      bf16x8 xf[MT], wf[4];
#pragma unroll
      for (int mi = 0; mi < MT; ++mi)
        xf[mi] = *(const bf16x8*)(as + (wm * (MT * 16) + mi * 16 + fr) * 144 + (kk * 32 + fq * 8) * 2);
#pragma unroll
      for (int ni = 0; ni < 4; ++ni)
        wf[ni] = *(const bf16x8*)(bs + (wn * 64 + ni * 16 + fr) * 144 + (kk * 32 + fq * 8) * 2);
#pragma unroll
      for (int mi = 0; mi < MT; ++mi)
#pragma unroll
        for (int ni = 0; ni < 4; ++ni) acc[mi][ni] = mfma16(wf[ni], xf[mi], acc[mi][ni]);
    }
    if (kt + 1 < nk) SSTORE((kt + 1) & 1);
    __syncthreads();
  }
#undef GLOAD
#undef SSTORE
}
template <int MT>
DI void zero_acc(f32x4 (&acc)[MT][4]) {
#pragma unroll
  for (int i = 0; i < MT; ++i)
#pragma unroll
    for (int j = 0; j < 4; ++j) acc[i][j] = f32x4{0.f, 0.f, 0.f, 0.f};
}

DI void transpose_job(const float* __restrict__ src, int K, int N, u16* __restrict__ dst, const float* kscale, char* smem) {
  float(*tile)[65] = (float(*)[65])smem;
  const int ntn = (N + 63) >> 6, ntk = K >> 6, tid = ltid();
  for (int t = lbid(); t < ntn * ntk; t += lgdim()) {
    const int tk = t / ntn, tn = t % ntn, k0 = tk * 64, n0 = tn * 64;
    {
      const int n = tid & 63, kb = tid >> 6;
      for (int i = 0; i < 16; ++i) {
        const int k = kb + 4 * i;
        float v = (n0 + n < N) ? src[(size_t)(k0 + k) * N + n0 + n] : 0.f;
        if (kscale) v *= kscale[k0 + k];
        tile[k][n] = v;
      }
    }
    __syncthreads();
    {
      const int k = tid & 63, nb = tid >> 6;
      for (int i = 0; i < 16; ++i) {
        const int n = nb + 4 * i;
        if (n0 + n < N) dst[(size_t)(n0 + n) * K + k0 + k] = f2bf(tile[k][n]);
      }
    }
    __syncthreads();
  }
}

DI void phase0(const Params& p, char* smem) {
  const size_t gtid = (size_t)lbid() * 256 + ltid(), gsz = (size_t)lgdim() * 256;
  for (int l = 0; l < 2; ++l) {
    transpose_job(p.w_in + (size_t)l * 1024 * 7120, 1024, 7120, p.win(l), nullptr, smem);
    transpose_job(p.w_branch_a + (size_t)l * 512 * 1024, 512, 1024, p.wbra(l), nullptr, smem);
    transpose_job(p.w_branch_b + (size_t)l * 512 * 1024, 512, 1024, p.wbrb(l), nullptr, smem);
    transpose_job(p.w_o + (size_t)l * 1024 * 1024, 1024, 1024, p.wo(l), nullptr, smem);
    transpose_job(p.w_ff1 + (size_t)l * 1024 * 4096, 1024, 4096, p.wf1(l), nullptr, smem);
    transpose_job(p.w_ff2 + (size_t)l * 4096 * 1024, 4096, 1024, p.wf2(l), nullptr, smem);
    transpose_job(p.c_w_qidx + (size_t)l * 256 * 512, 256, 512, p.wqx(l) + 1024 * 256, p.c_q_norm_g + l * 256, smem);
    {
      const float* uq = p.c_w_uq + (size_t)l * 256 * 512;
      const float* uk = p.c_w_uk + (size_t)l * 128 * 512;
      const float* g = p.c_q_norm_g + l * 256;
      for (size_t e = gtid; e < 1024 * 256; e += gsz) {
        const int n = (int)(e >> 8), k = (int)(e & 255), h = n >> 7, r2 = n & 127;
        const float4* a = (const float4*)(uq + (k * 8 + h) * 64);
        const float4* b = (const float4*)(uk + (r2 * 8 + h) * 64);
        float s = 0.f;
        for (int d = 0; d < 16; ++d) { float4 x = a[d], y = b[d]; s += x.x * y.x + x.y * y.y + x.z * y.z + x.w * y.w; }
        p.wqx(l)[e] = f2bf(s * g[k]);
      }
    }
    {
      const float* uv = p.c_w_uv + (size_t)l * 128 * 512;
      const float* bc = p.w_branch_c + (size_t)l * 512 * 1024;
      for (size_t e = gtid; e < 1024 * 1024; e += gsz) {
        const int k = (int)(e >> 10), n = (int)(e & 1023), h = k >> 7, r = k & 127;
        const float* a = uv + (r * 8 + h) * 64;
        const float* b = bc + (size_t)(h * 64) * 1024 + n;
        float s = 0.f;
        for (int d = 0; d < 64; ++d) s += a[d] * b[(size_t)d * 1024];
        p.wbrc(l)[(size_t)n * 1024 + k] = f2bf(s);
      }
    }
  }
  for (size_t e = gtid; e < (size_t)NT * 1024 / 8; e += gsz) {
    const float4 a = ((const float4*)p.x)[2 * e], b = ((const float4*)p.x)[2 * e + 1];
    uint4 o;
    o.x = pack2(a.x, a.y); o.y = pack2(a.z, a.w); o.z = pack2(b.x, b.y); o.w = pack2(b.z, b.w);
    ((uint4*)p.XB())[e] = o;
  }
  if (gtid < 2) {
    const int l = (int)gtid;
    const float* lp = p.a_lambda + l * 256;
    float s1 = 0.f, s2 = 0.f;
    for (int i = 0; i < 64; ++i) { s1 += lp[i] * lp[64 + i]; s2 += lp[128 + i] * lp[192 + i]; }
    const float lam_init = 0.8f - 0.6f * expf(-0.3f * l);
    p.LAM()[l] = expf(s1) - expf(s2) + lam_init;
    p.LAM()[2 + l] = lam_init;
    p.CNT()[l] = 0;
  }
}

DI void ln_phase(const float* S, const float* __restrict__ g, const float* __restrict__ b, u16* XBo, float* fout) {
  const int l = ltid() & 63;
  const int wave = lbid() * 4 + (ltid() >> 6), nw = lgdim() * 4;
  for (int row = wave; row < NT; row += nw) {
    float4 v[4];
    float s = 0.f;
#pragma unroll
    for (int i = 0; i < 4; ++i) { v[i] = *(const float4*)(S + (size_t)row * 1024 + i * 256 + l * 4); s += v[i].x + v[i].y + v[i].z + v[i].w; }
#pragma unroll
    for (int o = 32; o; o >>= 1) s += __shfl_xor(s, o);
    const float mu = s * (1.f / 1024.f);
    float q = 0.f;
#pragma unroll
    for (int i = 0; i < 4; ++i) { float a = v[i].x - mu, bb = v[i].y - mu, c = v[i].z - mu, d = v[i].w - mu; q += a * a + bb * bb + c * c + d * d; }
#pragma unroll
    for (int o = 32; o; o >>= 1) q += __shfl_xor(q, o);
    const float rs = rsqrtf(q * (1.f / 1024.f) + EPS);
#pragma unroll
    for (int i = 0; i < 4; ++i) {
      const int c = i * 256 + l * 4;
      const float4 gg = *(const float4*)(g + c), bb = *(const float4*)(b + c);
      float4 y;
      y.x = (v[i].x - mu) * rs * gg.x + bb.x; y.y = (v[i].y - mu) * rs * gg.y + bb.y;
      y.z = (v[i].z - mu) * rs * gg.z + bb.z; y.w = (v[i].w - mu) * rs * gg.w + bb.w;
      if (fout) *(float4*)(fout + (size_t)row * 1024 + c) = y;
      if (XBo) { uint2 o; o.x = pack2(y.x, y.y); o.y = pack2(y.z, y.w); *(uint2*)(XBo + (size_t)row * 1024 + c) = o; }
    }
  }
}

#define EPI_LOOP(MT_)                                                     \
  const int l_ = ltid() & 63, w_ = ltid() >> 6;                 \
  const int wm_ = w_ >> 1, wn_ = w_ & 1, fr_ = l_ & 15, fq_ = l_ >> 4;    \
  _Pragma("unroll") for (int mi = 0; mi < MT_; ++mi)                      \
  _Pragma("unroll") for (int ni = 0; ni < 4; ++ni)

DI void phase_inproj(const Params& p, int l, char* smem) {
  for (int t = lbid(); t < 256 * 32; t += lgdim()) {
    const int rt = t >> 5, ct = t & 31, r0 = rt * 128, c0 = ct * 128;
    f32x4 acc[4][4];
    zero_acc<4>(acc);
    gemm_core<4>(p.XB() + (size_t)r0 * 1024, 1024, p.win(l) + (size_t)c0 * 1024, 1024, 1024, acc, smem);
    EPI_LOOP(4) {
      const int row = r0 + wm_ * 64 + mi * 16 + fr_, col = c0 + wn_ * 64 + ni * 16 + fq_ * 4;
      if (col < PC) {
        uint2 o;
        o.x = pack2(acc[mi][ni][0], acc[mi][ni][1]); o.y = pack2(acc[mi][ni][2], acc[mi][ni][3]);
        *(uint2*)(p.P() + (size_t)row * PC + col) = o;
        if (col >= BQ && col < BZ && (row & 63) >= 61)
          *(uint2*)(p.HALO() + ((size_t)(row >> 6) * 3 + ((row & 63) - 61)) * 1536 + (col - BQ)) = o;
      }
    }
  }
}

DI void qx_tile(const Params& p, int l, int t, char* smem) {
  const int rt = t / 12, ct = t % 12, r0 = rt * 128, c0 = ct * 128;
  float* rsv = (float*)(smem + 73728);
  {
    const int row = ltid() >> 1, half = ltid() & 1;
    const uint4* src = (const uint4*)(p.P() + (size_t)(r0 + row) * PC + CQ + half * 128);
    float ss = 0.f;
    for (int i = 0; i < 16; ++i) {
      uint4 v = src[i];
      float a;
      a = bflo(v.x); ss += a * a; a = bfhi(v.x); ss += a * a; a = bflo(v.y); ss += a * a; a = bfhi(v.y); ss += a * a;
      a = bflo(v.z); ss += a * a; a = bfhi(v.z); ss += a * a; a = bflo(v.w); ss += a * a; a = bfhi(v.w); ss += a * a;
    }
    ss += __shfl_xor(ss, 1);
    if (!half) rsv[row] = rsqrtf(ss * (1.f / 256.f) + EPS);
  }
  f32x4 acc[4][4];
  zero_acc<4>(acc);
  gemm_core<4>(p.P() + (size_t)r0 * PC + CQ, PC, p.wqx(l) + (size_t)c0 * 256, 256, 256, acc, smem);
  u16* QX = (u16*)p.out;
  EPI_LOOP(4) {
    const int rl = wm_ * 64 + mi * 16 + fr_, col = c0 + wn_ * 64 + ni * 16 + fq_ * 4;
    const float rs = rsv[rl];
    uint2 o;
    o.x = pack2(acc[mi][ni][0] * rs, acc[mi][ni][1] * rs); o.y = pack2(acc[mi][ni][2] * rs, acc[mi][ni][3] * rs);
    *(uint2*)(QX + (size_t)(r0 + rl) * 1536 + col) = o;
  }
  __syncthreads();
}

DI void phase_merge(const Params& p, int l, char* smem) {
  const u16* QX = (const u16*)p.out;
  for (int t = lbid(); t < 512 * 8; t += lgdim()) {
    const int rt = t >> 3, ct = t & 7, r0 = rt * 64, c0 = ct * 128;
    f32x4 mg[2][4];
    zero_acc<2>(mg);
#pragma unroll 1
    for (int j = 0; j < 3; ++j) {
      if ((j == 0 && !EN_A) || (j == 1 && !EN_B) || (j == 2 && !EN_C)) continue;
      const u16* Ab; const u16* Wb; int lda, K;
      if (j == 0) { Ab = p.P() + (size_t)r0 * PC + AQ; lda = PC; Wb = p.wbra(l) + (size_t)c0 * 512; K = 512; }
      else if (j == 1) { Ab = p.P() + (size_t)r0 * PC + BZ; lda = PC; Wb = p.wbrb(l) + (size_t)c0 * 512; K = 512; }
      else { Ab = QX + (size_t)r0 * 1536; lda = 1536; Wb = p.wbrc(l) + (size_t)c0 * 1024; K = 1024; }
      f32x4 g[2][4];
      zero_acc<2>(g);
      gemm_core<2>(p.XB() + (size_t)r0 * 1024, 1024, p.win(l) + (size_t)(GATES + j * 1024 + c0) * 1024, 1024, 1024, g, smem);
      const float* bg = p.b_gate + l * 3072 + j * 1024;
      {
        EPI_LOOP(2) {
          const int col = c0 + wn_ * 64 + ni * 16 + fq_ * 4;
          const float4 bb = *(const float4*)(bg + col);
          g[mi][ni][0] = sigmoidf_(g[mi][ni][0] + bb.x);
          g[mi][ni][1] = sigmoidf_(g[mi][ni][1] + bb.y);
          g[mi][ni][2] = sigmoidf_(g[mi][ni][2] + bb.z);
          g[mi][ni][3] = sigmoidf_(g[mi][ni][3] + bb.w);
        }
      }
      f32x4 br[2][4];
      zero_acc<2>(br);
      gemm_core<2>(Ab, lda, Wb, K, K, br, smem);
#pragma unroll
      for (int mi = 0; mi < 2; ++mi)
#pragma unroll
        for (int ni = 0; ni < 4; ++ni) mg[mi][ni] += g[mi][ni] * br[mi][ni];
    }
    EPI_LOOP(2) {
      const int row = r0 + wm_ * 32 + mi * 16 + fr_, col = c0 + wn_ * 64 + ni * 16 + fq_ * 4;
      uint2 o;
      o.x = pack2(mg[mi][ni][0], mg[mi][ni][1]); o.y = pack2(mg[mi][ni][2], mg[mi][ni][3]);
      *(uint2*)(p.MERGED() + (size_t)row * 1024 + col) = o;
    }
  }
}

DI void phase_resgemm(const Params& p, const u16* A, int lda, const u16* W, int K, char* smem) {
  for (int t = lbid(); t < 256 * 8; t += lgdim()) {
    const int rt = t >> 3, ct = t & 7, r0 = rt * 128, c0 = ct * 128;
    f32x4 acc[4][4];
    zero_acc<4>(acc);
    gemm_core<4>(A + (size_t)r0 * lda, lda, W + (size_t)c0 * K, K, K, acc, smem);
    EPI_LOOP(4) {
      const int row = r0 + wm_ * 64 + mi * 16 + fr_, col = c0 + wn_ * 64 + ni * 16 + fq_ * 4;
      const uint2 xb = *(const uint2*)(p.XB() + (size_t)row * 1024 + col);
      float4 o;
      o.x = DN_ALPHA * bflo(xb.x) + acc[mi][ni][0]; o.y = DN_ALPHA * bfhi(xb.x) + acc[mi][ni][1];
      o.z = DN_ALPHA * bflo(xb.y) + acc[mi][ni][2]; o.w = DN_ALPHA * bfhi(xb.y) + acc[mi][ni][3];
      *(float4*)(p.out + (size_t)row * 1024 + col) = o;
    }
  }
}

DI void phase_ff1(const Params& p, int l, char* smem) {
  for (int t = lbid(); t < 256 * 32; t += lgdim()) {
    const int rt = t >> 5, ct = t & 31, r0 = rt * 128, c0 = ct * 128;
    f32x4 acc[4][4];
    zero_acc<4>(acc);
    gemm_core<4>(p.XB() + (size_t)r0 * 1024, 1024, p.wf1(l) + (size_t)c0 * 1024, 1024, 1024, acc, smem);
    EPI_LOOP(4) {
      const int row = r0 + wm_ * 64 + mi * 16 + fr_, col = c0 + wn_ * 64 + ni * 16 + fq_ * 4;
      float a0 = fmaxf(acc[mi][ni][0], 0.f), a1 = fmaxf(acc[mi][ni][1], 0.f), a2 = fmaxf(acc[mi][ni][2], 0.f), a3 = fmaxf(acc[mi][ni][3], 0.f);
      uint2 o;
      o.x = pack2(a0 * a0, a1 * a1); o.y = pack2(a2 * a2, a3 * a3);
      *(uint2*)(p.P() + (size_t)row * 4096 + col) = o;
    }
  }
}

DI void dsa_kprep_item(const Params& p, int l, int it) {
  const int ln = ltid() & 63, w = ltid() >> 6;
  const float g0 = p.c_kv_norm_g[l * 128 + 2 * ln], g1 = p.c_kv_norm_g[l * 128 + 2 * ln + 1];
  const float kg = p.c_kidx_g[l * 64 + ln], kb = p.c_kidx_b[l * 64 + ln];
  for (int i = 0; i < 16; ++i) {
    const size_t tok = (size_t)it * 64 + w * 16 + i;
    const u16* pr = p.P() + tok * PC;
    const u32 v = *(const u32*)(pr + CKVc + 2 * ln);
    const float a = bflo(v), b = bfhi(v);
    float ss = a * a + b * b;
#pragma unroll
    for (int o = 32; o; o >>= 1) ss += __shfl_xor(ss, o);
    const float rs = rsqrtf(ss * (1.f / 128.f) + EPS);
    *(u32*)(p.CKV() + tok * 128 + 2 * ln) = pack2(a * rs * g0, b * rs * g1);
    const float k = bf2f(pr[CKI + ln]);
    float s = k;
#pragma unroll
    for (int o = 32; o; o >>= 1) s += __shfl_xor(s, o);
    const float mu = s * (1.f / 64.f);
    float q = (k - mu) * (k - mu);
#pragma unroll
    for (int o = 32; o; o >>= 1) q += __shfl_xor(q, o);
    p.KIDX()[tok * 64 + ln] = f2bf((k - mu) * rsqrtf(q * (1.f / 64.f) + EPS) * kg + kb);
    if (ln < 8) p.WIDX()[tok * 8 + ln] = bf2f(pr[CWI + ln]) * 0.04419417382f;
  }
}

DI void gdn_prep_item(const Params& p, int l, int it, char* smem) {
  const int cidx = it >> 2, h = it & 3, n = cidx & 255;
  const size_t t0g = (size_t)cidx * 64;
  const int tid = ltid(), ln = tid & 63, w = tid >> 6;
  char* qs = smem;
  char* ks = smem + 17408;
  char* vs = smem + 2 * 17408;
  float* Lm = (float*)(smem + 3 * 17408);
  float* gcs = Lm + 4096;
  float* bts = gcs + 64;
  float* egs = bts + 64;
  u16* proj = p.P();
  {
    const int c = tid & 127, rh = tid >> 7;
#pragma unroll
    for (int part = 0; part < 3; ++part) {
      const int colg = BQ + part * 512 + h * 128 + c, wch = part * 512 + h * 128 + c;
      const float* cw = p.b_conv_w + (size_t)l * 4 * 1536 + wch;
      const float w0 = cw[0], w1 = cw[1536], w2 = cw[2 * 1536], w3 = cw[3 * 1536];
      float xm3, xm2, xm1;
      if (rh == 0) {
        if (n == 0) { xm3 = xm2 = xm1 = 0.f; }
        else {
          const u16* hp = p.HALO() + ((size_t)(cidx - 1) * 3) * 1536 + (colg - BQ);
          xm3 = bf2f(hp[0]); xm2 = bf2f(hp[1536]); xm1 = bf2f(hp[2 * 1536]);
        }
      } else {
        xm3 = bf2f(proj[(t0g + 29) * PC + colg]); xm2 = bf2f(proj[(t0g + 30) * PC + colg]); xm1 = bf2f(proj[(t0g + 31) * PC + colg]);
      }
      char* dst = (part == 0 ? qs : (part == 1 ? ks : vs));
      for (int i = 0; i < 32; ++i) {
        const int r = rh * 32 + i;
        const float x = bf2f(proj[(t0g + r) * PC + colg]);
        const float y = w0 * xm3 + w1 * xm2 + w2 * xm1 + w3 * x;
        xm3 = xm2; xm2 = xm1; xm1 = x;
        *(u16*)(dst + r * 272 + c * 2) = f2bf(siluf_(y));
      }
    }
  }
  if (w == 0) {
    const float a = bf2f(proj[(t0g + ln) * PC + BA + h]) + p.b_dt_bias[l * 4 + h];
    const float sp = (a > 20.f) ? a : log1pf(__expf(a));
    float g = -__expf(p.b_a_log[l * 4 + h]) * sp;
#pragma unroll
    for (int o = 1; o < 64; o <<= 1) { float t = __shfl_up(g, o); if (ln >= o) g += t; }
    gcs[ln] = g;
    egs[ln] = __expf(g);
    bts[ln] = sigmoidf_(bf2f(proj[(t0g + ln) * PC + BB + h]));
  }
  __syncthreads();
  {
    const int row = tid >> 2, qr = tid & 3;
#pragma unroll
    for (int part = 0; part < 2; ++part) {
      char* base = (part == 0 ? qs : ks) + row * 272 + qr * 64;
      uint4 v[4];
      float ss = 0.f;
#pragma unroll
      for (int i = 0; i < 4; ++i) {
        v[i] = *(uint4*)(base + i * 16);
        float a;
        a = bflo(v[i].x); ss += a * a; a = bfhi(v[i].x); ss += a * a; a = bflo(v[i].y); ss += a * a; a = bfhi(v[i].y); ss += a * a;
        a = bflo(v[i].z); ss += a * a; a = bfhi(v[i].z); ss += a * a; a = bflo(v[i].w); ss += a * a; a = bfhi(v[i].w); ss += a * a;
      }
      ss += __shfl_xor(ss, 1);
      ss += __shfl_xor(ss, 2);
      const float rs = rsqrtf(ss + EPS) * (part == 0 ? 0.08838834764f : 1.f);
#pragma unroll
      for (int i = 0; i < 4; ++i) {
        uint4 o;
        o.x = pack2(bflo(v[i].x) * rs, bfhi(v[i].x) * rs); o.y = pack2(bflo(v[i].y) * rs, bfhi(v[i].y) * rs);
        o.z = pack2(bflo(v[i].z) * rs, bfhi(v[i].z) * rs); o.w = pack2(bflo(v[i].w) * rs, bfhi(v[i].w) * rs);
        *(uint4*)(base + i * 16) = o;
      }
    }
  }
  __syncthreads();
  {
    const int fr = ln & 15, fq = ln >> 4;
    f32x4 kk[4], qk[4];
#pragma unroll
    for (int nt = 0; nt < 4; ++nt) { kk[nt] = f32x4{0, 0, 0, 0}; qk[nt] = f32x4{0, 0, 0, 0}; }
#pragma unroll
    for (int s = 0; s < 4; ++s) {
      const bf16x8 ak = *(const bf16x8*)(ks + (16 * w + fr) * 272 + (32 * s + 8 * fq) * 2);
      const bf16x8 aq = *(const bf16x8*)(qs + (16 * w + fr) * 272 + (32 * s + 8 * fq) * 2);
#pragma unroll
      for (int nt = 0; nt < 4; ++nt) {
        const bf16x8 bk = *(const bf16x8*)(ks + (16 * nt + fr) * 272 + (32 * s + 8 * fq) * 2);
        kk[nt] = mfma16(ak, bk, kk[nt]);
        qk[nt] = mfma16(aq, bk, qk[nt]);
      }
    }
#pragma unroll
    for (int nt = 0; nt < 4; ++nt)
#pragma unroll
      for (int jj = 0; jj < 4; ++jj) {
        const int i = 16 * w + 4 * fq + jj, j = 16 * nt + fr;
        const float dec = (i >= j) ? __expf(gcs[i] - gcs[j]) : 0.f;
        Lm[i * 64 + j] = (i > j) ? bts[i] * kk[nt][jj] * dec : 0.f;
        p.ATT()[(t0g + i) * 256 + h * 64 + j] = f2bf((i >= j) ? qk[nt][jj] * dec : 0.f);
      }
  }
  __syncthreads();
  {
    const int c = tid;
    const bool isu = c < 128;
    const char* src = isu ? (vs + c * 2) : (ks + (c - 128) * 2);
    float x[64];
#pragma unroll
    for (int i = 0; i < 64; ++i) {
      float a = bf2f(*(const u16*)(src + i * 272)) * bts[i] * (isu ? 1.f : egs[i]);
      const float* Lr = Lm + i * 64;
#pragma unroll
      for (int j = 0; j < i; ++j) a -= Lr[j] * x[j];
      x[i] = a;
    }
    if (isu) {
      u32 pk[32];
#pragma unroll
      for (int pos = 0; pos < 64; pos += 2) {
        const int hh = pos >> 5, Tt = (pos >> 4) & 1, ii = pos & 15;
        const int r0 = 32 * Tt + (ii & 3) + 8 * (ii >> 2) + 4 * hh;
        const int i1 = ii + 1;
        const int r1 = 32 * Tt + (i1 & 3) + 8 * (i1 >> 2) + 4 * hh;
        pk[pos >> 1] = pack2(x[r0], x[r1]);
      }
      char* dst = (char*)proj + ((t0g + (c >> 1)) * PC + BV + h * 128) * 2 + (c & 1) * 128;
#pragma unroll
      for (int i = 0; i < 8; ++i) *(uint4*)(dst + i * 16) = uint4{pk[4 * i], pk[4 * i + 1], pk[4 * i + 2], pk[4 * i + 3]};
    } else {
#pragma unroll
      for (int i = 0; i < 64; ++i) proj[(t0g + i) * PC + BK_ + h * 128 + (c - 128)] = f2bf(x[i]);
    }
  }
  {
    const float glast = gcs[63];
#pragma unroll
    for (int i = 0; i < 4; ++i) {
      const int piece = tid + 256 * i, row = piece >> 4, ch = piece & 15;
      const uint4 v = *(const uint4*)(qs + row * 272 + ch * 16);
      const float e = egs[row];
      uint4 o;
      o.x = pack2(bflo(v.x) * e, bfhi(v.x) * e); o.y = pack2(bflo(v.y) * e, bfhi(v.y) * e);
      o.z = pack2(bflo(v.z) * e, bfhi(v.z) * e); o.w = pack2(bflo(v.w) * e, bfhi(v.w) * e);
      *(uint4*)(proj + (t0g + row) * PC + BQ + h * 128 + ch * 8) = o;
    }
    const int d = tid & 127, half = tid >> 7;
    u32 pk[16];
#pragma unroll
    for (int i = 0; i < 16; ++i) {
      const int r0 = half * 32 + 2 * i;
      const float a = bf2f(*(const u16*)(ks + r0 * 272 + d * 2)) * __expf(glast - gcs[r0]);
      const float b = bf2f(*(const u16*)(ks + (r0 + 1) * 272 + d * 2)) * __expf(glast - gcs[r0 + 1]);
      pk[i] = pack2(a, b);
    }
    u16* dst = p.KDT() + (((size_t)cidx * 4 + h) * 128 + d) * 64 + half * 32;
#pragma unroll
    for (int i = 0; i < 4; ++i) *(uint4*)(dst + i * 8) = uint4{pk[4 * i], pk[4 * i + 1], pk[4 * i + 2], pk[4 * i + 3]};
    if (tid == 0) p.GL()[cidx * 4 + h] = egs[63];
  }
  __syncthreads();
}

DI void gdn_rec_item(const Params& p, int l, int bh, char* smem) {
  const int b = bh >> 2, h = bh & 3;
  const int tid = ltid(), ln = tid & 63, w = tid >> 6, hh = ln >> 5, c31 = ln & 31;
  char* Wm = smem;
  char* Qd = smem + 16896;
  char* Kt = smem + 2 * 16896;
  char* At = Kt + 17408;
  float* Ot = (float*)smem;
  u16* proj = p.P();
  f32x16 S[4];
#pragma unroll
  for (int i = 0; i < 4; ++i)
#pragma unroll
    for (int j = 0; j < 16; ++j) S[i][j] = 0.f;
  const int e = 32 * w + c31;
  const float* ng = p.b_norm_g + l * 128;
  for (int n = 0; n < 256; ++n) {
    const int cidx = b * 256 + n;
    const size_t t0g = (size_t)cidx * 64;
    __syncthreads();
#pragma unroll
    for (int i = 0; i < 4; ++i) {
      const int piece = tid + 256 * i, row = piece >> 4, ch = piece & 15;
      const uint4 a = *(const uint4*)(proj + (t0g + row) * PC + BK_ + h * 128 + ch * 8);
      const uint4 q = *(const uint4*)(proj + (t0g + row) * PC + BQ + h * 128 + ch * 8);
      *(uint2*)(Wm + row * 264 + ch * 16) = uint2{a.x, a.y}; *(uint2*)(Wm + row * 264 + ch * 16 + 8) = uint2{a.z, a.w};
      *(uint2*)(Qd + row * 264 + ch * 16) = uint2{q.x, q.y}; *(uint2*)(Qd + row * 264 + ch * 16 + 8) = uint2{q.z, q.w};
      const int row2 = piece >> 3, ch2 = piece & 7;
      const uint4 k = *(const uint4*)(p.KDT() + (((size_t)cidx * 4 + h) * 128 + row2) * 64 + ch2 * 8);
      *(uint2*)(Kt + row2 * 136 + ch2 * 16) = uint2{k.x, k.y}; *(uint2*)(Kt + row2 * 136 + ch2 * 16 + 8) = uint2{k.z, k.w};
    }
#pragma unroll
    for (int i = 0; i < 2; ++i) {
      const int piece = tid + 256 * i, row = piece >> 3, ch = piece & 7;
      const uint4 a = *(const uint4*)(p.ATT() + (t0g + row) * 256 + h * 64 + ch * 8);
      *(uint2*)(At + row * 136 + ch * 16) = uint2{a.x, a.y}; *(uint2*)(At + row * 136 + ch * 16 + 8) = uint2{a.z, a.w};
    }
    f32x16 vn[2];
    {
      const uint4* up = (const uint4*)((const char*)proj + ((t0g + (e >> 1)) * PC + BV + h * 128) * 2 + (e & 1) * 128 + hh * 64);
#pragma unroll
      for (int i = 0; i < 4; ++i) {
        const uint4 u = up[i];
        const int Tt = i >> 1, o = (i & 1) * 8;
        vn[Tt][o + 0] = bflo(u.x); vn[Tt][o + 1] = bfhi(u.x); vn[Tt][o + 2] = bflo(u.y); vn[Tt][o + 3] = bfhi(u.y);
        vn[Tt][o + 4] = bflo(u.z); vn[Tt][o + 5] = bfhi(u.z); vn[Tt][o + 6] = bflo(u.w); vn[Tt][o + 7] = bfhi(u.w);
      }
    }
    const float gl = p.GL()[cidx * 4 + h];
    __syncthreads();
    bf16x8 sp[4][2];
#pragma unroll
    for (int Tt = 0; Tt < 4; ++Tt) { sp[Tt][0] = pack8(S[Tt], 0); sp[Tt][1] = pack8(S[Tt], 1); }
    f32x16 ws[2], o[2];
#pragma unroll
    for (int i = 0; i < 2; ++i)
#pragma unroll
      for (int j = 0; j < 16; ++j) { ws[i][j] = 0.f; o[i][j] = 0.f; }
#pragma unroll
    for (int Tt = 0; Tt < 4; ++Tt)
#pragma unroll
      for (int s = 0; s < 2; ++s) {
        const int kb = 32 * Tt + 16 * s;
#pragma unroll
        for (int Tc = 0; Tc < 2; ++Tc) {
          ws[Tc] = mfma32(afrag_perm(Wm, 32 * Tc + c31, 264, kb, hh), sp[Tt][s], ws[Tc]);
          o[Tc] = mfma32(afrag_perm(Qd, 32 * Tc + c31, 264, kb, hh), sp[Tt][s], o[Tc]);
        }
      }
#pragma unroll
    for (int Tc = 0; Tc < 2; ++Tc)
#pragma unroll
      for (int j = 0; j < 16; ++j) vn[Tc][j] -= ws[Tc][j];
    bf16x8 vp[2][2];
#pragma unroll
    for (int Tc = 0; Tc < 2; ++Tc) { vp[Tc][0] = pack8(vn[Tc], 0); vp[Tc][1] = pack8(vn[Tc], 1); }
#pragma unroll
    for (int s = 0; s < 2; ++s) {
      o[0] = mfma32(afrag_perm(At, c31, 136, 16 * s, hh), vp[0][s], o[0]);
      o[1] = mfma32(afrag_perm(At, 32 + c31, 136, 16 * s, hh), vp[0][s], o[1]);
      o[1] = mfma32(afrag_perm(At, 32 + c31, 136, 32 + 16 * s, hh), vp[1][s], o[1]);
    }
#pragma unroll
    for (int Tt = 0; Tt < 4; ++Tt)
#pragma unroll
      for (int j = 0; j < 16; ++j) S[Tt][j] *= gl;
#pragma unroll
    for (int Tc = 0; Tc < 2; ++Tc)
#pragma unroll
      for (int s = 0; s < 2; ++s)
#pragma unroll
        for (int Tt = 0; Tt < 4; ++Tt)
          S[Tt] = mfma32(afrag_perm(Kt, 32 * Tt + c31, 136, 32 * Tc + 16 * s, hh), vp[Tc][s], S[Tt]);
    __syncthreads();
#pragma unroll
    for (int Tc = 0; Tc < 2; ++Tc)
#pragma unroll
      for (int j = 0; j < 16; ++j) Ot[(32 * Tc + crow(j, hh)) * 132 + e] = o[Tc][j];
    __syncthreads();
    {
      const int row = tid >> 2, qr = tid & 3;
      const float* orow = Ot + row * 132 + qr * 32;
      float ov[32];
      float ss = 0.f;
#pragma unroll
      for (int i = 0; i < 8; ++i) {
        const float4 v = *(const float4*)(orow + 4 * i);
        ov[4 * i] = v.x; ov[4 * i + 1] = v.y; ov[4 * i + 2] = v.z; ov[4 * i + 3] = v.w;
        ss += v.x * v.x + v.y * v.y + v.z * v.z + v.w * v.w;
      }
      ss += __shfl_xor(ss, 1);
      ss += __shfl_xor(ss, 2);
      const float rs = rsqrtf(ss * (1.f / 128.f) + EPS);
      u16* zp = proj + (t0g + row) * PC + BZ + h * 128 + qr * 32;
#pragma unroll
      for (int i = 0; i < 4; ++i) {
        const uint4 z = *(const uint4*)(zp + 8 * i);
        const float* gg = ng + qr * 32 + 8 * i;
        uint4 r;
        r.x = pack2(ov[8 * i + 0] * rs * gg[0] * siluf_(bflo(z.x)), ov[8 * i + 1] * rs * gg[1] * siluf_(bfhi(z.x)));
        r.y = pack2(ov[8 * i + 2] * rs * gg[2] * siluf_(bflo(z.y)), ov[8 * i + 3] * rs * gg[3] * siluf_(bfhi(z.y)));
        r.z = pack2(ov[8 * i + 4] * rs * gg[4] * siluf_(bflo(z.z)), ov[8 * i + 5] * rs * gg[5] * siluf_(bfhi(z.z)));
        r.w = pack2(ov[8 * i + 6] * rs * gg[6] * siluf_(bflo(z.w)), ov[8 * i + 7] * rs * gg[7] * siluf_(bfhi(z.w)));
        *(uint4*)(zp + 8 * i) = r;
      }
    }
  }
  __syncthreads();
}

DI void diff_item(const Params& p, int l, int m, char* smem) {
  const int qt = 255 - (m >> 3), bh = m & 7, b = bh >> 2, h = bh & 3;
  const int tid = ltid(), ln = tid & 63, w = tid >> 6, hh = ln >> 5, c31 = ln & 31;
  const int st = w & 1, c = w >> 1;
  const size_t tokbase = (size_t)b * T;
  const int qb = qt * 64 + 32 * st + c31;
  u16* proj = p.P();
  bf16x8 qf[4];
  {
    const u16* qrow = proj + (tokbase + qb) * PC + AQ + h * 128 + c * 64 + 8 * hh;
#pragma unroll
    for (int s = 0; s < 4; ++s) qf[s] = *(const bf16x8*)(qrow + 16 * s);
  }
  f32x16 O[4];
#pragma unroll
  for (int i = 0; i < 4; ++i)
#pragma unroll
    for (int j = 0; j < 16; ++j) O[i][j] = 0.f;
  float mrun = -INFINITY, lrun = 0.f;
  const float sc = 0.125f * 1.44269504089f;
  char* Ks = smem;
  char* Vs = smem + 17408;
  uint4 rk0, rk1, rk2, rk3, rv0, rv1, rv2, rv3;
  const int srow = tid >> 4, sch = tid & 15;
#define DLOAD1(i, kt)                                                                \
  {                                                                                  \
    const u16* base = proj + (tokbase + (kt) * 64 + srow + 16 * i) * PC + h * 128 + sch * 8; \
    rk##i = *(const uint4*)(base + AK);                                              \
    rv##i = *(const uint4*)(base + AV);                                              \
  }
#define DLOAD(kt) { DLOAD1(0, kt) DLOAD1(1, kt) DLOAD1(2, kt) DLOAD1(3, kt) }
#define DSTORE1(i)                                                \
  *(uint4*)(Ks + (srow + 16 * i) * 272 + sch * 16) = rk##i;       \
  *(uint4*)(Vs + (srow + 16 * i) * 320 + sch * 16) = rv##i;
  DLOAD(0);
  for (int kt = 0; kt <= qt; ++kt) {
    __syncthreads();
    DSTORE1(0) DSTORE1(1) DSTORE1(2) DSTORE1(3)
    __syncthreads();
    if (kt < qt) { DLOAD(kt + 1); }
    f32x16 sa[2];
#pragma unroll
    for (int k2 = 0; k2 < 2; ++k2) {
#pragma unroll
      for (int j = 0; j < 16; ++j) sa[k2][j] = 0.f;
#pragma unroll
      for (int s = 0; s < 4; ++s)
        sa[k2] = mfma32(*(const bf16x8*)(Ks + (32 * k2 + c31) * 272 + (c * 64 + 16 * s + 8 * hh) * 2), qf[s], sa[k2]);
    }
    if (kt == qt) {
#pragma unroll
      for (int k2 = 0; k2 < 2; ++k2)
#pragma unroll
        for (int j = 0; j < 16; ++j)
          if (kt * 64 + 32 * k2 + crow(j, hh) > qb) sa[k2][j] = -INFINITY;
    }
    float tmax = sa[0][0];
#pragma unroll
    for (int k2 = 0; k2 < 2; ++k2)
#pragma unroll
      for (int j = 0; j < 16; ++j) tmax = fmaxf(tmax, sa[k2][j]);
    tmax = fmaxf(tmax, __shfl_xor(tmax, 32));
    const float mnew = fmaxf(mrun, tmax * sc);
    const float alpha = __builtin_amdgcn_exp2f(mrun - mnew);
    mrun = mnew;
    float psum = 0.f;
#pragma unroll
    for (int k2 = 0; k2 < 2; ++k2)
#pragma unroll
      for (int j = 0; j < 16; ++j) { const float pv = __builtin_amdgcn_exp2f(sa[k2][j] * sc - mnew); sa[k2][j] = pv; psum += pv; }
    lrun = lrun * alpha + psum;
    if (__any(alpha != 1.f)) {
#pragma unroll
      for (int i = 0; i < 4; ++i)
#pragma unroll
        for (int j = 0; j < 16; ++j) O[i][j] *= alpha;
    }
#pragma unroll
    for (int k2 = 0; k2 < 2; ++k2)
#pragma unroll
      for (int s2 = 0; s2 < 2; ++s2) {
        const bf16x8 pp = pack8(sa[k2], s2);
#pragma unroll
        for (int mt = 0; mt < 4; ++mt) O[mt] = mfma32(trfrag(Vs, 320, 32 * k2 + 16 * s2, 32 * mt, ln), pp, O[mt]);
      }
  }
#undef DLOAD
#undef DLOAD1
#undef DSTORE1
  __syncthreads();
  const float ltot = lrun + __shfl_xor(lrun, 32);
  const float inv = 1.f / ltot;
  float* xch = (float*)smem + st * 32 * 132;
  if (c == 1) {
#pragma unroll
    for (int mt = 0; mt < 4; ++mt)
#pragma unroll
      for (int i4 = 0; i4 < 4; ++i4)
        *(float4*)(xch + c31 * 132 + 32 * mt + 8 * i4 + 4 * hh) =
            float4{O[mt][4 * i4] * inv, O[mt][4 * i4 + 1] * inv, O[mt][4 * i4 + 2] * inv, O[mt][4 * i4 + 3] * inv};
  }
  __syncthreads();
  if (c == 0) {
    const float lam = p.LAM()[l], oml = 1.f - p.LAM()[2 + l];
    float ss = 0.f;
#pragma unroll
    for (int mt = 0; mt < 4; ++mt)
#pragma unroll
      for (int i4 = 0; i4 < 4; ++i4) {
        const float4 o1 = *(const float4*)(xch + c31 * 132 + 32 * mt + 8 * i4 + 4 * hh);
        float d;
        d = O[mt][4 * i4] * inv - lam * o1.x; O[mt][4 * i4] = d; ss += d * d;
        d = O[mt][4 * i4 + 1] * inv - lam * o1.y; O[mt][4 * i4 + 1] = d; ss += d * d;
        d = O[mt][4 * i4 + 2] * inv - lam * o1.z; O[mt][4 * i4 + 2] = d; ss += d * d;
        d = O[mt][4 * i4 + 3] * inv - lam * o1.w; O[mt][4 * i4 + 3] = d; ss += d * d;
      }
    ss += __shfl_xor(ss, 32);
    const float rs = rsqrtf(ss * (1.f / 128.f) + EPS) * oml;
    const float* sg = p.a_subln_g + l * 128;
    u16* orow = proj + (tokbase + qb) * PC + AQ + h * 128;
#pragma unroll
    for (int mt = 0; mt < 4; ++mt)
#pragma unroll
      for (int i4 = 0; i4 < 4; ++i4) {
        const int dv = 32 * mt + 8 * i4 + 4 * hh;
        const float4 gg = *(const float4*)(sg + dv);
        uint2 o;
        o.x = pack2(O[mt][4 * i4] * rs * gg.x, O[mt][4 * i4 + 1] * rs * gg.y);
        o.y = pack2(O[mt][4 * i4 + 2] * rs * gg.z, O[mt][4 * i4 + 3] * rs * gg.w);
        *(uint2*)(orow + dv) = o;
      }
  }
  __syncthreads();
}

DI u32 mono_key(float f) { u32 u = __float_as_uint(f); return (u & 0x80000000u) ? ~u : (u | 0x80000000u); }

DI void dsa_prune(u32* ck, u16* ci, int& cnt, u32& tau, int ln) {
  u32 kv[8];
  u16 iv[8];
#pragma unroll
  for (int j = 0; j < 8; ++j) {
    const int pos = ln + 64 * j;
    const bool vd = pos < cnt;
    kv[j] = vd ? ck[pos] : 0u;
    iv[j] = vd ? ci[pos] : (u16)0;
  }
  u32 t = 0;
  for (int bit = 31; bit >= 0; --bit) {
    const u32 cand = t | (1u << bit);
    int c = 0;
#pragma unroll
    for (int j = 0; j < 8; ++j) c += __popcll(__ballot(kv[j] >= cand));
    if (c >= 256) t = cand;
  }
  int ngt = 0;
#pragma unroll
  for (int j = 0; j < 8; ++j) ngt += __popcll(__ballot(kv[j] > t));
  const int need = 256 - ngt;
  int run_gt = 0, run_eq = 0;
#pragma unroll
  for (int j = 0; j < 8; ++j) {
    const bool gt = kv[j] > t, eq = (kv[j] == t) && (t != 0u);
    const u64 mg = __ballot(gt), me = __ballot(eq);
    const int pg = run_gt + (int)lane_lt_cnt(mg), pe = run_eq + (int)lane_lt_cnt(me);
    if (gt) { ck[pg] = kv[j]; ci[pg] = iv[j]; }
    else if (eq && pe < need) { ck[ngt + pe] = kv[j]; ci[ngt + pe] = iv[j]; }
    run_gt += __popcll(mg);
    run_eq += __popcll(me);
  }
  cnt = 256;
  tau = t;
}

DI void dsa_item(const Params& p, int l, int m, char* smem) {
  const int tile16 = 1023 - (m >> 1), b = m & 1;
  const int tid = ltid(), ln = tid & 63, w = tid >> 6, hh = ln >> 5, c31 = ln & 31;
  const int t0 = tile16 * 16 + 4 * w;
  const size_t tokbase = (size_t)b * T;
  u16* QX = (u16*)p.out;
  char* wl = smem + w * 14336;
  u32* ckey = (u32*)wl;
  u16* cidx = (u16*)(wl + 8192);
  u16* ifin = (u16*)(wl + 12288);
  char* tile = wl;
  int cnt[4] = {0, 0, 0, 0};
  u32 tau[4] = {0u, 0u, 0u, 0u};
  {
    bf16x8 qa[4];
    {
      const int r = c31, ql = 2 * ((r >> 2) & 1) + (r >> 4), hd = 4 * ((r >> 3) & 1) + (r & 3);
      const u16* qrow = QX + (tokbase + t0 + ql) * 1536 + 1024 + hd * 64 + 8 * hh;
#pragma unroll
      for (int s = 0; s < 4; ++s) qa[s] = *(const bf16x8*)(qrow + 16 * s);
    }
    float wq[16];
    {
      const float4* wi = (const float4*)(p.WIDX() + (tokbase + t0 + 2 * hh) * 8);
#pragma unroll
      for (int i = 0; i < 4; ++i) { const float4 v = wi[i]; wq[4 * i] = v.x; wq[4 * i + 1] = v.y; wq[4 * i + 2] = v.z; wq[4 * i + 3] = v.w; }
    }
    const int qpos0 = t0 + 2 * hh;
    const int nkt = ((t0 + 3) >> 5) + 1;
    for (int kt = 0; kt < nkt; ++kt) {
#pragma unroll
      for (int qq = 0; qq < 4; ++qq)
        if (cnt[qq] > 480) dsa_prune(ckey + qq * 512, cidx + qq * 512, cnt[qq], tau[qq], ln);
      const int key = kt * 32 + c31;
      const u16* krow = p.KIDX() + (tokbase + key) * 64 + 8 * hh;
      f32x16 acc;
#pragma unroll
      for (int j = 0; j < 16; ++j) acc[j] = 0.f;
#pragma unroll
      for (int s = 0; s < 4; ++s) acc = mfma32(qa[s], *(const bf16x8*)(krow + 16 * s), acc);
      float s0 = 0.f, s1 = 0.f;
#pragma unroll
      for (int i = 0; i < 8; ++i) { s0 += wq[i] * fmaxf(acc[i], 0.f); s1 += wq[8 + i] * fmaxf(acc[8 + i], 0.f); }
      const u32 k0 = mono_key(s0), k1 = mono_key(s1);
#pragma unroll
      for (int qq = 0; qq < 4; ++qq) {
        const u32 kv = (qq & 1) ? k1 : k0;
        const int qp = qpos0 + (qq & 1);
        const bool cnd = (hh == (qq >> 1)) && (key <= qp) && (kv > tau[qq]);
        const u64 mask = __ballot(cnd);
        if (mask) {
          const int pos = cnt[qq] + (int)lane_lt_cnt(mask);
          if (cnd) { ckey[qq * 512 + pos] = kv; cidx[qq * 512 + pos] = (u16)key; }
          cnt[qq] += __popcll(mask);
        }
      }
    }
#pragma unroll
    for (int qq = 0; qq < 4; ++qq) {
      if (cnt[qq] > 256) dsa_prune(ckey + qq * 512, cidx + qq * 512, cnt[qq], tau[qq], ln);
#pragma unroll
      for (int j = 0; j < 4; ++j) {
        const int pos = ln + 64 * j;
        ifin[qq * 256 + pos] = (pos < cnt[qq]) ? cidx[qq * 512 + pos] : (u16)0;
      }
    }
  }
  const float sc = 0.125f * 1.44269504089f;
#pragma unroll 1
  for (int qq = 0; qq < 4; ++qq) {
    const int nsel = (qq == 0) ? cnt[0] : (qq == 1) ? cnt[1] : (qq == 2) ? cnt[2] : cnt[3];
    const size_t tq = tokbase + t0 + qq;
    bf16x8 qf[8];
    {
      const u16* qab = QX + tq * 1536 + (c31 & 7) * 128 + 8 * hh;
#pragma unroll
      for (int s = 0; s < 8; ++s) qf[s] = *(const bf16x8*)(qab + 16 * s);
    }
    f32x16 O[4];
#pragma unroll
    for (int i = 0; i < 4; ++i)
#pragma unroll
      for (int j = 0; j < 16; ++j) O[i][j] = 0.f;
    float mrun = -INFINITY, lrun = 0.f;
    const int ntile = (nsel + 31) >> 5;
    for (int tt = 0; tt < ntile; ++tt) {
#pragma unroll
      for (int i = 0; i < 8; ++i) {
        const int piece = ln + 64 * i, row = piece >> 4, ch = piece & 15;
        const int idx = ifin[qq * 256 + tt * 32 + row];
        const uint4 v = *(const uint4*)(p.CKV() + (tokbase + idx) * 128 + ch * 8);
        *(uint4*)(tile + row * 272 + ch * 16) = v;
      }
      __builtin_amdgcn_fence(__ATOMIC_RELEASE, "wavefront");
      f32x16 sa;
#pragma unroll
      for (int j = 0; j < 16; ++j) sa[j] = 0.f;
#pragma unroll
      for (int s = 0; s < 8; ++s) sa = mfma32(*(const bf16x8*)(tile + c31 * 272 + (16 * s + 8 * hh) * 2), qf[s], sa);
      float tmax = -INFINITY;
#pragma unroll
      for (int j = 0; j < 16; ++j) {
        if (tt * 32 + crow(j, hh) >= nsel) sa[j] = -INFINITY;
        tmax = fmaxf(tmax, sa[j]);
      }
      tmax = fmaxf(tmax, __shfl_xor(tmax, 32));
      const float mnew = fmaxf(mrun, tmax * sc);
      const float alpha = __builtin_amdgcn_exp2f(mrun - mnew);
      mrun = mnew;
      float psum = 0.f;
#pragma unroll
      for (int j = 0; j < 16; ++j) { const float pv = __builtin_amdgcn_exp2f(sa[j] * sc - mnew); sa[j] = pv; psum += pv; }
      lrun = lrun * alpha + psum;
#pragma unroll
      for (int i = 0; i < 4; ++i)
#pragma unroll
        for (int j = 0; j < 16; ++j) O[i][j] *= alpha;
#pragma unroll
      for (int s2 = 0; s2 < 2; ++s2) {
        const bf16x8 pp = pack8(sa, s2);
#pragma unroll
        for (int mt = 0; mt < 4; ++mt) O[mt] = mfma32(trfrag(tile, 272, 16 * s2, 32 * mt, ln), pp, O[mt]);
      }
      __builtin_amdgcn_fence(__ATOMIC_ACQ_REL, "wavefront");
    }
    const float ltot = lrun + __shfl_xor(lrun, 32);
    const float inv = 1.f / ltot;
    if (c31 < 8) {
      u16* orow = QX + tq * 1536 + c31 * 128;
#pragma unroll
      for (int mt = 0; mt < 4; ++mt)
#pragma unroll
        for (int i4 = 0; i4 < 4; ++i4) {
          uint2 o;
          o.x = pack2(O[mt][4 * i4] * inv, O[mt][4 * i4 + 1] * inv);
          o.y = pack2(O[mt][4 * i4 + 2] * inv, O[mt][4 * i4 + 3] * inv);
          *(uint2*)(orow + 32 * mt + 8 * i4 + 4 * hh) = o;
        }
    }
  }
  __syncthreads();
}

DI void phase_prep(const Params& p, int l, char* smem) {
  const int n_gdn = EN_B ? 2048 : 0, n_kp = EN_C ? 512 : 0, n_qx = EN_C ? 3072 : 0;
  for (int t = lbid(); t < n_gdn + n_kp + n_qx; t += lgdim()) {
    if (t < n_gdn) gdn_prep_item(p, l, t, smem);
    else if (t < n_gdn + n_kp) dsa_kprep_item(p, l, t - n_gdn);
    else qx_tile(p, l, t - n_gdn - n_kp, smem);
  }
}

DI void phase_mixers(const Params& p, int l, char* smem) {
  __shared__ int s_item;
  const int n_gdn = EN_B ? 8 : 0;
  const int n_total = n_gdn + 4096;
  for (;;) {
    __syncthreads();
    if (ltid() == 0) s_item = (int)atomicAdd(p.CNT() + l, 1u);
    __syncthreads();
    const int it = s_item;
    if (it >= n_total) break;
    if (it < n_gdn) gdn_rec_item(p, l, it, smem);
    else {
      const int j = it - n_gdn;
      if ((j & 1) == 0) { if (EN_A) diff_item(p, l, j >> 1, smem); }
      else { if (EN_C) dsa_item(p, l, j >> 1, smem); }
    }
  }
}

DI void run_phase(const Params& p, int ph, char* smem) {
  if (ph == 0) { phase0(p, smem); return; }
  const int l = (ph - 1) / 9, s = (ph - 1) % 9;
  switch (s) {
    case 0: phase_inproj(p, l, smem); break;
    case 1: phase_prep(p, l, smem); break;
    case 2: phase_mixers(p, l, smem); break;
    case 3: phase_merge(p, l, smem); break;
    case 4: phase_resgemm(p, p.MERGED(), 1024, p.wo(l), 1024, smem); break;
    case 5: ln_phase(p.out, p.ln1_g + l * 1024, p.ln1_b + l * 1024, p.XB(), nullptr); break;
    case 6: phase_ff1(p, l, smem); break;
    case 7: phase_resgemm(p, p.P(), 4096, p.wf2(l), 4096, smem); break;
    case 8: ln_phase(p.out, p.ln2_g + l * 1024, p.ln2_b + l * 1024, (l == 1) ? nullptr : p.XB(), (l == 1) ? p.out : nullptr); break;
  }
}

constexpr int N_PHASES = 19;

#if COOP
DI void gsync() { cg::this_grid().sync(); }
__global__ void __launch_bounds__(256, 2) mega_kernel(Params p, int ph_begin, int ph_end) {
  __shared__ __attribute__((aligned(16))) char smem[SMEM_BYTES];
  phase0(p, smem);
  gsync();
#pragma unroll 1
  for (int l = 0; l < 2; ++l) {
    phase_inproj(p, l, smem);
    gsync();
    phase_prep(p, l, smem);
    gsync();
    phase_mixers(p, l, smem);
    gsync();
    phase_merge(p, l, smem);
    gsync();
    phase_resgemm(p, p.MERGED(), 1024, p.wo(l), 1024, smem);
    gsync();
    ln_phase(p.out, p.ln1_g + l * 1024, p.ln1_b + l * 1024, p.XB(), nullptr);
    gsync();
    phase_ff1(p, l, smem);
    gsync();
    phase_resgemm(p, p.P(), 4096, p.wf2(l), 4096, smem);
    gsync();
    ln_phase(p.out, p.ln2_g + l * 1024, p.ln2_b + l * 1024, (l == 1) ? nullptr : p.XB(), (l == 1) ? p.out : nullptr);
    if (l == 0) gsync();
  }
}
#else
__global__ void __launch_bounds__(256, 2) mega_kernel(Params p, int ph_begin, int ph_end) {
  __shared__ __attribute__((aligned(16))) char smem[SMEM_BYTES];
  for (int ph = ph_begin; ph < ph_end; ++ph) run_phase(p, ph, smem);
}
#endif

extern "C" void kernel_launch(void* const* d_in, const int* in_sizes, int n_in, void* d_out, int out_size,
                              void* d_ws, size_t ws_size, hipStream_t stream) {
  static int grid_blocks = 0;
  if (!grid_blocks) {
    int dev = 0, cus = 0, per_cu = 0;
    hipGetDevice(&dev);
    hipDeviceGetAttribute(&cus, hipDeviceAttributeMultiprocessorCount, dev);
    hipOccupancyMaxActiveBlocksPerMultiprocessor(&per_cu, mega_kernel, 256, 0);
    if (per_cu < 1) per_cu = 1;
    if (per_cu > 2) per_cu = 2;
    grid_blocks = cus * per_cu;
  }
  Params p{};
  const float** pf = (const float**)&p;
  for (int i = 0; i < 27; ++i) pf[i] = (const float*)d_in[i];
  p.out = (float*)d_out;
  p.ws = (char*)d_ws;
  if (WS_NEED > ws_size) { fprintf(stderr, "workspace too small: need %zu have %zu\n", (size_t)WS_NEED, ws_size); return; }
#if COOP
  int b = 0, e = N_PHASES;
  void* args[] = {&p, &b, &e};
  hipError_t err = hipLaunchCooperativeKernel((void*)mega_kernel, dim3(grid_blocks), dim3(256), args, 0, stream);
  if (err != hipSuccess) fprintf(stderr, "cooperative launch failed: %s (grid %d)\n", hipGetErrorString(err), grid_blocks);
#else
  for (int ph = 0; ph < N_PHASES; ++ph) mega_kernel<<<grid_blocks, 256, 0, stream>>>(p, ph, ph + 1);
#endif
}
```

```cpp
#include <hip/hip_runtime.h>
#include <hip/hip_cooperative_groups.h>
#include <cstdio>
namespace cg = cooperative_groups;

#ifndef COOP
#define COOP 1
#endif
#ifndef REP0
#define REP0 1
#define REP1 1
#define REP2 1
#define REP3 1
#define REP4 1
#define REP5 1
#define REP6 1
#endif
#ifndef EN_A
#define EN_A 1
#endif
#ifndef EN_B
#define EN_B 1
#endif
#ifndef EN_C
#define EN_C 1
#endif

typedef unsigned short u16;
typedef unsigned int u32;
typedef unsigned long long u64;
using bf16x8 = __attribute__((ext_vector_type(8))) short;
using s16x4 = __attribute__((ext_vector_type(4))) short;
using f32x4 = __attribute__((ext_vector_type(4))) float;
using f32x16 = __attribute__((ext_vector_type(16))) float;
#define DI __device__ __forceinline__

constexpr int NT = 32768, T = 16384, PC = 4048;
constexpr int AQ = 0, AK = 512, AV = 1024, BQ = 1536, BK_ = 2048, BV = 2560, BZ = 3072, BA = 3584, BB = 3588,
              CQ = 3592, CKVc = 3848, CKI = 3976, CWI = 4040, GATES = 4048;
constexpr float EPS = 1e-6f;
constexpr float DN_ALPHA = 1.41421356237f;
constexpr int NTHR = 512;
constexpr int SMEM_BYTES = 147456 + 2048;

constexpr size_t al256(size_t x) { return (x + 255) & ~(size_t)255; }
constexpr size_t SZ_WIN = al256((size_t)7120 * 1024 * 2), SZ_WQX = al256((size_t)1536 * 256 * 2), SZ_WBR = al256((size_t)1024 * 512 * 2),
                 SZ_WBRC = al256((size_t)1024 * 1024 * 2), SZ_WO = al256((size_t)1024 * 1024 * 2), SZ_WF = al256((size_t)4096 * 1024 * 2);
constexpr size_t O_WIN = 0, O_WQX = O_WIN + SZ_WIN, O_WBRA = O_WQX + SZ_WQX, O_WBRB = O_WBRA + SZ_WBR, O_WBRC = O_WBRB + SZ_WBR,
                 O_WO = O_WBRC + SZ_WBRC, O_WF1 = O_WO + SZ_WO, O_WF2 = O_WF1 + SZ_WF, LAYER_W = O_WF2 + SZ_WF;
constexpr size_t O_P = 2 * LAYER_W, O_XB = O_P + (size_t)NT * 4096 * 2, O_M = O_XB + (size_t)NT * 1024 * 2;
constexpr size_t O_KDT = O_M, O_ATT = O_KDT + 33554432, O_HALO = O_ATT + 16777216, O_KIDX = O_HALO + 4718592, O_CKV = O_KIDX + 4194304,
                 O_MEND = O_CKV + 8388608;
constexpr size_t O_WIDX = O_MEND, O_GL = O_WIDX + (size_t)NT * 8 * 4, O_LAM = O_GL + 8192, O_CNT = O_LAM + 256, WS_NEED = O_CNT + 256;
static_assert(O_MEND - O_M >= (size_t)NT * 1024 * 2, "merged alias");

struct Params {
  const float *x, *w_in, *b_gate, *a_lambda, *a_subln_g, *b_conv_w, *b_a_log, *b_dt_bias, *b_norm_g,
      *c_q_norm_g, *c_kv_norm_g, *c_kidx_g, *c_kidx_b, *c_w_uq, *c_w_qidx, *c_w_uk, *c_w_uv,
      *w_branch_a, *w_branch_b, *w_branch_c, *w_o, *ln1_g, *ln1_b, *w_ff1, *w_ff2, *ln2_g, *ln2_b;
  float* out;
  char* ws;
  __device__ __forceinline__ u16* win(int l) const { return (u16*)(ws + l * LAYER_W + O_WIN); }
  __device__ __forceinline__ u16* wqx(int l) const { return (u16*)(ws + l * LAYER_W + O_WQX); }
  __device__ __forceinline__ u16* wbra(int l) const { return (u16*)(ws + l * LAYER_W + O_WBRA); }
  __device__ __forceinline__ u16* wbrb(int l) const { return (u16*)(ws + l * LAYER_W + O_WBRB); }
  __device__ __forceinline__ u16* wbrc(int l) const { return (u16*)(ws + l * LAYER_W + O_WBRC); }
  __device__ __forceinline__ u16* wo(int l) const { return (u16*)(ws + l * LAYER_W + O_WO); }
  __device__ __forceinline__ u16* wf1(int l) const { return (u16*)(ws + l * LAYER_W + O_WF1); }
  __device__ __forceinline__ u16* wf2(int l) const { return (u16*)(ws + l * LAYER_W + O_WF2); }
  __device__ __forceinline__ u16* P() const { return (u16*)(ws + O_P); }
  __device__ __forceinline__ u16* XB() const { return (u16*)(ws + O_XB); }
  __device__ __forceinline__ u16* KDT() const { return (u16*)(ws + O_KDT); }
  __device__ __forceinline__ u16* ATT() const { return (u16*)(ws + O_ATT); }
  __device__ __forceinline__ u16* HALO() const { return (u16*)(ws + O_HALO); }
  __device__ __forceinline__ u16* KIDX() const { return (u16*)(ws + O_KIDX); }
  __device__ __forceinline__ u16* CKV() const { return (u16*)(ws + O_CKV); }
  __device__ __forceinline__ u16* MERGED() const { return (u16*)(ws + O_M); }
  __device__ __forceinline__ float* WIDX() const { return (float*)(ws + O_WIDX); }
  __device__ __forceinline__ float* GL() const { return (float*)(ws + O_GL); }
  __device__ __forceinline__ float* LAM() const { return (float*)(ws + O_LAM); }
  __device__ __forceinline__ u32* CNT() const { return (u32*)(ws + O_CNT); }
};

DI int lbid() { int b = blockIdx.x; asm volatile("" : "+s"(b)); return b; }
DI int lgdim() { int b = gridDim.x; asm volatile("" : "+s"(b)); return b; }
DI int ltid() { int t = threadIdx.x; asm volatile("" : "+v"(t)); return t; }
DI u16 f2bf(float x) { u32 u = __float_as_uint(x); u += 0x7fffu + ((u >> 16) & 1u); return (u16)(u >> 16); }
DI float bf2f(u16 h) { return __uint_as_float(((u32)h) << 16); }
DI u32 pack2(float a, float b) { return (u32)f2bf(a) | ((u32)f2bf(b) << 16); }
DI float bflo(u32 v) { return __uint_as_float(v << 16); }
DI float bfhi(u32 v) { return __uint_as_float(v & 0xffff0000u); }
DI f32x4 mfma16(bf16x8 a, bf16x8 b, f32x4 c) { return __builtin_amdgcn_mfma_f32_16x16x32_bf16(a, b, c, 0, 0, 0); }
DI f32x16 mfma32(bf16x8 a, bf16x8 b, f32x16 c) { return __builtin_amdgcn_mfma_f32_32x32x16_bf16(a, b, c, 0, 0, 0); }
DI int crow(int i, int hh) { return (i & 3) + 8 * (i >> 2) + 4 * hh; }
DI float sigmoidf_(float x) { return 1.f / (1.f + __expf(-x)); }
DI float siluf_(float x) { return x / (1.f + __expf(-x)); }
DI u32 lane_lt_cnt(u64 m) { return __builtin_amdgcn_mbcnt_hi((u32)(m >> 32), __builtin_amdgcn_mbcnt_lo((u32)m, 0)); }

DI bf16x8 pack8(const f32x16& x, int s) {
  u32 p0, p1, p2, p3;
  if (s == 0) {
    asm volatile("v_cvt_pk_bf16_f32 %0, %4, %5\n\tv_cvt_pk_bf16_f32 %1, %6, %7\n\tv_cvt_pk_bf16_f32 %2, %8, %9\n\tv_cvt_pk_bf16_f32 %3, %10, %11\n\ts_nop 1"
                 : "=&v"(p0), "=&v"(p1), "=&v"(p2), "=&v"(p3)
                 : "v"(x[0]), "v"(x[1]), "v"(x[2]), "v"(x[3]), "v"(x[4]), "v"(x[5]), "v"(x[6]), "v"(x[7]));
  } else {
    asm volatile("v_cvt_pk_bf16_f32 %0, %4, %5\n\tv_cvt_pk_bf16_f32 %1, %6, %7\n\tv_cvt_pk_bf16_f32 %2, %8, %9\n\tv_cvt_pk_bf16_f32 %3, %10, %11\n\ts_nop 1"
                 : "=&v"(p0), "=&v"(p1), "=&v"(p2), "=&v"(p3)
                 : "v"(x[8]), "v"(x[9]), "v"(x[10]), "v"(x[11]), "v"(x[12]), "v"(x[13]), "v"(x[14]), "v"(x[15]));
  }
  typedef u32 u32x4 __attribute__((ext_vector_type(4)));
  u32x4 v = {p0, p1, p2, p3};
  return __builtin_bit_cast(bf16x8, v);
}
DI bf16x8 afrag_perm(const char* base, int row, int stride, int kbase, int hh) {
  const char* pr = base + row * stride + (kbase + 4 * hh) * 2;
  s16x4 lo = *(const s16x4*)pr;
  s16x4 hi = *(const s16x4*)(pr + 16);
  return __builtin_shufflevector(lo, hi, 0, 1, 2, 3, 4, 5, 6, 7);
}
DI bf16x8 trfrag(const char* img, int stride, int krow0, int col0, int ln) {
  const int hh = ln >> 5, chalf = (ln >> 4) & 1, q4 = (ln & 15) >> 2, p4 = ln & 3;
  u32 a = (u32)(size_t)(img + (krow0 + 4 * hh + q4) * stride + (col0 + 16 * chalf + 4 * p4) * 2);
  s16x4 lo, hi;
  asm volatile("ds_read_b64_tr_b16 %0, %2\n\tds_read_b64_tr_b16 %1, %3\n\ts_waitcnt lgkmcnt(0)"
               : "=&v"(lo), "=&v"(hi) : "v"(a), "v"(a + 8 * stride) : "memory");
  return __builtin_shufflevector(lo, hi, 0, 1, 2, 3, 4, 5, 6, 7);
}

template <int MT, int NT>
DI void gemm_core(const u16* __restrict__ A, int lda, const u16* __restrict__ B, int ldb, int K,
                  f32x4 (&acc)[MT][NT], char* smem) {
  constexpr int BM = 64 * MT, BN = 32 * NT;
  constexpr int ASZ = BM * 144, BSZ = BN * 144, BUF = ASZ + BSZ;
  constexpr int NA = BM / 64, NB = BN / 64;
  const int tid = ltid(), l = tid & 63, w = tid >> 6, wm = w >> 1, wn = w & 1;
  const int fr = l & 15, fq = l >> 4;
  uint4 ra0, ra1, ra2, ra3, rb0, rb1, rb2, rb3;
  const int nk = K >> 6;
  const int srow = tid >> 3, sch = tid & 7;
#define GL1(i, kt)                                                                                        \
  if (NA > i) ra##i = *(const uint4*)(A + (size_t)(srow + 64 * i) * lda + (kt) * 64 + sch * 8);           \
  if (NB > i) rb##i = *(const uint4*)(B + (size_t)(srow + 64 * i) * ldb + (kt) * 64 + sch * 8);
#define GLOAD(kt) { GL1(0, kt) GL1(1, kt) GL1(2, kt) GL1(3, kt) }
#define SS1(i)                                                                   \
  if (NA > i) *(uint4*)(as_ + (srow + 64 * i) * 144 + sch * 16) = ra##i;         \
  if (NB > i) *(uint4*)(bs_ + (srow + 64 * i) * 144 + sch * 16) = rb##i;
#define SSTORE(buf)                              \
  {                                              \
    char* as_ = smem + (buf) * BUF;              \
    char* bs_ = as_ + ASZ;                       \
    SS1(0) SS1(1) SS1(2) SS1(3)                  \
  }
  GLOAD(0);
  SSTORE(0);
  __syncthreads();
#pragma unroll 1
  for (int kt = 0; kt < nk; ++kt) {
    if (kt + 1 < nk) GLOAD(kt + 1);
    const char* as = smem + (kt & 1) * BUF;
    const char* bs = as + ASZ;
#pragma unroll
    for (int kk = 0; kk < 2; ++kk) {
      bf16x8 xf[MT], wf[NT];
#pragma unroll
      for (int mi = 0; mi < MT; ++mi)
        xf[mi] = *(const bf16x8*)(as + (wm * (MT * 16) + mi * 16 + fr) * 144 + (kk * 32 + fq * 8) * 2);
#pragma unroll
      for (int ni = 0; ni < NT; ++ni)
        wf[ni] = *(const bf16x8*)(bs + (wn * (NT * 16) + ni * 16 + fr) * 144 + (kk * 32 + fq * 8) * 2);
#pragma unroll
      for (int mi = 0; mi < MT; ++mi)
#pragma unroll
        for (int ni = 0; ni < NT; ++ni) acc[mi][ni] = mfma16(wf[ni], xf[mi], acc[mi][ni]);
    }
    if (kt + 1 < nk) SSTORE((kt + 1) & 1);
    __syncthreads();
  }
#undef GLOAD
#undef SSTORE
#undef GL1
#undef SS1
}
template <int MT, int NT>
DI void zero_acc(f32x4 (&acc)[MT][NT]) {
#pragma unroll
  for (int i = 0; i < MT; ++i)
#pragma unroll
    for (int j = 0; j < NT; ++j) acc[i][j] = f32x4{0.f, 0.f, 0.f, 0.f};
}


DI bool next_tile(int it, int RT, int CT, int PR, int PCc, int& rt, int& ct) {
  const int bid = lbid(), x = bid & 7, j = bid >> 3, J = lgdim() >> 3;
  const int u = j + it * J;
  const int pcols = CT / PCc, npatch = (RT / PR) * pcols;
  const int pid = (u >> 6) * 8 + x;
  if (pid >= npatch) return false;
  const int w = u & 63, pr = pid / pcols, pc = pid - pr * pcols;
  rt = pr * PR + w / PCc;
  ct = pc * PCc + w % PCc;
  return true;
}
DI void transpose_job(const float* __restrict__ src, int K, int N, u16* __restrict__ dst, const float* kscale, char* smem) {
  float(*tile)[65] = (float(*)[65])smem;
  const int ntn = (N + 63) >> 6, ntk = K >> 6, tid = ltid();
  for (int t = lbid(); t < ntn * ntk; t += lgdim()) {
    const int tk = t / ntn, tn = t % ntn, k0 = tk * 64, n0 = tn * 64;
    {
      const int n = tid & 63, kb = tid >> 6;
      for (int i = 0; i < 8; ++i) {
        const int k = kb + 8 * i;
        float v = (n0 + n < N) ? src[(size_t)(k0 + k) * N + n0 + n] : 0.f;
        if (kscale) v *= kscale[k0 + k];
        tile[k][n] = v;
      }
    }
    __syncthreads();
    {
      const int k = tid & 63, nb = tid >> 6;
      for (int i = 0; i < 8; ++i) {
        const int n = nb + 8 * i;
        if (n0 + n < N) dst[(size_t)(n0 + n) * K + k0 + k] = f2bf(tile[k][n]);
      }
    }
    __syncthreads();
  }
}

DI void phase0(const Params& p, char* smem) {
  const size_t gtid = (size_t)lbid() * NTHR + ltid(), gsz = (size_t)lgdim() * NTHR;
  for (int l = 0; l < 2; ++l) {
    transpose_job(p.w_in + (size_t)l * 1024 * 7120, 1024, 7120, p.win(l), nullptr, smem);
    transpose_job(p.w_branch_a + (size_t)l * 512 * 1024, 512, 1024, p.wbra(l), nullptr, smem);
    transpose_job(p.w_branch_b + (size_t)l * 512 * 1024, 512, 1024, p.wbrb(l), nullptr, smem);
    transpose_job(p.w_o + (size_t)l * 1024 * 1024, 1024, 1024, p.wo(l), nullptr, smem);
    transpose_job(p.w_ff1 + (size_t)l * 1024 * 4096, 1024, 4096, p.wf1(l), nullptr, smem);
    transpose_job(p.w_ff2 + (size_t)l * 4096 * 1024, 4096, 1024, p.wf2(l), nullptr, smem);
    transpose_job(p.c_w_qidx + (size_t)l * 256 * 512, 256, 512, p.wqx(l) + 1024 * 256, p.c_q_norm_g + l * 256, smem);
    {
      const float* uq = p.c_w_uq + (size_t)l * 256 * 512;
      const float* uk = p.c_w_uk + (size_t)l * 128 * 512;
      const float* g = p.c_q_norm_g + l * 256;
      for (size_t e = gtid; e < 1024 * 256; e += gsz) {
        const int n = (int)(e >> 8), k = (int)(e & 255), h = n >> 7, r2 = n & 127;
        const float4* a = (const float4*)(uq + (k * 8 + h) * 64);
        const float4* b = (const float4*)(uk + (r2 * 8 + h) * 64);
        float s = 0.f;
        for (int d = 0; d < 16; ++d) { float4 x = a[d], y = b[d]; s += x.x * y.x + x.y * y.y + x.z * y.z + x.w * y.w; }
        p.wqx(l)[e] = f2bf(s * g[k]);
      }
    }
    {
      const float* uv = p.c_w_uv + (size_t)l * 128 * 512;
      const float* bc = p.w_branch_c + (size_t)l * 512 * 1024;
      for (size_t e = gtid; e < 1024 * 1024; e += gsz) {
        const int k = (int)(e >> 10), n = (int)(e & 1023), h = k >> 7, r = k & 127;
        const float* a = uv + (r * 8 + h) * 64;
        const float* b = bc + (size_t)(h * 64) * 1024 + n;
        float s = 0.f;
        for (int d = 0; d < 64; ++d) s += a[d] * b[(size_t)d * 1024];
        p.wbrc(l)[(size_t)n * 1024 + k] = f2bf(s);
      }
    }
  }
  for (size_t e = gtid; e < (size_t)NT * 1024 / 8; e += gsz) {
    const float4 a = ((const float4*)p.x)[2 * e], b = ((const float4*)p.x)[2 * e + 1];
    uint4 o;
    o.x = pack2(a.x, a.y); o.y = pack2(a.z, a.w); o.z = pack2(b.x, b.y); o.w = pack2(b.z, b.w);
    ((uint4*)p.XB())[e] = o;
  }
  if (gtid < 2) {
    const int l = (int)gtid;
    const float* lp = p.a_lambda + l * 256;
    float s1 = 0.f, s2 = 0.f;
    for (int i = 0; i < 64; ++i) { s1 += lp[i] * lp[64 + i]; s2 += lp[128 + i] * lp[192 + i]; }
    const float lam_init = 0.8f - 0.6f * expf(-0.3f * l);
    p.LAM()[l] = expf(s1) - expf(s2) + lam_init;
    p.LAM()[2 + l] = lam_init;
    for (int i = 0; i < 8; ++i) p.CNT()[l * 8 + i] = 0;
  }
}

DI void ln_phase(const float* S, const float* __restrict__ g, const float* __restrict__ b, u16* XBo, float* fout) {
  const int l = ltid() & 63;
  const int wave = lbid() * 8 + (ltid() >> 6), nw = lgdim() * 8;
  for (int row = wave; row < NT; row += nw) {
    float4 v[4];
    float s = 0.f;
#pragma unroll
    for (int i = 0; i < 4; ++i) { v[i] = *(const float4*)(S + (size_t)row * 1024 + i * 256 + l * 4); s += v[i].x + v[i].y + v[i].z + v[i].w; }
#pragma unroll
    for (int o = 32; o; o >>= 1) s += __shfl_xor(s, o);
    const float mu = s * (1.f / 1024.f);
    float q = 0.f;
#pragma unroll
    for (int i = 0; i < 4; ++i) { float a = v[i].x - mu, bb = v[i].y - mu, c = v[i].z - mu, d = v[i].w - mu; q += a * a + bb * bb + c * c + d * d; }
#pragma unroll
    for (int o = 32; o; o >>= 1) q += __shfl_xor(q, o);
    const float rs = rsqrtf(q * (1.f / 1024.f) + EPS);
#pragma unroll
    for (int i = 0; i < 4; ++i) {
      const int c = i * 256 + l * 4;
      const float4 gg = *(const float4*)(g + c), bb = *(const float4*)(b + c);
      float4 y;
      y.x = (v[i].x - mu) * rs * gg.x + bb.x; y.y = (v[i].y - mu) * rs * gg.y + bb.y;
      y.z = (v[i].z - mu) * rs * gg.z + bb.z; y.w = (v[i].w - mu) * rs * gg.w + bb.w;
      if (fout) *(float4*)(fout + (size_t)row * 1024 + c) = y;
      if (XBo) { uint2 o; o.x = pack2(y.x, y.y); o.y = pack2(y.z, y.w); *(uint2*)(XBo + (size_t)row * 1024 + c) = o; }
    }
  }
}

#define EPI_LOOP(MT_, NT_)                                                \
  const int l_ = ltid() & 63, w_ = ltid() >> 6;                           \
  const int wm_ = w_ >> 1, wn_ = w_ & 1, fr_ = l_ & 15, fq_ = l_ >> 4;    \
  _Pragma("unroll") for (int mi = 0; mi < MT_; ++mi)                      \
  _Pragma("unroll") for (int ni = 0; ni < NT_; ++ni)

DI void phase_inproj(const Params& p, int l, char* smem) {
  int rt, ct;
  for (int it = 0; next_tile(it, 128, 16, 8, 8, rt, ct); ++it) {
    const int r0 = rt * 256, c0 = ct * 256;
    f32x4 acc[4][8];
    zero_acc<4, 8>(acc);
    gemm_core<4, 8>(p.XB() + (size_t)r0 * 1024, 1024, p.win(l) + (size_t)c0 * 1024, 1024, 1024, acc, smem);
    EPI_LOOP(4, 8) {
      const int row = r0 + wm_ * 64 + mi * 16 + fr_, col = c0 + wn_ * 128 + ni * 16 + fq_ * 4;
      if (col < PC) {
        uint2 o;
        o.x = pack2(acc[mi][ni][0], acc[mi][ni][1]); o.y = pack2(acc[mi][ni][2], acc[mi][ni][3]);
        *(uint2*)(p.P() + (size_t)row * PC + col) = o;
        if (col >= BQ && col < BZ && (row & 63) >= 61)
          *(uint2*)(p.HALO() + ((size_t)(row >> 6) * 3 + ((row & 63) - 61)) * 1536 + (col - BQ)) = o;
      }
    }
  }
}

DI void qx_tile(const Params& p, int l, int rt, int ct, char* smem) {
  const int r0 = rt * 256, c0 = ct * 256;
  float* rsv = (float*)(smem + 147456);
  {
    const int row = ltid() >> 1, half = ltid() & 1;
    const uint4* src = (const uint4*)(p.P() + (size_t)(r0 + row) * PC + CQ + half * 128);
    float ss = 0.f;
    for (int i = 0; i < 16; ++i) {
      uint4 v = src[i];
      float a;
      a = bflo(v.x); ss += a * a; a = bfhi(v.x); ss += a * a; a = bflo(v.y); ss += a * a; a = bfhi(v.y); ss += a * a;
      a = bflo(v.z); ss += a * a; a = bfhi(v.z); ss += a * a; a = bflo(v.w); ss += a * a; a = bfhi(v.w); ss += a * a;
    }
    ss += __shfl_xor(ss, 1);
    if (!half) rsv[row] = rsqrtf(ss * (1.f / 256.f) + EPS);
  }
  f32x4 acc[4][8];
  zero_acc<4, 8>(acc);
  gemm_core<4, 8>(p.P() + (size_t)r0 * PC + CQ, PC, p.wqx(l) + (size_t)c0 * 256, 256, 256, acc, smem);
  u16* QX = (u16*)p.out;
  EPI_LOOP(4, 8) {
    const int rl = wm_ * 64 + mi * 16 + fr_, col = c0 + wn_ * 128 + ni * 16 + fq_ * 4;
    const float rs = rsv[rl];
    uint2 o;
    o.x = pack2(acc[mi][ni][0] * rs, acc[mi][ni][1] * rs); o.y = pack2(acc[mi][ni][2] * rs, acc[mi][ni][3] * rs);
    *(uint2*)(QX + (size_t)(r0 + rl) * 1536 + col) = o;
  }
  __syncthreads();
}

DI void phase_merge(const Params& p, int l, char* smem) {
  const u16* QX = (const u16*)p.out;
  int rt, ct;
  for (int it = 0; next_tile(it, 256, 8, 8, 8, rt, ct); ++it) {
    const int r0 = rt * 128, c0 = ct * 128;
    f32x4 mg[2][4];
    zero_acc<2, 4>(mg);
#pragma unroll 1
    for (int j = 0; j < 3; ++j) {
      if ((j == 0 && !EN_A) || (j == 1 && !EN_B) || (j == 2 && !EN_C)) continue;
      const u16* Ab; const u16* Wb; int lda, K;
      if (j == 0) { Ab = p.P() + (size_t)r0 * PC + AQ; lda = PC; Wb = p.wbra(l) + (size_t)c0 * 512; K = 512; }
      else if (j == 1) { Ab = p.P() + (size_t)r0 * PC + BZ; lda = PC; Wb = p.wbrb(l) + (size_t)c0 * 512; K = 512; }
      else { Ab = QX + (size_t)r0 * 1536; lda = 1536; Wb = p.wbrc(l) + (size_t)c0 * 1024; K = 1024; }
      f32x4 g[2][4];
      zero_acc<2, 4>(g);
      gemm_core<2, 4>(p.XB() + (size_t)r0 * 1024, 1024, p.win(l) + (size_t)(GATES + j * 1024 + c0) * 1024, 1024, 1024, g, smem);
      const float* bg = p.b_gate + l * 3072 + j * 1024;
      {
        EPI_LOOP(2, 4) {
          const int col = c0 + wn_ * 64 + ni * 16 + fq_ * 4;
          const float4 bb = *(const float4*)(bg + col);
          g[mi][ni][0] = sigmoidf_(g[mi][ni][0] + bb.x);
          g[mi][ni][1] = sigmoidf_(g[mi][ni][1] + bb.y);
          g[mi][ni][2] = sigmoidf_(g[mi][ni][2] + bb.z);
          g[mi][ni][3] = sigmoidf_(g[mi][ni][3] + bb.w);
        }
      }
      f32x4 br[2][4];
      zero_acc<2, 4>(br);
      gemm_core<2, 4>(Ab, lda, Wb, K, K, br, smem);
#pragma unroll
      for (int mi = 0; mi < 2; ++mi)
#pragma unroll
        for (int ni = 0; ni < 4; ++ni) mg[mi][ni] += g[mi][ni] * br[mi][ni];
    }
    EPI_LOOP(2, 4) {
      const int row = r0 + wm_ * 32 + mi * 16 + fr_, col = c0 + wn_ * 64 + ni * 16 + fq_ * 4;
      uint2 o;
      o.x = pack2(mg[mi][ni][0], mg[mi][ni][1]); o.y = pack2(mg[mi][ni][2], mg[mi][ni][3]);
      *(uint2*)(p.MERGED() + (size_t)row * 1024 + col) = o;
    }
  }
}

DI void phase_resgemm(const Params& p, const u16* A, int lda, const u16* W, int K, char* smem) {
  int rt, ct;
  for (int it = 0; next_tile(it, 128, 4, 16, 4, rt, ct); ++it) {
    const int r0 = rt * 256, c0 = ct * 256;
    f32x4 acc[4][8];
    zero_acc<4, 8>(acc);
    gemm_core<4, 8>(A + (size_t)r0 * lda, lda, W + (size_t)c0 * K, K, K, acc, smem);
    EPI_LOOP(4, 8) {
      const int row = r0 + wm_ * 64 + mi * 16 + fr_, col = c0 + wn_ * 128 + ni * 16 + fq_ * 4;
      const uint2 xb = *(const uint2*)(p.XB() + (size_t)row * 1024 + col);
      float4 o;
      o.x = DN_ALPHA * bflo(xb.x) + acc[mi][ni][0]; o.y = DN_ALPHA * bfhi(xb.x) + acc[mi][ni][1];
      o.z = DN_ALPHA * bflo(xb.y) + acc[mi][ni][2]; o.w = DN_ALPHA * bfhi(xb.y) + acc[mi][ni][3];
      *(float4*)(p.out + (size_t)row * 1024 + col) = o;
    }
  }
}

DI void phase_ff1(const Params& p, int l, char* smem) {
  int rt, ct;
  for (int it = 0; next_tile(it, 128, 16, 8, 8, rt, ct); ++it) {
    const int r0 = rt * 256, c0 = ct * 256;
    f32x4 acc[4][8];
    zero_acc<4, 8>(acc);
    gemm_core<4, 8>(p.XB() + (size_t)r0 * 1024, 1024, p.wf1(l) + (size_t)c0 * 1024, 1024, 1024, acc, smem);
    EPI_LOOP(4, 8) {
      const int row = r0 + wm_ * 64 + mi * 16 + fr_, col = c0 + wn_ * 128 + ni * 16 + fq_ * 4;
      float a0 = fmaxf(acc[mi][ni][0], 0.f), a1 = fmaxf(acc[mi][ni][1], 0.f), a2 = fmaxf(acc[mi][ni][2], 0.f), a3 = fmaxf(acc[mi][ni][3], 0.f);
      uint2 o;
      o.x = pack2(a0 * a0, a1 * a1); o.y = pack2(a2 * a2, a3 * a3);
      *(uint2*)(p.P() + (size_t)row * 4096 + col) = o;
    }
  }
}

DI void dsa_kprep_item(const Params& p, int l, int it) {
  const int ln = ltid() & 63, w = ltid() >> 6;
  const float g0 = p.c_kv_norm_g[l * 128 + 2 * ln], g1 = p.c_kv_norm_g[l * 128 + 2 * ln + 1];
  const float kg = p.c_kidx_g[l * 64 + ln], kb = p.c_kidx_b[l * 64 + ln];
  for (int i = 0; i < 8; ++i) {
    const size_t tok = (size_t)it * 64 + w * 8 + i;
    const u16* pr = p.P() + tok * PC;
    const u32 v = *(const u32*)(pr + CKVc + 2 * ln);
    const float a = bflo(v), b = bfhi(v);
    float ss = a * a + b * b;
#pragma unroll
    for (int o = 32; o; o >>= 1) ss += __shfl_xor(ss, o);
    const float rs = rsqrtf(ss * (1.f / 128.f) + EPS);
    *(u32*)(p.CKV() + tok * 128 + 2 * ln) = pack2(a * rs * g0, b * rs * g1);
    const float k = bf2f(pr[CKI + ln]);
    float s = k;
#pragma unroll
    for (int o = 32; o; o >>= 1) s += __shfl_xor(s, o);
    const float mu = s * (1.f / 64.f);
    float q = (k - mu) * (k - mu);
#pragma unroll
    for (int o = 32; o; o >>= 1) q += __shfl_xor(q, o);
    p.KIDX()[tok * 64 + ln] = f2bf((k - mu) * rsqrtf(q * (1.f / 64.f) + EPS) * kg + kb);
    if (ln < 8) p.WIDX()[tok * 8 + ln] = bf2f(pr[CWI + ln]) * 0.04419417382f;
  }
}

DI void gdn_prep_item(const Params& p, int l, int it, char* smem0) {
  const int half_ = ltid() >> 8;
  const int cidx = it >> 1, h = (it & 1) * 2 + half_, n = cidx & 255;
  const size_t t0g = (size_t)cidx * 64;
  char* smem = smem0 + half_ * 69632;
  const int tid = ltid() & 255, ln = tid & 63, w = tid >> 6;
  char* qs = smem;
  char* ks = smem + 17408;
  char* vs = smem + 2 * 17408;
  float* Lm = (float*)(smem + 3 * 17408);
  float* gcs = Lm + 4096;
  float* bts = gcs + 64;
  float* egs = bts + 64;
  u16* proj = p.P();
  {
    const int c = tid & 127, rh = tid >> 7;
#pragma unroll
    for (int part = 0; part < 3; ++part) {
      const int colg = BQ + part * 512 + h * 128 + c, wch = part * 512 + h * 128 + c;
      const float* cw = p.b_conv_w + (size_t)l * 4 * 1536 + wch;
      const float w0 = cw[0], w1 = cw[1536], w2 = cw[2 * 1536], w3 = cw[3 * 1536];
      float xm3, xm2, xm1;
      if (rh == 0) {
        if (n == 0) { xm3 = xm2 = xm1 = 0.f; }
        else {
          const u16* hp = p.HALO() + ((size_t)(cidx - 1) * 3) * 1536 + (colg - BQ);
          xm3 = bf2f(hp[0]); xm2 = bf2f(hp[1536]); xm1 = bf2f(hp[2 * 1536]);
        }
      } else {
        xm3 = bf2f(proj[(t0g + 29) * PC + colg]); xm2 = bf2f(proj[(t0g + 30) * PC + colg]); xm1 = bf2f(proj[(t0g + 31) * PC + colg]);
      }
      char* dst = (part == 0 ? qs : (part == 1 ? ks : vs));
      for (int i = 0; i < 32; ++i) {
        const int r = rh * 32 + i;
        const float x = bf2f(proj[(t0g + r) * PC + colg]);
        const float y = w0 * xm3 + w1 * xm2 + w2 * xm1 + w3 * x;
        xm3 = xm2; xm2 = xm1; xm1 = x;
        *(u16*)(dst + r * 272 + c * 2) = f2bf(siluf_(y));
      }
    }
  }
  if (w == 0) {
    const float a = bf2f(proj[(t0g + ln) * PC + BA + h]) + p.b_dt_bias[l * 4 + h];
    const float ea = __expf(a);
    const float sp = (a > 20.f) ? a : ((ea < 0.01f) ? ea * (1.f - ea * (0.5f - ea * 0.333333333f)) : __logf(1.f + ea));
    float g = -__expf(p.b_a_log[l * 4 + h]) * sp;
#pragma unroll
    for (int o = 1; o < 64; o <<= 1) { float t = __shfl_up(g, o); if (ln >= o) g += t; }
    gcs[ln] = g;
    egs[ln] = __expf(g);
    bts[ln] = sigmoidf_(bf2f(proj[(t0g + ln) * PC + BB + h]));
  }
  __syncthreads();
  {
    const int row = tid >> 2, qr = tid & 3;
#pragma unroll
    for (int part = 0; part < 2; ++part) {
      char* base = (part == 0 ? qs : ks) + row * 272 + qr * 64;
      uint4 v[4];
      float ss = 0.f;
#pragma unroll
      for (int i = 0; i < 4; ++i) {
        v[i] = *(uint4*)(base + i * 16);
        float a;
        a = bflo(v[i].x); ss += a * a; a = bfhi(v[i].x); ss += a * a; a = bflo(v[i].y); ss += a * a; a = bfhi(v[i].y); ss += a * a;
        a = bflo(v[i].z); ss += a * a; a = bfhi(v[i].z); ss += a * a; a = bflo(v[i].w); ss += a * a; a = bfhi(v[i].w); ss += a * a;
      }
      ss += __shfl_xor(ss, 1);
      ss += __shfl_xor(ss, 2);
      const float rs = rsqrtf(ss + EPS) * (part == 0 ? 0.08838834764f : 1.f);
#pragma unroll
      for (int i = 0; i < 4; ++i) {
        uint4 o;
        o.x = pack2(bflo(v[i].x) * rs, bfhi(v[i].x) * rs); o.y = pack2(bflo(v[i].y) * rs, bfhi(v[i].y) * rs);
        o.z = pack2(bflo(v[i].z) * rs, bfhi(v[i].z) * rs); o.w = pack2(bflo(v[i].w) * rs, bfhi(v[i].w) * rs);
        *(uint4*)(base + i * 16) = o;
      }
    }
  }
  __syncthreads();
  {
    const int fr = ln & 15, fq = ln >> 4;
    f32x4 kk[4], qk[4];
#pragma unroll
    for (int nt = 0; nt < 4; ++nt) { kk[nt] = f32x4{0, 0, 0, 0}; qk[nt] = f32x4{0, 0, 0, 0}; }
#pragma unroll
    for (int s = 0; s < 4; ++s) {
      const bf16x8 ak = *(const bf16x8*)(ks + (16 * w + fr) * 272 + (32 * s + 8 * fq) * 2);
      const bf16x8 aq = *(const bf16x8*)(qs + (16 * w + fr) * 272 + (32 * s + 8 * fq) * 2);
#pragma unroll
      for (int nt = 0; nt < 4; ++nt) {
        const bf16x8 bk = *(const bf16x8*)(ks + (16 * nt + fr) * 272 + (32 * s + 8 * fq) * 2);
        kk[nt] = mfma16(ak, bk, kk[nt]);
        qk[nt] = mfma16(aq, bk, qk[nt]);
      }
    }
#pragma unroll
    for (int nt = 0; nt < 4; ++nt)
#pragma unroll
      for (int jj = 0; jj < 4; ++jj) {
        const int i = 16 * w + 4 * fq + jj, j = 16 * nt + fr;
        const float dec = (i >= j) ? __expf(gcs[i] - gcs[j]) : 0.f;
        Lm[i * 64 + j] = (i > j) ? bts[i] * kk[nt][jj] * dec : 0.f;
        p.ATT()[(t0g + i) * 256 + h * 64 + j] = f2bf((i >= j) ? qk[nt][jj] * dec : 0.f);
      }
  }
  __syncthreads();
  {
    const int c = tid;
    const bool isu = c < 128;
    const char* src = isu ? (vs + c * 2) : (ks + (c - 128) * 2);
    const float wsel = isu ? 0.f : 1.f;
    float x[64];
#pragma unroll
    for (int i = 0; i < 64; ++i) {
      float a = bf2f(*(const u16*)(src + i * 272)) * bts[i] * fmaf(egs[i] - 1.f, wsel, 1.f);
      const float* Lr = Lm + i * 64;
#pragma unroll
      for (int j = 0; j < i; ++j) a -= Lr[j] * x[j];
      x[i] = a;
      asm volatile("" ::: "memory");
    }
    if (isu) {
      u32 pk[32];
#pragma unroll
      for (int pos = 0; pos < 64; pos += 2) {
        const int hh = pos >> 5, Tt = (pos >> 4) & 1, ii = pos & 15;
        const int r0 = 32 * Tt + (ii & 3) + 8 * (ii >> 2) + 4 * hh;
        const int i1 = ii + 1;
        const int r1 = 32 * Tt + (i1 & 3) + 8 * (i1 >> 2) + 4 * hh;
        pk[pos >> 1] = pack2(x[r0], x[r1]);
      }
      char* dst = (char*)proj + ((t0g + (c >> 1)) * PC + BV + h * 128) * 2 + (c & 1) * 128;
#pragma unroll
      for (int i = 0; i < 8; ++i) *(uint4*)(dst + i * 16) = uint4{pk[4 * i], pk[4 * i + 1], pk[4 * i + 2], pk[4 * i + 3]};
    } else {
#pragma unroll
      for (int i = 0; i < 64; ++i) proj[(t0g + i) * PC + BK_ + h * 128 + (c - 128)] = f2bf(x[i]);
    }
  }
  {
    const float glast = gcs[63];
#pragma unroll
    for (int i = 0; i < 4; ++i) {
      const int piece = tid + 256 * i, row = piece >> 4, ch = piece & 15;
      const uint4 v = *(const uint4*)(qs + row * 272 + ch * 16);
      const float e = egs[row];
      uint4 o;
      o.x = pack2(bflo(v.x) * e, bfhi(v.x) * e); o.y = pack2(bflo(v.y) * e, bfhi(v.y) * e);
      o.z = pack2(bflo(v.z) * e, bfhi(v.z) * e); o.w = pack2(bflo(v.w) * e, bfhi(v.w) * e);
      *(uint4*)(proj + (t0g + row) * PC + BQ + h * 128 + ch * 8) = o;
    }
    const int d = tid & 127, half = tid >> 7;
    u32 pk[16];
#pragma unroll
    for (int i = 0; i < 16; ++i) {
      const int r0 = half * 32 + 2 * i;
      const float a = bf2f(*(const u16*)(ks + r0 * 272 + d * 2)) * __expf(glast - gcs[r0]);
      const float b = bf2f(*(const u16*)(ks + (r0 + 1) * 272 + d * 2)) * __expf(glast - gcs[r0 + 1]);
      pk[i] = pack2(a, b);
    }
    u16* dst = p.KDT() + (((size_t)cidx * 4 + h) * 128 + d) * 64 + half * 32;
#pragma unroll
    for (int i = 0; i < 4; ++i) *(uint4*)(dst + i * 8) = uint4{pk[4 * i], pk[4 * i + 1], pk[4 * i + 2], pk[4 * i + 3]};
    if (tid == 0) p.GL()[cidx * 4 + h] = egs[63];
  }
  __syncthreads();
}

DI void gdn_rec_item(const Params& p, int l, int bhp, char* smem0) {
  const int half_ = ltid() >> 8;
  const int bh = bhp * 2 + half_;
  const int b = bh >> 2, h = bh & 3;
  char* smem = smem0 + half_ * 61440;
  const int tid = ltid() & 255, ln = tid & 63, w = tid >> 6, hh = ln >> 5, c31 = ln & 31;
  char* Wm = smem;
  char* Qd = smem + 16896;
  char* Kt = smem + 2 * 16896;
  char* At = Kt + 17408;
  float* Ot = (float*)smem;
  u16* proj = p.P();
  f32x16 S[4];
#pragma unroll
  for (int i = 0; i < 4; ++i)
#pragma unroll
    for (int j = 0; j < 16; ++j) S[i][j] = 0.f;
  const int e = 32 * w + c31;
  const float* ng = p.b_norm_g + l * 128;
  for (int n = 0; n < 256; ++n) {
    const int cidx = b * 256 + n;
    const size_t t0g = (size_t)cidx * 64;
    __syncthreads();
#pragma unroll
    for (int i = 0; i < 4; ++i) {
      const int piece = tid + 256 * i, row = piece >> 4, ch = piece & 15;
      const uint4 a = *(const uint4*)(proj + (t0g + row) * PC + BK_ + h * 128 + ch * 8);
      const uint4 q = *(const uint4*)(proj + (t0g + row) * PC + BQ + h * 128 + ch * 8);
      *(uint2*)(Wm + row * 264 + ch * 16) = uint2{a.x, a.y}; *(uint2*)(Wm + row * 264 + ch * 16 + 8) = uint2{a.z, a.w};
      *(uint2*)(Qd + row * 264 + ch * 16) = uint2{q.x, q.y}; *(uint2*)(Qd + row * 264 + ch * 16 + 8) = uint2{q.z, q.w};
      const int row2 = piece >> 3, ch2 = piece & 7;
      const uint4 k = *(const uint4*)(p.KDT() + (((size_t)cidx * 4 + h) * 128 + row2) * 64 + ch2 * 8);
      *(uint2*)(Kt + row2 * 136 + ch2 * 16) = uint2{k.x, k.y}; *(uint2*)(Kt + row2 * 136 + ch2 * 16 + 8) = uint2{k.z, k.w};
    }
#pragma unroll
    for (int i = 0; i < 2; ++i) {
      const int piece = tid + 256 * i, row = piece >> 3, ch = piece & 7;
      const uint4 a = *(const uint4*)(p.ATT() + (t0g + row) * 256 + h * 64 + ch * 8);
      *(uint2*)(At + row * 136 + ch * 16) = uint2{a.x, a.y}; *(uint2*)(At + row * 136 + ch * 16 + 8) = uint2{a.z, a.w};
    }
    f32x16 vn[2];
    {
      const uint4* up = (const uint4*)((const char*)proj + ((t0g + (e >> 1)) * PC + BV + h * 128) * 2 + (e & 1) * 128 + hh * 64);
#pragma unroll
      for (int i = 0; i < 4; ++i) {
        const uint4 u = up[i];
        const int Tt = i >> 1, o = (i & 1) * 8;
        vn[Tt][o + 0] = bflo(u.x); vn[Tt][o + 1] = bfhi(u.x); vn[Tt][o + 2] = bflo(u.y); vn[Tt][o + 3] = bfhi(u.y);
        vn[Tt][o + 4] = bflo(u.z); vn[Tt][o + 5] = bfhi(u.z); vn[Tt][o + 6] = bflo(u.w); vn[Tt][o + 7] = bfhi(u.w);
      }
    }
    const float gl = p.GL()[cidx * 4 + h];
    __syncthreads();
    bf16x8 sp[4][2];
#pragma unroll
    for (int Tt = 0; Tt < 4; ++Tt) { sp[Tt][0] = pack8(S[Tt], 0); sp[Tt][1] = pack8(S[Tt], 1); }
    f32x16 ws[2], o[2];
#pragma unroll
    for (int i = 0; i < 2; ++i)
#pragma unroll
      for (int j = 0; j < 16; ++j) { ws[i][j] = 0.f; o[i][j] = 0.f; }
#pragma unroll
    for (int Tt = 0; Tt < 4; ++Tt)
#pragma unroll
      for (int s = 0; s < 2; ++s) {
        const int kb = 32 * Tt + 16 * s;
#pragma unroll
        for (int Tc = 0; Tc < 2; ++Tc) {
          ws[Tc] = mfma32(afrag_perm(Wm, 32 * Tc + c31, 264, kb, hh), sp[Tt][s], ws[Tc]);
          o[Tc] = mfma32(afrag_perm(Qd, 32 * Tc + c31, 264, kb, hh), sp[Tt][s], o[Tc]);
        }
      }
#pragma unroll
    for (int Tc = 0; Tc < 2; ++Tc)
#pragma unroll
      for (int j = 0; j < 16; ++j) vn[Tc][j] -= ws[Tc][j];
    bf16x8 vp[2][2];
#pragma unroll
    for (int Tc = 0; Tc < 2; ++Tc) { vp[Tc][0] = pack8(vn[Tc], 0); vp[Tc][1] = pack8(vn[Tc], 1); }
#pragma unroll
    for (int s = 0; s < 2; ++s) {
      o[0] = mfma32(afrag_perm(At, c31, 136, 16 * s, hh), vp[0][s], o[0]);
      o[1] = mfma32(afrag_perm(At, 32 + c31, 136, 16 * s, hh), vp[0][s], o[1]);
      o[1] = mfma32(afrag_perm(At, 32 + c31, 136, 32 + 16 * s, hh), vp[1][s], o[1]);
    }
#pragma unroll
    for (int Tt = 0; Tt < 4; ++Tt)
#pragma unroll
      for (int j = 0; j < 16; ++j) S[Tt][j] *= gl;
#pragma unroll
    for (int Tc = 0; Tc < 2; ++Tc)
#pragma unroll
      for (int s = 0; s < 2; ++s)
#pragma unroll
        for (int Tt = 0; Tt < 4; ++Tt)
          S[Tt] = mfma32(afrag_perm(Kt, 32 * Tt + c31, 136, 32 * Tc + 16 * s, hh), vp[Tc][s], S[Tt]);
    __syncthreads();
#pragma unroll
    for (int Tc = 0; Tc < 2; ++Tc)
#pragma unroll
      for (int j = 0; j < 16; ++j) Ot[(32 * Tc + crow(j, hh)) * 132 + e] = o[Tc][j];
    __syncthreads();
    {
      const int row = tid >> 2, qr = tid & 3;
      const float* orow = Ot + row * 132 + qr * 32;
      float ov[32];
      float ss = 0.f;
#pragma unroll
      for (int i = 0; i < 8; ++i) {
        const float4 v = *(const float4*)(orow + 4 * i);
        ov[4 * i] = v.x; ov[4 * i + 1] = v.y; ov[4 * i + 2] = v.z; ov[4 * i + 3] = v.w;
        ss += v.x * v.x + v.y * v.y + v.z * v.z + v.w * v.w;
      }
      ss += __shfl_xor(ss, 1);
      ss += __shfl_xor(ss, 2);
      const float rs = rsqrtf(ss * (1.f / 128.f) + EPS);
      u16* zp = proj + (t0g + row) * PC + BZ + h * 128 + qr * 32;
#pragma unroll
      for (int i = 0; i < 4; ++i) {
        const uint4 z = *(const uint4*)(zp + 8 * i);
        const float* gg = ng + qr * 32 + 8 * i;
        uint4 r;
        r.x = pack2(ov[8 * i + 0] * rs * gg[0] * siluf_(bflo(z.x)), ov[8 * i + 1] * rs * gg[1] * siluf_(bfhi(z.x)));
        r.y = pack2(ov[8 * i + 2] * rs * gg[2] * siluf_(bflo(z.y)), ov[8 * i + 3] * rs * gg[3] * siluf_(bfhi(z.y)));
        r.z = pack2(ov[8 * i + 4] * rs * gg[4] * siluf_(bflo(z.z)), ov[8 * i + 5] * rs * gg[5] * siluf_(bfhi(z.z)));
        r.w = pack2(ov[8 * i + 6] * rs * gg[6] * siluf_(bflo(z.w)), ov[8 * i + 7] * rs * gg[7] * siluf_(bfhi(z.w)));
        *(uint4*)(zp + 8 * i) = r;
      }
    }
  }
  __syncthreads();
}

DI void diff_item(const Params& p, int l, int qt, int bh, char* smem) {
  const int b = bh >> 2, h = bh & 3;
  const int tid = ltid(), ln = tid & 63, w = tid >> 6, hh = ln >> 5, c31 = ln & 31;
  const int st = w & 3, c = w >> 2;
  const size_t tokbase = (size_t)b * T;
  const int qb = qt * 128 + 32 * st + c31;
  u16* proj = p.P();
  bf16x8 qf[4];
  {
    const u16* qrow = proj + (tokbase + qb) * PC + AQ + h * 128 + c * 64 + 8 * hh;
#pragma unroll
    for (int s = 0; s < 4; ++s) qf[s] = *(const bf16x8*)(qrow + 16 * s);
  }
  f32x16 O[4];
#pragma unroll
  for (int i = 0; i < 4; ++i)
#pragma unroll
    for (int j = 0; j < 16; ++j) O[i][j] = 0.f;
  float mrun = -INFINITY, lrun = 0.f;
  const float sc = 0.125f * 1.44269504089f;
  char* Ks = smem;
  char* Vs = smem + 17408;
  uint4 rk0, rk1, rv0, rv1;
  const int srow = tid >> 4, sch = tid & 15;
#define DLOAD1(i, kt)                                                                \
  {                                                                                  \
    const u16* base = proj + (tokbase + (kt) * 64 + srow + 32 * i) * PC + h * 128 + sch * 8; \
    rk##i = *(const uint4*)(base + AK);                                              \
    rv##i = *(const uint4*)(base + AV);                                              \
  }
#define DLOAD(kt) { DLOAD1(0, kt) DLOAD1(1, kt) }
#define DSTORE1(i)                                                \
  *(uint4*)(Ks + (srow + 32 * i) * 272 + sch * 16) = rk##i;       \
  *(uint4*)(Vs + (srow + 32 * i) * 320 + sch * 16) = rv##i;
  const int nkt = 2 * qt + 2;
  DLOAD(0);
  for (int kt = 0; kt < nkt; ++kt) {
    __syncthreads();
    DSTORE1(0) DSTORE1(1)
    __syncthreads();
    if (kt + 1 < nkt) { DLOAD(kt + 1); }
    if (kt * 64 > qt * 128 + 32 * st + 31) continue;
    f32x16 sa[2];
#pragma unroll
    for (int k2 = 0; k2 < 2; ++k2) {
#pragma unroll
      for (int j = 0; j < 16; ++j) sa[k2][j] = 0.f;
#pragma unroll
      for (int s = 0; s < 4; ++s)
        sa[k2] = mfma32(*(const bf16x8*)(Ks + (32 * k2 + c31) * 272 + (c * 64 + 16 * s + 8 * hh) * 2), qf[s], sa[k2]);
    }
    if (kt >= 2 * qt) {
#pragma unroll
      for (int k2 = 0; k2 < 2; ++k2)
#pragma unroll
        for (int j = 0; j < 16; ++j)
          if (kt * 64 + 32 * k2 + crow(j, hh) > qb) sa[k2][j] = -INFINITY;
    }
    float tmax = sa[0][0];
#pragma unroll
    for (int k2 = 0; k2 < 2; ++k2)
#pragma unroll
      for (int j = 0; j < 16; ++j) tmax = fmaxf(tmax, sa[k2][j]);
    tmax = fmaxf(tmax, __shfl_xor(tmax, 32));
    const float mnew = fmaxf(mrun, tmax * sc);
    const float alpha = __builtin_amdgcn_exp2f(mrun - mnew);
    mrun = mnew;
    float psum = 0.f;
#pragma unroll
    for (int k2 = 0; k2 < 2; ++k2)
#pragma unroll
      for (int j = 0; j < 16; ++j) { const float pv = __builtin_amdgcn_exp2f(sa[k2][j] * sc - mnew); sa[k2][j] = pv; psum += pv; }
    lrun = lrun * alpha + psum;
    if (__any(alpha != 1.f)) {
#pragma unroll
      for (int i = 0; i < 4; ++i)
#pragma unroll
        for (int j = 0; j < 16; ++j) O[i][j] *= alpha;
    }
#pragma unroll
    for (int k2 = 0; k2 < 2; ++k2)
#pragma unroll
      for (int s2 = 0; s2 < 2; ++s2) {
        const bf16x8 pp = pack8(sa[k2], s2);
#pragma unroll
        for (int mt = 0; mt < 4; ++mt) O[mt] = mfma32(trfrag(Vs, 320, 32 * k2 + 16 * s2, 32 * mt, ln), pp, O[mt]);
      }
  }
#undef DLOAD
#undef DLOAD1
#undef DSTORE1
  __syncthreads();
  const float ltot = lrun + __shfl_xor(lrun, 32);
  const float inv = 1.f / ltot;
  float* xch = (float*)smem + st * 32 * 132;
  if (c == 1) {
#pragma unroll
    for (int mt = 0; mt < 4; ++mt)
#pragma unroll
      for (int i4 = 0; i4 < 4; ++i4)
        *(float4*)(xch + c31 * 132 + 32 * mt + 8 * i4 + 4 * hh) =
            float4{O[mt][4 * i4] * inv, O[mt][4 * i4 + 1] * inv, O[mt][4 * i4 + 2] * inv, O[mt][4 * i4 + 3] * inv};
  }
  __syncthreads();
  if (c == 0) {
    const float lam = p.LAM()[l], oml = 1.f - p.LAM()[2 + l];
    float ss = 0.f;
#pragma unroll
    for (int mt = 0; mt < 4; ++mt)
#pragma unroll
      for (int i4 = 0; i4 < 4; ++i4) {
        const float4 o1 = *(const float4*)(xch + c31 * 132 + 32 * mt + 8 * i4 + 4 * hh);
        float d;
        d = O[mt][4 * i4] * inv - lam * o1.x; O[mt][4 * i4] = d; ss += d * d;
        d = O[mt][4 * i4 + 1] * inv - lam * o1.y; O[mt][4 * i4 + 1] = d; ss += d * d;
        d = O[mt][4 * i4 + 2] * inv - lam * o1.z; O[mt][4 * i4 + 2] = d; ss += d * d;
        d = O[mt][4 * i4 + 3] * inv - lam * o1.w; O[mt][4 * i4 + 3] = d; ss += d * d;
      }
    ss += __shfl_xor(ss, 32);
    const float rs = rsqrtf(ss * (1.f / 128.f) + EPS) * oml;
    const float* sg = p.a_subln_g + l * 128;
    int qb_e = qb;
    asm volatile("" : "+v"(qb_e));
    u16* orow = proj + (tokbase + qb_e) * PC + AQ + h * 128;
#pragma unroll
    for (int mt = 0; mt < 4; ++mt)
#pragma unroll
      for (int i4 = 0; i4 < 4; ++i4) {
        const int dv = 32 * mt + 8 * i4 + 4 * hh;
        const float4 gg = *(const float4*)(sg + dv);
        uint2 o;
        o.x = pack2(O[mt][4 * i4] * rs * gg.x, O[mt][4 * i4 + 1] * rs * gg.y);
        o.y = pack2(O[mt][4 * i4 + 2] * rs * gg.z, O[mt][4 * i4 + 3] * rs * gg.w);
        *(uint2*)(orow + dv) = o;
      }
  }
  __syncthreads();
}

DI u32 mono_key(float f) { u32 u = __float_as_uint(f); return (u & 0x80000000u) ? ~u : (u | 0x80000000u); }

DI void dsa_prune(u32* ck, u16* ci, int& cnt, u32& tau, int ln) {
  u32 kv[8];
  u16 iv[8];
#pragma unroll
  for (int j = 0; j < 8; ++j) {
    const int pos = ln + 64 * j;
    const bool vd = pos < cnt;
    kv[j] = vd ? ck[pos] : 0u;
    iv[j] = vd ? ci[pos] : (u16)0;
  }
  u32 t = 0;
  for (int bit = 31; bit >= 0; --bit) {
    const u32 cand = t | (1u << bit);
    int c = 0;
#pragma unroll
    for (int j = 0; j < 8; ++j) c += __popcll(__ballot(kv[j] >= cand));
    if (c >= 256) t = cand;
  }
  int ngt = 0;
#pragma unroll
  for (int j = 0; j < 8; ++j) ngt += __popcll(__ballot(kv[j] > t));
  const int need = 256 - ngt;
  int run_gt = 0, run_eq = 0;
#pragma unroll
  for (int j = 0; j < 8; ++j) {
    const bool gt = kv[j] > t, eq = (kv[j] == t) && (t != 0u);
    const u64 mg = __ballot(gt), me = __ballot(eq);
    const int pg = run_gt + (int)lane_lt_cnt(mg), pe = run_eq + (int)lane_lt_cnt(me);
    if (gt) { ck[pg] = kv[j]; ci[pg] = iv[j]; }
    else if (eq && pe < need) { ck[ngt + pe] = kv[j]; ci[ngt + pe] = iv[j]; }
    run_gt += __popcll(mg);
    run_eq += __popcll(me);
  }
  cnt = 256;
  tau = t;
}

DI void dsa_item(const Params& p, int l, int tile32, int b, char* smem) {
  const int tid = ltid(), ln = tid & 63, w = tid >> 6, hh = ln >> 5, c31 = ln & 31;
  const int t0 = tile32 * 32 + 4 * w;
  const size_t tokbase = (size_t)b * T;
  u16* QX = (u16*)p.out;
  char* wl = smem + w * 14336;
  u32* ckey = (u32*)wl;
  u16* cidx = (u16*)(wl + 8192);
  u16* ifin = (u16*)(wl + 12288);
  char* tile = wl;
  int cnt[4] = {0, 0, 0, 0};
  u32 tau[4] = {0u, 0u, 0u, 0u};
  {
    bf16x8 qa[4];
    {
      const int r = c31, ql = 2 * ((r >> 2) & 1) + (r >> 4), hd = 4 * ((r >> 3) & 1) + (r & 3);
      const u16* qrow = QX + (tokbase + t0 + ql) * 1536 + 1024 + hd * 64 + 8 * hh;
#pragma unroll
      for (int s = 0; s < 4; ++s) qa[s] = *(const bf16x8*)(qrow + 16 * s);
    }
    float wq[16];
    {
      const float4* wi = (const float4*)(p.WIDX() + (tokbase + t0 + 2 * hh) * 8);
#pragma unroll
      for (int i = 0; i < 4; ++i) { const float4 v = wi[i]; wq[4 * i] = v.x; wq[4 * i + 1] = v.y; wq[4 * i + 2] = v.z; wq[4 * i + 3] = v.w; }
    }
    const int qpos0 = t0 + 2 * hh;
    const int nkt = ((t0 + 3) >> 5) + 1;
    bf16x8 kn[4];
    {
      const u16* krow = p.KIDX() + (tokbase + c31) * 64 + 8 * hh;
#pragma unroll
      for (int s = 0; s < 4; ++s) kn[s] = *(const bf16x8*)(krow + 16 * s);
    }
    for (int kt = 0; kt < nkt; ++kt) {
#pragma unroll
      for (int qq = 0; qq < 4; ++qq)
        if (cnt[qq] > 480) dsa_prune(ckey + qq * 512, cidx + qq * 512, cnt[qq], tau[qq], ln);
      const int key = kt * 32 + c31;
      bf16x8 kc[4];
#pragma unroll
      for (int s = 0; s < 4; ++s) kc[s] = kn[s];
      if (kt + 1 < nkt) {
        const u16* krow = p.KIDX() + (tokbase + key + 32) * 64 + 8 * hh;
#pragma unroll
        for (int s = 0; s < 4; ++s) kn[s] = *(const bf16x8*)(krow + 16 * s);
      }
      f32x16 acc;
#pragma unroll
      for (int j = 0; j < 16; ++j) acc[j] = 0.f;
#pragma unroll
      for (int s = 0; s < 4; ++s) acc = mfma32(qa[s], kc[s], acc);
      float s0 = 0.f, s1 = 0.f;
#pragma unroll
      for (int i = 0; i < 8; ++i) { s0 += wq[i] * fmaxf(acc[i], 0.f); s1 += wq[8 + i] * fmaxf(acc[8 + i], 0.f); }
      const u32 k0 = mono_key(s0), k1 = mono_key(s1);
#pragma unroll
      for (int qq = 0; qq < 4; ++qq) {
        const u32 kv = (qq & 1) ? k1 : k0;
        const int qp = qpos0 + (qq & 1);
        const bool cnd = (hh == (qq >> 1)) && (key <= qp) && (kv > tau[qq]);
        const u64 mask = __ballot(cnd);
        if (mask) {
          const int pos = cnt[qq] + (int)lane_lt_cnt(mask);
          if (cnd) { ckey[qq * 512 + pos] = kv; cidx[qq * 512 + pos] = (u16)key; }
          cnt[qq] += __popcll(mask);
        }
      }
    }
#pragma unroll
    for (int qq = 0; qq < 4; ++qq) {
      if (cnt[qq] > 256) dsa_prune(ckey + qq * 512, cidx + qq * 512, cnt[qq], tau[qq], ln);
#pragma unroll
      for (int j = 0; j < 4; ++j) {
        const int pos = ln + 64 * j;
        ifin[qq * 256 + pos] = (pos < cnt[qq]) ? cidx[qq * 512 + pos] : (u16)0;
      }
    }
  }
  const float sc = 0.125f * 1.44269504089f;
#pragma unroll 1
  for (int qq = 0; qq < 4; ++qq) {
    const int nsel = (qq == 0) ? cnt[0] : (qq == 1) ? cnt[1] : (qq == 2) ? cnt[2] : cnt[3];
    const size_t tq = tokbase + t0 + qq;
    bf16x8 qf[8];
    {
      const u16* qab = QX + tq * 1536 + (c31 & 7) * 128 + 8 * hh;
#pragma unroll
      for (int s = 0; s < 8; ++s) qf[s] = *(const bf16x8*)(qab + 16 * s);
    }
    f32x16 O[4];
#pragma unroll
    for (int i = 0; i < 4; ++i)
#pragma unroll
      for (int j = 0; j < 16; ++j) O[i][j] = 0.f;
    float mrun = -INFINITY, lrun = 0.f;
    const int ntile = (nsel + 31) >> 5;
    for (int tt = 0; tt < ntile; ++tt) {
#pragma unroll
      for (int i = 0; i < 8; ++i) {
        const int piece = ln + 64 * i, row = piece >> 4, ch = piece & 15;
        const int idx = ifin[qq * 256 + tt * 32 + row];
        const uint4 v = *(const uint4*)(p.CKV() + (tokbase + idx) * 128 + ch * 8);
        *(uint4*)(tile + row * 272 + ch * 16) = v;
      }
      __builtin_amdgcn_fence(__ATOMIC_RELEASE, "wavefront");
      f32x16 sa;
#pragma unroll
      for (int j = 0; j < 16; ++j) sa[j] = 0.f;
#pragma unroll
      for (int s = 0; s < 8; ++s) sa = mfma32(*(const bf16x8*)(tile + c31 * 272 + (16 * s + 8 * hh) * 2), qf[s], sa);
      float tmax = -INFINITY;
#pragma unroll
      for (int j = 0; j < 16; ++j) {
        if (tt * 32 + crow(j, hh) >= nsel) sa[j] = -INFINITY;
        tmax = fmaxf(tmax, sa[j]);
      }
      tmax = fmaxf(tmax, __shfl_xor(tmax, 32));
      const float mnew = fmaxf(mrun, tmax * sc);
      const float alpha = __builtin_amdgcn_exp2f(mrun - mnew);
      mrun = mnew;
      float psum = 0.f;
#pragma unroll
      for (int j = 0; j < 16; ++j) { const float pv = __builtin_amdgcn_exp2f(sa[j] * sc - mnew); sa[j] = pv; psum += pv; }
      lrun = lrun * alpha + psum;
#pragma unroll
      for (int i = 0; i < 4; ++i)
#pragma unroll
        for (int j = 0; j < 16; ++j) O[i][j] *= alpha;
#pragma unroll
      for (int s2 = 0; s2 < 2; ++s2) {
        const bf16x8 pp = pack8(sa, s2);
#pragma unroll
        for (int mt = 0; mt < 4; ++mt) O[mt] = mfma32(trfrag(tile, 272, 16 * s2, 32 * mt, ln), pp, O[mt]);
      }
      __builtin_amdgcn_fence(__ATOMIC_ACQ_REL, "wavefront");
    }
    const float ltot = lrun + __shfl_xor(lrun, 32);
    const float inv = 1.f / ltot;
    if (c31 < 8) {
      u16* orow = QX + tq * 1536 + c31 * 128;
#pragma unroll
      for (int mt = 0; mt < 4; ++mt)
#pragma unroll
        for (int i4 = 0; i4 < 4; ++i4) {
          uint2 o;
          o.x = pack2(O[mt][4 * i4] * inv, O[mt][4 * i4 + 1] * inv);
          o.y = pack2(O[mt][4 * i4 + 2] * inv, O[mt][4 * i4 + 3] * inv);
          *(uint2*)(orow + 32 * mt + 8 * i4 + 4 * hh) = o;
        }
    }
  }
  __syncthreads();
}

DI void phase_prep(const Params& p, int l, char* smem) {
  if (EN_C) {
    int rt, ct;
    for (int it = 0; next_tile(it, 128, 6, 32, 2, rt, ct); ++it) qx_tile(p, l, rt, ct, smem);
  }
  const int n_gdn = EN_B ? 1024 : 0, n_kp = EN_C ? 512 : 0;
  for (int t = lbid(); t < n_gdn + n_kp; t += lgdim()) {
    if (t < n_gdn) gdn_prep_item(p, l, t, smem);
    else dsa_kprep_item(p, l, t - n_gdn);
  }
}

DI int xcc_id() { return (int)(__builtin_amdgcn_s_getreg((3 << 11) | 20) & 0x7u); }

DI void phase_mixers(const Params& p, int l, char* smem) {
  __shared__ int s_item;
  const int x0 = xcc_id();
  int xs = x0;
  for (;;) {
    __syncthreads();
    {
      int qi = l * 8 + xs;
      asm volatile("" : "+s"(qi));
      if (ltid() == 0) s_item = (int)atomicAdd(p.CNT() + qi, 1u);
    }
    __syncthreads();
    const int it = s_item;
    const int n_gdn = (EN_B && xs < 4) ? 1 : 0;
    if (it >= n_gdn + 256) {
      xs = (xs + 1) & 7;
      if (xs == x0) break;
      continue;
    }
    const int x = xs;
    if (it < n_gdn) gdn_rec_item(p, l, x, smem);
    else {
      const int j = it - n_gdn, k = j >> 1;
      if ((j & 1) == 0) { if (EN_A) diff_item(p, l, 127 - k, x, smem); }
      else { if (EN_C) dsa_item(p, l, 511 - (k * 4 + (x >> 1)), x & 1, smem); }
    }
  }
}

DI void run_phase(const Params& p, int ph, char* smem) {
  if (ph == 0) { phase0(p, smem); return; }
  const int l = (ph - 1) / 9, s = (ph - 1) % 9;
  switch (s) {
    case 0: phase_inproj(p, l, smem); break;
    case 1: phase_prep(p, l, smem); break;
    case 2: phase_mixers(p, l, smem); break;
    case 3: phase_merge(p, l, smem); break;
    case 4: phase_resgemm(p, p.MERGED(), 1024, p.wo(l), 1024, smem); break;
    case 5: ln_phase(p.out, p.ln1_g + l * 1024, p.ln1_b + l * 1024, p.XB(), nullptr); break;
    case 6: phase_ff1(p, l, smem); break;
    case 7: phase_resgemm(p, p.P(), 4096, p.wf2(l), 4096, smem); break;
    case 8: ln_phase(p.out, p.ln2_g + l * 1024, p.ln2_b + l * 1024, (l == 1) ? nullptr : p.XB(), (l == 1) ? p.out : nullptr); break;
  }
}

constexpr int N_PHASES = 19;

#if COOP
DI void gsync() { cg::this_grid().sync(); }
__global__ void __launch_bounds__(512, 1) mega_kernel(Params p, int ph_begin, int ph_end) {
  __shared__ __attribute__((aligned(16))) char smem[SMEM_BYTES];
  for (int r = 0; r < REP0; ++r) { phase0(p, smem); gsync(); }
#pragma unroll 1
  for (int l = 0; l < 2; ++l) {
    for (int r = 0; r < REP1; ++r) { phase_inproj(p, l, smem); gsync(); }
    phase_prep(p, l, smem);
    gsync();
    phase_mixers(p, l, smem);
    gsync();
    for (int r = 0; r < REP2; ++r) { phase_merge(p, l, smem); gsync(); }
    for (int r = 0; r < REP3; ++r) { phase_resgemm(p, p.MERGED(), 1024, p.wo(l), 1024, smem); gsync(); }
    for (int r = 0; r < REP4; ++r) { ln_phase(p.out, p.ln1_g + l * 1024, p.ln1_b + l * 1024, p.XB(), nullptr); gsync(); }
    for (int r = 0; r < REP5; ++r) { phase_ff1(p, l, smem); gsync(); }
    for (int r = 0; r < REP6; ++r) { phase_resgemm(p, p.P(), 4096, p.wf2(l), 4096, smem); gsync(); }
    ln_phase(p.out, p.ln2_g + l * 1024, p.ln2_b + l * 1024, (l == 1) ? nullptr : p.XB(), (l == 1) ? p.out : nullptr);
    if (l == 0) gsync();
  }
}
#else
__global__ void __launch_bounds__(512, 1) mega_kernel(Params p, int ph_begin, int ph_end) {
  __shared__ __attribute__((aligned(16))) char smem[SMEM_BYTES];
  for (int ph = ph_begin; ph < ph_end; ++ph) run_phase(p, ph, smem);
}
#endif

extern "C" void kernel_launch(void* const* d_in, const int* in_sizes, int n_in, void* d_out, int out_size,
                              void* d_ws, size_t ws_size, hipStream_t stream) {
  static int grid_blocks = 0;
  if (!grid_blocks) {
    int dev = 0, cus = 0, per_cu = 0;
    hipGetDevice(&dev);
    hipDeviceGetAttribute(&cus, hipDeviceAttributeMultiprocessorCount, dev);
    hipOccupancyMaxActiveBlocksPerMultiprocessor(&per_cu, mega_kernel, NTHR, 0);
    if (per_cu < 1) per_cu = 1;
    if (per_cu > 1) per_cu = 1;
    grid_blocks = cus * per_cu;
  }
  Params p{};
  const float** pf = (const float**)&p;
  for (int i = 0; i < 27; ++i) pf[i] = (const float*)d_in[i];
  p.out = (float*)d_out;
  p.ws = (char*)d_ws;
  if (WS_NEED > ws_size) { fprintf(stderr, "workspace too small: need %zu have %zu\n", (size_t)WS_NEED, ws_size); return; }
#if COOP
  int b = 0, e = N_PHASES;
  void* args[] = {&p, &b, &e};
  hipError_t err = hipLaunchCooperativeKernel((void*)mega_kernel, dim3(grid_blocks), dim3(NTHR), args, 0, stream);
  if (err != hipSuccess) fprintf(stderr, "cooperative launch failed: %s (grid %d)\n", hipGetErrorString(err), grid_blocks);
#else
  for (int ph = 0; ph < N_PHASES; ++ph) mega_kernel<<<grid_blocks, NTHR, 0, stream>>>(p, ph, ph + 1);
#endif
}
```

```cpp
#include <hip/hip_runtime.h>
#include <hip/hip_cooperative_groups.h>
#include <cstdio>
namespace cg = cooperative_groups;

#ifndef COOP
#define COOP 1
#endif
#ifndef REP0
#define REP0 1
#define REP1 1
#define REP2 1
#define REP3 1
#define REP4 1
#define REP5 1
#define REP6 1
#endif
#ifndef DUP_GDN
#define DUP_GDN 1
#endif
#ifndef DUP_DIFF
#define DUP_DIFF 1
#endif
#ifndef DUP_DSA1
#define DUP_DSA1 1
#endif
#ifndef DUP_DSA2
#define DUP_DSA2 1
#endif
#ifndef EN_A
#define EN_A 1
#endif
#ifndef EN_B
#define EN_B 1
#endif
#ifndef EN_C
#define EN_C 1
#endif

typedef unsigned short u16;
typedef unsigned int u32;
typedef unsigned long long u64;
using bf16x8 = __attribute__((ext_vector_type(8))) short;
using s16x4 = __attribute__((ext_vector_type(4))) short;
using f32x4 = __attribute__((ext_vector_type(4))) float;
using f32x16 = __attribute__((ext_vector_type(16))) float;
#define DI __device__ __forceinline__

constexpr int NT = 32768, T = 16384, PC = 4048;
constexpr int AQ = 0, AK = 512, AV = 1024, BQ = 1536, BK_ = 2048, BV = 2560, BZ = 3072, BA = 3584, BB = 3588,
              CQ = 3592, CKVc = 3848, CKI = 3976, CWI = 4040, GATES = 4048;
constexpr float EPS = 1e-6f;
constexpr float DN_ALPHA = 1.41421356237f;
constexpr int NTHR = 512;
constexpr int SMEM_BYTES = 153600 + 512;

constexpr size_t al256(size_t x) { return (x + 255) & ~(size_t)255; }
constexpr int LDX = 1088, LDH = 4160, LDQ = 1600;
constexpr int KP1024 = 1088, KP512 = 576, KP256 = 320, KP4096 = 4160;
constexpr size_t SZ_WIN = al256((size_t)7120 * KP1024 * 2), SZ_WQX = al256((size_t)1536 * KP256 * 2), SZ_WBR = al256((size_t)1024 * KP512 * 2),
                 SZ_WBRC = al256((size_t)1024 * KP1024 * 2), SZ_WO = al256((size_t)1024 * KP1024 * 2), SZ_WF1 = al256((size_t)4096 * KP1024 * 2), SZ_WF2 = al256((size_t)1024 * KP4096 * 2);
constexpr size_t O_WIN = 0, O_WQX = O_WIN + SZ_WIN, O_WBRA = O_WQX + SZ_WQX, O_WBRB = O_WBRA + SZ_WBR, O_WBRC = O_WBRB + SZ_WBR,
                 O_WO = O_WBRC + SZ_WBRC, O_WF1 = O_WO + SZ_WO, O_WF2 = O_WF1 + SZ_WF1, LAYER_W = O_WF2 + SZ_WF2;
constexpr size_t O_P = 2 * LAYER_W, O_XB = O_P + (size_t)NT * LDH * 2, O_M = O_XB + (size_t)NT * LDX * 2;
constexpr size_t O_KDT = O_M, O_ATT = O_KDT + 33554432, O_HALO = O_ATT + 16777216, O_KIDX = O_HALO + 4718592, O_CKV = O_KIDX + 4194304,
                 O_MEND = O_CKV + 8388608 + 4194304;
constexpr size_t O_WIDX = O_MEND, O_GL = O_WIDX + (size_t)NT * 8 * 4, O_LAM = O_GL + 8192, O_CNT = O_LAM + 256, WS_NEED = O_CNT + 256;
static_assert(O_MEND - O_M >= (size_t)NT * LDX * 2, "merged alias");

struct Params {
  const float *x, *w_in, *b_gate, *a_lambda, *a_subln_g, *b_conv_w, *b_a_log, *b_dt_bias, *b_norm_g,
      *c_q_norm_g, *c_kv_norm_g, *c_kidx_g, *c_kidx_b, *c_w_uq, *c_w_qidx, *c_w_uk, *c_w_uv,
      *w_branch_a, *w_branch_b, *w_branch_c, *w_o, *ln1_g, *ln1_b, *w_ff1, *w_ff2, *ln2_g, *ln2_b;
  float* out;
  char* ws;
  __device__ __forceinline__ u16* win(int l) const { return (u16*)(ws + l * LAYER_W + O_WIN); }
  __device__ __forceinline__ u16* wqx(int l) const { return (u16*)(ws + l * LAYER_W + O_WQX); }
  __device__ __forceinline__ u16* wbra(int l) const { return (u16*)(ws + l * LAYER_W + O_WBRA); }
  __device__ __forceinline__ u16* wbrb(int l) const { return (u16*)(ws + l * LAYER_W + O_WBRB); }
  __device__ __forceinline__ u16* wbrc(int l) const { return (u16*)(ws + l * LAYER_W + O_WBRC); }
  __device__ __forceinline__ u16* wo(int l) const { return (u16*)(ws + l * LAYER_W + O_WO); }
  __device__ __forceinline__ u16* wf1(int l) const { return (u16*)(ws + l * LAYER_W + O_WF1); }
  __device__ __forceinline__ u16* wf2(int l) const { return (u16*)(ws + l * LAYER_W + O_WF2); }
  __device__ __forceinline__ u16* P() const { return (u16*)(ws + O_P); }
  __device__ __forceinline__ u16* XB() const { return (u16*)(ws + O_XB); }
  __device__ __forceinline__ u16* KDT() const { return (u16*)(ws + O_KDT); }
  __device__ __forceinline__ u16* ATT() const { return (u16*)(ws + O_ATT); }
  __device__ __forceinline__ u16* HALO() const { return (u16*)(ws + O_HALO); }
  __device__ __forceinline__ u16* KIDX() const { return (u16*)(ws + O_KIDX); }
  __device__ __forceinline__ u16* CKV() const { return (u16*)(ws + O_CKV); }
  __device__ __forceinline__ u16* MERGED() const { return (u16*)(ws + O_M); }
  __device__ __forceinline__ float* WIDX() const { return (float*)(ws + O_WIDX); }
  __device__ __forceinline__ float* GL() const { return (float*)(ws + O_GL); }
  __device__ __forceinline__ float* LAM() const { return (float*)(ws + O_LAM); }
  __device__ __forceinline__ u32* CNT() const { return (u32*)(ws + O_CNT); }
};

DI int lbid() { int b = blockIdx.x; asm volatile("" : "+s"(b)); return b; }
DI int lgdim() { int b = gridDim.x; asm volatile("" : "+s"(b)); return b; }
DI int ltid() { int t = threadIdx.x; asm volatile("" : "+v"(t)); return t; }
DI u16 f2bf(float x) { u32 u = __float_as_uint(x); u += 0x7fffu + ((u >> 16) & 1u); return (u16)(u >> 16); }
DI float bf2f(u16 h) { return __uint_as_float(((u32)h) << 16); }
DI u32 pack2(float a, float b) { return (u32)f2bf(a) | ((u32)f2bf(b) << 16); }
DI float bflo(u32 v) { return __uint_as_float(v << 16); }
DI float bfhi(u32 v) { return __uint_as_float(v & 0xffff0000u); }
DI f32x4 mfma16(bf16x8 a, bf16x8 b, f32x4 c) { return __builtin_amdgcn_mfma_f32_16x16x32_bf16(a, b, c, 0, 0, 0); }
DI f32x16 mfma32(bf16x8 a, bf16x8 b, f32x16 c) { return __builtin_amdgcn_mfma_f32_32x32x16_bf16(a, b, c, 0, 0, 0); }
DI int crow(int i, int hh) { return (i & 3) + 8 * (i >> 2) + 4 * hh; }
DI float sigmoidf_(float x) { return 1.f / (1.f + __expf(-x)); }
DI float siluf_(float x) { return x / (1.f + __expf(-x)); }
DI u32 lane_lt_cnt(u64 m) { return __builtin_amdgcn_mbcnt_hi((u32)(m >> 32), __builtin_amdgcn_mbcnt_lo((u32)m, 0)); }

DI bf16x8 pack8(const f32x16& x, int s) {
  u32 p0, p1, p2, p3;
  if (s == 0) {
    asm volatile("v_cvt_pk_bf16_f32 %0, %4, %5\n\tv_cvt_pk_bf16_f32 %1, %6, %7\n\tv_cvt_pk_bf16_f32 %2, %8, %9\n\tv_cvt_pk_bf16_f32 %3, %10, %11\n\ts_nop 1"
                 : "=&v"(p0), "=&v"(p1), "=&v"(p2), "=&v"(p3)
                 : "v"(x[0]), "v"(x[1]), "v"(x[2]), "v"(x[3]), "v"(x[4]), "v"(x[5]), "v"(x[6]), "v"(x[7]));
  } else {
    asm volatile("v_cvt_pk_bf16_f32 %0, %4, %5\n\tv_cvt_pk_bf16_f32 %1, %6, %7\n\tv_cvt_pk_bf16_f32 %2, %8, %9\n\tv_cvt_pk_bf16_f32 %3, %10, %11\n\ts_nop 1"
                 : "=&v"(p0), "=&v"(p1), "=&v"(p2), "=&v"(p3)
                 : "v"(x[8]), "v"(x[9]), "v"(x[10]), "v"(x[11]), "v"(x[12]), "v"(x[13]), "v"(x[14]), "v"(x[15]));
  }
  typedef u32 u32x4 __attribute__((ext_vector_type(4)));
  u32x4 v = {p0, p1, p2, p3};
  return __builtin_bit_cast(bf16x8, v);
}
DI bf16x8 afrag_perm(const char* base, int row, int stride, int kbase, int hh) {
  const char* pr = base + row * stride + (kbase + 4 * hh) * 2;
  s16x4 lo = *(const s16x4*)pr;
  s16x4 hi = *(const s16x4*)(pr + 16);
  return __builtin_shufflevector(lo, hi, 0, 1, 2, 3, 4, 5, 6, 7);
}
DI bf16x8 trfrag(const char* img, int stride, int krow0, int col0, int ln) {
  const int hh = ln >> 5, chalf = (ln >> 4) & 1, q4 = (ln & 15) >> 2, p4 = ln & 3;
  u32 a = (u32)(size_t)(img + (krow0 + 4 * hh + q4) * stride + (col0 + 16 * chalf + 4 * p4) * 2);
  s16x4 lo, hi;
  asm volatile("ds_read_b64_tr_b16 %0, %2\n\tds_read_b64_tr_b16 %1, %3\n\ts_waitcnt lgkmcnt(0)"
               : "=&v"(lo), "=&v"(hi) : "v"(a), "v"(a + 8 * stride) : "memory");
  return __builtin_shufflevector(lo, hi, 0, 1, 2, 3, 4, 5, 6, 7);
}

template <int STRIDE>
DI void trfrag4(const char* img, int krow0, int ln, bf16x8 (&f)[4]) {
  const int hh = ln >> 5, chalf = (ln >> 4) & 1, q4 = (ln & 15) >> 2, p4 = ln & 3;
  const u32 a = (u32)(size_t)(img + (krow0 + 4 * hh + q4) * STRIDE + (16 * chalf + 4 * p4) * 2);
  s16x4 l0, h0, l1, h1, l2, h2, l3, h3;
  asm volatile(
      "ds_read_b64_tr_b16 %0, %8\n\tds_read_b64_tr_b16 %1, %8 offset:%9\n\t"
      "ds_read_b64_tr_b16 %2, %8 offset:64\n\tds_read_b64_tr_b16 %3, %8 offset:%10\n\t"
      "ds_read_b64_tr_b16 %4, %8 offset:128\n\tds_read_b64_tr_b16 %5, %8 offset:%11\n\t"
      "ds_read_b64_tr_b16 %6, %8 offset:192\n\tds_read_b64_tr_b16 %7, %8 offset:%12\n\t"
      "s_waitcnt lgkmcnt(0)"
      : "=&v"(l0), "=&v"(h0), "=&v"(l1), "=&v"(h1), "=&v"(l2), "=&v"(h2), "=&v"(l3), "=&v"(h3)
      : "v"(a), "i"(8 * STRIDE), "i"(8 * STRIDE + 64), "i"(8 * STRIDE + 128), "i"(8 * STRIDE + 192)
      : "memory");
  f[0] = __builtin_shufflevector(l0, h0, 0, 1, 2, 3, 4, 5, 6, 7);
  f[1] = __builtin_shufflevector(l1, h1, 0, 1, 2, 3, 4, 5, 6, 7);
  f[2] = __builtin_shufflevector(l2, h2, 0, 1, 2, 3, 4, 5, 6, 7);
  f[3] = __builtin_shufflevector(l3, h3, 0, 1, 2, 3, 4, 5, 6, 7);
}

template <int MT, int NT>
DI void gemm_core(const u16* __restrict__ A, int lda, const u16* __restrict__ B, int ldb, int K,
                  f32x4 (&acc)[MT][NT], char* smem) {
  constexpr int BM = 64 * MT, BN = 32 * NT;
  constexpr int ASZ = BM * 144, BSZ = BN * 144, BUF = ASZ + BSZ;
  constexpr int NA = BM / 64, NB = BN / 64;
  const int tid = ltid(), l = tid & 63, w = tid >> 6, wm = w >> 1, wn = w & 1;
  const int fr = l & 15, fq = l >> 4;
  uint4 ra0, ra1, ra2, ra3, rb0, rb1, rb2, rb3;
  const int nk = K >> 6;
  const int srow = tid >> 3, sch = tid & 7;
#define GL1(i, kt)                                                                                        \
  if (NA > i) ra##i = *(const uint4*)(A + (size_t)(srow + 64 * i) * lda + (kt) * 64 + sch * 8);           \
  if (NB > i) rb##i = *(const uint4*)(B + (size_t)(srow + 64 * i) * ldb + (kt) * 64 + sch * 8);
#define GLOAD(kt) { GL1(0, kt) GL1(1, kt) GL1(2, kt) GL1(3, kt) }
#define SS1(i)                                                                   \
  if (NA > i) *(uint4*)(as_ + (srow + 64 * i) * 144 + sch * 16) = ra##i;         \
  if (NB > i) *(uint4*)(bs_ + (srow + 64 * i) * 144 + sch * 16) = rb##i;
#define SSTORE(buf)                              \
  {                                              \
    char* as_ = smem + (buf) * BUF;              \
    char* bs_ = as_ + ASZ;                       \
    SS1(0) SS1(1) SS1(2) SS1(3)                  \
  }
  GLOAD(0);
  SSTORE(0);
  __syncthreads();
#pragma unroll 1
  for (int kt = 0; kt < nk; ++kt) {
    if (kt + 1 < nk) GLOAD(kt + 1);
    const char* as = smem + (kt & 1) * BUF;
    const char* bs = as + ASZ;
#pragma unroll
    for (int kk = 0; kk < 2; ++kk) {
      bf16x8 xf[MT], wf[NT];
#pragma unroll
      for (int mi = 0; mi < MT; ++mi)
        xf[mi] = *(const bf16x8*)(as + (wm * (MT * 16) + mi * 16 + fr) * 144 + (kk * 32 + fq * 8) * 2);
#pragma unroll
      for (int ni = 0; ni < NT; ++ni)
        wf[ni] = *(const bf16x8*)(bs + (wn * (NT * 16) + ni * 16 + fr) * 144 + (kk * 32 + fq * 8) * 2);
#pragma unroll
      for (int mi = 0; mi < MT; ++mi)
#pragma unroll
        for (int ni = 0; ni < NT; ++ni) acc[mi][ni] = mfma16(wf[ni], xf[mi], acc[mi][ni]);
    }
    if (kt + 1 < nk) SSTORE((kt + 1) & 1);
    __syncthreads();
  }
#undef GLOAD
#undef SSTORE
#undef GL1
#undef SS1
}
template <int MT, int NT>
DI void zero_acc(f32x4 (&acc)[MT][NT]) {
#pragma unroll
  for (int i = 0; i < MT; ++i)
#pragma unroll
    for (int j = 0; j < NT; ++j) acc[i][j] = f32x4{0.f, 0.f, 0.f, 0.f};
}


DI bool next_tile(int it, int RT, int CT, int PR, int PCc, int& rt, int& ct) {
  const int bid = lbid(), x = bid & 7, j = bid >> 3, J = lgdim() >> 3;
  const int u = j + it * J;
  const int pcols = CT / PCc, npatch = (RT / PR) * pcols;
  const int pid = (u >> 6) * 8 + x;
  if (pid >= npatch) return false;
  const int w = u & 63, pr = pid / pcols, pc = pid - pr * pcols;
  rt = pr * PR + w / PCc;
  ct = pc * PCc + w % PCc;
  return true;
}
DI void transpose_job(const float* __restrict__ src, int K, int N, u16* __restrict__ dst, int ldd, const float* kscale, char* smem) {
  float(*tile)[65] = (float(*)[65])smem;
  const int ntn = (N + 63) >> 6, ntk = K >> 6, tid = ltid();
  for (int t = lbid(); t < ntn * ntk; t += lgdim()) {
    const int tk = t / ntn, tn = t % ntn, k0 = tk * 64, n0 = tn * 64;
    {
      const int n = tid & 63, kb = tid >> 6;
      for (int i = 0; i < 8; ++i) {
        const int k = kb + 8 * i;
        float v = (n0 + n < N) ? src[(size_t)(k0 + k) * N + n0 + n] : 0.f;
        if (kscale) v *= kscale[k0 + k];
        tile[k][n] = v;
      }
    }
    __syncthreads();
    {
      const int k = tid & 63, nb = tid >> 6;
      for (int i = 0; i < 8; ++i) {
        const int n = nb + 8 * i;
        if (n0 + n < N) dst[(size_t)(n0 + n) * ldd + k0 + k] = f2bf(tile[k][n]);
      }
    }
    __syncthreads();
  }
}

DI void phase0(const Params& p, char* smem) {
  const size_t gtid = (size_t)lbid() * NTHR + ltid(), gsz = (size_t)lgdim() * NTHR;
  for (int l = 0; l < 2; ++l) {
    transpose_job(p.w_in + (size_t)l * 1024 * 7120, 1024, 7120, p.win(l), KP1024, nullptr, smem);
    transpose_job(p.w_branch_a + (size_t)l * 512 * 1024, 512, 1024, p.wbra(l), KP512, nullptr, smem);
    transpose_job(p.w_branch_b + (size_t)l * 512 * 1024, 512, 1024, p.wbrb(l), KP512, nullptr, smem);
    transpose_job(p.w_o + (size_t)l * 1024 * 1024, 1024, 1024, p.wo(l), KP1024, nullptr, smem);
    transpose_job(p.w_ff1 + (size_t)l * 1024 * 4096, 1024, 4096, p.wf1(l), KP1024, nullptr, smem);
    transpose_job(p.w_ff2 + (size_t)l * 4096 * 1024, 4096, 1024, p.wf2(l), KP4096, nullptr, smem);
    transpose_job(p.c_w_qidx + (size_t)l * 256 * 512, 256, 512, p.wqx(l) + 1024 * KP256, KP256, p.c_q_norm_g + l * 256, smem);
    {
      const float* uq = p.c_w_uq + (size_t)l * 256 * 512;
      const float* uk = p.c_w_uk + (size_t)l * 128 * 512;
      const float* g = p.c_q_norm_g + l * 256;
      for (size_t e = gtid; e < 1024 * 256; e += gsz) {
        const int n = (int)(e >> 8), k = (int)(e & 255), h = n >> 7, r2 = n & 127;
        const float4* a = (const float4*)(uq + (k * 8 + h) * 64);
        const float4* b = (const float4*)(uk + (r2 * 8 + h) * 64);
        float s = 0.f;
        for (int d = 0; d < 16; ++d) { float4 x = a[d], y = b[d]; s += x.x * y.x + x.y * y.y + x.z * y.z + x.w * y.w; }
        p.wqx(l)[(size_t)n * KP256 + k] = f2bf(s * g[k]);
      }
    }
    {
      const float* uv = p.c_w_uv + (size_t)l * 128 * 512;
      const float* bc = p.w_branch_c + (size_t)l * 512 * 1024;
      for (size_t e = gtid; e < 1024 * 256; e += gsz) {
        const int k = (int)(e >> 8), n4 = (int)(e & 255) * 4, h = k >> 7, r = k & 127;
        const float* a = uv + (r * 8 + h) * 64;
        const float* b = bc + (size_t)(h * 64) * 1024 + n4;
        float4 acc4 = float4{0.f, 0.f, 0.f, 0.f};
#pragma unroll 8
        for (int d = 0; d < 64; ++d) {
          const float4 v = *(const float4*)(b + (size_t)d * 1024);
          const float ad = a[d];
          acc4.x += ad * v.x; acc4.y += ad * v.y; acc4.z += ad * v.z; acc4.w += ad * v.w;
        }
        u16* dst = p.wbrc(l) + (size_t)n4 * KP1024 + k;
        dst[0] = f2bf(acc4.x); dst[KP1024] = f2bf(acc4.y); dst[2 * KP1024] = f2bf(acc4.z); dst[3 * KP1024] = f2bf(acc4.w);
      }
    }
  }
  for (size_t e = gtid; e < (size_t)NT * 1024 / 8; e += gsz) {
    const float4 a = ((const float4*)p.x)[2 * e], b = ((const float4*)p.x)[2 * e + 1];
    uint4 o;
    o.x = pack2(a.x, a.y); o.y = pack2(a.z, a.w); o.z = pack2(b.x, b.y); o.w = pack2(b.z, b.w);
    *(uint4*)(p.XB() + (e >> 7) * LDX + (e & 127) * 8) = o;
  }
  if (gtid < 2) {
    const int l = (int)gtid;
    const float* lp = p.a_lambda + l * 256;
    float s1 = 0.f, s2 = 0.f;
    for (int i = 0; i < 64; ++i) { s1 += lp[i] * lp[64 + i]; s2 += lp[128 + i] * lp[192 + i]; }
    const float lam_init = 0.8f - 0.6f * expf(-0.3f * l);
    p.LAM()[l] = expf(s1) - expf(s2) + lam_init;
    p.LAM()[2 + l] = lam_init;
    for (int i = 0; i < 8; ++i) p.CNT()[l * 8 + i] = 0;
  }
}

DI void ln_phase(const float* S, const float* __restrict__ g, const float* __restrict__ b, u16* XBo, float* fout) {
  const int l = ltid() & 63;
  const int wave = lbid() * 8 + (ltid() >> 6), nw = lgdim() * 8;
  for (int row = wave; row < NT; row += nw) {
    float4 v[4];
    float s = 0.f;
#pragma unroll
    for (int i = 0; i < 4; ++i) { v[i] = *(const float4*)(S + (size_t)row * 1024 + i * 256 + l * 4); s += v[i].x + v[i].y + v[i].z + v[i].w; }
#pragma unroll
    for (int o = 32; o; o >>= 1) s += __shfl_xor(s, o);
    const float mu = s * (1.f / 1024.f);
    float q = 0.f;
#pragma unroll
    for (int i = 0; i < 4; ++i) { float a = v[i].x - mu, bb = v[i].y - mu, c = v[i].z - mu, d = v[i].w - mu; q += a * a + bb * bb + c * c + d * d; }
#pragma unroll
    for (int o = 32; o; o >>= 1) q += __shfl_xor(q, o);
    const float rs = rsqrtf(q * (1.f / 1024.f) + EPS);
#pragma unroll
    for (int i = 0; i < 4; ++i) {
      const int c = i * 256 + l * 4;
      const float4 gg = *(const float4*)(g + c), bb = *(const float4*)(b + c);
      float4 y;
      y.x = (v[i].x - mu) * rs * gg.x + bb.x; y.y = (v[i].y - mu) * rs * gg.y + bb.y;
      y.z = (v[i].z - mu) * rs * gg.z + bb.z; y.w = (v[i].w - mu) * rs * gg.w + bb.w;
      if (fout) *(float4*)(fout + (size_t)row * 1024 + c) = y;
      if (XBo) { uint2 o; o.x = pack2(y.x, y.y); o.y = pack2(y.z, y.w); *(uint2*)(XBo + (size_t)row * LDX + c) = o; }
    }
  }
}

#define EPI_LOOP(MT_, NT_)                                                \
  const int l_ = ltid() & 63, w_ = ltid() >> 6;                           \
  const int wm_ = w_ >> 1, wn_ = w_ & 1, fr_ = l_ & 15, fq_ = l_ >> 4;    \
  _Pragma("unroll") for (int mi = 0; mi < MT_; ++mi)                      \
  _Pragma("unroll") for (int ni = 0; ni < NT_; ++ni)

DI void phase_inproj(const Params& p, int l, char* smem) {
  int rt, ct;
  for (int it = 0; next_tile(it, 128, 16, 8, 8, rt, ct); ++it) {
    const int r0 = rt * 256, c0 = ct * 256;
    f32x4 acc[4][8];
    zero_acc<4, 8>(acc);
    gemm_core<4, 8>(p.XB() + (size_t)r0 * LDX, LDX, p.win(l) + (size_t)c0 * KP1024, KP1024, 1024, acc, smem);
    EPI_LOOP(4, 8) {
      const int row = r0 + wm_ * 64 + mi * 16 + fr_, col = c0 + wn_ * 128 + ni * 16 + fq_ * 4;
      if (col < PC) {
        uint2 o;
        o.x = pack2(acc[mi][ni][0], acc[mi][ni][1]); o.y = pack2(acc[mi][ni][2], acc[mi][ni][3]);
        *(uint2*)(p.P() + (size_t)row * PC + col) = o;
        if (col >= BQ && col < BZ && (row & 63) >= 61)
          *(uint2*)(p.HALO() + ((size_t)(row >> 6) * 3 + ((row & 63) - 61)) * 1536 + (col - BQ)) = o;
      }
    }
  }
}

DI void qx_tile(const Params& p, int l, int rt, int ct, char* smem) {
  const int r0 = rt * 256, c0 = ct * 256;
  float* rsv = (float*)(smem + 147456);
  {
    const int row = ltid() >> 1, half = ltid() & 1;
    const uint4* src = (const uint4*)(p.P() + (size_t)(r0 + row) * PC + CQ + half * 128);
    float ss = 0.f;
    for (int i = 0; i < 16; ++i) {
      uint4 v = src[i];
      float a;
      a = bflo(v.x); ss += a * a; a = bfhi(v.x); ss += a * a; a = bflo(v.y); ss += a * a; a = bfhi(v.y); ss += a * a;
      a = bflo(v.z); ss += a * a; a = bfhi(v.z); ss += a * a; a = bflo(v.w); ss += a * a; a = bfhi(v.w); ss += a * a;
    }
    ss += __shfl_xor(ss, 1);
    if (!half) rsv[row] = rsqrtf(ss * (1.f / 256.f) + EPS);
  }
  f32x4 acc[4][8];
  zero_acc<4, 8>(acc);
  gemm_core<4, 8>(p.P() + (size_t)r0 * PC + CQ, PC, p.wqx(l) + (size_t)c0 * KP256, KP256, 256, acc, smem);
  u16* QX = (u16*)p.out;
  EPI_LOOP(4, 8) {
    const int rl = wm_ * 64 + mi * 16 + fr_, col = c0 + wn_ * 128 + ni * 16 + fq_ * 4;
    const float rs = rsv[rl];
    uint2 o;
    o.x = pack2(acc[mi][ni][0] * rs, acc[mi][ni][1] * rs); o.y = pack2(acc[mi][ni][2] * rs, acc[mi][ni][3] * rs);
    *(uint2*)(QX + (size_t)(r0 + rl) * LDQ + col) = o;
  }
  __syncthreads();
}

DI void phase_merge(const Params& p, int l, char* smem) {
  const u16* QX = (const u16*)p.out;
  int rt, ct;
  for (int it = 0; next_tile(it, 256, 8, 8, 8, rt, ct); ++it) {
    const int r0 = rt * 128, c0 = ct * 128;
    f32x4 mg[2][4];
    zero_acc<2, 4>(mg);
#pragma unroll 1
    for (int j = 0; j < 3; ++j) {
      if ((j == 0 && !EN_A) || (j == 1 && !EN_B) || (j == 2 && !EN_C)) continue;
      const u16* Ab; const u16* Wb; int lda, K;
      int ldw;
      if (j == 0) { Ab = p.P() + (size_t)r0 * PC + AQ; lda = PC; Wb = p.wbra(l) + (size_t)c0 * KP512; K = 512; ldw = KP512; }
      else if (j == 1) { Ab = p.P() + (size_t)r0 * PC + BZ; lda = PC; Wb = p.wbrb(l) + (size_t)c0 * KP512; K = 512; ldw = KP512; }
      else { Ab = QX + (size_t)r0 * LDQ; lda = LDQ; Wb = p.wbrc(l) + (size_t)c0 * KP1024; K = 1024; ldw = KP1024; }
      f32x4 g[2][4];
      zero_acc<2, 4>(g);
      gemm_core<2, 4>(p.XB() + (size_t)r0 * LDX, LDX, p.win(l) + (size_t)(GATES + j * 1024 + c0) * KP1024, KP1024, 1024, g, smem);
      const float* bg = p.b_gate + l * 3072 + j * 1024;
      {
        EPI_LOOP(2, 4) {
          const int col = c0 + wn_ * 64 + ni * 16 + fq_ * 4;
          const float4 bb = *(const float4*)(bg + col);
          g[mi][ni][0] = sigmoidf_(g[mi][ni][0] + bb.x);
          g[mi][ni][1] = sigmoidf_(g[mi][ni][1] + bb.y);
          g[mi][ni][2] = sigmoidf_(g[mi][ni][2] + bb.z);
          g[mi][ni][3] = sigmoidf_(g[mi][ni][3] + bb.w);
        }
      }
      f32x4 br[2][4];
      zero_acc<2, 4>(br);
      gemm_core<2, 4>(Ab, lda, Wb, ldw, K, br, smem);
#pragma unroll
      for (int mi = 0; mi < 2; ++mi)
#pragma unroll
        for (int ni = 0; ni < 4; ++ni) mg[mi][ni] += g[mi][ni] * br[mi][ni];
    }
    EPI_LOOP(2, 4) {
      const int row = r0 + wm_ * 32 + mi * 16 + fr_, col = c0 + wn_ * 64 + ni * 16 + fq_ * 4;
      uint2 o;
      o.x = pack2(mg[mi][ni][0], mg[mi][ni][1]); o.y = pack2(mg[mi][ni][2], mg[mi][ni][3]);
      *(uint2*)(p.MERGED() + (size_t)row * LDX + col) = o;
    }
  }
}

DI void phase_resgemm(const Params& p, const u16* A, int lda, const u16* W, int ldw, int K, char* smem) {
  int rt, ct;
  for (int it = 0; next_tile(it, 128, 4, 16, 4, rt, ct); ++it) {
    const int r0 = rt * 256, c0 = ct * 256;
    f32x4 acc[4][8];
    zero_acc<4, 8>(acc);
    gemm_core<4, 8>(A + (size_t)r0 * lda, lda, W + (size_t)c0 * ldw, ldw, K, acc, smem);
    EPI_LOOP(4, 8) {
      const int row = r0 + wm_ * 64 + mi * 16 + fr_, col = c0 + wn_ * 128 + ni * 16 + fq_ * 4;
      const uint2 xb = *(const uint2*)(p.XB() + (size_t)row * LDX + col);
      float4 o;
      o.x = DN_ALPHA * bflo(xb.x) + acc[mi][ni][0]; o.y = DN_ALPHA * bfhi(xb.x) + acc[mi][ni][1];
      o.z = DN_ALPHA * bflo(xb.y) + acc[mi][ni][2]; o.w = DN_ALPHA * bfhi(xb.y) + acc[mi][ni][3];
      *(float4*)(p.out + (size_t)row * 1024 + col) = o;
    }
  }
}

DI void phase_ff1(const Params& p, int l, char* smem) {
  int rt, ct;
  for (int it = 0; next_tile(it, 128, 16, 8, 8, rt, ct); ++it) {
    const int r0 = rt * 256, c0 = ct * 256;
    f32x4 acc[4][8];
    zero_acc<4, 8>(acc);
    gemm_core<4, 8>(p.XB() + (size_t)r0 * LDX, LDX, p.wf1(l) + (size_t)c0 * KP1024, KP1024, 1024, acc, smem);
    EPI_LOOP(4, 8) {
      const int row = r0 + wm_ * 64 + mi * 16 + fr_, col = c0 + wn_ * 128 + ni * 16 + fq_ * 4;
      float a0 = fmaxf(acc[mi][ni][0], 0.f), a1 = fmaxf(acc[mi][ni][1], 0.f), a2 = fmaxf(acc[mi][ni][2], 0.f), a3 = fmaxf(acc[mi][ni][3], 0.f);
      uint2 o;
      o.x = pack2(a0 * a0, a1 * a1); o.y = pack2(a2 * a2, a3 * a3);
      *(uint2*)(p.P() + (size_t)row * LDH + col) = o;
    }
  }
}

DI void dsa_kprep_item(const Params& p, int l, int it) {
  const int ln = ltid() & 63, w = ltid() >> 6;
  const float g0 = p.c_kv_norm_g[l * 128 + 2 * ln], g1 = p.c_kv_norm_g[l * 128 + 2 * ln + 1];
  const float kg = p.c_kidx_g[l * 64 + ln], kb = p.c_kidx_b[l * 64 + ln];
  for (int i = 0; i < 8; ++i) {
    const size_t tok = (size_t)it * 64 + w * 8 + i;
    const u16* pr = p.P() + tok * PC;
    const u32 v = *(const u32*)(pr + CKVc + 2 * ln);
    const float a = bflo(v), b = bfhi(v);
    float ss = a * a + b * b;
#pragma unroll
    for (int o = 32; o; o >>= 1) ss += __shfl_xor(ss, o);
    const float rs = rsqrtf(ss * (1.f / 128.f) + EPS);
    *(u32*)(p.CKV() + tok * 128 + 2 * ln) = pack2(a * rs * g0, b * rs * g1);
    const float k = bf2f(pr[CKI + ln]);
    float s = k;
#pragma unroll
    for (int o = 32; o; o >>= 1) s += __shfl_xor(s, o);
    const float mu = s * (1.f / 64.f);
    float q = (k - mu) * (k - mu);
#pragma unroll
    for (int o = 32; o; o >>= 1) q += __shfl_xor(q, o);
    p.KIDX()[tok * 64 + ln] = f2bf((k - mu) * rsqrtf(q * (1.f / 64.f) + EPS) * kg + kb);
    if (ln < 8) p.WIDX()[tok * 8 + ln] = bf2f(pr[CWI + ln]) * 0.04419417382f;
  }
}

DI void gdn_prep_item(const Params& p, int l, int it, char* smem0) {
  const int half_ = ltid() >> 8;
  const int cidx = it >> 1, h = (it & 1) * 2 + half_, n = cidx & 255;
  const size_t t0g = (size_t)cidx * 64;
  char* smem = smem0 + half_ * 69632;
  const int tid = ltid() & 255, ln = tid & 63, w = tid >> 6;
  char* qs = smem;
  char* ks = smem + 17408;
  char* vs = smem + 2 * 17408;
  float* Lm = (float*)(smem + 3 * 17408);
  float* gcs = Lm + 4096;
  float* bts = gcs + 64;
  float* egs = bts + 64;
  u16* proj = p.P();
  {
    const int c = tid & 127, rh = tid >> 7;
    uint4 st[12];
#pragma unroll
    for (int part = 0; part < 3; ++part)
#pragma unroll
      for (int i = 0; i < 4; ++i) {
        const int piece = tid + 256 * i, row = piece >> 4, ch = piece & 15;
        st[part * 4 + i] = *(const uint4*)(proj + (t0g + row) * PC + BQ + part * 512 + h * 128 + ch * 8);
      }
    float hx[9];
#pragma unroll
    for (int i = 0; i < 9; ++i) hx[i] = 0.f;
    if (rh == 0 && n != 0) {
#pragma unroll
      for (int part = 0; part < 3; ++part) {
        const u16* hp = p.HALO() + ((size_t)(cidx - 1) * 3) * 1536 + part * 512 + h * 128 + c;
        hx[part * 3 + 0] = bf2f(hp[0]); hx[part * 3 + 1] = bf2f(hp[1536]); hx[part * 3 + 2] = bf2f(hp[2 * 1536]);
      }
    }
#pragma unroll
    for (int part = 0; part < 3; ++part)
#pragma unroll
      for (int i = 0; i < 4; ++i) {
        const int piece = tid + 256 * i, row = piece >> 4, ch = piece & 15;
        char* dst = (part == 0 ? qs : (part == 1 ? ks : vs));
        *(uint4*)(dst + row * 272 + ch * 16) = st[part * 4 + i];
      }
    __syncthreads();
    if (rh == 1) {
#pragma unroll
      for (int part = 0; part < 3; ++part) {
        const char* src = (part == 0 ? qs : (part == 1 ? ks : vs));
        hx[part * 3 + 0] = bf2f(*(const u16*)(src + 29 * 272 + c * 2));
        hx[part * 3 + 1] = bf2f(*(const u16*)(src + 30 * 272 + c * 2));
        hx[part * 3 + 2] = bf2f(*(const u16*)(src + 31 * 272 + c * 2));
      }
    }
    __syncthreads();
#pragma unroll
    for (int part = 0; part < 3; ++part) {
      const int wch = part * 512 + h * 128 + c;
      const float* cw = p.b_conv_w + (size_t)l * 4 * 1536 + wch;
      const float w0 = cw[0], w1 = cw[1536], w2 = cw[2 * 1536], w3 = cw[3 * 1536];
      float xm3 = hx[part * 3 + 0], xm2 = hx[part * 3 + 1], xm1 = hx[part * 3 + 2];
      char* dst = (part == 0 ? qs : (part == 1 ? ks : vs));
#pragma unroll 8
      for (int i = 0; i < 32; ++i) {
        const int r = rh * 32 + i;
        u16* px = (u16*)(dst + r * 272 + c * 2);
        const float x = bf2f(*px);
        const float y = w0 * xm3 + w1 * xm2 + w2 * xm1 + w3 * x;
        xm3 = xm2; xm2 = xm1; xm1 = x;
        *px = f2bf(siluf_(y));
      }
    }
  }
  if (w == 0) {
    const float a = bf2f(proj[(t0g + ln) * PC + BA + h]) + p.b_dt_bias[l * 4 + h];
    const float ea = __expf(a);
    const float sp = (a > 20.f) ? a : ((ea < 0.01f) ? ea * (1.f - ea * (0.5f - ea * 0.333333333f)) : __logf(1.f + ea));
    float g = -__expf(p.b_a_log[l * 4 + h]) * sp;
#pragma unroll
    for (int o = 1; o < 64; o <<= 1) { float t = __shfl_up(g, o); if (ln >= o) g += t; }
    gcs[ln] = g;
    egs[ln] = __expf(g);
    bts[ln] = sigmoidf_(bf2f(proj[(t0g + ln) * PC + BB + h]));
  }
  __syncthreads();
  {
    const int row = tid >> 2, qr = tid & 3;
#pragma unroll
    for (int part = 0; part < 2; ++part) {
      char* base = (part == 0 ? qs : ks) + row * 272 + qr * 64;
      uint4 v[4];
      float ss = 0.f;
#pragma unroll
      for (int i = 0; i < 4; ++i) {
        v[i] = *(uint4*)(base + i * 16);
        float a;
        a = bflo(v[i].x); ss += a * a; a = bfhi(v[i].x); ss += a * a; a = bflo(v[i].y); ss += a * a; a = bfhi(v[i].y); ss += a * a;
        a = bflo(v[i].z); ss += a * a; a = bfhi(v[i].z); ss += a * a; a = bflo(v[i].w); ss += a * a; a = bfhi(v[i].w); ss += a * a;
      }
      ss += __shfl_xor(ss, 1);
      ss += __shfl_xor(ss, 2);
      const float rs = rsqrtf(ss + EPS) * (part == 0 ? 0.08838834764f : 1.f);
#pragma unroll
      for (int i = 0; i < 4; ++i) {
        uint4 o;
        o.x = pack2(bflo(v[i].x) * rs, bfhi(v[i].x) * rs); o.y = pack2(bflo(v[i].y) * rs, bfhi(v[i].y) * rs);
        o.z = pack2(bflo(v[i].z) * rs, bfhi(v[i].z) * rs); o.w = pack2(bflo(v[i].w) * rs, bfhi(v[i].w) * rs);
        *(uint4*)(base + i * 16) = o;
      }
    }
  }
  __syncthreads();
  {
    const int fr = ln & 15, fq = ln >> 4;
    f32x4 kk[4], qk[4];
#pragma unroll
    for (int nt = 0; nt < 4; ++nt) { kk[nt] = f32x4{0, 0, 0, 0}; qk[nt] = f32x4{0, 0, 0, 0}; }
#pragma unroll
    for (int s = 0; s < 4; ++s) {
      const bf16x8 ak = *(const bf16x8*)(ks + (16 * w + fr) * 272 + (32 * s + 8 * fq) * 2);
      const bf16x8 aq = *(const bf16x8*)(qs + (16 * w + fr) * 272 + (32 * s + 8 * fq) * 2);
#pragma unroll
      for (int nt = 0; nt < 4; ++nt) {
        const bf16x8 bk = *(const bf16x8*)(ks + (16 * nt + fr) * 272 + (32 * s + 8 * fq) * 2);
        kk[nt] = mfma16(ak, bk, kk[nt]);
        qk[nt] = mfma16(aq, bk, qk[nt]);
      }
    }
#pragma unroll
    for (int nt = 0; nt < 4; ++nt)
#pragma unroll
      for (int jj = 0; jj < 4; ++jj) {
        const int i = 16 * w + 4 * fq + jj, j = 16 * nt + fr;
        const float dec = (i >= j) ? __expf(gcs[i] - gcs[j]) : 0.f;
        Lm[i * 64 + j] = (i > j) ? bts[i] * kk[nt][jj] * dec : 0.f;
        p.ATT()[(t0g + i) * 256 + h * 64 + j] = f2bf((i >= j) ? qk[nt][jj] * dec : 0.f);
      }
  }
  __syncthreads();
  {
    const int c = tid;
    const bool isu = c < 128;
    const char* src = isu ? (vs + c * 2) : (ks + (c - 128) * 2);
    const float wsel = isu ? 0.f : 1.f;
    float x[64];
#pragma unroll
    for (int i = 0; i < 64; ++i) {
      float a = bf2f(*(const u16*)(src + i * 272)) * bts[i] * fmaf(egs[i] - 1.f, wsel, 1.f);
      const float* Lr = Lm + i * 64;
#pragma unroll
      for (int j = 0; j < i; ++j) a -= Lr[j] * x[j];
      x[i] = a;
      asm volatile("" ::: "memory");
    }
    if (isu) {
      u32 pk[32];
#pragma unroll
      for (int pos = 0; pos < 64; pos += 2) {
        const int hh = pos >> 5, Tt = (pos >> 4) & 1, ii = pos & 15;
        const int r0 = 32 * Tt + (ii & 3) + 8 * (ii >> 2) + 4 * hh;
        const int i1 = ii + 1;
        const int r1 = 32 * Tt + (i1 & 3) + 8 * (i1 >> 2) + 4 * hh;
        pk[pos >> 1] = pack2(x[r0], x[r1]);
      }
      char* dst = (char*)proj + ((t0g + (c >> 1)) * PC + BV + h * 128) * 2 + (c & 1) * 128;
#pragma unroll
      for (int i = 0; i < 8; ++i) *(uint4*)(dst + i * 16) = uint4{pk[4 * i], pk[4 * i + 1], pk[4 * i + 2], pk[4 * i + 3]};
    } else {
#pragma unroll
      for (int i = 0; i < 64; ++i) proj[(t0g + i) * PC + BK_ + h * 128 + (c - 128)] = f2bf(x[i]);
    }
  }
  {
    const float glast = gcs[63];
#pragma unroll
    for (int i = 0; i < 4; ++i) {
      const int piece = tid + 256 * i, row = piece >> 4, ch = piece & 15;
      const uint4 v = *(const uint4*)(qs + row * 272 + ch * 16);
      const float e = egs[row];
      uint4 o;
      o.x = pack2(bflo(v.x) * e, bfhi(v.x) * e); o.y = pack2(bflo(v.y) * e, bfhi(v.y) * e);
      o.z = pack2(bflo(v.z) * e, bfhi(v.z) * e); o.w = pack2(bflo(v.w) * e, bfhi(v.w) * e);
      *(uint4*)(proj + (t0g + row) * PC + BQ + h * 128 + ch * 8) = o;
    }
    const int d = tid & 127, half = tid >> 7;
    u32 pk[16];
#pragma unroll
    for (int i = 0; i < 16; ++i) {
      const int r0 = half * 32 + 2 * i;
      const float a = bf2f(*(const u16*)(ks + r0 * 272 + d * 2)) * __expf(glast - gcs[r0]);
      const float b = bf2f(*(const u16*)(ks + (r0 + 1) * 272 + d * 2)) * __expf(glast - gcs[r0 + 1]);
      pk[i] = pack2(a, b);
    }
    u16* dst = p.KDT() + (((size_t)cidx * 4 + h) * 128 + d) * 64 + half * 32;
#pragma unroll
    for (int i = 0; i < 4; ++i) *(uint4*)(dst + i * 8) = uint4{pk[4 * i], pk[4 * i + 1], pk[4 * i + 2], pk[4 * i + 3]};
    if (tid == 0) p.GL()[cidx * 4 + h] = egs[63];
  }
  __syncthreads();
}

DI void gdn_rec_item(const Params& p, int l, int bh, char* smem, bool wr) {
  const int b = bh >> 2, h = bh & 3;
  const int tid = ltid(), ln = tid & 63, w = tid >> 6, hh = ln >> 5, c31 = ln & 31;
  const bool is_comp = w < 4;
  constexpr int BUFB = 59904;
  float* Ot = (float*)(smem + 2 * BUFB);
  u16* proj = p.P();
  const float* ng = p.b_norm_g + l * 128;
  const int lt = tid & 255;
#define LD_AQ(i, n_)                                                                                      \
  {                                                                                                       \
    const size_t t0g_ = ((size_t)b * 256 + (n_)) * 64;                                                    \
    const int piece = ltv + 256 * i, row = piece >> 4, ch = piece & 15;                                   \
    la##i = *(const uint4*)(proj + (t0g_ + row) * PC + BK_ + h * 128 + ch * 8);                           \
    lq##i = *(const uint4*)(proj + (t0g_ + row) * PC + BQ + h * 128 + ch * 8);                            \
  }
#define LD_K(i, n_)                                                                                       \
  {                                                                                                       \
    const int piece = ltv + 256 * i, row2 = piece >> 3, ch2 = piece & 7;                                  \
    lk##i = *(const uint4*)(p.KDT() + ((((size_t)b * 256 + (n_)) * 4 + h) * 128 + row2) * 64 + ch2 * 8);  \
  }
#define LD_T(i, n_)                                                                                       \
  {                                                                                                       \
    const size_t t0g_ = ((size_t)b * 256 + (n_)) * 64;                                                    \
    const int piece = ltv + 256 * i, row = piece >> 3, ch = piece & 7;                                     \
    lt##i = *(const uint4*)(p.ATT() + (t0g_ + row) * 256 + h * 64 + ch * 8);                              \
  }
#define LD_R1(n_) { LD_AQ(0, n_) LD_AQ(1, n_) LD_AQ(2, n_) LD_AQ(3, n_) }
#define LD_R2(n_) { LD_K(0, n_) LD_K(1, n_) LD_K(2, n_) LD_K(3, n_) LD_T(0, n_) LD_T(1, n_) }
#define ST_AQ(i, buf_)                                                                                    \
  {                                                                                                       \
    char* Wm_ = smem + (buf_) * BUFB; char* Qd_ = Wm_ + 16896;                                            \
    const int piece = ltv + 256 * i, row = piece >> 4, ch = piece & 15;                                   \
    *(uint2*)(Wm_ + row * 264 + ch * 16) = uint2{la##i.x, la##i.y}; *(uint2*)(Wm_ + row * 264 + ch * 16 + 8) = uint2{la##i.z, la##i.w}; \
    *(uint2*)(Qd_ + row * 264 + ch * 16) = uint2{lq##i.x, lq##i.y}; *(uint2*)(Qd_ + row * 264 + ch * 16 + 8) = uint2{lq##i.z, lq##i.w}; \
  }
#define ST_K(i, buf_)                                                                                     \
  {                                                                                                       \
    char* Kt_ = smem + (buf_) * BUFB + 2 * 16896;                                                         \
    const int piece = ltv + 256 * i, row2 = piece >> 3, ch2 = piece & 7;                                  \
    *(uint2*)(Kt_ + row2 * 136 + ch2 * 16) = uint2{lk##i.x, lk##i.y}; *(uint2*)(Kt_ + row2 * 136 + ch2 * 16 + 8) = uint2{lk##i.z, lk##i.w}; \
  }
#define ST_T(i, buf_)                                                                                     \
  {                                                                                                       \
    char* At_ = smem + (buf_) * BUFB + 2 * 16896 + 17408;                                                 \
    const int piece = ltv + 256 * i, row = piece >> 3, ch = piece & 7;                                     \
    *(uint2*)(At_ + row * 136 + ch * 16) = uint2{lt##i.x, lt##i.y}; *(uint2*)(At_ + row * 136 + ch * 16 + 8) = uint2{lt##i.z, lt##i.w}; \
  }
#define ST_R1(buf_) { ST_AQ(0, buf_) ST_AQ(1, buf_) ST_AQ(2, buf_) ST_AQ(3, buf_) }
#define ST_R2(buf_) { ST_K(0, buf_) ST_K(1, buf_) ST_K(2, buf_) ST_K(3, buf_) ST_T(0, buf_) ST_T(1, buf_) }
#define LD_Z(n_)                                                                                          \
  {                                                                                                       \
    const u16* zp_ = proj + (((size_t)b * 256 + (n_)) * 64 + nrow) * PC + BZ + h * 128 + nqr * 32;        \
    lz0 = *(const uint4*)(zp_); lz1 = *(const uint4*)(zp_ + 8); lz2 = *(const uint4*)(zp_ + 16); lz3 = *(const uint4*)(zp_ + 24); \
  }
  f32x16 S[4];
#pragma unroll
  for (int i = 0; i < 4; ++i)
#pragma unroll
    for (int j = 0; j < 16; ++j) S[i][j] = 0.f;
  const int e = 32 * w + c31;
  uint4 un0, un1, un2, un3;
  float gln = 0.f;
#define LD_U(n_)                                                                                          \
  {                                                                                                       \
    const uint4* up_ = (const uint4*)((const char*)proj + ((((size_t)b * 256 + (n_)) * 64 + (e >> 1)) * PC + BV + h * 128) * 2 + (e & 1) * 128 + hh * 64); \
    un0 = up_[0]; un1 = up_[1]; un2 = up_[2]; un3 = up_[3];                                               \
    gln = p.GL()[((size_t)b * 256 + (n_)) * 4 + h];                                                       \
  }
  if (!is_comp) {
    const int ltv = lt;
    uint4 la0, la1, la2, la3, lq0, lq1, lq2, lq3, lk0, lk1, lk2, lk3, lt0, lt1;
    LD_R1(0) LD_R2(0)
    ST_R1(0) ST_R2(0)
  } else {
    LD_U(0)
  }
  for (int n = 0; n < 256; ++n) {
    f32x16 o[2];
    __syncthreads();
    if (is_comp) {
      int lnv = ln;
      asm volatile("" : "+v"(lnv));
      const int hh = lnv >> 5, c31 = lnv & 31;
      const char* Wm = smem + (n & 1) * BUFB;
      const char* Qd = Wm + 16896;
      const char* Kt = Wm + 2 * 16896;
      const char* At = Kt + 17408;
      f32x16 ws[2];
#pragma unroll
      for (int i = 0; i < 2; ++i)
#pragma unroll
        for (int j = 0; j < 16; ++j) { ws[i][j] = 0.f; o[i][j] = 0.f; }
#pragma unroll
      for (int Tt = 0; Tt < 4; ++Tt)
#pragma unroll
        for (int s = 0; s < 2; ++s) {
          const int kb = 32 * Tt + 16 * s;
          const bf16x8 sps = pack8(S[Tt], s);
#pragma unroll
          for (int Tc = 0; Tc < 2; ++Tc) {
            ws[Tc] = mfma32(afrag_perm(Wm, 32 * Tc + c31, 264, kb, hh), sps, ws[Tc]);
            o[Tc] = mfma32(afrag_perm(Qd, 32 * Tc + c31, 264, kb, hh), sps, o[Tc]);
          }
        }
      f32x16 vn[2];
      vn[0][0] = bflo(un0.x) - ws[0][0]; vn[0][1] = bfhi(un0.x) - ws[0][1]; vn[0][2] = bflo(un0.y) - ws[0][2]; vn[0][3] = bfhi(un0.y) - ws[0][3];
      vn[0][4] = bflo(un0.z) - ws[0][4]; vn[0][5] = bfhi(un0.z) - ws[0][5]; vn[0][6] = bflo(un0.w) - ws[0][6]; vn[0][7] = bfhi(un0.w) - ws[0][7];
      vn[0][8] = bflo(un1.x) - ws[0][8]; vn[0][9] = bfhi(un1.x) - ws[0][9]; vn[0][10] = bflo(un1.y) - ws[0][10]; vn[0][11] = bfhi(un1.y) - ws[0][11];
      vn[0][12] = bflo(un1.z) - ws[0][12]; vn[0][13] = bfhi(un1.z) - ws[0][13]; vn[0][14] = bflo(un1.w) - ws[0][14]; vn[0][15] = bfhi(un1.w) - ws[0][15];
      vn[1][0] = bflo(un2.x) - ws[1][0]; vn[1][1] = bfhi(un2.x) - ws[1][1]; vn[1][2] = bflo(un2.y) - ws[1][2]; vn[1][3] = bfhi(un2.y) - ws[1][3];
      vn[1][4] = bflo(un2.z) - ws[1][4]; vn[1][5] = bfhi(un2.z) - ws[1][5]; vn[1][6] = bflo(un2.w) - ws[1][6]; vn[1][7] = bfhi(un2.w) - ws[1][7];
      vn[1][8] = bflo(un3.x) - ws[1][8]; vn[1][9] = bfhi(un3.x) - ws[1][9]; vn[1][10] = bflo(un3.y) - ws[1][10]; vn[1][11] = bfhi(un3.y) - ws[1][11];
      vn[1][12] = bflo(un3.z) - ws[1][12]; vn[1][13] = bfhi(un3.z) - ws[1][13]; vn[1][14] = bflo(un3.w) - ws[1][14]; vn[1][15] = bfhi(un3.w) - ws[1][15];
      const float gl = gln;
      if (n + 1 < 256) LD_U(n + 1)
      bf16x8 vp[2][2];
#pragma unroll
      for (int Tc = 0; Tc < 2; ++Tc) { vp[Tc][0] = pack8(vn[Tc], 0); vp[Tc][1] = pack8(vn[Tc], 1); }
#pragma unroll
      for (int s = 0; s < 2; ++s) {
        o[0] = mfma32(afrag_perm(At, c31, 136, 16 * s, hh), vp[0][s], o[0]);
        o[1] = mfma32(afrag_perm(At, 32 + c31, 136, 16 * s, hh), vp[0][s], o[1]);
        o[1] = mfma32(afrag_perm(At, 32 + c31, 136, 32 + 16 * s, hh), vp[1][s], o[1]);
      }
#pragma unroll
      for (int Tt = 0; Tt < 4; ++Tt)
#pragma unroll
        for (int j = 0; j < 16; ++j) S[Tt][j] *= gl;
#pragma unroll
      for (int Tc = 0; Tc < 2; ++Tc)
#pragma unroll
        for (int s = 0; s < 2; ++s)
#pragma unroll
          for (int Tt = 0; Tt < 4; ++Tt)
            S[Tt] = mfma32(afrag_perm(Kt, 32 * Tt + c31, 136, 32 * Tc + 16 * s, hh), vp[Tc][s], S[Tt]);
    } else {
      int ltv = lt;
      asm volatile("" : "+v"(ltv));
      const int nrow = ltv >> 2, nqr = ltv & 3;
      const int nn = (n + 1 < 256) ? n + 1 : 255;
      {
        uint4 la0, la1, la2, la3, lq0, lq1, lq2, lq3;
        LD_R1(nn)
        ST_R1((n + 1) & 1)
      }
      uint4 lz0, lz1, lz2, lz3;
      {
        uint4 lk0, lk1, lk2, lk3, lt0, lt1;
        LD_R2(nn)
        const int nz = (n > 0) ? n - 1 : 0;
        LD_Z(nz)
        ST_R2((n + 1) & 1)
      }
      if (n > 0) {
        const float* orow = Ot + nrow * 132 + nqr * 32;
        float ss = 0.f;
#pragma unroll
        for (int i = 0; i < 8; ++i) {
          const float4 v = *(const float4*)(orow + 4 * i);
          ss += v.x * v.x + v.y * v.y + v.z * v.z + v.w * v.w;
        }
        ss += __shfl_xor(ss, 1);
        ss += __shfl_xor(ss, 2);
        const float rs = rsqrtf(ss * (1.f / 128.f) + EPS);
        u16* zp = proj + (((size_t)b * 256 + (n - 1)) * 64 + nrow) * PC + BZ + h * 128 + nqr * 32;
        const float* gg = ng + nqr * 32;
#define GN1(i, Z)                                                                                          \
        {                                                                                                  \
          const float4 oa = *(const float4*)(orow + 8 * i), ob = *(const float4*)(orow + 8 * i + 4);       \
          uint4 r;                                                                                         \
          r.x = pack2(oa.x * rs * gg[8 * i + 0] * siluf_(bflo(Z.x)), oa.y * rs * gg[8 * i + 1] * siluf_(bfhi(Z.x))); \
          r.y = pack2(oa.z * rs * gg[8 * i + 2] * siluf_(bflo(Z.y)), oa.w * rs * gg[8 * i + 3] * siluf_(bfhi(Z.y))); \
          r.z = pack2(ob.x * rs * gg[8 * i + 4] * siluf_(bflo(Z.z)), ob.y * rs * gg[8 * i + 5] * siluf_(bfhi(Z.z))); \
          r.w = pack2(ob.z * rs * gg[8 * i + 6] * siluf_(bflo(Z.w)), ob.w * rs * gg[8 * i + 7] * siluf_(bfhi(Z.w))); \
          if (wr) *(uint4*)(zp + 8 * i) = r;                                                               \
        }
        GN1(0, lz0) GN1(1, lz1) GN1(2, lz2) GN1(3, lz3)
      }
    }
    __syncthreads();
    if (is_comp) {
#pragma unroll
      for (int Tc = 0; Tc < 2; ++Tc)
#pragma unroll
        for (int j = 0; j < 16; ++j) Ot[(32 * Tc + crow(j, hh)) * 132 + e] = o[Tc][j];
    }
  }
  __syncthreads();
  if (!is_comp) {
    const int n = 256;
    const int nrow = lt >> 2, nqr = lt & 3;
    uint4 lz0, lz1, lz2, lz3;
    LD_Z(255)
    const float* orow = Ot + nrow * 132 + nqr * 32;
    float ss = 0.f;
#pragma unroll
    for (int i = 0; i < 8; ++i) {
      const float4 v = *(const float4*)(orow + 4 * i);
      ss += v.x * v.x + v.y * v.y + v.z * v.z + v.w * v.w;
    }
    ss += __shfl_xor(ss, 1);
    ss += __shfl_xor(ss, 2);
    const float rs = rsqrtf(ss * (1.f / 128.f) + EPS);
    u16* zp = proj + (((size_t)b * 256 + (n - 1)) * 64 + nrow) * PC + BZ + h * 128 + nqr * 32;
    const float* gg = ng + nqr * 32;
    GN1(0, lz0) GN1(1, lz1) GN1(2, lz2) GN1(3, lz3)
  }
#undef GN1
#undef LD_AQ
#undef LD_K
#undef LD_R1
#undef LD_R2
#undef LD_T
#undef ST_AQ
#undef ST_K
#undef ST_R1
#undef ST_R2
#undef ST_T
#undef LD_Z
#undef LD_U
  __syncthreads();
}

DI void diff_item(const Params& p, int l, int qt, int bh, char* smem) {
  const int b = bh >> 2, h = bh & 3;
  const int tid = ltid(), ln = tid & 63, w = tid >> 6, hh = ln >> 5, c31 = ln & 31;
  const int st = w & 3, c = w >> 2;
  const size_t tokbase = (size_t)b * T;
  const int qb = qt * 128 + 32 * st + c31;
  u16* proj = p.P();
  bf16x8 qf[4];
  {
    const u16* qrow = proj + (tokbase + qb) * PC + AQ + h * 128 + c * 64 + 8 * hh;
#pragma unroll
    for (int s = 0; s < 4; ++s) qf[s] = *(const bf16x8*)(qrow + 16 * s);
  }
  f32x16 O[4];
  float mrun, lrun;
  const float sc = 0.125f * 1.44269504089f;
  char* Ks = smem;
  char* Vs = smem + 17408;
  uint4 rk0, rk1, rv0, rv1;
  const int srow = tid >> 4, sch = tid & 15;
#define DLOAD1(i, kt)                                                                \
  {                                                                                  \
    const u16* base = proj + (tokbase + (kt) * 64 + srow + 32 * i) * PC + h * 128 + sch * 8; \
    rk##i = *(const uint4*)(base + AK);                                              \
    rv##i = *(const uint4*)(base + AV);                                              \
  }
#define DLOAD(kt) { DLOAD1(0, kt) DLOAD1(1, kt) }
#define DSTORE1(i)                                                \
  *(uint4*)(Ks + (srow + 32 * i) * 272 + sch * 16) = rk##i;       \
  *(uint4*)(Vs + (srow + 32 * i) * 320 + sch * 16) = rv##i;
  const int nkt = 2 * qt + 2;
#pragma unroll 1
  for (int rep = 0; rep < DUP_DIFF; ++rep) {
#pragma unroll
  for (int i = 0; i < 4; ++i)
#pragma unroll
    for (int j = 0; j < 16; ++j) O[i][j] = 0.f;
  mrun = -INFINITY; lrun = 0.f;
  DLOAD(0);
  for (int kt = 0; kt < nkt; ++kt) {
    __syncthreads();
    DSTORE1(0) DSTORE1(1)
    __syncthreads();
    if (kt + 1 < nkt) { DLOAD(kt + 1); }
    if (kt * 64 > qt * 128 + 32 * st + 31) continue;
    f32x16 sa[2];
#pragma unroll
    for (int k2 = 0; k2 < 2; ++k2) {
#pragma unroll
      for (int j = 0; j < 16; ++j) sa[k2][j] = 0.f;
#pragma unroll
      for (int s = 0; s < 4; ++s)
        sa[k2] = mfma32(*(const bf16x8*)(Ks + (32 * k2 + c31) * 272 + (c * 64 + 16 * s + 8 * hh) * 2), qf[s], sa[k2]);
    }
    if (kt >= 2 * qt) {
#pragma unroll
      for (int k2 = 0; k2 < 2; ++k2)
#pragma unroll
        for (int j = 0; j < 16; ++j)
          if (kt * 64 + 32 * k2 + crow(j, hh) > qb) sa[k2][j] = -INFINITY;
    }
    float tmax = sa[0][0];
#pragma unroll
    for (int k2 = 0; k2 < 2; ++k2)
#pragma unroll
      for (int j = 0; j < 16; ++j) tmax = fmaxf(tmax, sa[k2][j]);
    tmax = fmaxf(tmax, __shfl_xor(tmax, 32));
    const float mnew = fmaxf(mrun, tmax * sc);
    const float alpha = __builtin_amdgcn_exp2f(mrun - mnew);
    mrun = mnew;
    float psum = 0.f;
#pragma unroll
    for (int k2 = 0; k2 < 2; ++k2)
#pragma unroll
      for (int j = 0; j < 16; ++j) { const float pv = __builtin_amdgcn_exp2f(sa[k2][j] * sc - mnew); sa[k2][j] = pv; psum += pv; }
    lrun = lrun * alpha + psum;
    if (__any(alpha != 1.f)) {
#pragma unroll
      for (int i = 0; i < 4; ++i)
#pragma unroll
        for (int j = 0; j < 16; ++j) O[i][j] *= alpha;
    }
#pragma unroll
    for (int k2 = 0; k2 < 2; ++k2)
#pragma unroll
      for (int s2 = 0; s2 < 2; ++s2) {
        const bf16x8 pp = pack8(sa[k2], s2);
        bf16x8 vf[4];
        trfrag4<320>(Vs, 32 * k2 + 16 * s2, ln, vf);
#pragma unroll
        for (int mt = 0; mt < 4; ++mt) O[mt] = mfma32(vf[mt], pp, O[mt]);
      }
  }
  }
#undef DLOAD
#undef DLOAD1
#undef DSTORE1
  __syncthreads();
  const float ltot = lrun + __shfl_xor(lrun, 32);
  const float inv = 1.f / ltot;
  float* xch = (float*)smem + st * 32 * 132;
  if (c == 1) {
#pragma unroll
    for (int mt = 0; mt < 4; ++mt)
#pragma unroll
      for (int i4 = 0; i4 < 4; ++i4)
        *(float4*)(xch + c31 * 132 + 32 * mt + 8 * i4 + 4 * hh) =
            float4{O[mt][4 * i4] * inv, O[mt][4 * i4 + 1] * inv, O[mt][4 * i4 + 2] * inv, O[mt][4 * i4 + 3] * inv};
  }
  __syncthreads();
  if (c == 0) {
    const float lam = p.LAM()[l], oml = 1.f - p.LAM()[2 + l];
    float ss = 0.f;
#pragma unroll
    for (int mt = 0; mt < 4; ++mt)
#pragma unroll
      for (int i4 = 0; i4 < 4; ++i4) {
        const float4 o1 = *(const float4*)(xch + c31 * 132 + 32 * mt + 8 * i4 + 4 * hh);
        float d;
        d = O[mt][4 * i4] * inv - lam * o1.x; O[mt][4 * i4] = d; ss += d * d;
        d = O[mt][4 * i4 + 1] * inv - lam * o1.y; O[mt][4 * i4 + 1] = d; ss += d * d;
        d = O[mt][4 * i4 + 2] * inv - lam * o1.z; O[mt][4 * i4 + 2] = d; ss += d * d;
        d = O[mt][4 * i4 + 3] * inv - lam * o1.w; O[mt][4 * i4 + 3] = d; ss += d * d;
      }
    ss += __shfl_xor(ss, 32);
    const float rs = rsqrtf(ss * (1.f / 128.f) + EPS) * oml;
    const float* sg = p.a_subln_g + l * 128;
    int qb_e = qb;
    asm volatile("" : "+v"(qb_e));
    u16* orow = proj + (tokbase + qb_e) * PC + AQ + h * 128;
#pragma unroll
    for (int mt = 0; mt < 4; ++mt)
#pragma unroll
      for (int i4 = 0; i4 < 4; ++i4) {
        const int dv = 32 * mt + 8 * i4 + 4 * hh;
        const float4 gg = *(const float4*)(sg + dv);
        uint2 o;
        o.x = pack2(O[mt][4 * i4] * rs * gg.x, O[mt][4 * i4 + 1] * rs * gg.y);
        o.y = pack2(O[mt][4 * i4 + 2] * rs * gg.z, O[mt][4 * i4 + 3] * rs * gg.w);
        *(uint2*)(orow + dv) = o;
      }
  }
  __syncthreads();
}

DI u32 mono_key(float f) { u32 u = __float_as_uint(f); return (u & 0x80000000u) ? ~u : (u | 0x80000000u); }

constexpr int DCAP = 640;
DI u32 dsa_prune(u32* ck, u16* ci, int cnt, u32 tau_old, bool exact, int ln, int& newcnt) {
  u32 kv[10];
  u16 iv[10];
  u32 mx = 0u;
#pragma unroll
  for (int j = 0; j < 10; ++j) {
    const int pos = ln + 64 * j;
    const bool vd = pos < cnt;
    kv[j] = vd ? ck[pos] : 0u;
    iv[j] = vd ? ci[pos] : (u16)0;
    mx = max(mx, kv[j]);
  }
#pragma unroll
  for (int o = 32; o; o >>= 1) mx = max(mx, (u32)__shfl_xor((int)mx, o));
  u32 L = tau_old + 1u, H = mx + 1u;
  int curL = cnt;
  while ((exact || curL > 384) && (H - L) > 1u) {
    const u32 mid = L + ((H - L) >> 1);
    int c = 0;
#pragma unroll
    for (int j = 0; j < 10; ++j) c += __popcll(__ballot(kv[j] >= mid));
    if (c >= 256) { L = mid; curL = c; } else H = mid;
  }
  int ngt = 0;
#pragma unroll
  for (int j = 0; j < 10; ++j) ngt += __popcll(__ballot(kv[j] > L));
  const int target = (!exact && curL <= 384) ? curL : 256;
  const int need = target - ngt;
  int run_gt = 0, run_eq = 0;
#pragma unroll
  for (int j = 0; j < 10; ++j) {
    const bool gt = kv[j] > L, eq = (kv[j] == L);
    const u64 mg = __ballot(gt), me = __ballot(eq);
    const int pg = run_gt + (int)lane_lt_cnt(mg), pe = run_eq + (int)lane_lt_cnt(me);
    if (gt) { ck[pg] = kv[j]; ci[pg] = iv[j]; }
    else if (eq && pe < need) { ck[ngt + pe] = kv[j]; ci[ngt + pe] = iv[j]; }
    run_gt += __popcll(mg);
    run_eq += __popcll(me);
  }
  newcnt = target;
  return L;
}

DI void dsa_item(const Params& p, int l, int tile32, int b, char* smem) {
  const int tid = ltid(), ln = tid & 63, w = tid >> 6, hh = ln >> 5, c31 = ln & 31;
  const int t0 = tile32 * 32 + 4 * w;
  const size_t tokbase = (size_t)b * T;
  u16* QX = (u16*)p.out;
  char* wl = smem + w * 17408;
  u32* ckey = (u32*)wl;
  u16* cidx = (u16*)(wl + 10240);
  u16* ifin = (u16*)(wl + 15360);
  char* tile = wl;
  int cnt0 = 0, cnt1 = 0, cnt2 = 0, cnt3 = 0;
  {
    bf16x8 qa[4];
    {
      const int r = c31, ql = 2 * ((r >> 2) & 1) + (r >> 4), hd = 4 * ((r >> 3) & 1) + (r & 3);
      const u16* qrow = QX + (tokbase + t0 + ql) * LDQ + 1024 + hd * 64 + 8 * hh;
#pragma unroll
      for (int s = 0; s < 4; ++s) qa[s] = *(const bf16x8*)(qrow + 16 * s);
    }
    float wq[16];
    {
      const float4* wi = (const float4*)(p.WIDX() + (tokbase + t0 + 2 * hh) * 8);
#pragma unroll
      for (int i = 0; i < 4; ++i) { const float4 v = wi[i]; wq[4 * i] = v.x; wq[4 * i + 1] = v.y; wq[4 * i + 2] = v.z; wq[4 * i + 3] = v.w; }
    }
    const int qpos0 = t0 + 2 * hh;
    const int nkt = ((t0 + 3) >> 5) + 1;
    const u32 lmask = (1u << c31) - 1u;
#pragma unroll 1
    for (int rep = 0; rep < DUP_DSA1; ++rep) {
    cnt0 = cnt1 = cnt2 = cnt3 = 0;
    u32 tau0 = 0u, tau1 = 0u, tau2 = 0u, tau3 = 0u;
    bf16x8 kn[4][4];
    {
#pragma unroll
      for (int t = 0; t < 4; ++t) {
        const u16* krow = p.KIDX() + (tokbase + t * 32 + c31) * 64 + 8 * hh;
#pragma unroll
        for (int s = 0; s < 4; ++s) kn[t][s] = *(const bf16x8*)(krow + 16 * s);
      }
    }
    const int ngrp = (nkt + 3) >> 2;
    for (int g = 0; g <= ngrp; ++g) {
      const int lim = (g < ngrp) ? (DCAP - 128) : 256;
      for (;;) {
        const int q = (cnt0 > lim) ? 0 : (cnt1 > lim) ? 1 : (cnt2 > lim) ? 2 : (cnt3 > lim) ? 3 : -1;
        if (q < 0) break;
        const int c = (q == 0) ? cnt0 : (q == 1) ? cnt1 : (q == 2) ? cnt2 : cnt3;
        const u32 to = (q == 0) ? tau0 : (q == 1) ? tau1 : (q == 2) ? tau2 : tau3;
        int nc;
        const u32 t = dsa_prune(ckey + q * DCAP, cidx + q * DCAP, c, to, g == ngrp, ln, nc);
        if (q == 0) { cnt0 = nc; tau0 = t; } else if (q == 1) { cnt1 = nc; tau1 = t; }
        else if (q == 2) { cnt2 = nc; tau2 = t; } else { cnt3 = nc; tau3 = t; }
      }
      if (g == ngrp) break;
      bf16x8 kc[4][4];
#pragma unroll
      for (int t = 0; t < 4; ++t)
#pragma unroll
        for (int s = 0; s < 4; ++s) kc[t][s] = kn[t][s];
      if (g + 1 < ngrp) {
#pragma unroll
        for (int t = 0; t < 4; ++t) {
          const u16* krow = p.KIDX() + (tokbase + (g + 1) * 128 + t * 32 + c31) * 64 + 8 * hh;
#pragma unroll
          for (int s = 0; s < 4; ++s) kn[t][s] = *(const bf16x8*)(krow + 16 * s);
        }
      }
      const u32 tauA = hh ? tau2 : tau0, tauB = hh ? tau3 : tau1;
#pragma unroll
      for (int t = 0; t < 4; ++t) {
        const int key = (g * 4 + t) * 32 + c31;
        f32x16 acc;
#pragma unroll
        for (int j = 0; j < 16; ++j) acc[j] = 0.f;
#pragma unroll
        for (int s = 0; s < 4; ++s) acc = mfma32(qa[s], kc[t][s], acc);
        float s0 = 0.f, s1 = 0.f;
#pragma unroll
        for (int i = 0; i < 8; ++i) { s0 += wq[i] * __builtin_amdgcn_fmed3f(acc[i], 0.f, 3.0e38f); s1 += wq[8 + i] * __builtin_amdgcn_fmed3f(acc[8 + i], 0.f, 3.0e38f); }
        const u32 k0 = mono_key(s0), k1 = mono_key(s1);
        const bool c0 = (key <= qpos0) && (k0 > tauA), c1 = (key <= qpos0 + 1) && (k1 > tauB);
        const u64 m0 = __ballot(c0), m1 = __ballot(c1);
        if (m0 | m1) {
          const u32 h0 = hh ? (u32)(m0 >> 32) : (u32)m0, h1 = hh ? (u32)(m1 >> 32) : (u32)m1;
          const int pA = (hh ? cnt2 : cnt0) + __popc(h0 & lmask), pB = (hh ? cnt3 : cnt1) + __popc(h1 & lmask);
          if (c0) { ckey[(2 * hh) * DCAP + pA] = k0; cidx[(2 * hh) * DCAP + pA] = (u16)key; }
          if (c1) { ckey[(2 * hh + 1) * DCAP + pB] = k1; cidx[(2 * hh + 1) * DCAP + pB] = (u16)key; }
          cnt0 += __popc((u32)m0); cnt2 += __popc((u32)(m0 >> 32));
          cnt1 += __popc((u32)m1); cnt3 += __popc((u32)(m1 >> 32));
        }
      }
    }
#pragma unroll
    for (int qq = 0; qq < 4; ++qq) {
      const int cq = (qq == 0) ? cnt0 : (qq == 1) ? cnt1 : (qq == 2) ? cnt2 : cnt3;
#pragma unroll
      for (int j = 0; j < 4; ++j) {
        const int pos = ln + 64 * j;
        ifin[qq * 256 + pos] = (pos < cq) ? cidx[qq * DCAP + pos] : (u16)0;
      }
    }
    }
  }
  const float sc = 0.125f * 1.44269504089f;
#pragma unroll 1
  for (int rep2 = 0; rep2 < DUP_DSA2; ++rep2)
#pragma unroll 1
  for (int qq = 0; qq < 4; ++qq) {
    const int nsel = (qq == 0) ? cnt0 : (qq == 1) ? cnt1 : (qq == 2) ? cnt2 : cnt3;
    const size_t tq = tokbase + t0 + qq;
    bf16x8 qf[8];
    {
      const u16* qab = QX + tq * LDQ + (c31 & 7) * 128 + 8 * hh;
#pragma unroll
      for (int s = 0; s < 8; ++s) qf[s] = *(const bf16x8*)(qab + 16 * s);
    }
    f32x16 O[4];
#pragma unroll
    for (int i = 0; i < 4; ++i)
#pragma unroll
      for (int j = 0; j < 16; ++j) O[i][j] = 0.f;
    float mrun = -INFINITY, lrun = 0.f;
    const int ntile = (nsel + 31) >> 5;
    uint4 gr0, gr1, gr2, gr3, gr4, gr5, gr6, gr7;
#define GGATHER1(i, tt_)                                                                     \
    {                                                                                        \
      const int piece = ln + 64 * i, row = piece >> 4, ch = piece & 15;                      \
      const int idx = ifin[qq * 256 + (tt_) * 32 + row];                                     \
      gr##i = *(const uint4*)(p.CKV() + (tokbase + idx) * 128 + ch * 8);                     \
    }
#define GGATHER(tt_) { GGATHER1(0, tt_) GGATHER1(1, tt_) GGATHER1(2, tt_) GGATHER1(3, tt_) GGATHER1(4, tt_) GGATHER1(5, tt_) GGATHER1(6, tt_) GGATHER1(7, tt_) }
#define GSTORE1(i) { const int piece = ln + 64 * i, row = piece >> 4, ch = piece & 15; *(uint4*)(tile + row * 272 + ch * 16) = gr##i; }
    if (ntile > 0) GGATHER(0)
    for (int tt = 0; tt < ntile; ++tt) {
      GSTORE1(0) GSTORE1(1) GSTORE1(2) GSTORE1(3) GSTORE1(4) GSTORE1(5) GSTORE1(6) GSTORE1(7)
      if (tt + 1 < ntile) GGATHER(tt + 1)
      __builtin_amdgcn_fence(__ATOMIC_RELEASE, "wavefront");
      f32x16 sa;
#pragma unroll
      for (int j = 0; j < 16; ++j) sa[j] = 0.f;
#pragma unroll
      for (int s = 0; s < 8; ++s) sa = mfma32(*(const bf16x8*)(tile + c31 * 272 + (16 * s + 8 * hh) * 2), qf[s], sa);
      float tmax = -INFINITY;
#pragma unroll
      for (int j = 0; j < 16; ++j) {
        if (tt * 32 + crow(j, hh) >= nsel) sa[j] = -INFINITY;
        tmax = fmaxf(tmax, sa[j]);
      }
      tmax = fmaxf(tmax, __shfl_xor(tmax, 32));
      const float mnew = fmaxf(mrun, tmax * sc);
      const float alpha = __builtin_amdgcn_exp2f(mrun - mnew);
      mrun = mnew;
      float psum = 0.f;
#pragma unroll
      for (int j = 0; j < 16; ++j) { const float pv = __builtin_amdgcn_exp2f(sa[j] * sc - mnew); sa[j] = pv; psum += pv; }
      lrun = lrun * alpha + psum;
#pragma unroll
      for (int i = 0; i < 4; ++i)
#pragma unroll
        for (int j = 0; j < 16; ++j) O[i][j] *= alpha;
#pragma unroll
      for (int s2 = 0; s2 < 2; ++s2) {
        const bf16x8 pp = pack8(sa, s2);
        bf16x8 vf[4];
        trfrag4<272>(tile, 16 * s2, ln, vf);
#pragma unroll
        for (int mt = 0; mt < 4; ++mt) O[mt] = mfma32(vf[mt], pp, O[mt]);
      }
      __builtin_amdgcn_fence(__ATOMIC_ACQ_REL, "wavefront");
    }
#undef GGATHER1
#undef GGATHER
#undef GSTORE1
    const float ltot = lrun + __shfl_xor(lrun, 32);
    const float inv = 1.f / ltot;
    if (c31 < 8 && rep2 == DUP_DSA2 - 1) {
      u16* orow = QX + tq * LDQ + c31 * 128;
#pragma unroll
      for (int mt = 0; mt < 4; ++mt)
#pragma unroll
        for (int i4 = 0; i4 < 4; ++i4) {
          uint2 o;
          o.x = pack2(O[mt][4 * i4] * inv, O[mt][4 * i4 + 1] * inv);
          o.y = pack2(O[mt][4 * i4 + 2] * inv, O[mt][4 * i4 + 3] * inv);
          *(uint2*)(orow + 32 * mt + 8 * i4 + 4 * hh) = o;
        }
    }
  }
  __syncthreads();
}

DI void phase_prep(const Params& p, int l, char* smem) {
  if (EN_C) {
    int rt, ct;
    for (int it = 0; next_tile(it, 128, 6, 32, 2, rt, ct); ++it) qx_tile(p, l, rt, ct, smem);
  }
  const int n_gdn = EN_B ? 1024 : 0, n_kp = EN_C ? 512 : 0;
  for (int t = lbid(); t < n_gdn + n_kp; t += lgdim()) {
    if (t < n_gdn) gdn_prep_item(p, l, t, smem);
    else dsa_kprep_item(p, l, t - n_gdn);
  }
}

DI int xcc_id() { return (int)(__builtin_amdgcn_s_getreg((3 << 11) | 20) & 0x7u); }

DI void phase_mixers(const Params& p, int l, char* smem) {
  __shared__ int s_item;
  const int x0 = xcc_id();
  int xs = x0;
  for (;;) {
    __syncthreads();
    {
      int qi = l * 8 + xs;
      asm volatile("" : "+s"(qi));
      if (ltid() == 0) s_item = (int)atomicAdd(p.CNT() + qi, 1u);
    }
    __syncthreads();
    const int it = s_item;
    const int n_gdn = EN_B ? 1 : 0;
    if (it >= n_gdn + 256) {
      xs = (xs + 1) & 7;
      if (xs == x0) break;
      continue;
    }
    const int x = xs;
    if (it < n_gdn) {
#pragma unroll 1
      for (int rep = 0; rep < DUP_GDN; ++rep) gdn_rec_item(p, l, x, smem, rep == DUP_GDN - 1);
    }
    else {
      const int j = it - n_gdn, k = j >> 1;
      if ((j & 1) == 0) { if (EN_A) diff_item(p, l, 127 - k, x, smem); }
      else { if (EN_C) dsa_item(p, l, 511 - (k * 4 + (x >> 1)), x & 1, smem); }
    }
  }
}

DI void run_phase(const Params& p, int ph, char* smem) {
  if (ph == 0) { phase0(p, smem); return; }
  const int l = (ph - 1) / 9, s = (ph - 1) % 9;
  switch (s) {
    case 0: phase_inproj(p, l, smem); break;
    case 1: phase_prep(p, l, smem); break;
    case 2: phase_mixers(p, l, smem); break;
    case 3: phase_merge(p, l, smem); break;
    case 4: phase_resgemm(p, p.MERGED(), LDX, p.wo(l), KP1024, 1024, smem); break;
    case 5: ln_phase(p.out, p.ln1_g + l * 1024, p.ln1_b + l * 1024, p.XB(), nullptr); break;
    case 6: phase_ff1(p, l, smem); break;
    case 7: phase_resgemm(p, p.P(), LDH, p.wf2(l), KP4096, 4096, smem); break;
    case 8: ln_phase(p.out, p.ln2_g + l * 1024, p.ln2_b + l * 1024, (l == 1) ? nullptr : p.XB(), (l == 1) ? p.out : nullptr); break;
  }
}

constexpr int N_PHASES = 19;

#if COOP
DI void gsync() { cg::this_grid().sync(); }
__global__ void __launch_bounds__(512, 1) mega_kernel(Params p, int ph_begin, int ph_end) {
  __shared__ __attribute__((aligned(16))) char smem[SMEM_BYTES];
  for (int r = 0; r < REP0; ++r) { phase0(p, smem); gsync(); }
#pragma unroll 1
  for (int l = 0; l < 2; ++l) {
    for (int r = 0; r < REP1; ++r) { phase_inproj(p, l, smem); gsync(); }
    phase_prep(p, l, smem);
    gsync();
    phase_mixers(p, l, smem);
    gsync();
    for (int r = 0; r < REP2; ++r) { phase_merge(p, l, smem); gsync(); }
    for (int r = 0; r < REP3; ++r) { phase_resgemm(p, p.MERGED(), LDX, p.wo(l), KP1024, 1024, smem); gsync(); }
    for (int r = 0; r < REP4; ++r) { ln_phase(p.out, p.ln1_g + l * 1024, p.ln1_b + l * 1024, p.XB(), nullptr); gsync(); }
    for (int r = 0; r < REP5; ++r) { phase_ff1(p, l, smem); gsync(); }
    for (int r = 0; r < REP6; ++r) { phase_resgemm(p, p.P(), LDH, p.wf2(l), KP4096, 4096, smem); gsync(); }
    ln_phase(p.out, p.ln2_g + l * 1024, p.ln2_b + l * 1024, (l == 1) ? nullptr : p.XB(), (l == 1) ? p.out : nullptr);
    if (l == 0) gsync();
  }
}
#else
__global__ void __launch_bounds__(512, 1) mega_kernel(Params p, int ph_begin, int ph_end) {
  __shared__ __attribute__((aligned(16))) char smem[SMEM_BYTES];
  for (int ph = ph_begin; ph < ph_end; ++ph) run_phase(p, ph, smem);
}
#endif

extern "C" void kernel_launch(void* const* d_in, const int* in_sizes, int n_in, void* d_out, int out_size,
                              void* d_ws, size_t ws_size, hipStream_t stream) {
  static int grid_blocks = 0;
  if (!grid_blocks) {
    int dev = 0, cus = 0, per_cu = 0;
    hipGetDevice(&dev);
    hipDeviceGetAttribute(&cus, hipDeviceAttributeMultiprocessorCount, dev);
    hipOccupancyMaxActiveBlocksPerMultiprocessor(&per_cu, mega_kernel, NTHR, 0);
    if (per_cu < 1) per_cu = 1;
    if (per_cu > 1) per_cu = 1;
    grid_blocks = cus * per_cu;
  }
  Params p{};
  const float** pf = (const float**)&p;
  for (int i = 0; i < 27; ++i) pf[i] = (const float*)d_in[i];
  p.out = (float*)d_out;
  p.ws = (char*)d_ws;
  if (WS_NEED > ws_size) { fprintf(stderr, "workspace too small: need %zu have %zu\n", (size_t)WS_NEED, ws_size); return; }
#if COOP
  int b = 0, e = N_PHASES;
  void* args[] = {&p, &b, &e};
  hipError_t err = hipLaunchCooperativeKernel((void*)mega_kernel, dim3(grid_blocks), dim3(NTHR), args, 0, stream);
  if (err != hipSuccess) fprintf(stderr, "cooperative launch failed: %s (grid %d)\n", hipGetErrorString(err), grid_blocks);
#else
  for (int ph = 0; ph < N_PHASES; ++ph) mega_kernel<<<grid_blocks, NTHR, 0, stream>>>(p, ph, ph + 1);
#endif
}
```

```cpp
#include <hip/hip_runtime.h>
#include <hip/hip_cooperative_groups.h>
#include <cstdio>
namespace cg = cooperative_groups;

#ifndef COOP
#define COOP 1
#endif
#ifndef REP0
#define REP0 1
#define REP1 1
#define REP2 1
#define REP3 1
#define REP4 1
#define REP5 1
#define REP6 1
#endif
#ifndef DUP_GDN
#define DUP_GDN 1
#endif
#ifndef DUP_DIFF
#define DUP_DIFF 1
#endif
#ifndef DUP_DSA1
#define DUP_DSA1 1
#endif
#ifndef DUP_DSA2
#define DUP_DSA2 1
#endif
#ifndef EN_A
#define EN_A 1
#endif
#ifndef EN_B
#define EN_B 1
#endif
#ifndef EN_C
#define EN_C 1
#endif

typedef unsigned short u16;
typedef unsigned int u32;
typedef unsigned long long u64;
using bf16x8 = __attribute__((ext_vector_type(8))) short;
using s16x4 = __attribute__((ext_vector_type(4))) short;
using f32x4 = __attribute__((ext_vector_type(4))) float;
using f32x16 = __attribute__((ext_vector_type(16))) float;
#define DI __device__ __forceinline__

constexpr int NT = 32768, T = 16384, PC = 4048;
constexpr int AQ = 0, AK = 512, AV = 1024, BQ = 1536, BK_ = 2048, BV = 2560, BZ = 3072, BA = 3584, BB = 3588,
              CQ = 3592, CKVc = 3848, CKI = 3976, CWI = 4040, GATES = 4048;
constexpr float EPS = 1e-6f;
constexpr float DN_ALPHA = 1.41421356237f;
constexpr int NTHR = 512;
constexpr int SMEM_BYTES = 153600 + 512;

constexpr size_t al256(size_t x) { return (x + 255) & ~(size_t)255; }
constexpr int LDX = 1088, LDH = 4160, LDQ = 1600;
constexpr int KP1024 = 1088, KP512 = 576, KP256 = 320, KP4096 = 4160;
constexpr size_t SZ_WIN = al256((size_t)7120 * KP1024 * 2), SZ_WQX = al256((size_t)1536 * KP256 * 2), SZ_WBR = al256((size_t)1024 * KP512 * 2),
                 SZ_WBRC = al256((size_t)1024 * KP1024 * 2), SZ_WO = al256((size_t)1024 * KP1024 * 2), SZ_WF1 = al256((size_t)4096 * KP1024 * 2), SZ_WF2 = al256((size_t)1024 * KP4096 * 2);
constexpr size_t O_WIN = 0, O_WQX = O_WIN + SZ_WIN, O_WBRA = O_WQX + SZ_WQX, O_WBRB = O_WBRA + SZ_WBR, O_WBRC = O_WBRB + SZ_WBR,
                 O_WO = O_WBRC + SZ_WBRC, O_WF1 = O_WO + SZ_WO, O_WF2 = O_WF1 + SZ_WF1, LAYER_W = O_WF2 + SZ_WF2;
constexpr size_t O_P = 2 * LAYER_W, O_XB = O_P + (size_t)NT * LDH * 2, O_M = O_XB + (size_t)NT * LDX * 2;
constexpr size_t O_KDT = O_M, O_ATT = O_KDT + 33554432, O_HALO = O_ATT + 16777216, O_KIDX = O_HALO + 4718592, O_CKV = O_KIDX + 4194304,
                 O_MEND = O_CKV + 8388608 + 4194304;
constexpr size_t O_WIDX = O_MEND, O_GL = O_WIDX + (size_t)NT * 8 * 4, O_LAM = O_GL + 8192, O_CNT = O_LAM + 256, O_BAR = O_CNT + 256, WS_NEED = O_BAR + 4096;
static_assert(O_MEND - O_M >= (size_t)NT * LDX * 2, "merged alias");

struct Params {
  const float *x, *w_in, *b_gate, *a_lambda, *a_subln_g, *b_conv_w, *b_a_log, *b_dt_bias, *b_norm_g,
      *c_q_norm_g, *c_kv_norm_g, *c_kidx_g, *c_kidx_b, *c_w_uq, *c_w_qidx, *c_w_uk, *c_w_uv,
      *w_branch_a, *w_branch_b, *w_branch_c, *w_o, *ln1_g, *ln1_b, *w_ff1, *w_ff2, *ln2_g, *ln2_b;
  float* out;
  char* ws;
  __device__ __forceinline__ u16* win(int l) const { return (u16*)(ws + l * LAYER_W + O_WIN); }
  __device__ __forceinline__ u16* wqx(int l) const { return (u16*)(ws + l * LAYER_W + O_WQX); }
  __device__ __forceinline__ u16* wbra(int l) const { return (u16*)(ws + l * LAYER_W + O_WBRA); }
  __device__ __forceinline__ u16* wbrb(int l) const { return (u16*)(ws + l * LAYER_W + O_WBRB); }
  __device__ __forceinline__ u16* wbrc(int l) const { return (u16*)(ws + l * LAYER_W + O_WBRC); }
  __device__ __forceinline__ u16* wo(int l) const { return (u16*)(ws + l * LAYER_W + O_WO); }
  __device__ __forceinline__ u16* wf1(int l) const { return (u16*)(ws + l * LAYER_W + O_WF1); }
  __device__ __forceinline__ u16* wf2(int l) const { return (u16*)(ws + l * LAYER_W + O_WF2); }
  __device__ __forceinline__ u16* P() const { return (u16*)(ws + O_P); }
  __device__ __forceinline__ u16* XB() const { return (u16*)(ws + O_XB); }
  __device__ __forceinline__ u16* KDT() const { return (u16*)(ws + O_KDT); }
  __device__ __forceinline__ u16* ATT() const { return (u16*)(ws + O_ATT); }
  __device__ __forceinline__ u16* HALO() const { return (u16*)(ws + O_HALO); }
  __device__ __forceinline__ u16* KIDX() const { return (u16*)(ws + O_KIDX); }
  __device__ __forceinline__ u16* CKV() const { return (u16*)(ws + O_CKV); }
  __device__ __forceinline__ u16* MERGED() const { return (u16*)(ws + O_M); }
  __device__ __forceinline__ float* WIDX() const { return (float*)(ws + O_WIDX); }
  __device__ __forceinline__ float* GL() const { return (float*)(ws + O_GL); }
  __device__ __forceinline__ float* LAM() const { return (float*)(ws + O_LAM); }
  __device__ __forceinline__ u32* CNT() const { return (u32*)(ws + O_CNT); }
  __device__ __forceinline__ u32* BAR() const { return (u32*)(ws + O_BAR); }
};

DI int lbid() { int b = blockIdx.x; asm volatile("" : "+s"(b)); return b; }
DI int lgdim() { int b = gridDim.x; asm volatile("" : "+s"(b)); return b; }
DI int ltid() { int t = threadIdx.x; asm volatile("" : "+v"(t)); return t; }
DI u16 f2bf(float x) { u32 u = __float_as_uint(x); u += 0x7fffu + ((u >> 16) & 1u); return (u16)(u >> 16); }
DI float bf2f(u16 h) { return __uint_as_float(((u32)h) << 16); }
DI u32 pack2(float a, float b) { return (u32)f2bf(a) | ((u32)f2bf(b) << 16); }
DI float bflo(u32 v) { return __uint_as_float(v << 16); }
DI float bfhi(u32 v) { return __uint_as_float(v & 0xffff0000u); }
DI f32x4 mfma16(bf16x8 a, bf16x8 b, f32x4 c) { return __builtin_amdgcn_mfma_f32_16x16x32_bf16(a, b, c, 0, 0, 0); }
DI f32x16 mfma32(bf16x8 a, bf16x8 b, f32x16 c) { return __builtin_amdgcn_mfma_f32_32x32x16_bf16(a, b, c, 0, 0, 0); }
DI int crow(int i, int hh) { return (i & 3) + 8 * (i >> 2) + 4 * hh; }
DI float sigmoidf_(float x) { return 1.f / (1.f + __expf(-x)); }
DI float siluf_(float x) { return x / (1.f + __expf(-x)); }
DI u32 lane_lt_cnt(u64 m) { return __builtin_amdgcn_mbcnt_hi((u32)(m >> 32), __builtin_amdgcn_mbcnt_lo((u32)m, 0)); }

DI bf16x8 pack8(const f32x16& x, int s) {
  u32 p0, p1, p2, p3;
  if (s == 0) {
    asm volatile("v_cvt_pk_bf16_f32 %0, %4, %5\n\tv_cvt_pk_bf16_f32 %1, %6, %7\n\tv_cvt_pk_bf16_f32 %2, %8, %9\n\tv_cvt_pk_bf16_f32 %3, %10, %11\n\ts_nop 1"
                 : "=&v"(p0), "=&v"(p1), "=&v"(p2), "=&v"(p3)
                 : "v"(x[0]), "v"(x[1]), "v"(x[2]), "v"(x[3]), "v"(x[4]), "v"(x[5]), "v"(x[6]), "v"(x[7]));
  } else {
    asm volatile("v_cvt_pk_bf16_f32 %0, %4, %5\n\tv_cvt_pk_bf16_f32 %1, %6, %7\n\tv_cvt_pk_bf16_f32 %2, %8, %9\n\tv_cvt_pk_bf16_f32 %3, %10, %11\n\ts_nop 1"
                 : "=&v"(p0), "=&v"(p1), "=&v"(p2), "=&v"(p3)
                 : "v"(x[8]), "v"(x[9]), "v"(x[10]), "v"(x[11]), "v"(x[12]), "v"(x[13]), "v"(x[14]), "v"(x[15]));
  }
  typedef u32 u32x4 __attribute__((ext_vector_type(4)));
  u32x4 v = {p0, p1, p2, p3};
  return __builtin_bit_cast(bf16x8, v);
}
DI bf16x8 afrag_perm(const char* base, int row, int stride, int kbase, int hh) {
  const char* pr = base + row * stride + (kbase + 4 * hh) * 2;
  s16x4 lo = *(const s16x4*)pr;
  s16x4 hi = *(const s16x4*)(pr + 16);
  return __builtin_shufflevector(lo, hi, 0, 1, 2, 3, 4, 5, 6, 7);
}
DI bf16x8 trfrag(const char* img, int stride, int krow0, int col0, int ln) {
  const int hh = ln >> 5, chalf = (ln >> 4) & 1, q4 = (ln & 15) >> 2, p4 = ln & 3;
  u32 a = (u32)(size_t)(img + (krow0 + 4 * hh + q4) * stride + (col0 + 16 * chalf + 4 * p4) * 2);
  s16x4 lo, hi;
  asm volatile("ds_read_b64_tr_b16 %0, %2\n\tds_read_b64_tr_b16 %1, %3\n\ts_waitcnt lgkmcnt(0)"
               : "=&v"(lo), "=&v"(hi) : "v"(a), "v"(a + 8 * stride) : "memory");
  return __builtin_shufflevector(lo, hi, 0, 1, 2, 3, 4, 5, 6, 7);
}

template <int STRIDE>
DI void trfrag4(const char* img, int krow0, int ln, bf16x8 (&f)[4]) {
  const int hh = ln >> 5, chalf = (ln >> 4) & 1, q4 = (ln & 15) >> 2, p4 = ln & 3;
  const u32 a = (u32)(size_t)(img + (krow0 + 4 * hh + q4) * STRIDE + (16 * chalf + 4 * p4) * 2);
  s16x4 l0, h0, l1, h1, l2, h2, l3, h3;
  asm volatile(
      "ds_read_b64_tr_b16 %0, %8\n\tds_read_b64_tr_b16 %1, %8 offset:%9\n\t"
      "ds_read_b64_tr_b16 %2, %8 offset:64\n\tds_read_b64_tr_b16 %3, %8 offset:%10\n\t"
      "ds_read_b64_tr_b16 %4, %8 offset:128\n\tds_read_b64_tr_b16 %5, %8 offset:%11\n\t"
      "ds_read_b64_tr_b16 %6, %8 offset:192\n\tds_read_b64_tr_b16 %7, %8 offset:%12\n\t"
      "s_waitcnt lgkmcnt(0)"
      : "=&v"(l0), "=&v"(h0), "=&v"(l1), "=&v"(h1), "=&v"(l2), "=&v"(h2), "=&v"(l3), "=&v"(h3)
      : "v"(a), "i"(8 * STRIDE), "i"(8 * STRIDE + 64), "i"(8 * STRIDE + 128), "i"(8 * STRIDE + 192)
      : "memory");
  f[0] = __builtin_shufflevector(l0, h0, 0, 1, 2, 3, 4, 5, 6, 7);
  f[1] = __builtin_shufflevector(l1, h1, 0, 1, 2, 3, 4, 5, 6, 7);
  f[2] = __builtin_shufflevector(l2, h2, 0, 1, 2, 3, 4, 5, 6, 7);
  f[3] = __builtin_shufflevector(l3, h3, 0, 1, 2, 3, 4, 5, 6, 7);
}

template <int MT, int NT>
DI void gemm_core(const u16* __restrict__ A, int lda, const u16* __restrict__ B, int ldb, int K,
                  f32x4 (&acc)[MT][NT], char* smem) {
  constexpr int BM = 64 * MT, BN = 32 * NT;
  constexpr int ASZ = BM * 128, BSZ = BN * 128, BUF = ASZ + BSZ;
  constexpr int NA = BM / 64, NB = BN / 64;
  const int tid = ltid(), l = tid & 63, w = tid >> 6, wm = w >> 1, wn = w & 1;
  const int fr = l & 15, fq = l >> 4;
  uint4 ra0, ra1, ra2, ra3, rb0, rb1, rb2, rb3;
  const int nk = K >> 6;
  const int srow = tid >> 3, sch = tid & 7;
  const int ssw = sch ^ ((srow >> 1) & 7);
  const int fsw = (fr >> 1) & 7;
#define GL1(i, kt)                                                                                        \
  if (NA > i) ra##i = *(const uint4*)(A + (size_t)(srow + 64 * i) * lda + (kt) * 64 + sch * 8);           \
  if (NB > i) rb##i = *(const uint4*)(B + (size_t)(srow + 64 * i) * ldb + (kt) * 64 + sch * 8);
#define GLOAD(kt) { GL1(0, kt) GL1(1, kt) GL1(2, kt) GL1(3, kt) }
#define SS1(i)                                                                   \
  if (NA > i) *(uint4*)(as_ + (srow + 64 * i) * 128 + ssw * 16) = ra##i;         \
  if (NB > i) *(uint4*)(bs_ + (srow + 64 * i) * 128 + ssw * 16) = rb##i;
#define SSTORE(buf)                              \
  {                                              \
    char* as_ = smem + (buf) * BUF;              \
    char* bs_ = as_ + ASZ;                       \
    SS1(0) SS1(1) SS1(2) SS1(3)                  \
  }
  GLOAD(0);
  SSTORE(0);
  __syncthreads();
#pragma unroll 1
  for (int kt = 0; kt < nk; ++kt) {
    if (kt + 1 < nk) GLOAD(kt + 1);
    const char* as = smem + (kt & 1) * BUF;
    const char* bs = as + ASZ;
#pragma unroll
    for (int kk = 0; kk < 2; ++kk) {
      bf16x8 xf[MT], wf[NT];
#pragma unroll
      for (int mi = 0; mi < MT; ++mi)
        xf[mi] = *(const bf16x8*)(as + (wm * (MT * 16) + mi * 16 + fr) * 128 + (((kk * 4 + fq) ^ fsw) * 16));
#pragma unroll
      for (int ni = 0; ni < NT; ++ni)
        wf[ni] = *(const bf16x8*)(bs + (wn * (NT * 16) + ni * 16 + fr) * 128 + (((kk * 4 + fq) ^ fsw) * 16));
#pragma unroll
      for (int mi = 0; mi < MT; ++mi)
#pragma unroll
        for (int ni = 0; ni < NT; ++ni) acc[mi][ni] = mfma16(wf[ni], xf[mi], acc[mi][ni]);
    }
    if (kt + 1 < nk) SSTORE((kt + 1) & 1);
    __syncthreads();
  }
#undef GLOAD
#undef SSTORE
#undef GL1
#undef SS1
}
template <int MT, int NT>
DI void zero_acc(f32x4 (&acc)[MT][NT]) {
#pragma unroll
  for (int i = 0; i < MT; ++i)
#pragma unroll
    for (int j = 0; j < NT; ++j) acc[i][j] = f32x4{0.f, 0.f, 0.f, 0.f};
}


DI bool next_tile(int it, int RT, int CT, int PR, int PCc, int& rt, int& ct) {
  const int bid = lbid(), x = bid & 7, j = bid >> 3, J = lgdim() >> 3;
  const int u = j + it * J;
  const int pcols = CT / PCc, npatch = (RT / PR) * pcols;
  const int pid = (u >> 6) * 8 + x;
  if (pid >= npatch) return false;
  const int w = u & 63, pr = pid / pcols, pc = pid - pr * pcols;
  rt = pr * PR + w / PCc;
  ct = pc * PCc + w % PCc;
  return true;
}
DI void transpose_job(const float* __restrict__ src, int K, int N, u16* __restrict__ dst, int ldd, const float* kscale, char* smem) {
  float(*tile)[65] = (float(*)[65])smem;
  const int ntn = (N + 63) >> 6, ntk = K >> 6, tid = ltid();
  for (int t = lbid(); t < ntn * ntk; t += lgdim()) {
    const int tk = t / ntn, tn = t % ntn, k0 = tk * 64, n0 = tn * 64;
    {
      const int n = tid & 63, kb = tid >> 6;
      for (int i = 0; i < 8; ++i) {
        const int k = kb + 8 * i;
        float v = (n0 + n < N) ? src[(size_t)(k0 + k) * N + n0 + n] : 0.f;
        if (kscale) v *= kscale[k0 + k];
        tile[k][n] = v;
      }
    }
    __syncthreads();
    {
      const int k = tid & 63, nb = tid >> 6;
      for (int i = 0; i < 8; ++i) {
        const int n = nb + 8 * i;
        if (n0 + n < N) dst[(size_t)(n0 + n) * ldd + k0 + k] = f2bf(tile[k][n]);
      }
    }
    __syncthreads();
  }
}

DI void phase0(const Params& p, char* smem) {
  const size_t gtid = (size_t)lbid() * NTHR + ltid(), gsz = (size_t)lgdim() * NTHR;
  for (int l = 0; l < 2; ++l) {
    transpose_job(p.w_in + (size_t)l * 1024 * 7120, 1024, 7120, p.win(l), KP1024, nullptr, smem);
    transpose_job(p.w_branch_a + (size_t)l * 512 * 1024, 512, 1024, p.wbra(l), KP512, nullptr, smem);
    transpose_job(p.w_branch_b + (size_t)l * 512 * 1024, 512, 1024, p.wbrb(l), KP512, nullptr, smem);
    transpose_job(p.w_o + (size_t)l * 1024 * 1024, 1024, 1024, p.wo(l), KP1024, nullptr, smem);
    transpose_job(p.w_ff1 + (size_t)l * 1024 * 4096, 1024, 4096, p.wf1(l), KP1024, nullptr, smem);
    transpose_job(p.w_ff2 + (size_t)l * 4096 * 1024, 4096, 1024, p.wf2(l), KP4096, nullptr, smem);
    transpose_job(p.c_w_qidx + (size_t)l * 256 * 512, 256, 512, p.wqx(l) + 1024 * KP256, KP256, p.c_q_norm_g + l * 256, smem);
    {
      const float* uq = p.c_w_uq + (size_t)l * 256 * 512;
      const float* uk = p.c_w_uk + (size_t)l * 128 * 512;
      const float* g = p.c_q_norm_g + l * 256;
      for (size_t e = gtid; e < 1024 * 256; e += gsz) {
        const int n = (int)(e >> 8), k = (int)(e & 255), h = n >> 7, r2 = n & 127;
        const float4* a = (const float4*)(uq + (k * 8 + h) * 64);
        const float4* b = (const float4*)(uk + (r2 * 8 + h) * 64);
        float s = 0.f;
        for (int d = 0; d < 16; ++d) { float4 x = a[d], y = b[d]; s += x.x * y.x + x.y * y.y + x.z * y.z + x.w * y.w; }
        p.wqx(l)[(size_t)n * KP256 + k] = f2bf(s * g[k]);
      }
    }
    {
      const float* uv = p.c_w_uv + (size_t)l * 128 * 512;
      const float* bc = p.w_branch_c + (size_t)l * 512 * 1024;
      for (size_t e = gtid; e < 1024 * 256; e += gsz) {
        const int k = (int)(e >> 8), n4 = (int)(e & 255) * 4, h = k >> 7, r = k & 127;
        const float* a = uv + (r * 8 + h) * 64;
        const float* b = bc + (size_t)(h * 64) * 1024 + n4;
        float4 acc4 = float4{0.f, 0.f, 0.f, 0.f};
#pragma unroll 8
        for (int d = 0; d < 64; ++d) {
          const float4 v = *(const float4*)(b + (size_t)d * 1024);
          const float ad = a[d];
          acc4.x += ad * v.x; acc4.y += ad * v.y; acc4.z += ad * v.z; acc4.w += ad * v.w;
        }
        u16* dst = p.wbrc(l) + (size_t)n4 * KP1024 + k;
        dst[0] = f2bf(acc4.x); dst[KP1024] = f2bf(acc4.y); dst[2 * KP1024] = f2bf(acc4.z); dst[3 * KP1024] = f2bf(acc4.w);
      }
    }
  }
  for (size_t e = gtid; e < (size_t)NT * 1024 / 8; e += gsz) {
    const float4 a = ((const float4*)p.x)[2 * e], b = ((const float4*)p.x)[2 * e + 1];
    uint4 o;
    o.x = pack2(a.x, a.y); o.y = pack2(a.z, a.w); o.z = pack2(b.x, b.y); o.w = pack2(b.z, b.w);
    *(uint4*)(p.XB() + (e >> 7) * LDX + (e & 127) * 8) = o;
  }
  if (gtid < 2) {
    const int l = (int)gtid;
    const float* lp = p.a_lambda + l * 256;
    float s1 = 0.f, s2 = 0.f;
    for (int i = 0; i < 64; ++i) { s1 += lp[i] * lp[64 + i]; s2 += lp[128 + i] * lp[192 + i]; }
    const float lam_init = 0.8f - 0.6f * expf(-0.3f * l);
    p.LAM()[l] = expf(s1) - expf(s2) + lam_init;
    p.LAM()[2 + l] = lam_init;
    for (int i = 0; i < 8; ++i) p.CNT()[l * 8 + i] = 0;
  }
}

DI void ln_phase(const float* S, const float* __restrict__ g, const float* __restrict__ b, u16* XBo, float* fout) {
  const int l = ltid() & 63;
  const int wave = lbid() * 8 + (ltid() >> 6), nw = lgdim() * 8;
  for (int row = wave; row < NT; row += nw) {
    float4 v[4];
    float s = 0.f;
#pragma unroll
    for (int i = 0; i < 4; ++i) { v[i] = *(const float4*)(S + (size_t)row * 1024 + i * 256 + l * 4); s += v[i].x + v[i].y + v[i].z + v[i].w; }
#pragma unroll
    for (int o = 32; o; o >>= 1) s += __shfl_xor(s, o);
    const float mu = s * (1.f / 1024.f);
    float q = 0.f;
#pragma unroll
    for (int i = 0; i < 4; ++i) { float a = v[i].x - mu, bb = v[i].y - mu, c = v[i].z - mu, d = v[i].w - mu; q += a * a + bb * bb + c * c + d * d; }
#pragma unroll
    for (int o = 32; o; o >>= 1) q += __shfl_xor(q, o);
    const float rs = rsqrtf(q * (1.f / 1024.f) + EPS);
#pragma unroll
    for (int i = 0; i < 4; ++i) {
      const int c = i * 256 + l * 4;
      const float4 gg = *(const float4*)(g + c), bb = *(const float4*)(b + c);
      float4 y;
      y.x = (v[i].x - mu) * rs * gg.x + bb.x; y.y = (v[i].y - mu) * rs * gg.y + bb.y;
      y.z = (v[i].z - mu) * rs * gg.z + bb.z; y.w = (v[i].w - mu) * rs * gg.w + bb.w;
      if (fout) *(float4*)(fout + (size_t)row * 1024 + c) = y;
      if (XBo) { uint2 o; o.x = pack2(y.x, y.y); o.y = pack2(y.z, y.w); *(uint2*)(XBo + (size_t)row * LDX + c) = o; }
    }
  }
}

#define EPI_LOOP(MT_, NT_)                                                \
  const int l_ = ltid() & 63, w_ = ltid() >> 6;                           \
  const int wm_ = w_ >> 1, wn_ = w_ & 1, fr_ = l_ & 15, fq_ = l_ >> 4;    \
  _Pragma("unroll") for (int mi = 0; mi < MT_; ++mi)                      \
  _Pragma("unroll") for (int ni = 0; ni < NT_; ++ni)

DI void phase_inproj(const Params& p, int l, char* smem) {
  int rt, ct;
  for (int it = 0; next_tile(it, 128, 16, 8, 8, rt, ct); ++it) {
    const int r0 = rt * 256, c0 = ct * 256;
    f32x4 acc[4][8];
    zero_acc<4, 8>(acc);
    gemm_core<4, 8>(p.XB() + (size_t)r0 * LDX, LDX, p.win(l) + (size_t)c0 * KP1024, KP1024, 1024, acc, smem);
    EPI_LOOP(4, 8) {
      const int row = r0 + wm_ * 64 + mi * 16 + fr_, col = c0 + wn_ * 128 + ni * 16 + fq_ * 4;
      if (col < PC) {
        uint2 o;
        o.x = pack2(acc[mi][ni][0], acc[mi][ni][1]); o.y = pack2(acc[mi][ni][2], acc[mi][ni][3]);
        *(uint2*)(p.P() + (size_t)row * PC + col) = o;
        if (col >= BQ && col < BZ && (row & 63) >= 61)
          *(uint2*)(p.HALO() + ((size_t)(row >> 6) * 3 + ((row & 63) - 61)) * 1536 + (col - BQ)) = o;
      }
    }
  }
}

DI void qx_tile(const Params& p, int l, int rt, int ct, char* smem) {
  const int r0 = rt * 256, c0 = ct * 256;
  float* rsv = (float*)(smem + 147456);
  {
    const int row = ltid() >> 1, half = ltid() & 1;
    const uint4* src = (const uint4*)(p.P() + (size_t)(r0 + row) * PC + CQ + half * 128);
    float ss = 0.f;
    for (int i = 0; i < 16; ++i) {
      uint4 v = src[i];
      float a;
      a = bflo(v.x); ss += a * a; a = bfhi(v.x); ss += a * a; a = bflo(v.y); ss += a * a; a = bfhi(v.y); ss += a * a;
      a = bflo(v.z); ss += a * a; a = bfhi(v.z); ss += a * a; a = bflo(v.w); ss += a * a; a = bfhi(v.w); ss += a * a;
    }
    ss += __shfl_xor(ss, 1);
    if (!half) rsv[row] = rsqrtf(ss * (1.f / 256.f) + EPS);
  }
  f32x4 acc[4][8];
  zero_acc<4, 8>(acc);
  gemm_core<4, 8>(p.P() + (size_t)r0 * PC + CQ, PC, p.wqx(l) + (size_t)c0 * KP256, KP256, 256, acc, smem);
  u16* QX = (u16*)p.out;
  EPI_LOOP(4, 8) {
    const int rl = wm_ * 64 + mi * 16 + fr_, col = c0 + wn_ * 128 + ni * 16 + fq_ * 4;
    const float rs = rsv[rl];
    uint2 o;
    o.x = pack2(acc[mi][ni][0] * rs, acc[mi][ni][1] * rs); o.y = pack2(acc[mi][ni][2] * rs, acc[mi][ni][3] * rs);
    *(uint2*)(QX + (size_t)(r0 + rl) * LDQ + col) = o;
  }
  __syncthreads();
}

DI void phase_merge(const Params& p, int l, char* smem) {
  const u16* QX = (const u16*)p.out;
  int rt, ct;
  for (int it = 0; next_tile(it, 256, 8, 8, 8, rt, ct); ++it) {
    const int r0 = rt * 128, c0 = ct * 128;
    f32x4 mg[2][4];
    zero_acc<2, 4>(mg);
#pragma unroll 1
    for (int j = 0; j < 3; ++j) {
      if ((j == 0 && !EN_A) || (j == 1 && !EN_B) || (j == 2 && !EN_C)) continue;
      const u16* Ab; const u16* Wb; int lda, K;
      int ldw;
      if (j == 0) { Ab = p.P() + (size_t)r0 * PC + AQ; lda = PC; Wb = p.wbra(l) + (size_t)c0 * KP512; K = 512; ldw = KP512; }
      else if (j == 1) { Ab = p.P() + (size_t)r0 * PC + BZ; lda = PC; Wb = p.wbrb(l) + (size_t)c0 * KP512; K = 512; ldw = KP512; }
      else { Ab = QX + (size_t)r0 * LDQ; lda = LDQ; Wb = p.wbrc(l) + (size_t)c0 * KP1024; K = 1024; ldw = KP1024; }
      f32x4 g[2][4];
      zero_acc<2, 4>(g);
      gemm_core<2, 4>(p.XB() + (size_t)r0 * LDX, LDX, p.win(l) + (size_t)(GATES + j * 1024 + c0) * KP1024, KP1024, 1024, g, smem);
      const float* bg = p.b_gate + l * 3072 + j * 1024;
      {
        EPI_LOOP(2, 4) {
          const int col = c0 + wn_ * 64 + ni * 16 + fq_ * 4;
          const float4 bb = *(const float4*)(bg + col);
          g[mi][ni][0] = sigmoidf_(g[mi][ni][0] + bb.x);
          g[mi][ni][1] = sigmoidf_(g[mi][ni][1] + bb.y);
          g[mi][ni][2] = sigmoidf_(g[mi][ni][2] + bb.z);
          g[mi][ni][3] = sigmoidf_(g[mi][ni][3] + bb.w);
        }
      }
      f32x4 br[2][4];
      zero_acc<2, 4>(br);
      gemm_core<2, 4>(Ab, lda, Wb, ldw, K, br, smem);
#pragma unroll
      for (int mi = 0; mi < 2; ++mi)
#pragma unroll
        for (int ni = 0; ni < 4; ++ni) mg[mi][ni] += g[mi][ni] * br[mi][ni];
    }
    EPI_LOOP(2, 4) {
      const int row = r0 + wm_ * 32 + mi * 16 + fr_, col = c0 + wn_ * 64 + ni * 16 + fq_ * 4;
      uint2 o;
      o.x = pack2(mg[mi][ni][0], mg[mi][ni][1]); o.y = pack2(mg[mi][ni][2], mg[mi][ni][3]);
      *(uint2*)(p.MERGED() + (size_t)row * LDX + col) = o;
    }
  }
}

DI void phase_resgemm(const Params& p, const u16* A, int lda, const u16* W, int ldw, int K, char* smem) {
  int rt, ct;
  for (int it = 0; next_tile(it, 128, 4, 16, 4, rt, ct); ++it) {
    const int r0 = rt * 256, c0 = ct * 256;
    f32x4 acc[4][8];
    zero_acc<4, 8>(acc);
    gemm_core<4, 8>(A + (size_t)r0 * lda, lda, W + (size_t)c0 * ldw, ldw, K, acc, smem);
    EPI_LOOP(4, 8) {
      const int row = r0 + wm_ * 64 + mi * 16 + fr_, col = c0 + wn_ * 128 + ni * 16 + fq_ * 4;
      const uint2 xb = *(const uint2*)(p.XB() + (size_t)row * LDX + col);
      float4 o;
      o.x = DN_ALPHA * bflo(xb.x) + acc[mi][ni][0]; o.y = DN_ALPHA * bfhi(xb.x) + acc[mi][ni][1];
      o.z = DN_ALPHA * bflo(xb.y) + acc[mi][ni][2]; o.w = DN_ALPHA * bfhi(xb.y) + acc[mi][ni][3];
      *(float4*)(p.out + (size_t)row * 1024 + col) = o;
    }
  }
}

DI void phase_ff1(const Params& p, int l, char* smem) {
  int rt, ct;
  for (int it = 0; next_tile(it, 128, 16, 8, 8, rt, ct); ++it) {
    const int r0 = rt * 256, c0 = ct * 256;
    f32x4 acc[4][8];
    zero_acc<4, 8>(acc);
    gemm_core<4, 8>(p.XB() + (size_t)r0 * LDX, LDX, p.wf1(l) + (size_t)c0 * KP1024, KP1024, 1024, acc, smem);
    EPI_LOOP(4, 8) {
      const int row = r0 + wm_ * 64 + mi * 16 + fr_, col = c0 + wn_ * 128 + ni * 16 + fq_ * 4;
      float a0 = fmaxf(acc[mi][ni][0], 0.f), a1 = fmaxf(acc[mi][ni][1], 0.f), a2 = fmaxf(acc[mi][ni][2], 0.f), a3 = fmaxf(acc[mi][ni][3], 0.f);
      uint2 o;
      o.x = pack2(a0 * a0, a1 * a1); o.y = pack2(a2 * a2, a3 * a3);
      *(uint2*)(p.P() + (size_t)row * LDH + col) = o;
    }
  }
}

DI void dsa_kprep_item(const Params& p, int l, int it) {
  const int ln = ltid() & 63, w = ltid() >> 6;
  const float g0 = p.c_kv_norm_g[l * 128 + 2 * ln], g1 = p.c_kv_norm_g[l * 128 + 2 * ln + 1];
  const float kg = p.c_kidx_g[l * 64 + ln], kb = p.c_kidx_b[l * 64 + ln];
  for (int i = 0; i < 8; ++i) {
    const size_t tok = (size_t)it * 64 + w * 8 + i;
    const u16* pr = p.P() + tok * PC;
    const u32 v = *(const u32*)(pr + CKVc + 2 * ln);
    const float a = bflo(v), b = bfhi(v);
    float ss = a * a + b * b;
#pragma unroll
    for (int o = 32; o; o >>= 1) ss += __shfl_xor(ss, o);
    const float rs = rsqrtf(ss * (1.f / 128.f) + EPS);
    *(u32*)(p.CKV() + tok * 128 + 2 * ln) = pack2(a * rs * g0, b * rs * g1);
    const float k = bf2f(pr[CKI + ln]);
    float s = k;
#pragma unroll
    for (int o = 32; o; o >>= 1) s += __shfl_xor(s, o);
    const float mu = s * (1.f / 64.f);
    float q = (k - mu) * (k - mu);
#pragma unroll
    for (int o = 32; o; o >>= 1) q += __shfl_xor(q, o);
    p.KIDX()[tok * 64 + ln] = f2bf((k - mu) * rsqrtf(q * (1.f / 64.f) + EPS) * kg + kb);
    if (ln < 8) p.WIDX()[tok * 8 + ln] = bf2f(pr[CWI + ln]) * 0.04419417382f;
  }
}

DI void gdn_prep_item(const Params& p, int l, int it, char* smem0) {
  const int half_ = ltid() >> 8;
  const int cidx = it >> 1, h = (it & 1) * 2 + half_, n = cidx & 255;
  const size_t t0g = (size_t)cidx * 64;
  char* smem = smem0 + half_ * 69632;
  const int tid = ltid() & 255, ln = tid & 63, w = tid >> 6;
  char* qs = smem;
  char* ks = smem + 17408;
  char* vs = smem + 2 * 17408;
  float* Lm = (float*)(smem + 3 * 17408);
  float* gcs = Lm + 4096;
  float* bts = gcs + 64;
  float* egs = bts + 64;
  u16* proj = p.P();
  {
    const int c = tid & 127, rh = tid >> 7;
    uint4 st[12];
#pragma unroll
    for (int part = 0; part < 3; ++part)
#pragma unroll
      for (int i = 0; i < 4; ++i) {
        const int piece = tid + 256 * i, row = piece >> 4, ch = piece & 15;
        st[part * 4 + i] = *(const uint4*)(proj + (t0g + row) * PC + BQ + part * 512 + h * 128 + ch * 8);
      }
    float hx[9];
#pragma unroll
    for (int i = 0; i < 9; ++i) hx[i] = 0.f;
    if (rh == 0 && n != 0) {
#pragma unroll
      for (int part = 0; part < 3; ++part) {
        const u16* hp = p.HALO() + ((size_t)(cidx - 1) * 3) * 1536 + part * 512 + h * 128 + c;
        hx[part * 3 + 0] = bf2f(hp[0]); hx[part * 3 + 1] = bf2f(hp[1536]); hx[part * 3 + 2] = bf2f(hp[2 * 1536]);
      }
    }
#pragma unroll
    for (int part = 0; part < 3; ++part)
#pragma unroll
      for (int i = 0; i < 4; ++i) {
        const int piece = tid + 256 * i, row = piece >> 4, ch = piece & 15;
        char* dst = (part == 0 ? qs : (part == 1 ? ks : vs));
        *(uint4*)(dst + row * 272 + ch * 16) = st[part * 4 + i];
      }
    __syncthreads();
    if (rh == 1) {
#pragma unroll
      for (int part = 0; part < 3; ++part) {
        const char* src = (part == 0 ? qs : (part == 1 ? ks : vs));
        hx[part * 3 + 0] = bf2f(*(const u16*)(src + 29 * 272 + c * 2));
        hx[part * 3 + 1] = bf2f(*(const u16*)(src + 30 * 272 + c * 2));
        hx[part * 3 + 2] = bf2f(*(const u16*)(src + 31 * 272 + c * 2));
      }
    }
    __syncthreads();
#pragma unroll
    for (int part = 0; part < 3; ++part) {
      const int wch = part * 512 + h * 128 + c;
      const float* cw = p.b_conv_w + (size_t)l * 4 * 1536 + wch;
      const float w0 = cw[0], w1 = cw[1536], w2 = cw[2 * 1536], w3 = cw[3 * 1536];
      float xm3 = hx[part * 3 + 0], xm2 = hx[part * 3 + 1], xm1 = hx[part * 3 + 2];
      char* dst = (part == 0 ? qs : (part == 1 ? ks : vs));
#pragma unroll 8
      for (int i = 0; i < 32; ++i) {
        const int r = rh * 32 + i;
        u16* px = (u16*)(dst + r * 272 + c * 2);
        const float x = bf2f(*px);
        const float y = w0 * xm3 + w1 * xm2 + w2 * xm1 + w3 * x;
        xm3 = xm2; xm2 = xm1; xm1 = x;
        *px = f2bf(siluf_(y));
      }
    }
  }
  if (w == 0) {
    const float a = bf2f(proj[(t0g + ln) * PC + BA + h]) + p.b_dt_bias[l * 4 + h];
    const float ea = __expf(a);
    const float sp = (a > 20.f) ? a : ((ea < 0.01f) ? ea * (1.f - ea * (0.5f - ea * 0.333333333f)) : __logf(1.f + ea));
    float g = -__expf(p.b_a_log[l * 4 + h]) * sp;
#pragma unroll
    for (int o = 1; o < 64; o <<= 1) { float t = __shfl_up(g, o); if (ln >= o) g += t; }
    gcs[ln] = g;
    egs[ln] = __expf(g);
    bts[ln] = sigmoidf_(bf2f(proj[(t0g + ln) * PC + BB + h]));
  }
  __syncthreads();
  {
    const int row = tid >> 2, qr = tid & 3;
#pragma unroll
    for (int part = 0; part < 2; ++part) {
      char* base = (part == 0 ? qs : ks) + row * 272 + qr * 64;
      uint4 v[4];
      float ss = 0.f;
#pragma unroll
      for (int i = 0; i < 4; ++i) {
        v[i] = *(uint4*)(base + i * 16);
        float a;
        a = bflo(v[i].x); ss += a * a; a = bfhi(v[i].x); ss += a * a; a = bflo(v[i].y); ss += a * a; a = bfhi(v[i].y); ss += a * a;
        a = bflo(v[i].z); ss += a * a; a = bfhi(v[i].z); ss += a * a; a = bflo(v[i].w); ss += a * a; a = bfhi(v[i].w); ss += a * a;
      }
      ss += __shfl_xor(ss, 1);
      ss += __shfl_xor(ss, 2);
      const float rs = rsqrtf(ss + EPS) * (part == 0 ? 0.08838834764f : 1.f);
#pragma unroll
      for (int i = 0; i < 4; ++i) {
        uint4 o;
        o.x = pack2(bflo(v[i].x) * rs, bfhi(v[i].x) * rs); o.y = pack2(bflo(v[i].y) * rs, bfhi(v[i].y) * rs);
        o.z = pack2(bflo(v[i].z) * rs, bfhi(v[i].z) * rs); o.w = pack2(bflo(v[i].w) * rs, bfhi(v[i].w) * rs);
        *(uint4*)(base + i * 16) = o;
      }
    }
  }
  __syncthreads();
  {
    const int fr = ln & 15, fq = ln >> 4;
    f32x4 kk[4], qk[4];
#pragma unroll
    for (int nt = 0; nt < 4; ++nt) { kk[nt] = f32x4{0, 0, 0, 0}; qk[nt] = f32x4{0, 0, 0, 0}; }
#pragma unroll
    for (int s = 0; s < 4; ++s) {
      const bf16x8 ak = *(const bf16x8*)(ks + (16 * w + fr) * 272 + (32 * s + 8 * fq) * 2);
      const bf16x8 aq = *(const bf16x8*)(qs + (16 * w + fr) * 272 + (32 * s + 8 * fq) * 2);
#pragma unroll
      for (int nt = 0; nt < 4; ++nt) {
        const bf16x8 bk = *(const bf16x8*)(ks + (16 * nt + fr) * 272 + (32 * s + 8 * fq) * 2);
        kk[nt] = mfma16(ak, bk, kk[nt]);
        qk[nt] = mfma16(aq, bk, qk[nt]);
      }
    }
#pragma unroll
    for (int nt = 0; nt < 4; ++nt)
#pragma unroll
      for (int jj = 0; jj < 4; ++jj) {
        const int i = 16 * w + 4 * fq + jj, j = 16 * nt + fr;
        const float dec = (i >= j) ? __expf(gcs[i] - gcs[j]) : 0.f;
        Lm[i * 64 + j] = (i > j) ? bts[i] * kk[nt][jj] * dec : 0.f;
        p.ATT()[(t0g + i) * 256 + h * 64 + j] = f2bf((i >= j) ? qk[nt][jj] * dec : 0.f);
      }
  }
  __syncthreads();
  {
    const int c = tid;
    const bool isu = c < 128;
    const char* src = isu ? (vs + c * 2) : (ks + (c - 128) * 2);
    const float wsel = isu ? 0.f : 1.f;
    float x[64];
#pragma unroll
    for (int i = 0; i < 64; ++i) {
      float a = bf2f(*(const u16*)(src + i * 272)) * bts[i] * fmaf(egs[i] - 1.f, wsel, 1.f);
      const float* Lr = Lm + i * 64;
#pragma unroll
      for (int j = 0; j < i; ++j) a -= Lr[j] * x[j];
      x[i] = a;
      asm volatile("" ::: "memory");
    }
    if (isu) {
      u32 pk[32];
#pragma unroll
      for (int pos = 0; pos < 64; pos += 2) {
        const int hh = pos >> 5, Tt = (pos >> 4) & 1, ii = pos & 15;
        const int r0 = 32 * Tt + (ii & 3) + 8 * (ii >> 2) + 4 * hh;
        const int i1 = ii + 1;
        const int r1 = 32 * Tt + (i1 & 3) + 8 * (i1 >> 2) + 4 * hh;
        pk[pos >> 1] = pack2(x[r0], x[r1]);
      }
      char* dst = (char*)proj + ((t0g + (c >> 1)) * PC + BV + h * 128) * 2 + (c & 1) * 128;
#pragma unroll
      for (int i = 0; i < 8; ++i) *(uint4*)(dst + i * 16) = uint4{pk[4 * i], pk[4 * i + 1], pk[4 * i + 2], pk[4 * i + 3]};
    } else {
#pragma unroll
      for (int i = 0; i < 64; ++i) proj[(t0g + i) * PC + BK_ + h * 128 + (c - 128)] = f2bf(x[i]);
    }
  }
  {
    const float glast = gcs[63];
#pragma unroll
    for (int i = 0; i < 4; ++i) {
      const int piece = tid + 256 * i, row = piece >> 4, ch = piece & 15;
      const uint4 v = *(const uint4*)(qs + row * 272 + ch * 16);
      const float e = egs[row];
      uint4 o;
      o.x = pack2(bflo(v.x) * e, bfhi(v.x) * e); o.y = pack2(bflo(v.y) * e, bfhi(v.y) * e);
      o.z = pack2(bflo(v.z) * e, bfhi(v.z) * e); o.w = pack2(bflo(v.w) * e, bfhi(v.w) * e);
      *(uint4*)(proj + (t0g + row) * PC + BQ + h * 128 + ch * 8) = o;
    }
    const int d = tid & 127, half = tid >> 7;
    u32 pk[16];
#pragma unroll
    for (int i = 0; i < 16; ++i) {
      const int r0 = half * 32 + 2 * i;
      const float a = bf2f(*(const u16*)(ks + r0 * 272 + d * 2)) * __expf(glast - gcs[r0]);
      const float b = bf2f(*(const u16*)(ks + (r0 + 1) * 272 + d * 2)) * __expf(glast - gcs[r0 + 1]);
      pk[i] = pack2(a, b);
    }
    u16* dst = p.KDT() + (((size_t)cidx * 4 + h) * 128 + d) * 64 + half * 32;
#pragma unroll
    for (int i = 0; i < 4; ++i) *(uint4*)(dst + i * 8) = uint4{pk[4 * i], pk[4 * i + 1], pk[4 * i + 2], pk[4 * i + 3]};
    if (tid == 0) p.GL()[cidx * 4 + h] = egs[63];
  }
  __syncthreads();
}

DI void gdn_rec_item(const Params& p, int l, int bh, char* smem, bool wr) {
  const int b = bh >> 2, h = bh & 3;
  const int tid = ltid(), ln = tid & 63, w = tid >> 6, hh = ln >> 5, c31 = ln & 31;
  const bool is_comp = w < 4;
  constexpr int BUFB = 59904;
  float* Ot = (float*)(smem + 2 * BUFB);
  u16* proj = p.P();
  const float* ng = p.b_norm_g + l * 128;
  const int lt = tid & 255;
#define LD_AQ(i, n_)                                                                                      \
  {                                                                                                       \
    const size_t t0g_ = ((size_t)b * 256 + (n_)) * 64;                                                    \
    const int piece = ltv + 256 * i, row = piece >> 4, ch = piece & 15;                                   \
    la##i = *(const uint4*)(proj + (t0g_ + row) * PC + BK_ + h * 128 + ch * 8);                           \
    lq##i = *(const uint4*)(proj + (t0g_ + row) * PC + BQ + h * 128 + ch * 8);                            \
  }
#define LD_K(i, n_)                                                                                       \
  {                                                                                                       \
    const int piece = ltv + 256 * i, row2 = piece >> 3, ch2 = piece & 7;                                  \
    lk##i = *(const uint4*)(p.KDT() + ((((size_t)b * 256 + (n_)) * 4 + h) * 128 + row2) * 64 + ch2 * 8);  \
  }
#define LD_T(i, n_)                                                                                       \
  {                                                                                                       \
    const size_t t0g_ = ((size_t)b * 256 + (n_)) * 64;                                                    \
    const int piece = ltv + 256 * i, row = piece >> 3, ch = piece & 7;                                     \
    lt##i = *(const uint4*)(p.ATT() + (t0g_ + row) * 256 + h * 64 + ch * 8);                              \
  }
#define LD_R1(n_) { LD_AQ(0, n_) LD_AQ(1, n_) LD_AQ(2, n_) LD_AQ(3, n_) }
#define LD_R2(n_) { LD_K(0, n_) LD_K(1, n_) LD_K(2, n_) LD_K(3, n_) LD_T(0, n_) LD_T(1, n_) }
#define ST_AQ(i, buf_)                                                                                    \
  {                                                                                                       \
    char* Wm_ = smem + (buf_) * BUFB; char* Qd_ = Wm_ + 16896;                                            \
    const int piece = ltv + 256 * i, row = piece >> 4, ch = piece & 15;                                   \
    *(uint2*)(Wm_ + row * 264 + ch * 16) = uint2{la##i.x, la##i.y}; *(uint2*)(Wm_ + row * 264 + ch * 16 + 8) = uint2{la##i.z, la##i.w}; \
    *(uint2*)(Qd_ + row * 264 + ch * 16) = uint2{lq##i.x, lq##i.y}; *(uint2*)(Qd_ + row * 264 + ch * 16 + 8) = uint2{lq##i.z, lq##i.w}; \
  }
#define ST_K(i, buf_)                                                                                     \
  {                                                                                                       \
    char* Kt_ = smem + (buf_) * BUFB + 2 * 16896;                                                         \
    const int piece = ltv + 256 * i, row2 = piece >> 3, ch2 = piece & 7;                                  \
    *(uint2*)(Kt_ + row2 * 136 + ch2 * 16) = uint2{lk##i.x, lk##i.y}; *(uint2*)(Kt_ + row2 * 136 + ch2 * 16 + 8) = uint2{lk##i.z, lk##i.w}; \
  }
#define ST_T(i, buf_)                                                                                     \
  {                                                                                                       \
    char* At_ = smem + (buf_) * BUFB + 2 * 16896 + 17408;                                                 \
    const int piece = ltv + 256 * i, row = piece >> 3, ch = piece & 7;                                     \
    *(uint2*)(At_ + row * 136 + ch * 16) = uint2{lt##i.x, lt##i.y}; *(uint2*)(At_ + row * 136 + ch * 16 + 8) = uint2{lt##i.z, lt##i.w}; \
  }
#define ST_R1(buf_) { ST_AQ(0, buf_) ST_AQ(1, buf_) ST_AQ(2, buf_) ST_AQ(3, buf_) }
#define ST_R2(buf_) { ST_K(0, buf_) ST_K(1, buf_) ST_K(2, buf_) ST_K(3, buf_) ST_T(0, buf_) ST_T(1, buf_) }
#define LD_Z(n_)                                                                                          \
  {                                                                                                       \
    const u16* zp_ = proj + (((size_t)b * 256 + (n_)) * 64 + nrow) * PC + BZ + h * 128 + nqr * 32;        \
    lz0 = *(const uint4*)(zp_); lz1 = *(const uint4*)(zp_ + 8); lz2 = *(const uint4*)(zp_ + 16); lz3 = *(const uint4*)(zp_ + 24); \
  }
  f32x16 S[4];
#pragma unroll
  for (int i = 0; i < 4; ++i)
#pragma unroll
    for (int j = 0; j < 16; ++j) S[i][j] = 0.f;
  const int e = 32 * w + c31;
  uint4 un0, un1, un2, un3;
  float gln = 0.f;
#define LD_U(n_)                                                                                          \
  {                                                                                                       \
    const uint4* up_ = (const uint4*)((const char*)proj + ((((size_t)b * 256 + (n_)) * 64 + (e >> 1)) * PC + BV + h * 128) * 2 + (e & 1) * 128 + hh * 64); \
    un0 = up_[0]; un1 = up_[1]; un2 = up_[2]; un3 = up_[3];                                               \
    gln = p.GL()[((size_t)b * 256 + (n_)) * 4 + h];                                                       \
  }
  if (!is_comp) {
    const int ltv = lt;
    uint4 la0, la1, la2, la3, lq0, lq1, lq2, lq3, lk0, lk1, lk2, lk3, lt0, lt1;
    LD_R1(0) LD_R2(0)
    ST_R1(0) ST_R2(0)
  } else {
    LD_U(0)
  }
  for (int n = 0; n < 256; ++n) {
    f32x16 o[2];
    __syncthreads();
    if (is_comp) {
      int lnv = ln;
      asm volatile("" : "+v"(lnv));
      const int hh = lnv >> 5, c31 = lnv & 31;
      const char* Wm = smem + (n & 1) * BUFB;
      const char* Qd = Wm + 16896;
      const char* Kt = Wm + 2 * 16896;
      const char* At = Kt + 17408;
      f32x16 ws[2];
#pragma unroll
      for (int i = 0; i < 2; ++i)
#pragma unroll
        for (int j = 0; j < 16; ++j) { ws[i][j] = 0.f; o[i][j] = 0.f; }
#pragma unroll
      for (int Tt = 0; Tt < 4; ++Tt)
#pragma unroll
        for (int s = 0; s < 2; ++s) {
          const int kb = 32 * Tt + 16 * s;
          const bf16x8 sps = pack8(S[Tt], s);
#pragma unroll
          for (int Tc = 0; Tc < 2; ++Tc) {
            ws[Tc] = mfma32(afrag_perm(Wm, 32 * Tc + c31, 264, kb, hh), sps, ws[Tc]);
            o[Tc] = mfma32(afrag_perm(Qd, 32 * Tc + c31, 264, kb, hh), sps, o[Tc]);
          }
        }
      f32x16 vn[2];
      vn[0][0] = bflo(un0.x) - ws[0][0]; vn[0][1] = bfhi(un0.x) - ws[0][1]; vn[0][2] = bflo(un0.y) - ws[0][2]; vn[0][3] = bfhi(un0.y) - ws[0][3];
      vn[0][4] = bflo(un0.z) - ws[0][4]; vn[0][5] = bfhi(un0.z) - ws[0][5]; vn[0][6] = bflo(un0.w) - ws[0][6]; vn[0][7] = bfhi(un0.w) - ws[0][7];
      vn[0][8] = bflo(un1.x) - ws[0][8]; vn[0][9] = bfhi(un1.x) - ws[0][9]; vn[0][10] = bflo(un1.y) - ws[0][10]; vn[0][11] = bfhi(un1.y) - ws[0][11];
      vn[0][12] = bflo(un1.z) - ws[0][12]; vn[0][13] = bfhi(un1.z) - ws[0][13]; vn[0][14] = bflo(un1.w) - ws[0][14]; vn[0][15] = bfhi(un1.w) - ws[0][15];
      vn[1][0] = bflo(un2.x) - ws[1][0]; vn[1][1] = bfhi(un2.x) - ws[1][1]; vn[1][2] = bflo(un2.y) - ws[1][2]; vn[1][3] = bfhi(un2.y) - ws[1][3];
      vn[1][4] = bflo(un2.z) - ws[1][4]; vn[1][5] = bfhi(un2.z) - ws[1][5]; vn[1][6] = bflo(un2.w) - ws[1][6]; vn[1][7] = bfhi(un2.w) - ws[1][7];
      vn[1][8] = bflo(un3.x) - ws[1][8]; vn[1][9] = bfhi(un3.x) - ws[1][9]; vn[1][10] = bflo(un3.y) - ws[1][10]; vn[1][11] = bfhi(un3.y) - ws[1][11];
      vn[1][12] = bflo(un3.z) - ws[1][12]; vn[1][13] = bfhi(un3.z) - ws[1][13]; vn[1][14] = bflo(un3.w) - ws[1][14]; vn[1][15] = bfhi(un3.w) - ws[1][15];
      const float gl = gln;
      if (n + 1 < 256) LD_U(n + 1)
      bf16x8 vp[2][2];
#pragma unroll
      for (int Tc = 0; Tc < 2; ++Tc) { vp[Tc][0] = pack8(vn[Tc], 0); vp[Tc][1] = pack8(vn[Tc], 1); }
#pragma unroll
      for (int s = 0; s < 2; ++s) {
        o[0] = mfma32(afrag_perm(At, c31, 136, 16 * s, hh), vp[0][s], o[0]);
        o[1] = mfma32(afrag_perm(At, 32 + c31, 136, 16 * s, hh), vp[0][s], o[1]);
        o[1] = mfma32(afrag_perm(At, 32 + c31, 136, 32 + 16 * s, hh), vp[1][s], o[1]);
      }
#pragma unroll
      for (int Tt = 0; Tt < 4; ++Tt)
#pragma unroll
        for (int j = 0; j < 16; ++j) S[Tt][j] *= gl;
#pragma unroll
      for (int Tc = 0; Tc < 2; ++Tc)
#pragma unroll
        for (int s = 0; s < 2; ++s)
#pragma unroll
          for (int Tt = 0; Tt < 4; ++Tt)
            S[Tt] = mfma32(afrag_perm(Kt, 32 * Tt + c31, 136, 32 * Tc + 16 * s, hh), vp[Tc][s], S[Tt]);
    } else {
      int ltv = lt;
      asm volatile("" : "+v"(ltv));
      const int nrow = ltv >> 2, nqr = ltv & 3;
      const int nn = (n + 1 < 256) ? n + 1 : 255;
      {
        uint4 la0, la1, la2, la3, lq0, lq1, lq2, lq3;
        LD_R1(nn)
        ST_R1((n + 1) & 1)
      }
      uint4 lz0, lz1, lz2, lz3;
      {
        uint4 lk0, lk1, lk2, lk3, lt0, lt1;
        LD_R2(nn)
        const int nz = (n > 0) ? n - 1 : 0;
        LD_Z(nz)
        ST_R2((n + 1) & 1)
      }
      if (n > 0) {
        const float* orow = Ot + nrow * 132 + nqr * 32;
        float ss = 0.f;
#pragma unroll
        for (int i = 0; i < 8; ++i) {
          const float4 v = *(const float4*)(orow + 4 * i);
          ss += v.x * v.x + v.y * v.y + v.z * v.z + v.w * v.w;
        }
        ss += __shfl_xor(ss, 1);
        ss += __shfl_xor(ss, 2);
        const float rs = rsqrtf(ss * (1.f / 128.f) + EPS);
        u16* zp = proj + (((size_t)b * 256 + (n - 1)) * 64 + nrow) * PC + BZ + h * 128 + nqr * 32;
        const float* gg = ng + nqr * 32;
#define GN1(i, Z)                                                                                          \
        {                                                                                                  \
          const float4 oa = *(const float4*)(orow + 8 * i), ob = *(const float4*)(orow + 8 * i + 4);       \
          uint4 r;                                                                                         \
          r.x = pack2(oa.x * rs * gg[8 * i + 0] * siluf_(bflo(Z.x)), oa.y * rs * gg[8 * i + 1] * siluf_(bfhi(Z.x))); \
          r.y = pack2(oa.z * rs * gg[8 * i + 2] * siluf_(bflo(Z.y)), oa.w * rs * gg[8 * i + 3] * siluf_(bfhi(Z.y))); \
          r.z = pack2(ob.x * rs * gg[8 * i + 4] * siluf_(bflo(Z.z)), ob.y * rs * gg[8 * i + 5] * siluf_(bfhi(Z.z))); \
          r.w = pack2(ob.z * rs * gg[8 * i + 6] * siluf_(bflo(Z.w)), ob.w * rs * gg[8 * i + 7] * siluf_(bfhi(Z.w))); \
          if (wr) *(uint4*)(zp + 8 * i) = r;                                                               \
        }
        GN1(0, lz0) GN1(1, lz1) GN1(2, lz2) GN1(3, lz3)
      }
    }
    __syncthreads();
    if (is_comp) {
#pragma unroll
      for (int Tc = 0; Tc < 2; ++Tc)
#pragma unroll
        for (int j = 0; j < 16; ++j) Ot[(32 * Tc + crow(j, hh)) * 132 + e] = o[Tc][j];
    }
  }
  __syncthreads();
  if (!is_comp) {
    const int n = 256;
    const int nrow = lt >> 2, nqr = lt & 3;
    uint4 lz0, lz1, lz2, lz3;
    LD_Z(255)
    const float* orow = Ot + nrow * 132 + nqr * 32;
    float ss = 0.f;
#pragma unroll
    for (int i = 0; i < 8; ++i) {
      const float4 v = *(const float4*)(orow + 4 * i);
      ss += v.x * v.x + v.y * v.y + v.z * v.z + v.w * v.w;
    }
    ss += __shfl_xor(ss, 1);
    ss += __shfl_xor(ss, 2);
    const float rs = rsqrtf(ss * (1.f / 128.f) + EPS);
    u16* zp = proj + (((size_t)b * 256 + (n - 1)) * 64 + nrow) * PC + BZ + h * 128 + nqr * 32;
    const float* gg = ng + nqr * 32;
    GN1(0, lz0) GN1(1, lz1) GN1(2, lz2) GN1(3, lz3)
  }
#undef GN1
#undef LD_AQ
#undef LD_K
#undef LD_R1
#undef LD_R2
#undef LD_T
#undef ST_AQ
#undef ST_K
#undef ST_R1
#undef ST_R2
#undef ST_T
#undef LD_Z
#undef LD_U
  __syncthreads();
}

DI void diff_item(const Params& p, int l, int qt, int bh, char* smem) {
  const int b = bh >> 2, h = bh & 3;
  const int tid = ltid(), ln = tid & 63, w = tid >> 6, hh = ln >> 5, c31 = ln & 31;
  const int st = w & 3, c = w >> 2;
  const size_t tokbase = (size_t)b * T;
  const int qb = qt * 128 + 32 * st + c31;
  u16* proj = p.P();
  bf16x8 qf[4];
  {
    const u16* qrow = proj + (tokbase + qb) * PC + AQ + h * 128 + c * 64 + 8 * hh;
#pragma unroll
    for (int s = 0; s < 4; ++s) qf[s] = *(const bf16x8*)(qrow + 16 * s);
  }
  f32x16 O[4];
  float mrun, lrun;
  const float sc = 0.125f * 1.44269504089f;
  char* Ks = smem;
  char* Vs = smem + 17408;
  uint4 rk0, rk1, rv0, rv1;
  const int srow = tid >> 4, sch = tid & 15;
#define DLOAD1(i, kt)                                                                \
  {                                                                                  \
    const u16* base = proj + (tokbase + (kt) * 64 + srow + 32 * i) * PC + h * 128 + sch * 8; \
    rk##i = *(const uint4*)(base + AK);                                              \
    rv##i = *(const uint4*)(base + AV);                                              \
  }
#define DLOAD(kt) { DLOAD1(0, kt) DLOAD1(1, kt) }
#define DSTORE1(i)                                                \
  *(uint4*)(Ks + (srow + 32 * i) * 272 + sch * 16) = rk##i;       \
  *(uint4*)(Vs + (srow + 32 * i) * 320 + sch * 16) = rv##i;
  const int nkt = 2 * qt + 2;
#pragma unroll 1
  for (int rep = 0; rep < DUP_DIFF; ++rep) {
#pragma unroll
  for (int i = 0; i < 4; ++i)
#pragma unroll
    for (int j = 0; j < 16; ++j) O[i][j] = 0.f;
  mrun = -INFINITY; lrun = 0.f;
  DLOAD(0);
  for (int kt = 0; kt < nkt; ++kt) {
    __syncthreads();
    DSTORE1(0) DSTORE1(1)
    __syncthreads();
    if (kt + 1 < nkt) { DLOAD(kt + 1); }
    if (kt * 64 > qt * 128 + 32 * st + 31) continue;
    f32x16 sa[2];
#pragma unroll
    for (int k2 = 0; k2 < 2; ++k2) {
#pragma unroll
      for (int j = 0; j < 16; ++j) sa[k2][j] = 0.f;
#pragma unroll
      for (int s = 0; s < 4; ++s)
        sa[k2] = mfma32(*(const bf16x8*)(Ks + (32 * k2 + c31) * 272 + (c * 64 + 16 * s + 8 * hh) * 2), qf[s], sa[k2]);
    }
    if (kt >= 2 * qt) {
#pragma unroll
      for (int k2 = 0; k2 < 2; ++k2)
#pragma unroll
        for (int j = 0; j < 16; ++j)
          if (kt * 64 + 32 * k2 + crow(j, hh) > qb) sa[k2][j] = -INFINITY;
    }
    float tmax = sa[0][0];
#pragma unroll
    for (int k2 = 0; k2 < 2; ++k2)
#pragma unroll
      for (int j = 0; j < 16; ++j) tmax = fmaxf(tmax, sa[k2][j]);
    tmax = fmaxf(tmax, __shfl_xor(tmax, 32));
    const float mnew = fmaxf(mrun, tmax * sc);
    const float alpha = __builtin_amdgcn_exp2f(mrun - mnew);
    mrun = mnew;
    float psum = 0.f;
#pragma unroll
    for (int k2 = 0; k2 < 2; ++k2)
#pragma unroll
      for (int j = 0; j < 16; ++j) { const float pv = __builtin_amdgcn_exp2f(sa[k2][j] * sc - mnew); sa[k2][j] = pv; psum += pv; }
    lrun = lrun * alpha + psum;
    if (__any(alpha != 1.f)) {
#pragma unroll
      for (int i = 0; i < 4; ++i)
#pragma unroll
        for (int j = 0; j < 16; ++j) O[i][j] *= alpha;
    }
#pragma unroll
    for (int k2 = 0; k2 < 2; ++k2)
#pragma unroll
      for (int s2 = 0; s2 < 2; ++s2) {
        const bf16x8 pp = pack8(sa[k2], s2);
        bf16x8 vf[4];
        trfrag4<320>(Vs, 32 * k2 + 16 * s2, ln, vf);
#pragma unroll
        for (int mt = 0; mt < 4; ++mt) O[mt] = mfma32(vf[mt], pp, O[mt]);
      }
  }
  }
#undef DLOAD
#undef DLOAD1
#undef DSTORE1
  __syncthreads();
  const float ltot = lrun + __shfl_xor(lrun, 32);
  const float inv = 1.f / ltot;
  float* xch = (float*)smem + st * 32 * 132;
  if (c == 1) {
#pragma unroll
    for (int mt = 0; mt < 4; ++mt)
#pragma unroll
      for (int i4 = 0; i4 < 4; ++i4)
        *(float4*)(xch + c31 * 132 + 32 * mt + 8 * i4 + 4 * hh) =
            float4{O[mt][4 * i4] * inv, O[mt][4 * i4 + 1] * inv, O[mt][4 * i4 + 2] * inv, O[mt][4 * i4 + 3] * inv};
  }
  __syncthreads();
  if (c == 0) {
    const float lam = p.LAM()[l], oml = 1.f - p.LAM()[2 + l];
    float ss = 0.f;
#pragma unroll
    for (int mt = 0; mt < 4; ++mt)
#pragma unroll
      for (int i4 = 0; i4 < 4; ++i4) {
        const float4 o1 = *(const float4*)(xch + c31 * 132 + 32 * mt + 8 * i4 + 4 * hh);
        float d;
        d = O[mt][4 * i4] * inv - lam * o1.x; O[mt][4 * i4] = d; ss += d * d;
        d = O[mt][4 * i4 + 1] * inv - lam * o1.y; O[mt][4 * i4 + 1] = d; ss += d * d;
        d = O[mt][4 * i4 + 2] * inv - lam * o1.z; O[mt][4 * i4 + 2] = d; ss += d * d;
        d = O[mt][4 * i4 + 3] * inv - lam * o1.w; O[mt][4 * i4 + 3] = d; ss += d * d;
      }
    ss += __shfl_xor(ss, 32);
    const float rs = rsqrtf(ss * (1.f / 128.f) + EPS) * oml;
    const float* sg = p.a_subln_g + l * 128;
    int qb_e = qb;
    asm volatile("" : "+v"(qb_e));
    u16* orow = proj + (tokbase + qb_e) * PC + AQ + h * 128;
#pragma unroll
    for (int mt = 0; mt < 4; ++mt)
#pragma unroll
      for (int i4 = 0; i4 < 4; ++i4) {
        const int dv = 32 * mt + 8 * i4 + 4 * hh;
        const float4 gg = *(const float4*)(sg + dv);
        uint2 o;
        o.x = pack2(O[mt][4 * i4] * rs * gg.x, O[mt][4 * i4 + 1] * rs * gg.y);
        o.y = pack2(O[mt][4 * i4 + 2] * rs * gg.z, O[mt][4 * i4 + 3] * rs * gg.w);
        *(uint2*)(orow + dv) = o;
      }
  }
  __syncthreads();
}

DI u32 mono_key(float f) { u32 u = __float_as_uint(f); return (u & 0x80000000u) ? ~u : (u | 0x80000000u); }

constexpr int DCAP = 640;
DI u32 dsa_prune(u32* ck, u16* ci, int cnt, u32 tau_old, bool exact, int ln, int& newcnt) {
  u32 kv[10];
  u16 iv[10];
  u32 mx = 0u;
#pragma unroll
  for (int j = 0; j < 10; ++j) {
    const int pos = ln + 64 * j;
    const bool vd = pos < cnt;
    kv[j] = vd ? ck[pos] : 0u;
    iv[j] = vd ? ci[pos] : (u16)0;
    mx = max(mx, kv[j]);
  }
#pragma unroll
  for (int o = 32; o; o >>= 1) mx = max(mx, (u32)__shfl_xor((int)mx, o));
  u32 L = tau_old + 1u, H = mx + 1u;
  int curL = cnt;
  while ((exact || curL > 384) && (H - L) > 1u) {
    const u32 mid = L + ((H - L) >> 1);
    int c = 0;
#pragma unroll
    for (int j = 0; j < 10; ++j) c += __popcll(__ballot(kv[j] >= mid));
    if (c >= 256) { L = mid; curL = c; } else H = mid;
  }
  int ngt = 0;
#pragma unroll
  for (int j = 0; j < 10; ++j) ngt += __popcll(__ballot(kv[j] > L));
  const int target = (!exact && curL <= 384) ? curL : 256;
  const int need = target - ngt;
  int run_gt = 0, run_eq = 0;
#pragma unroll
  for (int j = 0; j < 10; ++j) {
    const bool gt = kv[j] > L, eq = (kv[j] == L);
    const u64 mg = __ballot(gt), me = __ballot(eq);
    const int pg = run_gt + (int)lane_lt_cnt(mg), pe = run_eq + (int)lane_lt_cnt(me);
    if (gt) { ck[pg] = kv[j]; ci[pg] = iv[j]; }
    else if (eq && pe < need) { ck[ngt + pe] = kv[j]; ci[ngt + pe] = iv[j]; }
    run_gt += __popcll(mg);
    run_eq += __popcll(me);
  }
  newcnt = target;
  return L;
}

DI void dsa_item(const Params& p, int l, int tile32, int b, char* smem) {
  const int tid = ltid(), ln = tid & 63, w = tid >> 6, hh = ln >> 5, c31 = ln & 31;
  const int t0 = tile32 * 32 + 4 * w;
  const size_t tokbase = (size_t)b * T;
  u16* QX = (u16*)p.out;
  char* wl = smem + w * 17408;
  u32* ckey = (u32*)wl;
  u16* cidx = (u16*)(wl + 10240);
  u16* ifin = (u16*)(wl + 15360);
  char* tile = wl;
  int cnt0 = 0, cnt1 = 0, cnt2 = 0, cnt3 = 0;
  {
    bf16x8 qa[4];
    {
      const int r = c31, ql = 2 * ((r >> 2) & 1) + (r >> 4), hd = 4 * ((r >> 3) & 1) + (r & 3);
      const u16* qrow = QX + (tokbase + t0 + ql) * LDQ + 1024 + hd * 64 + 8 * hh;
#pragma unroll
      for (int s = 0; s < 4; ++s) qa[s] = *(const bf16x8*)(qrow + 16 * s);
    }
    float wq[16];
    {
      const float4* wi = (const float4*)(p.WIDX() + (tokbase + t0 + 2 * hh) * 8);
#pragma unroll
      for (int i = 0; i < 4; ++i) { const float4 v = wi[i]; wq[4 * i] = v.x; wq[4 * i + 1] = v.y; wq[4 * i + 2] = v.z; wq[4 * i + 3] = v.w; }
    }
    const int qpos0 = t0 + 2 * hh;
    const int nkt = ((t0 + 3) >> 5) + 1;
    const u32 lmask = (1u << c31) - 1u;
#pragma unroll 1
    for (int rep = 0; rep < DUP_DSA1; ++rep) {
    cnt0 = cnt1 = cnt2 = cnt3 = 0;
    u32 tau0 = 0u, tau1 = 0u, tau2 = 0u, tau3 = 0u;
    bf16x8 kn[4][4];
    {
#pragma unroll
      for (int t = 0; t < 4; ++t) {
        const u16* krow = p.KIDX() + (tokbase + t * 32 + c31) * 64 + 8 * hh;
#pragma unroll
        for (int s = 0; s < 4; ++s) kn[t][s] = *(const bf16x8*)(krow + 16 * s);
      }
    }
    const int ngrp = (nkt + 3) >> 2;
    for (int g = 0; g <= ngrp; ++g) {
      const int lim = (g < ngrp) ? (DCAP - 128) : 256;
      for (;;) {
        const int q = (cnt0 > lim) ? 0 : (cnt1 > lim) ? 1 : (cnt2 > lim) ? 2 : (cnt3 > lim) ? 3 : -1;
        if (q < 0) break;
        const int c = (q == 0) ? cnt0 : (q == 1) ? cnt1 : (q == 2) ? cnt2 : cnt3;
        const u32 to = (q == 0) ? tau0 : (q == 1) ? tau1 : (q == 2) ? tau2 : tau3;
        int nc;
        const u32 t = dsa_prune(ckey + q * DCAP, cidx + q * DCAP, c, to, g == ngrp, ln, nc);
        if (q == 0) { cnt0 = nc; tau0 = t; } else if (q == 1) { cnt1 = nc; tau1 = t; }
        else if (q == 2) { cnt2 = nc; tau2 = t; } else { cnt3 = nc; tau3 = t; }
      }
      if (g == ngrp) break;
      bf16x8 kc[4][4];
#pragma unroll
      for (int t = 0; t < 4; ++t)
#pragma unroll
        for (int s = 0; s < 4; ++s) kc[t][s] = kn[t][s];
      if (g + 1 < ngrp) {
#pragma unroll
        for (int t = 0; t < 4; ++t) {
          const u16* krow = p.KIDX() + (tokbase + (g + 1) * 128 + t * 32 + c31) * 64 + 8 * hh;
#pragma unroll
          for (int s = 0; s < 4; ++s) kn[t][s] = *(const bf16x8*)(krow + 16 * s);
        }
      }
      const u32 tauA = hh ? tau2 : tau0, tauB = hh ? tau3 : tau1;
#pragma unroll
      for (int t = 0; t < 4; ++t) {
        const int key = (g * 4 + t) * 32 + c31;
        f32x16 acc;
#pragma unroll
        for (int j = 0; j < 16; ++j) acc[j] = 0.f;
#pragma unroll
        for (int s = 0; s < 4; ++s) acc = mfma32(qa[s], kc[t][s], acc);
        float s0 = 0.f, s1 = 0.f;
#pragma unroll
        for (int i = 0; i < 8; ++i) { s0 += wq[i] * __builtin_amdgcn_fmed3f(acc[i], 0.f, 3.0e38f); s1 += wq[8 + i] * __builtin_amdgcn_fmed3f(acc[8 + i], 0.f, 3.0e38f); }
        const u32 k0 = mono_key(s0), k1 = mono_key(s1);
        const bool c0 = (key <= qpos0) && (k0 > tauA), c1 = (key <= qpos0 + 1) && (k1 > tauB);
        const u64 m0 = __ballot(c0), m1 = __ballot(c1);
        if (m0 | m1) {
          const u32 h0 = hh ? (u32)(m0 >> 32) : (u32)m0, h1 = hh ? (u32)(m1 >> 32) : (u32)m1;
          const int pA = (hh ? cnt2 : cnt0) + __popc(h0 & lmask), pB = (hh ? cnt3 : cnt1) + __popc(h1 & lmask);
          if (c0) { ckey[(2 * hh) * DCAP + pA] = k0; cidx[(2 * hh) * DCAP + pA] = (u16)key; }
          if (c1) { ckey[(2 * hh + 1) * DCAP + pB] = k1; cidx[(2 * hh + 1) * DCAP + pB] = (u16)key; }
          cnt0 += __popc((u32)m0); cnt2 += __popc((u32)(m0 >> 32));
          cnt1 += __popc((u32)m1); cnt3 += __popc((u32)(m1 >> 32));
        }
      }
    }
#pragma unroll
    for (int qq = 0; qq < 4; ++qq) {
      const int cq = (qq == 0) ? cnt0 : (qq == 1) ? cnt1 : (qq == 2) ? cnt2 : cnt3;
#pragma unroll
      for (int j = 0; j < 4; ++j) {
        const int pos = ln + 64 * j;
        ifin[qq * 256 + pos] = (pos < cq) ? cidx[qq * DCAP + pos] : (u16)0;
      }
    }
    }
  }
  const float sc = 0.125f * 1.44269504089f;
#pragma unroll 1
  for (int rep2 = 0; rep2 < DUP_DSA2; ++rep2)
#pragma unroll 1
  for (int qq = 0; qq < 4; ++qq) {
    const int nsel = (qq == 0) ? cnt0 : (qq == 1) ? cnt1 : (qq == 2) ? cnt2 : cnt3;
    const size_t tq = tokbase + t0 + qq;
    bf16x8 qf[8];
    {
      const u16* qab = QX + tq * LDQ + (c31 & 7) * 128 + 8 * hh;
#pragma unroll
      for (int s = 0; s < 8; ++s) qf[s] = *(const bf16x8*)(qab + 16 * s);
    }
    f32x16 O[4];
#pragma unroll
    for (int i = 0; i < 4; ++i)
#pragma unroll
      for (int j = 0; j < 16; ++j) O[i][j] = 0.f;
    float mrun = -INFINITY, lrun = 0.f;
    const int ntile = (nsel + 31) >> 5;
    uint4 gr0, gr1, gr2, gr3, gr4, gr5, gr6, gr7;
#define GGATHER1(i, tt_)                                                                     \
    {                                                                                        \
      const int piece = ln + 64 * i, row = piece >> 4, ch = piece & 15;                      \
      const int idx = ifin[qq * 256 + (tt_) * 32 + row];                                     \
      gr##i = *(const uint4*)(p.CKV() + (tokbase + idx) * 128 + ch * 8);                     \
    }
#define GGATHER(tt_) { GGATHER1(0, tt_) GGATHER1(1, tt_) GGATHER1(2, tt_) GGATHER1(3, tt_) GGATHER1(4, tt_) GGATHER1(5, tt_) GGATHER1(6, tt_) GGATHER1(7, tt_) }
#define GSTORE1(i) { const int piece = ln + 64 * i, row = piece >> 4, ch = piece & 15; *(uint4*)(tile + row * 272 + ch * 16) = gr##i; }
    if (ntile > 0) GGATHER(0)
    for (int tt = 0; tt < ntile; ++tt) {
      GSTORE1(0) GSTORE1(1) GSTORE1(2) GSTORE1(3) GSTORE1(4) GSTORE1(5) GSTORE1(6) GSTORE1(7)
      if (tt + 1 < ntile) GGATHER(tt + 1)
      __builtin_amdgcn_fence(__ATOMIC_RELEASE, "wavefront");
      f32x16 sa;
#pragma unroll
      for (int j = 0; j < 16; ++j) sa[j] = 0.f;
#pragma unroll
      for (int s = 0; s < 8; ++s) sa = mfma32(*(const bf16x8*)(tile + c31 * 272 + (16 * s + 8 * hh) * 2), qf[s], sa);
      float tmax = -INFINITY;
#pragma unroll
      for (int j = 0; j < 16; ++j) {
        if (tt * 32 + crow(j, hh) >= nsel) sa[j] = -INFINITY;
        tmax = fmaxf(tmax, sa[j]);
      }
      tmax = fmaxf(tmax, __shfl_xor(tmax, 32));
      const float mnew = fmaxf(mrun, tmax * sc);
      const float alpha = __builtin_amdgcn_exp2f(mrun - mnew);
      mrun = mnew;
      float psum = 0.f;
#pragma unroll
      for (int j = 0; j < 16; ++j) { const float pv = __builtin_amdgcn_exp2f(sa[j] * sc - mnew); sa[j] = pv; psum += pv; }
      lrun = lrun * alpha + psum;
#pragma unroll
      for (int i = 0; i < 4; ++i)
#pragma unroll
        for (int j = 0; j < 16; ++j) O[i][j] *= alpha;
#pragma unroll
      for (int s2 = 0; s2 < 2; ++s2) {
        const bf16x8 pp = pack8(sa, s2);
        bf16x8 vf[4];
        trfrag4<272>(tile, 16 * s2, ln, vf);
#pragma unroll
        for (int mt = 0; mt < 4; ++mt) O[mt] = mfma32(vf[mt], pp, O[mt]);
      }
      __builtin_amdgcn_fence(__ATOMIC_ACQ_REL, "wavefront");
    }
#undef GGATHER1
#undef GGATHER
#undef GSTORE1
    const float ltot = lrun + __shfl_xor(lrun, 32);
    const float inv = 1.f / ltot;
    if (c31 < 8 && rep2 == DUP_DSA2 - 1) {
      u16* orow = QX + tq * LDQ + c31 * 128;
#pragma unroll
      for (int mt = 0; mt < 4; ++mt)
#pragma unroll
        for (int i4 = 0; i4 < 4; ++i4) {
          uint2 o;
          o.x = pack2(O[mt][4 * i4] * inv, O[mt][4 * i4 + 1] * inv);
          o.y = pack2(O[mt][4 * i4 + 2] * inv, O[mt][4 * i4 + 3] * inv);
          *(uint2*)(orow + 32 * mt + 8 * i4 + 4 * hh) = o;
        }
    }
  }
  __syncthreads();
}

DI void phase_prep(const Params& p, int l, char* smem) {
  if (EN_C) {
    int rt, ct;
    for (int it = 0; next_tile(it, 128, 6, 32, 2, rt, ct); ++it) qx_tile(p, l, rt, ct, smem);
  }
  const int n_gdn = EN_B ? 1024 : 0, n_kp = EN_C ? 512 : 0;
  for (int t = lbid(); t < n_gdn + n_kp; t += lgdim()) {
    if (t < n_gdn) gdn_prep_item(p, l, t, smem);
    else dsa_kprep_item(p, l, t - n_gdn);
  }
}

DI int xcc_id() { return (int)(__builtin_amdgcn_s_getreg((3 << 11) | 20) & 0x7u); }

DI void phase_mixers(const Params& p, int l, char* smem) {
  __shared__ int s_item;
  const int x0 = xcc_id();
  int xs = x0;
  for (;;) {
    __syncthreads();
    {
      int qi = l * 8 + xs;
      asm volatile("" : "+s"(qi));
      if (ltid() == 0) s_item = (int)atomicAdd(p.CNT() + qi, 1u);
    }
    __syncthreads();
    const int it = s_item;
    const int n_gdn = EN_B ? 1 : 0;
    if (it >= n_gdn + 256) {
      xs = (xs + 1) & 7;
      if (xs == x0) break;
      continue;
    }
    const int x = xs;
    if (it < n_gdn) {
#pragma unroll 1
      for (int rep = 0; rep < DUP_GDN; ++rep) gdn_rec_item(p, l, x, smem, rep == DUP_GDN - 1);
    }
    else {
      const int j = it - n_gdn, k = j >> 1;
      if ((j & 1) == 0) { if (EN_A) diff_item(p, l, 127 - k, x, smem); }
      else { if (EN_C) dsa_item(p, l, 511 - (k * 4 + (x >> 1)), x & 1, smem); }
    }
  }
}

DI void run_phase(const Params& p, int ph, char* smem) {
  if (ph == 0) { phase0(p, smem); return; }
  const int l = (ph - 1) / 9, s = (ph - 1) % 9;
  switch (s) {
    case 0: phase_inproj(p, l, smem); break;
    case 1: phase_prep(p, l, smem); break;
    case 2: phase_mixers(p, l, smem); break;
    case 3: phase_merge(p, l, smem); break;
    case 4: phase_resgemm(p, p.MERGED(), LDX, p.wo(l), KP1024, 1024, smem); break;
    case 5: ln_phase(p.out, p.ln1_g + l * 1024, p.ln1_b + l * 1024, p.XB(), nullptr); break;
    case 6: phase_ff1(p, l, smem); break;
    case 7: phase_resgemm(p, p.P(), LDH, p.wf2(l), KP4096, 4096, smem); break;
    case 8: ln_phase(p.out, p.ln2_g + l * 1024, p.ln2_b + l * 1024, (l == 1) ? nullptr : p.XB(), (l == 1) ? p.out : nullptr); break;
  }
}

constexpr int N_PHASES = 19;


DI u32 xb_ld(u32* p) { return __hip_atomic_load(p, __ATOMIC_RELAXED, __HIP_MEMORY_SCOPE_AGENT); }
DI u32 xb_add(u32* p, u32 v) { return __hip_atomic_fetch_add(p, v, __ATOMIC_RELAXED, __HIP_MEMORY_SCOPE_AGENT); }
DI void fast_sync(u32* bar, int x, const volatile int* st) {
  asm volatile("s_waitcnt vmcnt(0)" ::: "memory");
  __syncthreads();
  if (ltid() == 0) {
    __builtin_amdgcn_s_waitcnt(0);
    const u32 nloc = (u32)st[0], nx = (u32)st[1];
    const u32 old = xb_add(bar + 32 * (8 + x), 1u);
    const u32 gen = old / nloc;
    if (old + 1u == (gen + 1u) * nloc) {
      __builtin_amdgcn_fence(__ATOMIC_RELEASE, "agent");
      asm volatile("s_waitcnt vmcnt(0)" ::: "memory");
      const u32 og = xb_add(bar + 32 * 24, 1u);
      const u32 tg = og / nx;
      if (og + 1u == (tg + 1u) * nx) xb_add(bar + 32 * 25, 1u);
      else { while (xb_ld(bar + 32 * 25) == tg) __builtin_amdgcn_s_sleep(1); }
      __builtin_amdgcn_fence(__ATOMIC_ACQUIRE, "agent");
      xb_add(bar + 32 * (16 + x), 1u);
      asm volatile("s_waitcnt vmcnt(0)" ::: "memory");
    } else {
      while (xb_ld(bar + 32 * (16 + x)) == gen) __builtin_amdgcn_s_sleep(1);
      __builtin_amdgcn_fence(__ATOMIC_ACQUIRE, "agent");
      asm volatile("s_waitcnt vmcnt(0)" ::: "memory");
    }
  }
  __syncthreads();
}
#if COOP
DI void gsync() { cg::this_grid().sync(); }
__global__ void __launch_bounds__(512, 1) mega_kernel(Params p, int ph_begin, int ph_end) {
  __shared__ __attribute__((aligned(16))) char smem[SMEM_BYTES];
  __shared__ int xb_st[2];
  const int myx = xcc_id();
  if (ltid() == 0) (void)xb_add(p.BAR() + 32 * myx, 1u);
  for (int r = 0; r < REP0; ++r) { phase0(p, smem); cg::this_grid().sync(); }
  if (ltid() == 0) {
    int mine = 0, cnt = 0;
    for (int j = 0; j < 8; ++j) { const int c = (int)xb_ld(p.BAR() + 32 * j); cnt += (c > 0) ? 1 : 0; mine = (j == myx) ? c : mine; }
    xb_st[0] = mine > 0 ? mine : 1;
    xb_st[1] = cnt > 0 ? cnt : 1;
  }
  __syncthreads();
#define gsync() fast_sync(p.BAR(), myx, xb_st)
#pragma unroll 1
  for (int l = 0; l < 2; ++l) {
    for (int r = 0; r < REP1; ++r) { phase_inproj(p, l, smem); gsync(); }
    phase_prep(p, l, smem);
    gsync();
    phase_mixers(p, l, smem);
    gsync();
    for (int r = 0; r < REP2; ++r) { phase_merge(p, l, smem); gsync(); }
    for (int r = 0; r < REP3; ++r) { phase_resgemm(p, p.MERGED(), LDX, p.wo(l), KP1024, 1024, smem); gsync(); }
    for (int r = 0; r < REP4; ++r) { ln_phase(p.out, p.ln1_g + l * 1024, p.ln1_b + l * 1024, p.XB(), nullptr); gsync(); }
    for (int r = 0; r < REP5; ++r) { phase_ff1(p, l, smem); gsync(); }
    for (int r = 0; r < REP6; ++r) { phase_resgemm(p, p.P(), LDH, p.wf2(l), KP4096, 4096, smem); gsync(); }
    ln_phase(p.out, p.ln2_g + l * 1024, p.ln2_b + l * 1024, (l == 1) ? nullptr : p.XB(), (l == 1) ? p.out : nullptr);
    if (l == 0) gsync();
  }
}
#undef gsync
#else
__global__ void __launch_bounds__(512, 1) mega_kernel(Params p, int ph_begin, int ph_end) {
  __shared__ __attribute__((aligned(16))) char smem[SMEM_BYTES];
  for (int ph = ph_begin; ph < ph_end; ++ph) run_phase(p, ph, smem);
}
#endif

extern "C" void kernel_launch(void* const* d_in, const int* in_sizes, int n_in, void* d_out, int out_size,
                              void* d_ws, size_t ws_size, hipStream_t stream) {
  static int grid_blocks = 0;
  if (!grid_blocks) {
    int dev = 0, cus = 0, per_cu = 0;
    hipGetDevice(&dev);
    hipDeviceGetAttribute(&cus, hipDeviceAttributeMultiprocessorCount, dev);
    hipOccupancyMaxActiveBlocksPerMultiprocessor(&per_cu, mega_kernel, NTHR, 0);
    if (per_cu < 1) per_cu = 1;
    if (per_cu > 1) per_cu = 1;
    grid_blocks = cus * per_cu;
  }
  Params p{};
  const float** pf = (const float**)&p;
  for (int i = 0; i < 27; ++i) pf[i] = (const float*)d_in[i];
  p.out = (float*)d_out;
  p.ws = (char*)d_ws;
  if (WS_NEED > ws_size) { fprintf(stderr, "workspace too small: need %zu have %zu\n", (size_t)WS_NEED, ws_size); return; }
#if COOP
  hipMemsetAsync(p.ws + O_BAR, 0, 4096, stream);
  int b = 0, e = N_PHASES;
  void* args[] = {&p, &b, &e};
  hipError_t err = hipLaunchCooperativeKernel((void*)mega_kernel, dim3(grid_blocks), dim3(NTHR), args, 0, stream);
  if (err != hipSuccess) fprintf(stderr, "cooperative launch failed: %s (grid %d)\n", hipGetErrorString(err), grid_blocks);
#else
  for (int ph = 0; ph < N_PHASES; ++ph) mega_kernel<<<grid_blocks, NTHR, 0, stream>>>(p, ph, ph + 1);
#endif
}
```

```cpp
#include <hip/hip_runtime.h>
#include <hip/hip_cooperative_groups.h>
#include <cstdio>
namespace cg = cooperative_groups;

#ifndef COOP
#define COOP 1
#endif
#ifndef REP0
#define REP0 1
#define REP1 1
#define REP2 1
#define REP3 1
#define REP4 1
#define REP5 1
#define REP6 1
#endif
#ifndef DUP_GDN
#define DUP_GDN 1
#endif
#ifndef DUP_DIFF
#define DUP_DIFF 1
#endif
#ifndef DUP_DSA1
#define DUP_DSA1 1
#endif
#ifndef DUP_DSA2
#define DUP_DSA2 1
#endif
#ifndef EN_A
#define EN_A 1
#endif
#ifndef EN_B
#define EN_B 1
#endif
#ifndef EN_C
#define EN_C 1
#endif

typedef unsigned short u16;
typedef unsigned int u32;
typedef unsigned long long u64;
using bf16x8 = __attribute__((ext_vector_type(8))) short;
using s16x4 = __attribute__((ext_vector_type(4))) short;
using f32x4 = __attribute__((ext_vector_type(4))) float;
using f32x16 = __attribute__((ext_vector_type(16))) float;
#define DI __device__ __forceinline__

constexpr int NT = 32768, T = 16384, PC = 4048;
constexpr int AQ = 0, AK = 512, AV = 1024, BQ = 1536, BK_ = 2048, BV = 2560, BZ = 3072, BA = 3584, BB = 3588,
              CQ = 3592, CKVc = 3848, CKI = 3976, CWI = 4040, GATES = 4048;
constexpr float EPS = 1e-6f;
constexpr float DN_ALPHA = 1.41421356237f;
constexpr int NTHR = 512;
constexpr int SMEM_BYTES = 153600 + 512;

constexpr size_t al256(size_t x) { return (x + 255) & ~(size_t)255; }
constexpr int LDX = 1088, LDH = 4160, LDQ = 1600;
constexpr int KP1024 = 1088, KP512 = 576, KP256 = 320, KP4096 = 4160;
constexpr size_t SZ_WIN = al256((size_t)7120 * KP1024 * 2), SZ_WQX = al256((size_t)1536 * KP256 * 2), SZ_WBR = al256((size_t)1024 * KP512 * 2),
                 SZ_WBRC = al256((size_t)1024 * KP1024 * 2), SZ_WO = al256((size_t)1024 * KP1024 * 2), SZ_WF1 = al256((size_t)4096 * KP1024 * 2), SZ_WF2 = al256((size_t)1024 * KP4096 * 2);
constexpr size_t O_WIN = 0, O_WQX = O_WIN + SZ_WIN, O_WBRA = O_WQX + SZ_WQX, O_WBRB = O_WBRA + SZ_WBR, O_WBRC = O_WBRB + SZ_WBR,
                 O_WO = O_WBRC + SZ_WBRC, O_WF1 = O_WO + SZ_WO, O_WF2 = O_WF1 + SZ_WF1, LAYER_W = O_WF2 + SZ_WF2;
constexpr size_t O_P = 2 * LAYER_W, O_XB = O_P + (size_t)NT * LDH * 2, O_M = O_XB + (size_t)NT * LDX * 2;
constexpr size_t O_KDT = O_M, O_ATT = O_KDT + 33554432, O_HALO = O_ATT + 16777216, O_KIDX = O_HALO + 4718592, O_CKV = O_KIDX + 4194304,
                 O_MEND = O_CKV + 8388608 + 4194304;
constexpr size_t O_WIDX = O_MEND, O_GL = O_WIDX + (size_t)NT * 8 * 4, O_LAM = O_GL + 8192, O_CNT = O_LAM + 256, O_BAR = O_CNT + 256, WS_NEED = O_BAR + 4096;
static_assert(O_MEND - O_M >= (size_t)NT * LDX * 2, "merged alias");

struct Params {
  const float *x, *w_in, *b_gate, *a_lambda, *a_subln_g, *b_conv_w, *b_a_log, *b_dt_bias, *b_norm_g,
      *c_q_norm_g, *c_kv_norm_g, *c_kidx_g, *c_kidx_b, *c_w_uq, *c_w_qidx, *c_w_uk, *c_w_uv,
      *w_branch_a, *w_branch_b, *w_branch_c, *w_o, *ln1_g, *ln1_b, *w_ff1, *w_ff2, *ln2_g, *ln2_b;
  float* out;
  char* ws;
  __device__ __forceinline__ u16* win(int l) const { return (u16*)(ws + l * LAYER_W + O_WIN); }
  __device__ __forceinline__ u16* wqx(int l) const { return (u16*)(ws + l * LAYER_W + O_WQX); }
  __device__ __forceinline__ u16* wbra(int l) const { return (u16*)(ws + l * LAYER_W + O_WBRA); }
  __device__ __forceinline__ u16* wbrb(int l) const { return (u16*)(ws + l * LAYER_W + O_WBRB); }
  __device__ __forceinline__ u16* wbrc(int l) const { return (u16*)(ws + l * LAYER_W + O_WBRC); }
  __device__ __forceinline__ u16* wo(int l) const { return (u16*)(ws + l * LAYER_W + O_WO); }
  __device__ __forceinline__ u16* wf1(int l) const { return (u16*)(ws + l * LAYER_W + O_WF1); }
  __device__ __forceinline__ u16* wf2(int l) const { return (u16*)(ws + l * LAYER_W + O_WF2); }
  __device__ __forceinline__ u16* P() const { return (u16*)(ws + O_P); }
  __device__ __forceinline__ u16* XB() const { return (u16*)(ws + O_XB); }
  __device__ __forceinline__ u16* KDT() const { return (u16*)(ws + O_KDT); }
  __device__ __forceinline__ u16* ATT() const { return (u16*)(ws + O_ATT); }
  __device__ __forceinline__ u16* HALO() const { return (u16*)(ws + O_HALO); }
  __device__ __forceinline__ u16* KIDX() const { return (u16*)(ws + O_KIDX); }
  __device__ __forceinline__ u16* CKV() const { return (u16*)(ws + O_CKV); }
  __device__ __forceinline__ u16* MERGED() const { return (u16*)(ws + O_M); }
  __device__ __forceinline__ float* WIDX() const { return (float*)(ws + O_WIDX); }
  __device__ __forceinline__ float* GL() const { return (float*)(ws + O_GL); }
  __device__ __forceinline__ float* LAM() const { return (float*)(ws + O_LAM); }
  __device__ __forceinline__ u32* CNT() const { return (u32*)(ws + O_CNT); }
  __device__ __forceinline__ u32* BAR() const { return (u32*)(ws + O_BAR); }
};

DI int lbid() { int b = blockIdx.x; asm volatile("" : "+s"(b)); return b; }
DI int lgdim() { int b = gridDim.x; asm volatile("" : "+s"(b)); return b; }
DI int ltid() { int t = threadIdx.x; asm volatile("" : "+v"(t)); return t; }
DI u16 f2bf(float x) { u32 u = __float_as_uint(x); u += 0x7fffu + ((u >> 16) & 1u); return (u16)(u >> 16); }
DI float bf2f(u16 h) { return __uint_as_float(((u32)h) << 16); }
DI u32 pack2(float a, float b) { return (u32)f2bf(a) | ((u32)f2bf(b) << 16); }
DI float bflo(u32 v) { return __uint_as_float(v << 16); }
DI float bfhi(u32 v) { return __uint_as_float(v & 0xffff0000u); }
DI f32x4 mfma16(bf16x8 a, bf16x8 b, f32x4 c) { return __builtin_amdgcn_mfma_f32_16x16x32_bf16(a, b, c, 0, 0, 0); }
DI f32x16 mfma32(bf16x8 a, bf16x8 b, f32x16 c) { return __builtin_amdgcn_mfma_f32_32x32x16_bf16(a, b, c, 0, 0, 0); }
DI int crow(int i, int hh) { return (i & 3) + 8 * (i >> 2) + 4 * hh; }
DI float sigmoidf_(float x) { return 1.f / (1.f + __expf(-x)); }
DI float siluf_(float x) { return x / (1.f + __expf(-x)); }
DI u32 lane_lt_cnt(u64 m) { return __builtin_amdgcn_mbcnt_hi((u32)(m >> 32), __builtin_amdgcn_mbcnt_lo((u32)m, 0)); }

DI bf16x8 pack8(const f32x16& x, int s) {
  u32 p0, p1, p2, p3;
  if (s == 0) {
    asm volatile("v_cvt_pk_bf16_f32 %0, %4, %5\n\tv_cvt_pk_bf16_f32 %1, %6, %7\n\tv_cvt_pk_bf16_f32 %2, %8, %9\n\tv_cvt_pk_bf16_f32 %3, %10, %11\n\ts_nop 1"
                 : "=&v"(p0), "=&v"(p1), "=&v"(p2), "=&v"(p3)
                 : "v"(x[0]), "v"(x[1]), "v"(x[2]), "v"(x[3]), "v"(x[4]), "v"(x[5]), "v"(x[6]), "v"(x[7]));
  } else {
    asm volatile("v_cvt_pk_bf16_f32 %0, %4, %5\n\tv_cvt_pk_bf16_f32 %1, %6, %7\n\tv_cvt_pk_bf16_f32 %2, %8, %9\n\tv_cvt_pk_bf16_f32 %3, %10, %11\n\ts_nop 1"
                 : "=&v"(p0), "=&v"(p1), "=&v"(p2), "=&v"(p3)
                 : "v"(x[8]), "v"(x[9]), "v"(x[10]), "v"(x[11]), "v"(x[12]), "v"(x[13]), "v"(x[14]), "v"(x[15]));
  }
  typedef u32 u32x4 __attribute__((ext_vector_type(4)));
  u32x4 v = {p0, p1, p2, p3};
  return __builtin_bit_cast(bf16x8, v);
}
DI bf16x8 afrag_perm(const char* base, int row, int stride, int kbase, int hh) {
  const char* pr = base + row * stride + (kbase + 4 * hh) * 2;
  s16x4 lo = *(const s16x4*)pr;
  s16x4 hi = *(const s16x4*)(pr + 16);
  return __builtin_shufflevector(lo, hi, 0, 1, 2, 3, 4, 5, 6, 7);
}
DI bf16x8 trfrag(const char* img, int stride, int krow0, int col0, int ln) {
  const int hh = ln >> 5, chalf = (ln >> 4) & 1, q4 = (ln & 15) >> 2, p4 = ln & 3;
  u32 a = (u32)(size_t)(img + (krow0 + 4 * hh + q4) * stride + (col0 + 16 * chalf + 4 * p4) * 2);
  s16x4 lo, hi;
  asm volatile("ds_read_b64_tr_b16 %0, %2\n\tds_read_b64_tr_b16 %1, %3\n\ts_waitcnt lgkmcnt(0)"
               : "=&v"(lo), "=&v"(hi) : "v"(a), "v"(a + 8 * stride) : "memory");
  return __builtin_shufflevector(lo, hi, 0, 1, 2, 3, 4, 5, 6, 7);
}

template <int STRIDE>
DI void trfrag4(const char* img, int krow0, int ln, bf16x8 (&f)[4]) {
  const int hh = ln >> 5, chalf = (ln >> 4) & 1, q4 = (ln & 15) >> 2, p4 = ln & 3;
  const u32 a = (u32)(size_t)(img + (krow0 + 4 * hh + q4) * STRIDE + (16 * chalf + 4 * p4) * 2);
  s16x4 l0, h0, l1, h1, l2, h2, l3, h3;
  asm volatile(
      "ds_read_b64_tr_b16 %0, %8\n\tds_read_b64_tr_b16 %1, %8 offset:%9\n\t"
      "ds_read_b64_tr_b16 %2, %8 offset:64\n\tds_read_b64_tr_b16 %3, %8 offset:%10\n\t"
      "ds_read_b64_tr_b16 %4, %8 offset:128\n\tds_read_b64_tr_b16 %5, %8 offset:%11\n\t"
      "ds_read_b64_tr_b16 %6, %8 offset:192\n\tds_read_b64_tr_b16 %7, %8 offset:%12\n\t"
      "s_waitcnt lgkmcnt(0)"
      : "=&v"(l0), "=&v"(h0), "=&v"(l1), "=&v"(h1), "=&v"(l2), "=&v"(h2), "=&v"(l3), "=&v"(h3)
      : "v"(a), "i"(8 * STRIDE), "i"(8 * STRIDE + 64), "i"(8 * STRIDE + 128), "i"(8 * STRIDE + 192)
      : "memory");
  f[0] = __builtin_shufflevector(l0, h0, 0, 1, 2, 3, 4, 5, 6, 7);
  f[1] = __builtin_shufflevector(l1, h1, 0, 1, 2, 3, 4, 5, 6, 7);
  f[2] = __builtin_shufflevector(l2, h2, 0, 1, 2, 3, 4, 5, 6, 7);
  f[3] = __builtin_shufflevector(l3, h3, 0, 1, 2, 3, 4, 5, 6, 7);
}

template <int MT, int NT>
DI void gemm_core(const u16* __restrict__ A, int lda, const u16* __restrict__ B, int ldb, int K,
                  f32x4 (&acc)[MT][NT], char* smem) {
  constexpr int BM = 64 * MT, BN = 32 * NT;
  constexpr int ASZ = BM * 128, BSZ = BN * 128, BUF = ASZ + BSZ;
  constexpr int NA = BM / 64, NB = BN / 64;
  const int tid = ltid(), l = tid & 63, w = tid >> 6, wm = w >> 1, wn = w & 1;
  const int fr = l & 15, fq = l >> 4;
  uint4 ra0, ra1, ra2, ra3, rb0, rb1, rb2, rb3;
  const int nk = K >> 6;
  const int srow = tid >> 3, sch = tid & 7;
  const int ssw = sch ^ ((srow >> 1) & 7);
  const int fsw = (fr >> 1) & 7;
#define GL1(i, kt)                                                                                        \
  if (NA > i) ra##i = *(const uint4*)(A + (size_t)(srow + 64 * i) * lda + (kt) * 64 + sch * 8);           \
  if (NB > i) rb##i = *(const uint4*)(B + (size_t)(srow + 64 * i) * ldb + (kt) * 64 + sch * 8);
#define GLOAD(kt) { GL1(0, kt) GL1(1, kt) GL1(2, kt) GL1(3, kt) }
#define SS1(i)                                                                   \
  if (NA > i) *(uint4*)(as_ + (srow + 64 * i) * 128 + ssw * 16) = ra##i;         \
  if (NB > i) *(uint4*)(bs_ + (srow + 64 * i) * 128 + ssw * 16) = rb##i;
#define SSTORE(buf)                              \
  {                                              \
    char* as_ = smem + (buf) * BUF;              \
    char* bs_ = as_ + ASZ;                       \
    SS1(0) SS1(1) SS1(2) SS1(3)                  \
  }
  GLOAD(0);
  SSTORE(0);
  __syncthreads();
#pragma unroll 1
  for (int kt = 0; kt < nk; ++kt) {
    if (kt + 1 < nk) GLOAD(kt + 1);
    const char* as = smem + (kt & 1) * BUF;
    const char* bs = as + ASZ;
#pragma unroll
    for (int kk = 0; kk < 2; ++kk) {
      bf16x8 xf[MT], wf[NT];
#pragma unroll
      for (int mi = 0; mi < MT; ++mi)
        xf[mi] = *(const bf16x8*)(as + (wm * (MT * 16) + mi * 16 + fr) * 128 + (((kk * 4 + fq) ^ fsw) * 16));
#pragma unroll
      for (int ni = 0; ni < NT; ++ni)
        wf[ni] = *(const bf16x8*)(bs + (wn * (NT * 16) + ni * 16 + fr) * 128 + (((kk * 4 + fq) ^ fsw) * 16));
      __builtin_amdgcn_s_setprio(1);
#pragma unroll
      for (int mi = 0; mi < MT; ++mi)
#pragma unroll
        for (int ni = 0; ni < NT; ++ni) acc[mi][ni] = mfma16(wf[ni], xf[mi], acc[mi][ni]);
      __builtin_amdgcn_s_setprio(0);
    }
    if (kt + 1 < nk) SSTORE((kt + 1) & 1);
    __syncthreads();
  }
#undef GLOAD
#undef SSTORE
#undef GL1
#undef SS1
}
template <int MT, int NT>
DI void zero_acc(f32x4 (&acc)[MT][NT]) {
#pragma unroll
  for (int i = 0; i < MT; ++i)
#pragma unroll
    for (int j = 0; j < NT; ++j) acc[i][j] = f32x4{0.f, 0.f, 0.f, 0.f};
}


DI bool next_tile(int it, int RT, int CT, int PR, int PCc, int& rt, int& ct) {
  const int bid = lbid(), x = bid & 7, j = bid >> 3, J = lgdim() >> 3;
  const int u = j + it * J;
  const int pcols = CT / PCc, npatch = (RT / PR) * pcols;
  const int pid = (u >> 6) * 8 + x;
  if (pid >= npatch) return false;
  const int w = u & 63, pr = pid / pcols, pc = pid - pr * pcols;
  rt = pr * PR + w / PCc;
  ct = pc * PCc + w % PCc;
  return true;
}
DI void transpose_job(const float* __restrict__ src, int K, int N, u16* __restrict__ dst, int ldd, const float* kscale, char* smem) {
  float(*tile)[65] = (float(*)[65])smem;
  const int ntn = (N + 63) >> 6, ntk = K >> 6, tid = ltid();
  for (int t = lbid(); t < ntn * ntk; t += lgdim()) {
    const int tk = t / ntn, tn = t % ntn, k0 = tk * 64, n0 = tn * 64;
    {
      const int n = tid & 63, kb = tid >> 6;
      for (int i = 0; i < 8; ++i) {
        const int k = kb + 8 * i;
        float v = (n0 + n < N) ? src[(size_t)(k0 + k) * N + n0 + n] : 0.f;
        if (kscale) v *= kscale[k0 + k];
        tile[k][n] = v;
      }
    }
    __syncthreads();
    {
      const int n = tid >> 3, kc = tid & 7;
      if (n0 + n < N) {
        uint4 o;
        o.x = pack2(tile[kc * 8 + 0][n], tile[kc * 8 + 1][n]); o.y = pack2(tile[kc * 8 + 2][n], tile[kc * 8 + 3][n]);
        o.z = pack2(tile[kc * 8 + 4][n], tile[kc * 8 + 5][n]); o.w = pack2(tile[kc * 8 + 6][n], tile[kc * 8 + 7][n]);
        *(uint4*)(dst + (size_t)(n0 + n) * ldd + k0 + kc * 8) = o;
      }
    }
    __syncthreads();
  }
}

DI void phase0(const Params& p, char* smem) {
  const size_t gtid = (size_t)lbid() * NTHR + ltid(), gsz = (size_t)lgdim() * NTHR;
  for (int l = 0; l < 2; ++l) {
    transpose_job(p.w_in + (size_t)l * 1024 * 7120, 1024, 7120, p.win(l), KP1024, nullptr, smem);
    transpose_job(p.w_branch_a + (size_t)l * 512 * 1024, 512, 1024, p.wbra(l), KP512, nullptr, smem);
    transpose_job(p.w_branch_b + (size_t)l * 512 * 1024, 512, 1024, p.wbrb(l), KP512, nullptr, smem);
    transpose_job(p.w_o + (size_t)l * 1024 * 1024, 1024, 1024, p.wo(l), KP1024, nullptr, smem);
    transpose_job(p.w_ff1 + (size_t)l * 1024 * 4096, 1024, 4096, p.wf1(l), KP1024, nullptr, smem);
    transpose_job(p.w_ff2 + (size_t)l * 4096 * 1024, 4096, 1024, p.wf2(l), KP4096, nullptr, smem);
    transpose_job(p.c_w_qidx + (size_t)l * 256 * 512, 256, 512, p.wqx(l) + 1024 * KP256, KP256, p.c_q_norm_g + l * 256, smem);
    {
      const float* uq = p.c_w_uq + (size_t)l * 256 * 512;
      const float* uk = p.c_w_uk + (size_t)l * 128 * 512;
      const float* g = p.c_q_norm_g + l * 256;
      for (size_t e = gtid; e < 1024 * 256; e += gsz) {
        const int n = (int)(e >> 8), k = (int)(e & 255), h = n >> 7, r2 = n & 127;
        const float4* a = (const float4*)(uq + (k * 8 + h) * 64);
        const float4* b = (const float4*)(uk + (r2 * 8 + h) * 64);
        float s = 0.f;
        for (int d = 0; d < 16; ++d) { float4 x = a[d], y = b[d]; s += x.x * y.x + x.y * y.y + x.z * y.z + x.w * y.w; }
        p.wqx(l)[(size_t)n * KP256 + k] = f2bf(s * g[k]);
      }
    }
    {
      const float* uv = p.c_w_uv + (size_t)l * 128 * 512;
      const float* bc = p.w_branch_c + (size_t)l * 512 * 1024;
      for (size_t e = gtid; e < 1024 * 256; e += gsz) {
        const int k = (int)(e >> 8), n4 = (int)(e & 255) * 4, h = k >> 7, r = k & 127;
        const float* a = uv + (r * 8 + h) * 64;
        const float* b = bc + (size_t)(h * 64) * 1024 + n4;
        float4 acc4 = float4{0.f, 0.f, 0.f, 0.f};
#pragma unroll 8
        for (int d = 0; d < 64; ++d) {
          const float4 v = *(const float4*)(b + (size_t)d * 1024);
          const float ad = a[d];
          acc4.x += ad * v.x; acc4.y += ad * v.y; acc4.z += ad * v.z; acc4.w += ad * v.w;
        }
        u16* dst = p.wbrc(l) + (size_t)n4 * KP1024 + k;
        dst[0] = f2bf(acc4.x); dst[KP1024] = f2bf(acc4.y); dst[2 * KP1024] = f2bf(acc4.z); dst[3 * KP1024] = f2bf(acc4.w);
      }
    }
  }
  for (size_t e = gtid; e < (size_t)NT * 1024 / 8; e += gsz) {
    const float4 a = ((const float4*)p.x)[2 * e], b = ((const float4*)p.x)[2 * e + 1];
    uint4 o;
    o.x = pack2(a.x, a.y); o.y = pack2(a.z, a.w); o.z = pack2(b.x, b.y); o.w = pack2(b.z, b.w);
    *(uint4*)(p.XB() + (e >> 7) * LDX + (e & 127) * 8) = o;
  }
  if (gtid < 2) {
    const int l = (int)gtid;
    const float* lp = p.a_lambda + l * 256;
    float s1 = 0.f, s2 = 0.f;
    for (int i = 0; i < 64; ++i) { s1 += lp[i] * lp[64 + i]; s2 += lp[128 + i] * lp[192 + i]; }
    const float lam_init = 0.8f - 0.6f * expf(-0.3f * l);
    p.LAM()[l] = expf(s1) - expf(s2) + lam_init;
    p.LAM()[2 + l] = lam_init;
    for (int i = 0; i < 8; ++i) p.CNT()[l * 8 + i] = 0;
  }
}

DI void ln_phase(const float* S, const float* __restrict__ g, const float* __restrict__ b, u16* XBo, float* fout) {
  const int l = ltid() & 63;
  const int wave = lbid() * 8 + (ltid() >> 6), nw = lgdim() * 8;
  for (int row = wave; row < NT; row += nw) {
    float4 v[4];
    float s = 0.f;
#pragma unroll
    for (int i = 0; i < 4; ++i) { v[i] = *(const float4*)(S + (size_t)row * 1024 + i * 256 + l * 4); s += v[i].x + v[i].y + v[i].z + v[i].w; }
#pragma unroll
    for (int o = 32; o; o >>= 1) s += __shfl_xor(s, o);
    const float mu = s * (1.f / 1024.f);
    float q = 0.f;
#pragma unroll
    for (int i = 0; i < 4; ++i) { float a = v[i].x - mu, bb = v[i].y - mu, c = v[i].z - mu, d = v[i].w - mu; q += a * a + bb * bb + c * c + d * d; }
#pragma unroll
    for (int o = 32; o; o >>= 1) q += __shfl_xor(q, o);
    const float rs = rsqrtf(q * (1.f / 1024.f) + EPS);
#pragma unroll
    for (int i = 0; i < 4; ++i) {
      const int c = i * 256 + l * 4;
      const float4 gg = *(const float4*)(g + c), bb = *(const float4*)(b + c);
      float4 y;
      y.x = (v[i].x - mu) * rs * gg.x + bb.x; y.y = (v[i].y - mu) * rs * gg.y + bb.y;
      y.z = (v[i].z - mu) * rs * gg.z + bb.z; y.w = (v[i].w - mu) * rs * gg.w + bb.w;
      if (fout) *(float4*)(fout + (size_t)row * 1024 + c) = y;
      if (XBo) { uint2 o; o.x = pack2(y.x, y.y); o.y = pack2(y.z, y.w); *(uint2*)(XBo + (size_t)row * LDX + c) = o; }
    }
  }
}

#define EPI_LOOP(MT_, NT_)                                                \
  const int l_ = ltid() & 63, w_ = ltid() >> 6;                           \
  const int wm_ = w_ >> 1, wn_ = w_ & 1, fr_ = l_ & 15, fq_ = l_ >> 4;    \
  _Pragma("unroll") for (int mi = 0; mi < MT_; ++mi)                      \
  _Pragma("unroll") for (int ni = 0; ni < NT_; ++ni)

DI void phase_inproj(const Params& p, int l, char* smem) {
  int rt, ct;
  for (int it = 0; next_tile(it, 128, 16, 8, 8, rt, ct); ++it) {
    const int r0 = rt * 256, c0 = ct * 256;
    f32x4 acc[4][8];
    zero_acc<4, 8>(acc);
    gemm_core<4, 8>(p.XB() + (size_t)r0 * LDX, LDX, p.win(l) + (size_t)c0 * KP1024, KP1024, 1024, acc, smem);
    EPI_LOOP(4, 8) {
      const int row = r0 + wm_ * 64 + mi * 16 + fr_, col = c0 + wn_ * 128 + ni * 16 + fq_ * 4;
      if (col < PC) {
        uint2 o;
        o.x = pack2(acc[mi][ni][0], acc[mi][ni][1]); o.y = pack2(acc[mi][ni][2], acc[mi][ni][3]);
        *(uint2*)(p.P() + (size_t)row * PC + col) = o;
        if (col >= BQ && col < BZ && (row & 63) >= 61)
          *(uint2*)(p.HALO() + ((size_t)(row >> 6) * 3 + ((row & 63) - 61)) * 1536 + (col - BQ)) = o;
      }
    }
  }
}

DI void qx_tile(const Params& p, int l, int rt, int ct, char* smem) {
  const int r0 = rt * 256, c0 = ct * 256;
  float* rsv = (float*)(smem + 147456);
  {
    const int row = ltid() >> 1, half = ltid() & 1;
    const uint4* src = (const uint4*)(p.P() + (size_t)(r0 + row) * PC + CQ + half * 128);
    float ss = 0.f;
    for (int i = 0; i < 16; ++i) {
      uint4 v = src[i];
      float a;
      a = bflo(v.x); ss += a * a; a = bfhi(v.x); ss += a * a; a = bflo(v.y); ss += a * a; a = bfhi(v.y); ss += a * a;
      a = bflo(v.z); ss += a * a; a = bfhi(v.z); ss += a * a; a = bflo(v.w); ss += a * a; a = bfhi(v.w); ss += a * a;
    }
    ss += __shfl_xor(ss, 1);
    if (!half) rsv[row] = rsqrtf(ss * (1.f / 256.f) + EPS);
  }
  f32x4 acc[4][8];
  zero_acc<4, 8>(acc);
  gemm_core<4, 8>(p.P() + (size_t)r0 * PC + CQ, PC, p.wqx(l) + (size_t)c0 * KP256, KP256, 256, acc, smem);
  u16* QX = (u16*)p.out;
  EPI_LOOP(4, 8) {
    const int rl = wm_ * 64 + mi * 16 + fr_, col = c0 + wn_ * 128 + ni * 16 + fq_ * 4;
    const float rs = rsv[rl];
    uint2 o;
    o.x = pack2(acc[mi][ni][0] * rs, acc[mi][ni][1] * rs); o.y = pack2(acc[mi][ni][2] * rs, acc[mi][ni][3] * rs);
    *(uint2*)(QX + (size_t)(r0 + rl) * LDQ + col) = o;
  }
  __syncthreads();
}

DI void phase_merge(const Params& p, int l, char* smem) {
  const u16* QX = (const u16*)p.out;
  int rt, ct;
  for (int it = 0; next_tile(it, 128, 8, 8, 8, rt, ct); ++it) {
    const int r0 = rt * 256, c0 = ct * 128;
    bool first = true;
#pragma unroll 1
    for (int j = 0; j < 3; ++j) {
      if ((j == 0 && !EN_A) || (j == 1 && !EN_B) || (j == 2 && !EN_C)) continue;
      const u16* Ab; const u16* Wb; int lda, K;
      int ldw;
      if (j == 0) { Ab = p.P() + (size_t)r0 * PC + AQ; lda = PC; Wb = p.wbra(l) + (size_t)c0 * KP512; K = 512; ldw = KP512; }
      else if (j == 1) { Ab = p.P() + (size_t)r0 * PC + BZ; lda = PC; Wb = p.wbrb(l) + (size_t)c0 * KP512; K = 512; ldw = KP512; }
      else { Ab = QX + (size_t)r0 * LDQ; lda = LDQ; Wb = p.wbrc(l) + (size_t)c0 * KP1024; K = 1024; ldw = KP1024; }
      f32x4 g[4][4];
      zero_acc<4, 4>(g);
      gemm_core<4, 4>(p.XB() + (size_t)r0 * LDX, LDX, p.win(l) + (size_t)(GATES + j * 1024 + c0) * KP1024, KP1024, 1024, g, smem);
      const float* bg = p.b_gate + l * 3072 + j * 1024;
      {
        EPI_LOOP(4, 4) {
          const int col = c0 + wn_ * 64 + ni * 16 + fq_ * 4;
          const float4 bb = *(const float4*)(bg + col);
          g[mi][ni][0] = sigmoidf_(g[mi][ni][0] + bb.x);
          g[mi][ni][1] = sigmoidf_(g[mi][ni][1] + bb.y);
          g[mi][ni][2] = sigmoidf_(g[mi][ni][2] + bb.z);
          g[mi][ni][3] = sigmoidf_(g[mi][ni][3] + bb.w);
        }
      }
      f32x4 br[4][4];
      zero_acc<4, 4>(br);
      gemm_core<4, 4>(Ab, lda, Wb, ldw, K, br, smem);
      {
        EPI_LOOP(4, 4) {
          const int row = r0 + wm_ * 64 + mi * 16 + fr_, col = c0 + wn_ * 64 + ni * 16 + fq_ * 4;
          u16* mp = p.MERGED() + (size_t)row * LDX + col;
          float a0 = g[mi][ni][0] * br[mi][ni][0], a1 = g[mi][ni][1] * br[mi][ni][1];
          float a2 = g[mi][ni][2] * br[mi][ni][2], a3 = g[mi][ni][3] * br[mi][ni][3];
          if (!first) {
            const uint2 old = *(const uint2*)mp;
            a0 += bflo(old.x); a1 += bfhi(old.x); a2 += bflo(old.y); a3 += bfhi(old.y);
          }
          uint2 o;
          o.x = pack2(a0, a1); o.y = pack2(a2, a3);
          *(uint2*)mp = o;
        }
      }
      first = false;
    }
  }
}

DI void phase_resgemm(const Params& p, const u16* A, int lda, const u16* W, int ldw, int K, char* smem) {
  int rt, ct;
  for (int it = 0; next_tile(it, 128, 4, 16, 4, rt, ct); ++it) {
    const int r0 = rt * 256, c0 = ct * 256;
    f32x4 acc[4][8];
    zero_acc<4, 8>(acc);
    gemm_core<4, 8>(A + (size_t)r0 * lda, lda, W + (size_t)c0 * ldw, ldw, K, acc, smem);
    EPI_LOOP(4, 8) {
      const int row = r0 + wm_ * 64 + mi * 16 + fr_, col = c0 + wn_ * 128 + ni * 16 + fq_ * 4;
      const uint2 xb = *(const uint2*)(p.XB() + (size_t)row * LDX + col);
      float4 o;
      o.x = DN_ALPHA * bflo(xb.x) + acc[mi][ni][0]; o.y = DN_ALPHA * bfhi(xb.x) + acc[mi][ni][1];
      o.z = DN_ALPHA * bflo(xb.y) + acc[mi][ni][2]; o.w = DN_ALPHA * bfhi(xb.y) + acc[mi][ni][3];
      *(float4*)(p.out + (size_t)row * 1024 + col) = o;
    }
  }
}

DI void phase_ff1(const Params& p, int l, char* smem) {
  int rt, ct;
  for (int it = 0; next_tile(it, 128, 16, 8, 8, rt, ct); ++it) {
    const int r0 = rt * 256, c0 = ct * 256;
    f32x4 acc[4][8];
    zero_acc<4, 8>(acc);
    gemm_core<4, 8>(p.XB() + (size_t)r0 * LDX, LDX, p.wf1(l) + (size_t)c0 * KP1024, KP1024, 1024, acc, smem);
    EPI_LOOP(4, 8) {
      const int row = r0 + wm_ * 64 + mi * 16 + fr_, col = c0 + wn_ * 128 + ni * 16 + fq_ * 4;
      float a0 = fmaxf(acc[mi][ni][0], 0.f), a1 = fmaxf(acc[mi][ni][1], 0.f), a2 = fmaxf(acc[mi][ni][2], 0.f), a3 = fmaxf(acc[mi][ni][3], 0.f);
      uint2 o;
      o.x = pack2(a0 * a0, a1 * a1); o.y = pack2(a2 * a2, a3 * a3);
      *(uint2*)(p.P() + (size_t)row * LDH + col) = o;
    }
  }
}

DI void dsa_kprep_item(const Params& p, int l, int it) {
  const int ln = ltid() & 63, w = ltid() >> 6;
  const float g0 = p.c_kv_norm_g[l * 128 + 2 * ln], g1 = p.c_kv_norm_g[l * 128 + 2 * ln + 1];
  const float kg = p.c_kidx_g[l * 64 + ln], kb = p.c_kidx_b[l * 64 + ln];
  for (int i = 0; i < 8; ++i) {
    const size_t tok = (size_t)it * 64 + w * 8 + i;
    const u16* pr = p.P() + tok * PC;
    const u32 v = *(const u32*)(pr + CKVc + 2 * ln);
    const float a = bflo(v), b = bfhi(v);
    float ss = a * a + b * b;
#pragma unroll
    for (int o = 32; o; o >>= 1) ss += __shfl_xor(ss, o);
    const float rs = rsqrtf(ss * (1.f / 128.f) + EPS);
    *(u32*)(p.CKV() + tok * 128 + 2 * ln) = pack2(a * rs * g0, b * rs * g1);
    const float k = bf2f(pr[CKI + ln]);
    float s = k;
#pragma unroll
    for (int o = 32; o; o >>= 1) s += __shfl_xor(s, o);
    const float mu = s * (1.f / 64.f);
    float q = (k - mu) * (k - mu);
#pragma unroll
    for (int o = 32; o; o >>= 1) q += __shfl_xor(q, o);
    p.KIDX()[tok * 64 + ln] = f2bf((k - mu) * rsqrtf(q * (1.f / 64.f) + EPS) * kg + kb);
    if (ln < 8) p.WIDX()[tok * 8 + ln] = bf2f(pr[CWI + ln]) * 0.04419417382f;
  }
}

DI void gdn_prep_item(const Params& p, int l, int it, char* smem0) {
  const int half_ = ltid() >> 8;
  const int cidx = it >> 1, h = (it & 1) * 2 + half_, n = cidx & 255;
  const size_t t0g = (size_t)cidx * 64;
  char* smem = smem0 + half_ * 69632;
  const int tid = ltid() & 255, ln = tid & 63, w = tid >> 6;
  char* qs = smem;
  char* ks = smem + 17408;
  char* vs = smem + 2 * 17408;
  float* Lm = (float*)(smem + 3 * 17408);
  float* gcs = Lm + 4096;
  float* bts = gcs + 64;
  float* egs = bts + 64;
  u16* proj = p.P();
  {
    const int c = tid & 127, rh = tid >> 7;
    uint4 st[12];
#pragma unroll
    for (int part = 0; part < 3; ++part)
#pragma unroll
      for (int i = 0; i < 4; ++i) {
        const int piece = tid + 256 * i, row = piece >> 4, ch = piece & 15;
        st[part * 4 + i] = *(const uint4*)(proj + (t0g + row) * PC + BQ + part * 512 + h * 128 + ch * 8);
      }
    float hx[9];
#pragma unroll
    for (int i = 0; i < 9; ++i) hx[i] = 0.f;
    if (rh == 0 && n != 0) {
#pragma unroll
      for (int part = 0; part < 3; ++part) {
        const u16* hp = p.HALO() + ((size_t)(cidx - 1) * 3) * 1536 + part * 512 + h * 128 + c;
        hx[part * 3 + 0] = bf2f(hp[0]); hx[part * 3 + 1] = bf2f(hp[1536]); hx[part * 3 + 2] = bf2f(hp[2 * 1536]);
      }
    }
#pragma unroll
    for (int part = 0; part < 3; ++part)
#pragma unroll
      for (int i = 0; i < 4; ++i) {
        const int piece = tid + 256 * i, row = piece >> 4, ch = piece & 15;
        char* dst = (part == 0 ? qs : (part == 1 ? ks : vs));
        *(uint4*)(dst + row * 272 + ch * 16) = st[part * 4 + i];
      }
    __syncthreads();
    if (rh == 1) {
#pragma unroll
      for (int part = 0; part < 3; ++part) {
        const char* src = (part == 0 ? qs : (part == 1 ? ks : vs));
        hx[part * 3 + 0] = bf2f(*(const u16*)(src + 29 * 272 + c * 2));
        hx[part * 3 + 1] = bf2f(*(const u16*)(src + 30 * 272 + c * 2));
        hx[part * 3 + 2] = bf2f(*(const u16*)(src + 31 * 272 + c * 2));
      }
    }
    __syncthreads();
#pragma unroll
    for (int part = 0; part < 3; ++part) {
      const int wch = part * 512 + h * 128 + c;
      const float* cw = p.b_conv_w + (size_t)l * 4 * 1536 + wch;
      const float w0 = cw[0], w1 = cw[1536], w2 = cw[2 * 1536], w3 = cw[3 * 1536];
      float xm3 = hx[part * 3 + 0], xm2 = hx[part * 3 + 1], xm1 = hx[part * 3 + 2];
      char* dst = (part == 0 ? qs : (part == 1 ? ks : vs));
#pragma unroll 8
      for (int i = 0; i < 32; ++i) {
        const int r = rh * 32 + i;
        u16* px = (u16*)(dst + r * 272 + c * 2);
        const float x = bf2f(*px);
        const float y = w0 * xm3 + w1 * xm2 + w2 * xm1 + w3 * x;
        xm3 = xm2; xm2 = xm1; xm1 = x;
        *px = f2bf(siluf_(y));
      }
    }
  }
  if (w == 0) {
    const float a = bf2f(proj[(t0g + ln) * PC + BA + h]) + p.b_dt_bias[l * 4 + h];
    const float ea = __expf(a);
    const float sp = (a > 20.f) ? a : ((ea < 0.01f) ? ea * (1.f - ea * (0.5f - ea * 0.333333333f)) : __logf(1.f + ea));
    float g = -__expf(p.b_a_log[l * 4 + h]) * sp;
#pragma unroll
    for (int o = 1; o < 64; o <<= 1) { float t = __shfl_up(g, o); if (ln >= o) g += t; }
    gcs[ln] = g;
    egs[ln] = __expf(g);
    bts[ln] = sigmoidf_(bf2f(proj[(t0g + ln) * PC + BB + h]));
  }
  __syncthreads();
  {
    const int row = tid >> 2, qr = tid & 3;
#pragma unroll
    for (int part = 0; part < 2; ++part) {
      char* base = (part == 0 ? qs : ks) + row * 272 + qr * 64;
      uint4 v[4];
      float ss = 0.f;
#pragma unroll
      for (int i = 0; i < 4; ++i) {
        v[i] = *(uint4*)(base + i * 16);
        float a;
        a = bflo(v[i].x); ss += a * a; a = bfhi(v[i].x); ss += a * a; a = bflo(v[i].y); ss += a * a; a = bfhi(v[i].y); ss += a * a;
        a = bflo(v[i].z); ss += a * a; a = bfhi(v[i].z); ss += a * a; a = bflo(v[i].w); ss += a * a; a = bfhi(v[i].w); ss += a * a;
      }
      ss += __shfl_xor(ss, 1);
      ss += __shfl_xor(ss, 2);
      const float rs = rsqrtf(ss + EPS) * (part == 0 ? 0.08838834764f : 1.f);
#pragma unroll
      for (int i = 0; i < 4; ++i) {
        uint4 o;
        o.x = pack2(bflo(v[i].x) * rs, bfhi(v[i].x) * rs); o.y = pack2(bflo(v[i].y) * rs, bfhi(v[i].y) * rs);
        o.z = pack2(bflo(v[i].z) * rs, bfhi(v[i].z) * rs); o.w = pack2(bflo(v[i].w) * rs, bfhi(v[i].w) * rs);
        *(uint4*)(base + i * 16) = o;
      }
    }
  }
  __syncthreads();
  {
    const int fr = ln & 15, fq = ln >> 4;
    f32x4 kk[4], qk[4];
#pragma unroll
    for (int nt = 0; nt < 4; ++nt) { kk[nt] = f32x4{0, 0, 0, 0}; qk[nt] = f32x4{0, 0, 0, 0}; }
#pragma unroll
    for (int s = 0; s < 4; ++s) {
      const bf16x8 ak = *(const bf16x8*)(ks + (16 * w + fr) * 272 + (32 * s + 8 * fq) * 2);
      const bf16x8 aq = *(const bf16x8*)(qs + (16 * w + fr) * 272 + (32 * s + 8 * fq) * 2);
#pragma unroll
      for (int nt = 0; nt < 4; ++nt) {
        const bf16x8 bk = *(const bf16x8*)(ks + (16 * nt + fr) * 272 + (32 * s + 8 * fq) * 2);
        kk[nt] = mfma16(ak, bk, kk[nt]);
        qk[nt] = mfma16(aq, bk, qk[nt]);
      }
    }
#pragma unroll
    for (int nt = 0; nt < 4; ++nt)
#pragma unroll
      for (int jj = 0; jj < 4; ++jj) {
        const int i = 16 * w + 4 * fq + jj, j = 16 * nt + fr;
        const float dec = (i >= j) ? __expf(gcs[i] - gcs[j]) : 0.f;
        Lm[i * 64 + j] = (i > j) ? bts[i] * kk[nt][jj] * dec : 0.f;
        p.ATT()[(t0g + i) * 256 + h * 64 + j] = f2bf((i >= j) ? qk[nt][jj] * dec : 0.f);
      }
  }
  __syncthreads();
  {
    const int c = tid;
    const bool isu = c < 128;
    const char* src = isu ? (vs + c * 2) : (ks + (c - 128) * 2);
    const float wsel = isu ? 0.f : 1.f;
    float x[64];
#pragma unroll
    for (int i = 0; i < 64; ++i) {
      float a = bf2f(*(const u16*)(src + i * 272)) * bts[i] * fmaf(egs[i] - 1.f, wsel, 1.f);
      const float* Lr = Lm + i * 64;
#pragma unroll
      for (int j = 0; j < i; ++j) a -= Lr[j] * x[j];
      x[i] = a;
      asm volatile("" ::: "memory");
    }
    if (isu) {
      u32 pk[32];
#pragma unroll
      for (int pos = 0; pos < 64; pos += 2) {
        const int hh = pos >> 5, Tt = (pos >> 4) & 1, ii = pos & 15;
        const int r0 = 32 * Tt + (ii & 3) + 8 * (ii >> 2) + 4 * hh;
        const int i1 = ii + 1;
        const int r1 = 32 * Tt + (i1 & 3) + 8 * (i1 >> 2) + 4 * hh;
        pk[pos >> 1] = pack2(x[r0], x[r1]);
      }
      char* dst = (char*)proj + ((t0g + (c >> 1)) * PC + BV + h * 128) * 2 + (c & 1) * 128;
#pragma unroll
      for (int i = 0; i < 8; ++i) *(uint4*)(dst + i * 16) = uint4{pk[4 * i], pk[4 * i + 1], pk[4 * i + 2], pk[4 * i + 3]};
    } else {
#pragma unroll
      for (int i = 0; i < 64; ++i) proj[(t0g + i) * PC + BK_ + h * 128 + (c - 128)] = f2bf(x[i]);
    }
  }
  {
    const float glast = gcs[63];
#pragma unroll
    for (int i = 0; i < 4; ++i) {
      const int piece = tid + 256 * i, row = piece >> 4, ch = piece & 15;
      const uint4 v = *(const uint4*)(qs + row * 272 + ch * 16);
      const float e = egs[row];
      uint4 o;
      o.x = pack2(bflo(v.x) * e, bfhi(v.x) * e); o.y = pack2(bflo(v.y) * e, bfhi(v.y) * e);
      o.z = pack2(bflo(v.z) * e, bfhi(v.z) * e); o.w = pack2(bflo(v.w) * e, bfhi(v.w) * e);
      *(uint4*)(proj + (t0g + row) * PC + BQ + h * 128 + ch * 8) = o;
    }
    const int d = tid & 127, half = tid >> 7;
    u32 pk[16];
#pragma unroll
    for (int i = 0; i < 16; ++i) {
      const int r0 = half * 32 + 2 * i;
      const float a = bf2f(*(const u16*)(ks + r0 * 272 + d * 2)) * __expf(glast - gcs[r0]);
      const float b = bf2f(*(const u16*)(ks + (r0 + 1) * 272 + d * 2)) * __expf(glast - gcs[r0 + 1]);
      pk[i] = pack2(a, b);
    }
    u16* dst = p.KDT() + (((size_t)cidx * 4 + h) * 128 + d) * 64 + half * 32;
#pragma unroll
    for (int i = 0; i < 4; ++i) *(uint4*)(dst + i * 8) = uint4{pk[4 * i], pk[4 * i + 1], pk[4 * i + 2], pk[4 * i + 3]};
    if (tid == 0) p.GL()[cidx * 4 + h] = egs[63];
  }
  __syncthreads();
}

DI void gdn_rec_item(const Params& p, int l, int bh, char* smem, bool wr) {
  const int b = bh >> 2, h = bh & 3;
  const int tid = ltid(), ln = tid & 63, w = tid >> 6, hh = ln >> 5, c31 = ln & 31;
  const bool is_comp = w < 4;
  constexpr int BUFB = 59904;
  float* Ot = (float*)(smem + 2 * BUFB);
  u16* proj = p.P();
  const float* ng = p.b_norm_g + l * 128;
  const int lt = tid & 255;
#define LD_AQ(i, n_)                                                                                      \
  {                                                                                                       \
    const size_t t0g_ = ((size_t)b * 256 + (n_)) * 64;                                                    \
    const int piece = ltv + 256 * i, row = piece >> 4, ch = piece & 15;                                   \
    la##i = *(const uint4*)(proj + (t0g_ + row) * PC + BK_ + h * 128 + ch * 8);                           \
    lq##i = *(const uint4*)(proj + (t0g_ + row) * PC + BQ + h * 128 + ch * 8);                            \
  }
#define LD_K(i, n_)                                                                                       \
  {                                                                                                       \
    const int piece = ltv + 256 * i, row2 = piece >> 3, ch2 = piece & 7;                                  \
    lk##i = *(const uint4*)(p.KDT() + ((((size_t)b * 256 + (n_)) * 4 + h) * 128 + row2) * 64 + ch2 * 8);  \
  }
#define LD_T(i, n_)                                                                                       \
  {                                                                                                       \
    const size_t t0g_ = ((size_t)b * 256 + (n_)) * 64;                                                    \
    const int piece = ltv + 256 * i, row = piece >> 3, ch = piece & 7;                                     \
    lt##i = *(const uint4*)(p.ATT() + (t0g_ + row) * 256 + h * 64 + ch * 8);                              \
  }
#define LD_R1(n_) { LD_AQ(0, n_) LD_AQ(1, n_) LD_AQ(2, n_) LD_AQ(3, n_) }
#define LD_R2(n_) { LD_K(0, n_) LD_K(1, n_) LD_K(2, n_) LD_K(3, n_) LD_T(0, n_) LD_T(1, n_) }
#define ST_AQ(i, buf_)                                                                                    \
  {                                                                                                       \
    char* Wm_ = smem + (buf_) * BUFB; char* Qd_ = Wm_ + 16896;                                            \
    const int piece = ltv + 256 * i, row = piece >> 4, ch = piece & 15;                                   \
    *(uint2*)(Wm_ + row * 264 + ch * 16) = uint2{la##i.x, la##i.y}; *(uint2*)(Wm_ + row * 264 + ch * 16 + 8) = uint2{la##i.z, la##i.w}; \
    *(uint2*)(Qd_ + row * 264 + ch * 16) = uint2{lq##i.x, lq##i.y}; *(uint2*)(Qd_ + row * 264 + ch * 16 + 8) = uint2{lq##i.z, lq##i.w}; \
  }
#define ST_K(i, buf_)                                                                                     \
  {                                                                                                       \
    char* Kt_ = smem + (buf_) * BUFB + 2 * 16896;                                                         \
    const int piece = ltv + 256 * i, row2 = piece >> 3, ch2 = piece & 7;                                  \
    *(uint2*)(Kt_ + row2 * 136 + ch2 * 16) = uint2{lk##i.x, lk##i.y}; *(uint2*)(Kt_ + row2 * 136 + ch2 * 16 + 8) = uint2{lk##i.z, lk##i.w}; \
  }
#define ST_T(i, buf_)                                                                                     \
  {                                                                                                       \
    char* At_ = smem + (buf_) * BUFB + 2 * 16896 + 17408;                                                 \
    const int piece = ltv + 256 * i, row = piece >> 3, ch = piece & 7;                                     \
    *(uint2*)(At_ + row * 136 + ch * 16) = uint2{lt##i.x, lt##i.y}; *(uint2*)(At_ + row * 136 + ch * 16 + 8) = uint2{lt##i.z, lt##i.w}; \
  }
#define ST_R1(buf_) { ST_AQ(0, buf_) ST_AQ(1, buf_) ST_AQ(2, buf_) ST_AQ(3, buf_) }
#define ST_R2(buf_) { ST_K(0, buf_) ST_K(1, buf_) ST_K(2, buf_) ST_K(3, buf_) ST_T(0, buf_) ST_T(1, buf_) }
#define LD_Z(n_)                                                                                          \
  {                                                                                                       \
    const u16* zp_ = proj + (((size_t)b * 256 + (n_)) * 64 + nrow) * PC + BZ + h * 128 + nqr * 32;        \
    lz0 = *(const uint4*)(zp_); lz1 = *(const uint4*)(zp_ + 8); lz2 = *(const uint4*)(zp_ + 16); lz3 = *(const uint4*)(zp_ + 24); \
  }
  f32x16 S[4];
#pragma unroll
  for (int i = 0; i < 4; ++i)
#pragma unroll
    for (int j = 0; j < 16; ++j) S[i][j] = 0.f;
  const int e = 32 * w + c31;
  uint4 un0, un1, un2, un3;
  float gln = 0.f;
#define LD_U(n_)                                                                                          \
  {                                                                                                       \
    const uint4* up_ = (const uint4*)((const char*)proj + ((((size_t)b * 256 + (n_)) * 64 + (e >> 1)) * PC + BV + h * 128) * 2 + (e & 1) * 128 + hh * 64); \
    un0 = up_[0]; un1 = up_[1]; un2 = up_[2]; un3 = up_[3];                                               \
    gln = p.GL()[((size_t)b * 256 + (n_)) * 4 + h];                                                       \
  }
  if (!is_comp) {
    const int ltv = lt;
    uint4 la0, la1, la2, la3, lq0, lq1, lq2, lq3, lk0, lk1, lk2, lk3, lt0, lt1;
    LD_R1(0) LD_R2(0)
    ST_R1(0) ST_R2(0)
  } else {
    LD_U(0)
  }
  for (int n = 0; n < 256; ++n) {
    f32x16 o[2];
    __syncthreads();
    if (is_comp) {
      int lnv = ln;
      asm volatile("" : "+v"(lnv));
      const int hh = lnv >> 5, c31 = lnv & 31;
      const char* Wm = smem + (n & 1) * BUFB;
      const char* Qd = Wm + 16896;
      const char* Kt = Wm + 2 * 16896;
      const char* At = Kt + 17408;
      f32x16 ws[2];
#pragma unroll
      for (int i = 0; i < 2; ++i)
#pragma unroll
        for (int j = 0; j < 16; ++j) { ws[i][j] = 0.f; o[i][j] = 0.f; }
#pragma unroll
      for (int Tt = 0; Tt < 4; ++Tt)
#pragma unroll
        for (int s = 0; s < 2; ++s) {
          const int kb = 32 * Tt + 16 * s;
          const bf16x8 sps = pack8(S[Tt], s);
#pragma unroll
          for (int Tc = 0; Tc < 2; ++Tc) {
            ws[Tc] = mfma32(afrag_perm(Wm, 32 * Tc + c31, 264, kb, hh), sps, ws[Tc]);
            o[Tc] = mfma32(afrag_perm(Qd, 32 * Tc + c31, 264, kb, hh), sps, o[Tc]);
          }
        }
      f32x16 vn[2];
      vn[0][0] = bflo(un0.x) - ws[0][0]; vn[0][1] = bfhi(un0.x) - ws[0][1]; vn[0][2] = bflo(un0.y) - ws[0][2]; vn[0][3] = bfhi(un0.y) - ws[0][3];
      vn[0][4] = bflo(un0.z) - ws[0][4]; vn[0][5] = bfhi(un0.z) - ws[0][5]; vn[0][6] = bflo(un0.w) - ws[0][6]; vn[0][7] = bfhi(un0.w) - ws[0][7];
      vn[0][8] = bflo(un1.x) - ws[0][8]; vn[0][9] = bfhi(un1.x) - ws[0][9]; vn[0][10] = bflo(un1.y) - ws[0][10]; vn[0][11] = bfhi(un1.y) - ws[0][11];
      vn[0][12] = bflo(un1.z) - ws[0][12]; vn[0][13] = bfhi(un1.z) - ws[0][13]; vn[0][14] = bflo(un1.w) - ws[0][14]; vn[0][15] = bfhi(un1.w) - ws[0][15];
      vn[1][0] = bflo(un2.x) - ws[1][0]; vn[1][1] = bfhi(un2.x) - ws[1][1]; vn[1][2] = bflo(un2.y) - ws[1][2]; vn[1][3] = bfhi(un2.y) - ws[1][3];
      vn[1][4] = bflo(un2.z) - ws[1][4]; vn[1][5] = bfhi(un2.z) - ws[1][5]; vn[1][6] = bflo(un2.w) - ws[1][6]; vn[1][7] = bfhi(un2.w) - ws[1][7];
      vn[1][8] = bflo(un3.x) - ws[1][8]; vn[1][9] = bfhi(un3.x) - ws[1][9]; vn[1][10] = bflo(un3.y) - ws[1][10]; vn[1][11] = bfhi(un3.y) - ws[1][11];
      vn[1][12] = bflo(un3.z) - ws[1][12]; vn[1][13] = bfhi(un3.z) - ws[1][13]; vn[1][14] = bflo(un3.w) - ws[1][14]; vn[1][15] = bfhi(un3.w) - ws[1][15];
      const float gl = gln;
      if (n + 1 < 256) LD_U(n + 1)
      bf16x8 vp[2][2];
#pragma unroll
      for (int Tc = 0; Tc < 2; ++Tc) { vp[Tc][0] = pack8(vn[Tc], 0); vp[Tc][1] = pack8(vn[Tc], 1); }
#pragma unroll
      for (int s = 0; s < 2; ++s) {
        o[0] = mfma32(afrag_perm(At, c31, 136, 16 * s, hh), vp[0][s], o[0]);
        o[1] = mfma32(afrag_perm(At, 32 + c31, 136, 16 * s, hh), vp[0][s], o[1]);
        o[1] = mfma32(afrag_perm(At, 32 + c31, 136, 32 + 16 * s, hh), vp[1][s], o[1]);
      }
#pragma unroll
      for (int Tt = 0; Tt < 4; ++Tt)
#pragma unroll
        for (int j = 0; j < 16; ++j) S[Tt][j] *= gl;
#pragma unroll
      for (int Tc = 0; Tc < 2; ++Tc)
#pragma unroll
        for (int s = 0; s < 2; ++s)
#pragma unroll
          for (int Tt = 0; Tt < 4; ++Tt)
            S[Tt] = mfma32(afrag_perm(Kt, 32 * Tt + c31, 136, 32 * Tc + 16 * s, hh), vp[Tc][s], S[Tt]);
    } else {
      int ltv = lt;
      asm volatile("" : "+v"(ltv));
      const int nrow = ltv >> 2, nqr = ltv & 3;
      const int nn = (n + 1 < 256) ? n + 1 : 255;
      {
        uint4 la0, la1, la2, la3, lq0, lq1, lq2, lq3;
        LD_R1(nn)
        ST_R1((n + 1) & 1)
      }
      uint4 lz0, lz1, lz2, lz3;
      {
        uint4 lk0, lk1, lk2, lk3, lt0, lt1;
        LD_R2(nn)
        const int nz = (n > 0) ? n - 1 : 0;
        LD_Z(nz)
        ST_R2((n + 1) & 1)
      }
      if (n > 0) {
        const float* orow = Ot + nrow * 132 + nqr * 32;
        float ss = 0.f;
#pragma unroll
        for (int i = 0; i < 8; ++i) {
          const float4 v = *(const float4*)(orow + 4 * i);
          ss += v.x * v.x + v.y * v.y + v.z * v.z + v.w * v.w;
        }
        ss += __shfl_xor(ss, 1);
        ss += __shfl_xor(ss, 2);
        const float rs = rsqrtf(ss * (1.f / 128.f) + EPS);
        u16* zp = proj + (((size_t)b * 256 + (n - 1)) * 64 + nrow) * PC + BZ + h * 128 + nqr * 32;
        const float* gg = ng + nqr * 32;
#define GN1(i, Z)                                                                                          \
        {                                                                                                  \
          const float4 oa = *(const float4*)(orow + 8 * i), ob = *(const float4*)(orow + 8 * i + 4);       \
          uint4 r;                                                                                         \
          r.x = pack2(oa.x * rs * gg[8 * i + 0] * siluf_(bflo(Z.x)), oa.y * rs * gg[8 * i + 1] * siluf_(bfhi(Z.x))); \
          r.y = pack2(oa.z * rs * gg[8 * i + 2] * siluf_(bflo(Z.y)), oa.w * rs * gg[8 * i + 3] * siluf_(bfhi(Z.y))); \
          r.z = pack2(ob.x * rs * gg[8 * i + 4] * siluf_(bflo(Z.z)), ob.y * rs * gg[8 * i + 5] * siluf_(bfhi(Z.z))); \
          r.w = pack2(ob.z * rs * gg[8 * i + 6] * siluf_(bflo(Z.w)), ob.w * rs * gg[8 * i + 7] * siluf_(bfhi(Z.w))); \
          if (wr) *(uint4*)(zp + 8 * i) = r;                                                               \
        }
        GN1(0, lz0) GN1(1, lz1) GN1(2, lz2) GN1(3, lz3)
      }
    }
    __syncthreads();
    if (is_comp) {
#pragma unroll
      for (int Tc = 0; Tc < 2; ++Tc)
#pragma unroll
        for (int j = 0; j < 16; ++j) Ot[(32 * Tc + crow(j, hh)) * 132 + e] = o[Tc][j];
    }
  }
  __syncthreads();
  if (!is_comp) {
    const int n = 256;
    const int nrow = lt >> 2, nqr = lt & 3;
    uint4 lz0, lz1, lz2, lz3;
    LD_Z(255)
    const float* orow = Ot + nrow * 132 + nqr * 32;
    float ss = 0.f;
#pragma unroll
    for (int i = 0; i < 8; ++i) {
      const float4 v = *(const float4*)(orow + 4 * i);
      ss += v.x * v.x + v.y * v.y + v.z * v.z + v.w * v.w;
    }
    ss += __shfl_xor(ss, 1);
    ss += __shfl_xor(ss, 2);
    const float rs = rsqrtf(ss * (1.f / 128.f) + EPS);
    u16* zp = proj + (((size_t)b * 256 + (n - 1)) * 64 + nrow) * PC + BZ + h * 128 + nqr * 32;
    const float* gg = ng + nqr * 32;
    GN1(0, lz0) GN1(1, lz1) GN1(2, lz2) GN1(3, lz3)
  }
#undef GN1
#undef LD_AQ
#undef LD_K
#undef LD_R1
#undef LD_R2
#undef LD_T
#undef ST_AQ
#undef ST_K
#undef ST_R1
#undef ST_R2
#undef ST_T
#undef LD_Z
#undef LD_U
  __syncthreads();
}

DI void diff_item(const Params& p, int l, int qt, int bh, char* smem) {
  const int b = bh >> 2, h = bh & 3;
  const int tid = ltid(), ln = tid & 63, w = tid >> 6, hh = ln >> 5, c31 = ln & 31;
  const int st = w & 3, c = w >> 2;
  const size_t tokbase = (size_t)b * T;
  const int qb = qt * 128 + 32 * st + c31;
  u16* proj = p.P();
  bf16x8 qf[4];
  {
    const u16* qrow = proj + (tokbase + qb) * PC + AQ + h * 128 + c * 64 + 8 * hh;
#pragma unroll
    for (int s = 0; s < 4; ++s) qf[s] = *(const bf16x8*)(qrow + 16 * s);
  }
  f32x16 O[4];
  float mrun, lrun;
  const float sc = 0.125f * 1.44269504089f;
  char* Ks = smem;
  char* Vs = smem + 17408;
  uint4 rk0, rk1, rv0, rv1;
  const int srow = tid >> 4, sch = tid & 15;
#define DLOAD1(i, kt)                                                                \
  {                                                                                  \
    const u16* base = proj + (tokbase + (kt) * 64 + srow + 32 * i) * PC + h * 128 + sch * 8; \
    rk##i = *(const uint4*)(base + AK);                                              \
    rv##i = *(const uint4*)(base + AV);                                              \
  }
#define DLOAD(kt) { DLOAD1(0, kt) DLOAD1(1, kt) }
#define DSTORE1(i)                                                \
  *(uint4*)(Ks + (srow + 32 * i) * 272 + sch * 16) = rk##i;       \
  *(uint4*)(Vs + (srow + 32 * i) * 320 + sch * 16) = rv##i;
  const int nkt = 2 * qt + 2;
#pragma unroll 1
  for (int rep = 0; rep < DUP_DIFF; ++rep) {
#pragma unroll
  for (int i = 0; i < 4; ++i)
#pragma unroll
    for (int j = 0; j < 16; ++j) O[i][j] = 0.f;
  mrun = -INFINITY; lrun = 0.f;
  DLOAD(0);
  for (int kt = 0; kt < nkt; ++kt) {
    __syncthreads();
    DSTORE1(0) DSTORE1(1)
    __syncthreads();
    if (kt + 1 < nkt) { DLOAD(kt + 1); }
    if (kt * 64 > qt * 128 + 32 * st + 31) continue;
    f32x16 sa[2];
#pragma unroll
    for (int k2 = 0; k2 < 2; ++k2) {
#pragma unroll
      for (int j = 0; j < 16; ++j) sa[k2][j] = 0.f;
#pragma unroll
      for (int s = 0; s < 4; ++s)
        sa[k2] = mfma32(*(const bf16x8*)(Ks + (32 * k2 + c31) * 272 + (c * 64 + 16 * s + 8 * hh) * 2), qf[s], sa[k2]);
    }
    if (kt >= 2 * qt) {
#pragma unroll
      for (int k2 = 0; k2 < 2; ++k2)
#pragma unroll
        for (int j = 0; j < 16; ++j)
          if (kt * 64 + 32 * k2 + crow(j, hh) > qb) sa[k2][j] = -INFINITY;
    }
    float tmax = sa[0][0];
#pragma unroll
    for (int k2 = 0; k2 < 2; ++k2)
#pragma unroll
      for (int j = 0; j < 16; ++j) tmax = fmaxf(tmax, sa[k2][j]);
    tmax = fmaxf(tmax, __shfl_xor(tmax, 32));
    const float mnew = fmaxf(mrun, tmax * sc);
    const float alpha = __builtin_amdgcn_exp2f(mrun - mnew);
    mrun = mnew;
    float psum = 0.f;
#pragma unroll
    for (int k2 = 0; k2 < 2; ++k2)
#pragma unroll
      for (int j = 0; j < 16; ++j) { const float pv = __builtin_amdgcn_exp2f(sa[k2][j] * sc - mnew); sa[k2][j] = pv; psum += pv; }
    lrun = lrun * alpha + psum;
    if (__any(alpha != 1.f)) {
#pragma unroll
      for (int i = 0; i < 4; ++i)
#pragma unroll
        for (int j = 0; j < 16; ++j) O[i][j] *= alpha;
    }
#pragma unroll
    for (int k2 = 0; k2 < 2; ++k2)
#pragma unroll
      for (int s2 = 0; s2 < 2; ++s2) {
        const bf16x8 pp = pack8(sa[k2], s2);
        bf16x8 vf[4];
        trfrag4<320>(Vs, 32 * k2 + 16 * s2, ln, vf);
#pragma unroll
        for (int mt = 0; mt < 4; ++mt) O[mt] = mfma32(vf[mt], pp, O[mt]);
      }
  }
  }
#undef DLOAD
#undef DLOAD1
#undef DSTORE1
  __syncthreads();
  const float ltot = lrun + __shfl_xor(lrun, 32);
  const float inv = 1.f / ltot;
  float* xch = (float*)smem + st * 32 * 132;
  if (c == 1) {
#pragma unroll
    for (int mt = 0; mt < 4; ++mt)
#pragma unroll
      for (int i4 = 0; i4 < 4; ++i4)
        *(float4*)(xch + c31 * 132 + 32 * mt + 8 * i4 + 4 * hh) =
            float4{O[mt][4 * i4] * inv, O[mt][4 * i4 + 1] * inv, O[mt][4 * i4 + 2] * inv, O[mt][4 * i4 + 3] * inv};
  }
  __syncthreads();
  if (c == 0) {
    const float lam = p.LAM()[l], oml = 1.f - p.LAM()[2 + l];
    float ss = 0.f;
#pragma unroll
    for (int mt = 0; mt < 4; ++mt)
#pragma unroll
      for (int i4 = 0; i4 < 4; ++i4) {
        const float4 o1 = *(const float4*)(xch + c31 * 132 + 32 * mt + 8 * i4 + 4 * hh);
        float d;
        d = O[mt][4 * i4] * inv - lam * o1.x; O[mt][4 * i4] = d; ss += d * d;
        d = O[mt][4 * i4 + 1] * inv - lam * o1.y; O[mt][4 * i4 + 1] = d; ss += d * d;
        d = O[mt][4 * i4 + 2] * inv - lam * o1.z; O[mt][4 * i4 + 2] = d; ss += d * d;
        d = O[mt][4 * i4 + 3] * inv - lam * o1.w; O[mt][4 * i4 + 3] = d; ss += d * d;
      }
    ss += __shfl_xor(ss, 32);
    const float rs = rsqrtf(ss * (1.f / 128.f) + EPS) * oml;
    const float* sg = p.a_subln_g + l * 128;
    int qb_e = qb;
    asm volatile("" : "+v"(qb_e));
    u16* orow = proj + (tokbase + qb_e) * PC + AQ + h * 128;
#pragma unroll
    for (int mt = 0; mt < 4; ++mt)
#pragma unroll
      for (int i4 = 0; i4 < 4; ++i4) {
        const int dv = 32 * mt + 8 * i4 + 4 * hh;
        const float4 gg = *(const float4*)(sg + dv);
        uint2 o;
        o.x = pack2(O[mt][4 * i4] * rs * gg.x, O[mt][4 * i4 + 1] * rs * gg.y);
        o.y = pack2(O[mt][4 * i4 + 2] * rs * gg.z, O[mt][4 * i4 + 3] * rs * gg.w);
        *(uint2*)(orow + dv) = o;
      }
  }
  __syncthreads();
}

DI u32 mono_key(float f) { u32 u = __float_as_uint(f); return (u & 0x80000000u) ? ~u : (u | 0x80000000u); }

constexpr int DCAP = 640;
DI u32 dsa_prune(u32* ck, u16* ci, int cnt, u32 tau_old, bool exact, int ln, int& newcnt) {
  u32 kv[10];
  u16 iv[10];
  u32 mx = 0u;
#pragma unroll
  for (int j = 0; j < 10; ++j) {
    const int pos = ln + 64 * j;
    const bool vd = pos < cnt;
    kv[j] = vd ? ck[pos] : 0u;
    iv[j] = vd ? ci[pos] : (u16)0;
    mx = max(mx, kv[j]);
  }
#pragma unroll
  for (int o = 32; o; o >>= 1) mx = max(mx, (u32)__shfl_xor((int)mx, o));
  u32 L = tau_old + 1u, H = mx + 1u;
  int curL = cnt;
  while ((exact || curL > 384) && (H - L) > 1u) {
    const u32 mid = L + ((H - L) >> 1);
    int c = 0;
#pragma unroll
    for (int j = 0; j < 10; ++j) c += __popcll(__ballot(kv[j] >= mid));
    if (c >= 256) { L = mid; curL = c; } else H = mid;
  }
  int ngt = 0;
#pragma unroll
  for (int j = 0; j < 10; ++j) ngt += __popcll(__ballot(kv[j] > L));
  const int target = (!exact && curL <= 384) ? curL : 256;
  const int need = target - ngt;
  int run_gt = 0, run_eq = 0;
#pragma unroll
  for (int j = 0; j < 10; ++j) {
    const bool gt = kv[j] > L, eq = (kv[j] == L);
    const u64 mg = __ballot(gt), me = __ballot(eq);
    const int pg = run_gt + (int)lane_lt_cnt(mg), pe = run_eq + (int)lane_lt_cnt(me);
    if (gt) { ck[pg] = kv[j]; ci[pg] = iv[j]; }
    else if (eq && pe < need) { ck[ngt + pe] = kv[j]; ci[ngt + pe] = iv[j]; }
    run_gt += __popcll(mg);
    run_eq += __popcll(me);
  }
  newcnt = target;
  return L;
}

DI void dsa_item(const Params& p, int l, int tile32, int b, char* smem) {
  const int tid = ltid(), ln = tid & 63, w = tid >> 6, hh = ln >> 5, c31 = ln & 31;
  const int t0 = tile32 * 32 + 4 * w;
  const size_t tokbase = (size_t)b * T;
  u16* QX = (u16*)p.out;
  char* wl = smem + w * 17408;
  u32* ckey = (u32*)wl;
  u16* cidx = (u16*)(wl + 10240);
  u16* ifin = (u16*)(wl + 15360);
  char* tile = wl;
  int cnt0 = 0, cnt1 = 0, cnt2 = 0, cnt3 = 0;
  {
    bf16x8 qa[4];
    {
      const int r = c31, ql = 2 * ((r >> 2) & 1) + (r & 1), hd = ((r & 3) >> 1) + 2 * (r >> 3);
      const u16* qrow = QX + (tokbase + t0 + ql) * LDQ + 1024 + hd * 64 + 8 * hh;
#pragma unroll
      for (int s = 0; s < 4; ++s) qa[s] = *(const bf16x8*)(qrow + 16 * s);
    }
    typedef float f32x2 __attribute__((ext_vector_type(2)));
    f32x2 wq2[8];
    {
      const float4* wi = (const float4*)(p.WIDX() + (tokbase + t0 + 2 * hh) * 8);
      const float4 a0 = wi[0], a1 = wi[1], b0 = wi[2], b1 = wi[3];
      wq2[0] = f32x2{a0.x, b0.x}; wq2[1] = f32x2{a0.y, b0.y}; wq2[2] = f32x2{a0.z, b0.z}; wq2[3] = f32x2{a0.w, b0.w};
      wq2[4] = f32x2{a1.x, b1.x}; wq2[5] = f32x2{a1.y, b1.y}; wq2[6] = f32x2{a1.z, b1.z}; wq2[7] = f32x2{a1.w, b1.w};
    }
    const int qpos0 = t0 + 2 * hh;
    const int nkt = ((t0 + 3) >> 5) + 1;
    const u32 lmask = (1u << c31) - 1u;
#pragma unroll 1
    for (int rep = 0; rep < DUP_DSA1; ++rep) {
    cnt0 = cnt1 = cnt2 = cnt3 = 0;
    u32 tau0 = 0u, tau1 = 0u, tau2 = 0u, tau3 = 0u;
    bf16x8 kn[4][4];
    {
#pragma unroll
      for (int t = 0; t < 4; ++t) {
        const u16* krow = p.KIDX() + (tokbase + t * 32 + c31) * 64 + 8 * hh;
#pragma unroll
        for (int s = 0; s < 4; ++s) kn[t][s] = *(const bf16x8*)(krow + 16 * s);
      }
    }
    const int ngrp = (nkt + 3) >> 2;
    for (int g = 0; g <= ngrp; ++g) {
      const int lim = (g < ngrp) ? (DCAP - 128) : 256;
      for (;;) {
        const int q = (cnt0 > lim) ? 0 : (cnt1 > lim) ? 1 : (cnt2 > lim) ? 2 : (cnt3 > lim) ? 3 : -1;
        if (q < 0) break;
        const int c = (q == 0) ? cnt0 : (q == 1) ? cnt1 : (q == 2) ? cnt2 : cnt3;
        const u32 to = (q == 0) ? tau0 : (q == 1) ? tau1 : (q == 2) ? tau2 : tau3;
        int nc;
        const u32 t = dsa_prune(ckey + q * DCAP, cidx + q * DCAP, c, to, g == ngrp, ln, nc);
        if (q == 0) { cnt0 = nc; tau0 = t; } else if (q == 1) { cnt1 = nc; tau1 = t; }
        else if (q == 2) { cnt2 = nc; tau2 = t; } else { cnt3 = nc; tau3 = t; }
      }
      if (g == ngrp) break;
      bf16x8 kc[4][4];
#pragma unroll
      for (int t = 0; t < 4; ++t)
#pragma unroll
        for (int s = 0; s < 4; ++s) kc[t][s] = kn[t][s];
      if (g + 1 < ngrp) {
#pragma unroll
        for (int t = 0; t < 4; ++t) {
          const u16* krow = p.KIDX() + (tokbase + (g + 1) * 128 + t * 32 + c31) * 64 + 8 * hh;
#pragma unroll
          for (int s = 0; s < 4; ++s) kn[t][s] = *(const bf16x8*)(krow + 16 * s);
        }
      }
      const u32 tauA = hh ? tau2 : tau0, tauB = hh ? tau3 : tau1;
#pragma unroll
      for (int t = 0; t < 4; ++t) {
        const int key = (g * 4 + t) * 32 + c31;
        f32x16 acc;
#pragma unroll
        for (int j = 0; j < 16; ++j) acc[j] = 0.f;
#pragma unroll
        for (int s = 0; s < 4; ++s) acc = mfma32(qa[s], kc[t][s], acc);
        f32x2 ss2 = f32x2{0.f, 0.f};
#pragma unroll
        for (int hq = 0; hq < 8; ++hq) {
          const f32x2 rr = f32x2{__builtin_amdgcn_fmed3f(acc[2 * hq], 0.f, 3.0e38f), __builtin_amdgcn_fmed3f(acc[2 * hq + 1], 0.f, 3.0e38f)};
          ss2 = __builtin_elementwise_fma(wq2[hq], rr, ss2);
        }
        const float s0 = ss2.x, s1 = ss2.y;
        const u32 k0 = mono_key(s0), k1 = mono_key(s1);
        const bool c0 = (key <= qpos0) && (k0 > tauA), c1 = (key <= qpos0 + 1) && (k1 > tauB);
        const u64 m0 = __ballot(c0), m1 = __ballot(c1);
        if (m0 | m1) {
          const u32 h0 = hh ? (u32)(m0 >> 32) : (u32)m0, h1 = hh ? (u32)(m1 >> 32) : (u32)m1;
          const int pA = (hh ? cnt2 : cnt0) + __popc(h0 & lmask), pB = (hh ? cnt3 : cnt1) + __popc(h1 & lmask);
          if (c0) { ckey[(2 * hh) * DCAP + pA] = k0; cidx[(2 * hh) * DCAP + pA] = (u16)key; }
          if (c1) { ckey[(2 * hh + 1) * DCAP + pB] = k1; cidx[(2 * hh + 1) * DCAP + pB] = (u16)key; }
          cnt0 += __popc((u32)m0); cnt2 += __popc((u32)(m0 >> 32));
          cnt1 += __popc((u32)m1); cnt3 += __popc((u32)(m1 >> 32));
        }
      }
    }
#pragma unroll
    for (int qq = 0; qq < 4; ++qq) {
      const int cq = (qq == 0) ? cnt0 : (qq == 1) ? cnt1 : (qq == 2) ? cnt2 : cnt3;
#pragma unroll
      for (int j = 0; j < 4; ++j) {
        const int pos = ln + 64 * j;
        ifin[qq * 256 + pos] = (pos < cq) ? cidx[qq * DCAP + pos] : (u16)0;
      }
    }
    }
  }
  const float sc = 0.125f * 1.44269504089f;
#pragma unroll 1
  for (int rep2 = 0; rep2 < DUP_DSA2; ++rep2)
#pragma unroll 1
  for (int qq = 0; qq < 4; ++qq) {
    const int nsel = (qq == 0) ? cnt0 : (qq == 1) ? cnt1 : (qq == 2) ? cnt2 : cnt3;
    const size_t tq = tokbase + t0 + qq;
    bf16x8 qf[8];
    {
      const u16* qab = QX + tq * LDQ + (c31 & 7) * 128 + 8 * hh;
#pragma unroll
      for (int s = 0; s < 8; ++s) qf[s] = *(const bf16x8*)(qab + 16 * s);
    }
    f32x16 O[4];
#pragma unroll
    for (int i = 0; i < 4; ++i)
#pragma unroll
      for (int j = 0; j < 16; ++j) O[i][j] = 0.f;
    float mrun = -INFINITY, lrun = 0.f;
    const int ntile = (nsel + 31) >> 5;
    uint4 gr0, gr1, gr2, gr3, gr4, gr5, gr6, gr7;
#define GGATHER1(i, tt_)                                                                     \
    {                                                                                        \
      const int piece = ln + 64 * i, row = piece >> 4, ch = piece & 15;                      \
      const int idx = ifin[qq * 256 + (tt_) * 32 + row];                                     \
      gr##i = *(const uint4*)(p.CKV() + (tokbase + idx) * 128 + ch * 8);                     \
    }
#define GGATHER(tt_) { GGATHER1(0, tt_) GGATHER1(1, tt_) GGATHER1(2, tt_) GGATHER1(3, tt_) GGATHER1(4, tt_) GGATHER1(5, tt_) GGATHER1(6, tt_) GGATHER1(7, tt_) }
#define GSTORE1(i) { const int piece = ln + 64 * i, row = piece >> 4, ch = piece & 15; *(uint4*)(tile + row * 272 + ch * 16) = gr##i; }
    if (ntile > 0) GGATHER(0)
    for (int tt = 0; tt < ntile; ++tt) {
      GSTORE1(0) GSTORE1(1) GSTORE1(2) GSTORE1(3) GSTORE1(4) GSTORE1(5) GSTORE1(6) GSTORE1(7)
      if (tt + 1 < ntile) GGATHER(tt + 1)
      __builtin_amdgcn_fence(__ATOMIC_RELEASE, "wavefront");
      f32x16 sa;
#pragma unroll
      for (int j = 0; j < 16; ++j) sa[j] = 0.f;
#pragma unroll
      for (int s = 0; s < 8; ++s) sa = mfma32(*(const bf16x8*)(tile + c31 * 272 + (16 * s + 8 * hh) * 2), qf[s], sa);
      float tmax = -INFINITY;
#pragma unroll
      for (int j = 0; j < 16; ++j) {
        if (tt * 32 + crow(j, hh) >= nsel) sa[j] = -INFINITY;
        tmax = fmaxf(tmax, sa[j]);
      }
      tmax = fmaxf(tmax, __shfl_xor(tmax, 32));
      const float mnew = fmaxf(mrun, tmax * sc);
      const float alpha = __builtin_amdgcn_exp2f(mrun - mnew);
      mrun = mnew;
      float psum = 0.f;
#pragma unroll
      for (int j = 0; j < 16; ++j) { const float pv = __builtin_amdgcn_exp2f(sa[j] * sc - mnew); sa[j] = pv; psum += pv; }
      lrun = lrun * alpha + psum;
#pragma unroll
      for (int i = 0; i < 4; ++i)
#pragma unroll
        for (int j = 0; j < 16; ++j) O[i][j] *= alpha;
#pragma unroll
      for (int s2 = 0; s2 < 2; ++s2) {
        const bf16x8 pp = pack8(sa, s2);
        bf16x8 vf[4];
        trfrag4<272>(tile, 16 * s2, ln, vf);
#pragma unroll
        for (int mt = 0; mt < 4; ++mt) O[mt] = mfma32(vf[mt], pp, O[mt]);
      }
      __builtin_amdgcn_fence(__ATOMIC_ACQ_REL, "wavefront");
    }
#undef GGATHER1
#undef GGATHER
#undef GSTORE1
    const float ltot = lrun + __shfl_xor(lrun, 32);
    const float inv = 1.f / ltot;
    if (c31 < 8 && rep2 == DUP_DSA2 - 1) {
      u16* orow = QX + tq * LDQ + c31 * 128;
#pragma unroll
      for (int mt = 0; mt < 4; ++mt)
#pragma unroll
        for (int i4 = 0; i4 < 4; ++i4) {
          uint2 o;
          o.x = pack2(O[mt][4 * i4] * inv, O[mt][4 * i4 + 1] * inv);
          o.y = pack2(O[mt][4 * i4 + 2] * inv, O[mt][4 * i4 + 3] * inv);
          *(uint2*)(orow + 32 * mt + 8 * i4 + 4 * hh) = o;
        }
    }
  }
  __syncthreads();
}

DI void phase_prep(const Params& p, int l, char* smem) {
  if (EN_C) {
    int rt, ct;
    for (int it = 0; next_tile(it, 128, 6, 32, 2, rt, ct); ++it) qx_tile(p, l, rt, ct, smem);
  }
  const int n_gdn = EN_B ? 1024 : 0, n_kp = EN_C ? 512 : 0;
  for (int t = lbid(); t < n_gdn + n_kp; t += lgdim()) {
    if (t < n_gdn) gdn_prep_item(p, l, t, smem);
    else dsa_kprep_item(p, l, t - n_gdn);
  }
}

DI int xcc_id() { return (int)(__builtin_amdgcn_s_getreg((3 << 11) | 20) & 0x7u); }

DI void phase_mixers(const Params& p, int l, char* smem) {
  __shared__ int s_item;
  const int x0 = xcc_id();
  int xs = x0;
  for (;;) {
    __syncthreads();
    {
      int qi = l * 8 + xs;
      asm volatile("" : "+s"(qi));
      if (ltid() == 0) s_item = (int)atomicAdd(p.CNT() + qi, 1u);
    }
    __syncthreads();
    const int it = s_item;
    const int n_gdn = EN_B ? 1 : 0;
    if (it >= n_gdn + 256) {
      xs = (xs + 1) & 7;
      if (xs == x0) break;
      continue;
    }
    const int x = xs;
    if (it < n_gdn) {
#pragma unroll 1
      for (int rep = 0; rep < DUP_GDN; ++rep) gdn_rec_item(p, l, x, smem, rep == DUP_GDN - 1);
    }
    else {
      const int j = it - n_gdn, k = j >> 1;
      if ((j & 1) == 0) { if (EN_A) diff_item(p, l, 127 - k, x, smem); }
      else { if (EN_C) dsa_item(p, l, 511 - (k * 4 + (x >> 1)), x & 1, smem); }
    }
  }
}

DI void run_phase(const Params& p, int ph, char* smem) {
  if (ph == 0) { phase0(p, smem); return; }
  const int l = (ph - 1) / 9, s = (ph - 1) % 9;
  switch (s) {
    case 0: phase_inproj(p, l, smem); break;
    case 1: phase_prep(p, l, smem); break;
    case 2: phase_mixers(p, l, smem); break;
    case 3: phase_merge(p, l, smem); break;
    case 4: phase_resgemm(p, p.MERGED(), LDX, p.wo(l), KP1024, 1024, smem); break;
    case 5: ln_phase(p.out, p.ln1_g + l * 1024, p.ln1_b + l * 1024, p.XB(), nullptr); break;
    case 6: phase_ff1(p, l, smem); break;
    case 7: phase_resgemm(p, p.P(), LDH, p.wf2(l), KP4096, 4096, smem); break;
    case 8: ln_phase(p.out, p.ln2_g + l * 1024, p.ln2_b + l * 1024, (l == 1) ? nullptr : p.XB(), (l == 1) ? p.out : nullptr); break;
  }
}

constexpr int N_PHASES = 19;


DI u32 xb_ld(u32* p) { return __hip_atomic_load(p, __ATOMIC_RELAXED, __HIP_MEMORY_SCOPE_AGENT); }
DI u32 xb_add(u32* p, u32 v) { return __hip_atomic_fetch_add(p, v, __ATOMIC_RELAXED, __HIP_MEMORY_SCOPE_AGENT); }
DI void fast_sync(u32* bar, int x, const volatile int* st) {
  asm volatile("s_waitcnt vmcnt(0)" ::: "memory");
  __syncthreads();
  if (ltid() == 0) {
    __builtin_amdgcn_s_waitcnt(0);
    const u32 nloc = (u32)st[0], nx = (u32)st[1];
    const u32 old = xb_add(bar + 32 * (8 + x), 1u);
    const u32 gen = old / nloc;
    if (old + 1u == (gen + 1u) * nloc) {
      __builtin_amdgcn_fence(__ATOMIC_RELEASE, "agent");
      asm volatile("s_waitcnt vmcnt(0)" ::: "memory");
      const u32 og = xb_add(bar + 32 * 24, 1u);
      const u32 tg = og / nx;
      if (og + 1u == (tg + 1u) * nx) xb_add(bar + 32 * 25, 1u);
      else { while (xb_ld(bar + 32 * 25) == tg) __builtin_amdgcn_s_sleep(1); }
      __builtin_amdgcn_fence(__ATOMIC_ACQUIRE, "agent");
      xb_add(bar + 32 * (16 + x), 1u);
      asm volatile("s_waitcnt vmcnt(0)" ::: "memory");
    } else {
      while (xb_ld(bar + 32 * (16 + x)) == gen) __builtin_amdgcn_s_sleep(1);
      __builtin_amdgcn_fence(__ATOMIC_ACQUIRE, "agent");
      asm volatile("s_waitcnt vmcnt(0)" ::: "memory");
    }
  }
  __syncthreads();
}
#if COOP
DI void gsync() { cg::this_grid().sync(); }
__global__ void __launch_bounds__(512, 1) mega_kernel(Params p, int ph_begin, int ph_end) {
  __shared__ __attribute__((aligned(16))) char smem[SMEM_BYTES];
  __shared__ int xb_st[2];
  const int myx = xcc_id();
  if (ltid() == 0) (void)xb_add(p.BAR() + 32 * myx, 1u);
  for (int r = 0; r < REP0; ++r) { phase0(p, smem); cg::this_grid().sync(); }
  if (ltid() == 0) {
    int mine = 0, cnt = 0;
    for (int j = 0; j < 8; ++j) { const int c = (int)xb_ld(p.BAR() + 32 * j); cnt += (c > 0) ? 1 : 0; mine = (j == myx) ? c : mine; }
    xb_st[0] = mine > 0 ? mine : 1;
    xb_st[1] = cnt > 0 ? cnt : 1;
  }
  __syncthreads();
#define gsync() fast_sync(p.BAR(), myx, xb_st)
#pragma unroll 1
  for (int l = 0; l < 2; ++l) {
    for (int r = 0; r < REP1; ++r) { phase_inproj(p, l, smem); gsync(); }
    phase_prep(p, l, smem);
    gsync();
    phase_mixers(p, l, smem);
    gsync();
    for (int r = 0; r < REP2; ++r) { phase_merge(p, l, smem); gsync(); }
    for (int r = 0; r < REP3; ++r) { phase_resgemm(p, p.MERGED(), LDX, p.wo(l), KP1024, 1024, smem); gsync(); }
    for (int r = 0; r < REP4; ++r) { ln_phase(p.out, p.ln1_g + l * 1024, p.ln1_b + l * 1024, p.XB(), nullptr); gsync(); }
    for (int r = 0; r < REP5; ++r) { phase_ff1(p, l, smem); gsync(); }
    for (int r = 0; r < REP6; ++r) { phase_resgemm(p, p.P(), LDH, p.wf2(l), KP4096, 4096, smem); gsync(); }
    ln_phase(p.out, p.ln2_g + l * 1024, p.ln2_b + l * 1024, (l == 1) ? nullptr : p.XB(), (l == 1) ? p.out : nullptr);
    if (l == 0) gsync();
  }
}
#undef gsync
#else
__global__ void __launch_bounds__(512, 1) mega_kernel(Params p, int ph_begin, int ph_end) {
  __shared__ __attribute__((aligned(16))) char smem[SMEM_BYTES];
  for (int ph = ph_begin; ph < ph_end; ++ph) run_phase(p, ph, smem);
}
#endif

extern "C" void kernel_launch(void* const* d_in, const int* in_sizes, int n_in, void* d_out, int out_size,
                              void* d_ws, size_t ws_size, hipStream_t stream) {
  static int grid_blocks = 0;
  if (!grid_blocks) {
    int dev = 0, cus = 0, per_cu = 0;
    hipGetDevice(&dev);
    hipDeviceGetAttribute(&cus, hipDeviceAttributeMultiprocessorCount, dev);
    hipOccupancyMaxActiveBlocksPerMultiprocessor(&per_cu, mega_kernel, NTHR, 0);
    if (per_cu < 1) per_cu = 1;
    if (per_cu > 1) per_cu = 1;
    grid_blocks = cus * per_cu;
  }
  Params p{};
  const float** pf = (const float**)&p;
  for (int i = 0; i < 27; ++i) pf[i] = (const float*)d_in[i];
  p.out = (float*)d_out;
  p.ws = (char*)d_ws;
  if (WS_NEED > ws_size) { fprintf(stderr, "workspace too small: need %zu have %zu\n", (size_t)WS_NEED, ws_size); return; }
#if COOP
  hipMemsetAsync(p.ws + O_BAR, 0, 4096, stream);
  int b = 0, e = N_PHASES;
  void* args[] = {&p, &b, &e};
  hipError_t err = hipLaunchCooperativeKernel((void*)mega_kernel, dim3(grid_blocks), dim3(NTHR), args, 0, stream);
  if (err != hipSuccess) fprintf(stderr, "cooperative launch failed: %s (grid %d)\n", hipGetErrorString(err), grid_blocks);
#else
  for (int ph = 0; ph < N_PHASES; ++ph) mega_kernel<<<grid_blocks, NTHR, 0, stream>>>(p, ph, ph + 1);
#endif
}
```

```cpp
#include <hip/hip_runtime.h>
#include <hip/hip_cooperative_groups.h>
#include <cstdio>
namespace cg = cooperative_groups;

#ifndef COOP
#define COOP 1
#endif
#ifndef REP0
#define REP0 1
#define REP1 1
#define REP2 1
#define REP3 1
#define REP4 1
#define REP5 1
#define REP6 1
#endif
#ifndef DUP_GDN
#define DUP_GDN 1
#endif
#ifndef DUP_DIFF
#define DUP_DIFF 1
#endif
#ifndef DUP_DSA1
#define DUP_DSA1 1
#endif
#ifndef DUP_DSA2
#define DUP_DSA2 1
#endif
#ifndef EN_A
#define EN_A 1
#endif
#ifndef EN_B
#define EN_B 1
#endif
#ifndef EN_C
#define EN_C 1
#endif

typedef unsigned short u16;
typedef unsigned int u32;
typedef unsigned long long u64;
using bf16x8 = __attribute__((ext_vector_type(8))) short;
using s16x4 = __attribute__((ext_vector_type(4))) short;
using f32x4 = __attribute__((ext_vector_type(4))) float;
using f32x16 = __attribute__((ext_vector_type(16))) float;
#define DI __device__ __forceinline__

constexpr int NT = 32768, T = 16384, PC = 4048;
constexpr int AQ = 0, AK = 512, AV = 1024, BQ = 1536, BK_ = 2048, BV = 2560, BZ = 3072, BA = 3584, BB = 3588,
              CQ = 3592, CKVc = 3848, CKI = 3976, CWI = 4040, GATES = 4048;
constexpr float EPS = 1e-6f;
constexpr float DN_ALPHA = 1.41421356237f;
constexpr int NTHR = 512;
constexpr int SMEM_BYTES = 153600 + 512;

constexpr size_t al256(size_t x) { return (x + 255) & ~(size_t)255; }
constexpr int LDX = 1088, LDH = 4160, LDQ = 1600;
constexpr int KP1024 = 1088, KP512 = 576, KP256 = 320, KP4096 = 4160;
constexpr size_t SZ_WIN = al256((size_t)7120 * KP1024 * 2), SZ_WQX = al256((size_t)1536 * KP256 * 2), SZ_WBR = al256((size_t)1024 * KP512 * 2),
                 SZ_WBRC = al256((size_t)1024 * KP1024 * 2), SZ_WO = al256((size_t)1024 * KP1024 * 2), SZ_WF1 = al256((size_t)4096 * KP1024 * 2), SZ_WF2 = al256((size_t)1024 * KP4096 * 2);
constexpr size_t O_WIN = 0, O_WQX = O_WIN + SZ_WIN, O_WBRA = O_WQX + SZ_WQX, O_WBRB = O_WBRA + SZ_WBR, O_WBRC = O_WBRB + SZ_WBR,
                 O_WO = O_WBRC + SZ_WBRC, O_WF1 = O_WO + SZ_WO, O_WF2 = O_WF1 + SZ_WF1, LAYER_W = O_WF2 + SZ_WF2;
constexpr size_t O_P = 2 * LAYER_W, O_XB = O_P + (size_t)NT * LDH * 2, O_M = O_XB + (size_t)NT * LDX * 2;
constexpr size_t O_KDT = O_M, O_ATT = O_KDT + 33554432, O_HALO = O_ATT + 16777216, O_KIDX = O_HALO + 4718592, O_CKV = O_KIDX + 4194304,
                 O_MEND = O_CKV + 8388608 + 4194304;
constexpr size_t O_WIDX = O_MEND, O_GL = O_WIDX + (size_t)NT * 8 * 4, O_LAM = O_GL + 8192, O_CNT = O_LAM + 256, O_BAR = O_CNT + 256, WS_NEED = O_BAR + 4096;
static_assert(O_MEND - O_M >= (size_t)NT * LDX * 2, "merged alias");

struct Params {
  const float *x, *w_in, *b_gate, *a_lambda, *a_subln_g, *b_conv_w, *b_a_log, *b_dt_bias, *b_norm_g,
      *c_q_norm_g, *c_kv_norm_g, *c_kidx_g, *c_kidx_b, *c_w_uq, *c_w_qidx, *c_w_uk, *c_w_uv,
      *w_branch_a, *w_branch_b, *w_branch_c, *w_o, *ln1_g, *ln1_b, *w_ff1, *w_ff2, *ln2_g, *ln2_b;
  float* out;
  char* ws;
  __device__ __forceinline__ u16* win(int l) const { return (u16*)(ws + l * LAYER_W + O_WIN); }
  __device__ __forceinline__ u16* wqx(int l) const { return (u16*)(ws + l * LAYER_W + O_WQX); }
  __device__ __forceinline__ u16* wbra(int l) const { return (u16*)(ws + l * LAYER_W + O_WBRA); }
  __device__ __forceinline__ u16* wbrb(int l) const { return (u16*)(ws + l * LAYER_W + O_WBRB); }
  __device__ __forceinline__ u16* wbrc(int l) const { return (u16*)(ws + l * LAYER_W + O_WBRC); }
  __device__ __forceinline__ u16* wo(int l) const { return (u16*)(ws + l * LAYER_W + O_WO); }
  __device__ __forceinline__ u16* wf1(int l) const { return (u16*)(ws + l * LAYER_W + O_WF1); }
  __device__ __forceinline__ u16* wf2(int l) const { return (u16*)(ws + l * LAYER_W + O_WF2); }
  __device__ __forceinline__ u16* P() const { return (u16*)(ws + O_P); }
  __device__ __forceinline__ u16* XB() const { return (u16*)(ws + O_XB); }
  __device__ __forceinline__ u16* KDT() const { return (u16*)(ws + O_KDT); }
  __device__ __forceinline__ u16* ATT() const { return (u16*)(ws + O_ATT); }
  __device__ __forceinline__ u16* HALO() const { return (u16*)(ws + O_HALO); }
  __device__ __forceinline__ u16* KIDX() const { return (u16*)(ws + O_KIDX); }
  __device__ __forceinline__ u16* CKV() const { return (u16*)(ws + O_CKV); }
  __device__ __forceinline__ u16* MERGED() const { return (u16*)(ws + O_M); }
  __device__ __forceinline__ float* WIDX() const { return (float*)(ws + O_WIDX); }
  __device__ __forceinline__ float* GL() const { return (float*)(ws + O_GL); }
  __device__ __forceinline__ float* LAM() const { return (float*)(ws + O_LAM); }
  __device__ __forceinline__ u32* CNT() const { return (u32*)(ws + O_CNT); }
  __device__ __forceinline__ u32* BAR() const { return (u32*)(ws + O_BAR); }
};

DI int lbid() { int b = blockIdx.x; asm volatile("" : "+s"(b)); return b; }
DI int lgdim() { int b = gridDim.x; asm volatile("" : "+s"(b)); return b; }
DI int ltid() { int t = threadIdx.x; asm volatile("" : "+v"(t)); return t; }
DI u16 f2bf(float x) { u32 u = __float_as_uint(x); u += 0x7fffu + ((u >> 16) & 1u); return (u16)(u >> 16); }
DI float bf2f(u16 h) { return __uint_as_float(((u32)h) << 16); }
DI u32 pack2(float a, float b) { return (u32)f2bf(a) | ((u32)f2bf(b) << 16); }
DI float bflo(u32 v) { return __uint_as_float(v << 16); }
DI float bfhi(u32 v) { return __uint_as_float(v & 0xffff0000u); }
DI f32x4 mfma16(bf16x8 a, bf16x8 b, f32x4 c) { return __builtin_amdgcn_mfma_f32_16x16x32_bf16(a, b, c, 0, 0, 0); }
DI f32x16 mfma32(bf16x8 a, bf16x8 b, f32x16 c) { return __builtin_amdgcn_mfma_f32_32x32x16_bf16(a, b, c, 0, 0, 0); }
DI int crow(int i, int hh) { return (i & 3) + 8 * (i >> 2) + 4 * hh; }
DI float sigmoidf_(float x) { return 1.f / (1.f + __expf(-x)); }
DI float siluf_(float x) { return x / (1.f + __expf(-x)); }
DI float xhalf_max(float x) {
  const u32 u = __float_as_uint(x);
  const auto r = __builtin_amdgcn_permlane32_swap(u, u, false, false);
  return fmaxf(__uint_as_float(r[0]), __uint_as_float(r[1]));
}
DI float xhalf_sum(float x) {
  const u32 u = __float_as_uint(x);
  const auto r = __builtin_amdgcn_permlane32_swap(u, u, false, false);
  return __uint_as_float(r[0]) + __uint_as_float(r[1]);
}
DI u32 lane_lt_cnt(u64 m) { return __builtin_amdgcn_mbcnt_hi((u32)(m >> 32), __builtin_amdgcn_mbcnt_lo((u32)m, 0)); }

DI bf16x8 pack8(const f32x16& x, int s) {
  u32 p0, p1, p2, p3;
  if (s == 0) {
    asm volatile("v_cvt_pk_bf16_f32 %0, %4, %5\n\tv_cvt_pk_bf16_f32 %1, %6, %7\n\tv_cvt_pk_bf16_f32 %2, %8, %9\n\tv_cvt_pk_bf16_f32 %3, %10, %11\n\ts_nop 1"
                 : "=&v"(p0), "=&v"(p1), "=&v"(p2), "=&v"(p3)
                 : "v"(x[0]), "v"(x[1]), "v"(x[2]), "v"(x[3]), "v"(x[4]), "v"(x[5]), "v"(x[6]), "v"(x[7]));
  } else {
    asm volatile("v_cvt_pk_bf16_f32 %0, %4, %5\n\tv_cvt_pk_bf16_f32 %1, %6, %7\n\tv_cvt_pk_bf16_f32 %2, %8, %9\n\tv_cvt_pk_bf16_f32 %3, %10, %11\n\ts_nop 1"
                 : "=&v"(p0), "=&v"(p1), "=&v"(p2), "=&v"(p3)
                 : "v"(x[8]), "v"(x[9]), "v"(x[10]), "v"(x[11]), "v"(x[12]), "v"(x[13]), "v"(x[14]), "v"(x[15]));
  }
  typedef u32 u32x4 __attribute__((ext_vector_type(4)));
  u32x4 v = {p0, p1, p2, p3};
  return __builtin_bit_cast(bf16x8, v);
}
DI bf16x8 afrag_perm(const char* base, int row, int stride, int kbase, int hh) {
  const char* pr = base + row * stride + (kbase + 4 * hh) * 2;
  s16x4 lo = *(const s16x4*)pr;
  s16x4 hi = *(const s16x4*)(pr + 16);
  return __builtin_shufflevector(lo, hi, 0, 1, 2, 3, 4, 5, 6, 7);
}
DI bf16x8 trfrag(const char* img, int stride, int krow0, int col0, int ln) {
  const int hh = ln >> 5, chalf = (ln >> 4) & 1, q4 = (ln & 15) >> 2, p4 = ln & 3;
  u32 a = (u32)(size_t)(img + (krow0 + 4 * hh + q4) * stride + (col0 + 16 * chalf + 4 * p4) * 2);
  s16x4 lo, hi;
  asm volatile("ds_read_b64_tr_b16 %0, %2\n\tds_read_b64_tr_b16 %1, %3\n\ts_waitcnt lgkmcnt(0)"
               : "=&v"(lo), "=&v"(hi) : "v"(a), "v"(a + 8 * stride) : "memory");
  return __builtin_shufflevector(lo, hi, 0, 1, 2, 3, 4, 5, 6, 7);
}

template <int STRIDE>
DI void trfrag4(const char* img, int krow0, int ln, bf16x8 (&f)[4]) {
  const int hh = ln >> 5, chalf = (ln >> 4) & 1, q4 = (ln & 15) >> 2, p4 = ln & 3;
  const u32 a = (u32)(size_t)(img + (krow0 + 4 * hh + q4) * STRIDE + (16 * chalf + 4 * p4) * 2);
  s16x4 l0, h0, l1, h1, l2, h2, l3, h3;
  asm volatile(
      "ds_read_b64_tr_b16 %0, %8\n\tds_read_b64_tr_b16 %1, %8 offset:%9\n\t"
      "ds_read_b64_tr_b16 %2, %8 offset:64\n\tds_read_b64_tr_b16 %3, %8 offset:%10\n\t"
      "ds_read_b64_tr_b16 %4, %8 offset:128\n\tds_read_b64_tr_b16 %5, %8 offset:%11\n\t"
      "ds_read_b64_tr_b16 %6, %8 offset:192\n\tds_read_b64_tr_b16 %7, %8 offset:%12\n\t"
      "s_waitcnt lgkmcnt(0)"
      : "=&v"(l0), "=&v"(h0), "=&v"(l1), "=&v"(h1), "=&v"(l2), "=&v"(h2), "=&v"(l3), "=&v"(h3)
      : "v"(a), "i"(8 * STRIDE), "i"(8 * STRIDE + 64), "i"(8 * STRIDE + 128), "i"(8 * STRIDE + 192)
      : "memory");
  f[0] = __builtin_shufflevector(l0, h0, 0, 1, 2, 3, 4, 5, 6, 7);
  f[1] = __builtin_shufflevector(l1, h1, 0, 1, 2, 3, 4, 5, 6, 7);
  f[2] = __builtin_shufflevector(l2, h2, 0, 1, 2, 3, 4, 5, 6, 7);
  f[3] = __builtin_shufflevector(l3, h3, 0, 1, 2, 3, 4, 5, 6, 7);
}

template <int MT, int NT>
DI void gemm_core(const u16* __restrict__ A, int lda, const u16* __restrict__ B, int ldb, int K,
                  f32x4 (&acc)[MT][NT], char* smem) {
  constexpr int BM = 64 * MT, BN = 32 * NT;
  constexpr int ASZ = BM * 128, BSZ = BN * 128, BUF = ASZ + BSZ;
  constexpr int NA = BM / 64, NB = BN / 64;
  const int tid = ltid(), l = tid & 63, w = tid >> 6, wm = w >> 1, wn = w & 1;
  const int fr = l & 15, fq = l >> 4;
  uint4 ra0, ra1, ra2, ra3, rb0, rb1, rb2, rb3;
  const int nk = K >> 6;
  const int srow = tid >> 3, sch = tid & 7;
  const int ssw = sch ^ ((srow >> 1) & 7);
  const int fsw = (fr >> 1) & 7;
#define GL1(i, kt)                                                                                        \
  if (NA > i) ra##i = *(const uint4*)(A + (size_t)(srow + 64 * i) * lda + (kt) * 64 + sch * 8);           \
  if (NB > i) rb##i = *(const uint4*)(B + (size_t)(srow + 64 * i) * ldb + (kt) * 64 + sch * 8);
#define GLOAD(kt) { GL1(0, kt) GL1(1, kt) GL1(2, kt) GL1(3, kt) }
#define SS1(i)                                                                   \
  if (NA > i) *(uint4*)(as_ + (srow + 64 * i) * 128 + ssw * 16) = ra##i;         \
  if (NB > i) *(uint4*)(bs_ + (srow + 64 * i) * 128 + ssw * 16) = rb##i;
#define SSTORE(buf)                              \
  {                                              \
    char* as_ = smem + (buf) * BUF;              \
    char* bs_ = as_ + ASZ;                       \
    SS1(0) SS1(1) SS1(2) SS1(3)                  \
  }
  GLOAD(0);
  SSTORE(0);
  GLOAD(((1 < nk) ? 1 : 0));
#pragma unroll 1
  for (int kt = 0; kt < nk; ++kt) {
    __syncthreads();
    SSTORE((kt + 1) & 1);
    { const int kn_ = (kt + 2 < nk) ? kt + 2 : nk - 1; GLOAD(kn_); }
    const char* as = smem + (kt & 1) * BUF;
    const char* bs = as + ASZ;
#pragma unroll
    for (int kk = 0; kk < 2; ++kk) {
      bf16x8 xf[MT], wf[NT];
#pragma unroll
      for (int mi = 0; mi < MT; ++mi)
        xf[mi] = *(const bf16x8*)(as + (wm * (MT * 16) + mi * 16 + fr) * 128 + (((kk * 4 + fq) ^ fsw) * 16));
#pragma unroll
      for (int ni = 0; ni < NT; ++ni)
        wf[ni] = *(const bf16x8*)(bs + (wn * (NT * 16) + ni * 16 + fr) * 128 + (((kk * 4 + fq) ^ fsw) * 16));
      __builtin_amdgcn_s_setprio(1);
#pragma unroll
      for (int mi = 0; mi < MT; ++mi)
#pragma unroll
        for (int ni = 0; ni < NT; ++ni) acc[mi][ni] = mfma16(wf[ni], xf[mi], acc[mi][ni]);
      __builtin_amdgcn_s_setprio(0);
    }
  }
  __syncthreads();
#undef GLOAD
#undef SSTORE
#undef GL1
#undef SS1
}
template <int MT, int NT>
DI void zero_acc(f32x4 (&acc)[MT][NT]) {
#pragma unroll
  for (int i = 0; i < MT; ++i)
#pragma unroll
    for (int j = 0; j < NT; ++j) acc[i][j] = f32x4{0.f, 0.f, 0.f, 0.f};
}


DI bool next_tile(int it, int RT, int CT, int PR, int PCc, int& rt, int& ct) {
  const int bid = lbid(), x = bid & 7, j = bid >> 3, J = lgdim() >> 3;
  const int u = j + it * J;
  const int pcols = CT / PCc, npatch = (RT / PR) * pcols;
  const int pid = (u >> 6) * 8 + x;
  if (pid >= npatch) return false;
  const int w = u & 63, pr = pid / pcols, pc = pid - pr * pcols;
  rt = pr * PR + w / PCc;
  ct = pc * PCc + w % PCc;
  return true;
}
DI void transpose_job(const float* __restrict__ src, int K, int N, u16* __restrict__ dst, int ldd, const float* kscale, char* smem) {
  float(*tile)[65] = (float(*)[65])smem;
  const int ntn = (N + 63) >> 6, ntk = K >> 6, tid = ltid();
  for (int t = lbid(); t < ntn * ntk; t += lgdim()) {
    const int tk = t / ntn, tn = t % ntn, k0 = tk * 64, n0 = tn * 64;
    {
      const int n = tid & 63, kb = tid >> 6;
      for (int i = 0; i < 8; ++i) {
        const int k = kb + 8 * i;
        float v = (n0 + n < N) ? src[(size_t)(k0 + k) * N + n0 + n] : 0.f;
        if (kscale) v *= kscale[k0 + k];
        tile[k][n] = v;
      }
    }
    __syncthreads();
    {
      const int n = tid >> 3, kc = tid & 7;
      if (n0 + n < N) {
        uint4 o;
        o.x = pack2(tile[kc * 8 + 0][n], tile[kc * 8 + 1][n]); o.y = pack2(tile[kc * 8 + 2][n], tile[kc * 8 + 3][n]);
        o.z = pack2(tile[kc * 8 + 4][n], tile[kc * 8 + 5][n]); o.w = pack2(tile[kc * 8 + 6][n], tile[kc * 8 + 7][n]);
        *(uint4*)(dst + (size_t)(n0 + n) * ldd + k0 + kc * 8) = o;
      }
    }
    __syncthreads();
  }
}

DI void phase0(const Params& p, char* smem) {
  const size_t gtid = (size_t)lbid() * NTHR + ltid(), gsz = (size_t)lgdim() * NTHR;
  for (int l = 0; l < 2; ++l) {
    transpose_job(p.w_in + (size_t)l * 1024 * 7120, 1024, 7120, p.win(l), KP1024, nullptr, smem);
    transpose_job(p.w_branch_a + (size_t)l * 512 * 1024, 512, 1024, p.wbra(l), KP512, nullptr, smem);
    transpose_job(p.w_branch_b + (size_t)l * 512 * 1024, 512, 1024, p.wbrb(l), KP512, nullptr, smem);
    transpose_job(p.w_o + (size_t)l * 1024 * 1024, 1024, 1024, p.wo(l), KP1024, nullptr, smem);
    transpose_job(p.w_ff1 + (size_t)l * 1024 * 4096, 1024, 4096, p.wf1(l), KP1024, nullptr, smem);
    transpose_job(p.w_ff2 + (size_t)l * 4096 * 1024, 4096, 1024, p.wf2(l), KP4096, nullptr, smem);
    transpose_job(p.c_w_qidx + (size_t)l * 256 * 512, 256, 512, p.wqx(l) + 1024 * KP256, KP256, p.c_q_norm_g + l * 256, smem);
    {
      const float* uq = p.c_w_uq + (size_t)l * 256 * 512;
      const float* uk = p.c_w_uk + (size_t)l * 128 * 512;
      const float* g = p.c_q_norm_g + l * 256;
      for (size_t e = gtid; e < 1024 * 256; e += gsz) {
        const int n = (int)(e >> 8), k = (int)(e & 255), h = n >> 7, r2 = n & 127;
        const float4* a = (const float4*)(uq + (k * 8 + h) * 64);
        const float4* b = (const float4*)(uk + (r2 * 8 + h) * 64);
        float s = 0.f;
        for (int d = 0; d < 16; ++d) { float4 x = a[d], y = b[d]; s += x.x * y.x + x.y * y.y + x.z * y.z + x.w * y.w; }
        p.wqx(l)[(size_t)n * KP256 + k] = f2bf(s * g[k]);
      }
    }
    {
      const float* uv = p.c_w_uv + (size_t)l * 128 * 512;
      const float* bc = p.w_branch_c + (size_t)l * 512 * 1024;
      for (size_t e = gtid; e < 1024 * 256; e += gsz) {
        const int k = (int)(e >> 8), n4 = (int)(e & 255) * 4, h = k >> 7, r = k & 127;
        const float* a = uv + (r * 8 + h) * 64;
        const float* b = bc + (size_t)(h * 64) * 1024 + n4;
        float4 acc4 = float4{0.f, 0.f, 0.f, 0.f};
#pragma unroll 8
        for (int d = 0; d < 64; ++d) {
          const float4 v = *(const float4*)(b + (size_t)d * 1024);
          const float ad = a[d];
          acc4.x += ad * v.x; acc4.y += ad * v.y; acc4.z += ad * v.z; acc4.w += ad * v.w;
        }
        u16* dst = p.wbrc(l) + (size_t)n4 * KP1024 + k;
        dst[0] = f2bf(acc4.x); dst[KP1024] = f2bf(acc4.y); dst[2 * KP1024] = f2bf(acc4.z); dst[3 * KP1024] = f2bf(acc4.w);
      }
    }
  }
  for (size_t e = gtid; e < (size_t)NT * 1024 / 8; e += gsz) {
    const float4 a = ((const float4*)p.x)[2 * e], b = ((const float4*)p.x)[2 * e + 1];
    uint4 o;
    o.x = pack2(a.x, a.y); o.y = pack2(a.z, a.w); o.z = pack2(b.x, b.y); o.w = pack2(b.z, b.w);
    *(uint4*)(p.XB() + (e >> 7) * LDX + (e & 127) * 8) = o;
  }
  if (gtid < 2) {
    const int l = (int)gtid;
    const float* lp = p.a_lambda + l * 256;
    float s1 = 0.f, s2 = 0.f;
    for (int i = 0; i < 64; ++i) { s1 += lp[i] * lp[64 + i]; s2 += lp[128 + i] * lp[192 + i]; }
    const float lam_init = 0.8f - 0.6f * expf(-0.3f * l);
    p.LAM()[l] = expf(s1) - expf(s2) + lam_init;
    p.LAM()[2 + l] = lam_init;
    for (int i = 0; i < 8; ++i) p.CNT()[l * 8 + i] = 0;
  }
}

DI void ln_phase(const float* S, const float* __restrict__ g, const float* __restrict__ b, u16* XBo, float* fout) {
  const int l = ltid() & 63;
  const int wave = lbid() * 8 + (ltid() >> 6), nw = lgdim() * 8;
  for (int row = wave; row < NT; row += nw) {
    float4 v[4];
    float s = 0.f;
#pragma unroll
    for (int i = 0; i < 4; ++i) { v[i] = *(const float4*)(S + (size_t)row * 1024 + i * 256 + l * 4); s += v[i].x + v[i].y + v[i].z + v[i].w; }
#pragma unroll
    for (int o = 32; o; o >>= 1) s += __shfl_xor(s, o);
    const float mu = s * (1.f / 1024.f);
    float q = 0.f;
#pragma unroll
    for (int i = 0; i < 4; ++i) { float a = v[i].x - mu, bb = v[i].y - mu, c = v[i].z - mu, d = v[i].w - mu; q += a * a + bb * bb + c * c + d * d; }
#pragma unroll
    for (int o = 32; o; o >>= 1) q += __shfl_xor(q, o);
    const float rs = rsqrtf(q * (1.f / 1024.f) + EPS);
#pragma unroll
    for (int i = 0; i < 4; ++i) {
      const int c = i * 256 + l * 4;
      const float4 gg = *(const float4*)(g + c), bb = *(const float4*)(b + c);
      float4 y;
      y.x = (v[i].x - mu) * rs * gg.x + bb.x; y.y = (v[i].y - mu) * rs * gg.y + bb.y;
      y.z = (v[i].z - mu) * rs * gg.z + bb.z; y.w = (v[i].w - mu) * rs * gg.w + bb.w;
      if (fout) *(float4*)(fout + (size_t)row * 1024 + c) = y;
      if (XBo) { uint2 o; o.x = pack2(y.x, y.y); o.y = pack2(y.z, y.w); *(uint2*)(XBo + (size_t)row * LDX + c) = o; }
    }
  }
}

#define EPI_LOOP(MT_, NT_)                                                \
  const int l_ = ltid() & 63, w_ = ltid() >> 6;                           \
  const int wm_ = w_ >> 1, wn_ = w_ & 1, fr_ = l_ & 15, fq_ = l_ >> 4;    \
  _Pragma("unroll") for (int mi = 0; mi < MT_; ++mi)                      \
  _Pragma("unroll") for (int ni = 0; ni < NT_; ++ni)

DI void phase_inproj(const Params& p, int l, char* smem) {
  int rt, ct;
  for (int it = 0; next_tile(it, 128, 16, 8, 8, rt, ct); ++it) {
    const int r0 = rt * 256, c0 = ct * 256;
    f32x4 acc[4][8];
    zero_acc<4, 8>(acc);
    gemm_core<4, 8>(p.XB() + (size_t)r0 * LDX, LDX, p.win(l) + (size_t)c0 * KP1024, KP1024, 1024, acc, smem);
    EPI_LOOP(4, 8) {
      const int row = r0 + wm_ * 64 + mi * 16 + fr_, col = c0 + wn_ * 128 + ni * 16 + fq_ * 4;
      if (col < PC) {
        uint2 o;
        o.x = pack2(acc[mi][ni][0], acc[mi][ni][1]); o.y = pack2(acc[mi][ni][2], acc[mi][ni][3]);
        *(uint2*)(p.P() + (size_t)row * PC + col) = o;
        if (col >= BQ && col < BZ && (row & 63) >= 61)
          *(uint2*)(p.HALO() + ((size_t)(row >> 6) * 3 + ((row & 63) - 61)) * 1536 + (col - BQ)) = o;
      }
    }
  }
}

DI void qx_tile(const Params& p, int l, int rt, int ct, char* smem) {
  const int r0 = rt * 256, c0 = ct * 256;
  float* rsv = (float*)(smem + 147456);
  {
    const int row = ltid() >> 1, half = ltid() & 1;
    const uint4* src = (const uint4*)(p.P() + (size_t)(r0 + row) * PC + CQ + half * 128);
    float ss = 0.f;
    for (int i = 0; i < 16; ++i) {
      uint4 v = src[i];
      float a;
      a = bflo(v.x); ss += a * a; a = bfhi(v.x); ss += a * a; a = bflo(v.y); ss += a * a; a = bfhi(v.y); ss += a * a;
      a = bflo(v.z); ss += a * a; a = bfhi(v.z); ss += a * a; a = bflo(v.w); ss += a * a; a = bfhi(v.w); ss += a * a;
    }
    ss += __shfl_xor(ss, 1);
    if (!half) rsv[row] = rsqrtf(ss * (1.f / 256.f) + EPS);
  }
  f32x4 acc[4][8];
  zero_acc<4, 8>(acc);
  gemm_core<4, 8>(p.P() + (size_t)r0 * PC + CQ, PC, p.wqx(l) + (size_t)c0 * KP256, KP256, 256, acc, smem);
  u16* QX = (u16*)p.out;
  EPI_LOOP(4, 8) {
    const int rl = wm_ * 64 + mi * 16 + fr_, col = c0 + wn_ * 128 + ni * 16 + fq_ * 4;
    const float rs = rsv[rl];
    uint2 o;
    o.x = pack2(acc[mi][ni][0] * rs, acc[mi][ni][1] * rs); o.y = pack2(acc[mi][ni][2] * rs, acc[mi][ni][3] * rs);
    *(uint2*)(QX + (size_t)(r0 + rl) * LDQ + col) = o;
  }
  __syncthreads();
}

DI void phase_merge(const Params& p, int l, char* smem) {
  const u16* QX = (const u16*)p.out;
  int rt, ct;
  for (int it = 0; next_tile(it, 128, 8, 8, 8, rt, ct); ++it) {
    const int r0 = rt * 256, c0 = ct * 128;
    bool first = true;
#pragma unroll 1
    for (int j = 0; j < 3; ++j) {
      if ((j == 0 && !EN_A) || (j == 1 && !EN_B) || (j == 2 && !EN_C)) continue;
      const u16* Ab; const u16* Wb; int lda, K;
      int ldw;
      if (j == 0) { Ab = p.P() + (size_t)r0 * PC + AQ; lda = PC; Wb = p.wbra(l) + (size_t)c0 * KP512; K = 512; ldw = KP512; }
      else if (j == 1) { Ab = p.P() + (size_t)r0 * PC + BZ; lda = PC; Wb = p.wbrb(l) + (size_t)c0 * KP512; K = 512; ldw = KP512; }
      else { Ab = QX + (size_t)r0 * LDQ; lda = LDQ; Wb = p.wbrc(l) + (size_t)c0 * KP1024; K = 1024; ldw = KP1024; }
      f32x4 g[4][4];
      zero_acc<4, 4>(g);
      gemm_core<4, 4>(p.XB() + (size_t)r0 * LDX, LDX, p.win(l) + (size_t)(GATES + j * 1024 + c0) * KP1024, KP1024, 1024, g, smem);
      const float* bg = p.b_gate + l * 3072 + j * 1024;
      {
        EPI_LOOP(4, 4) {
          const int col = c0 + wn_ * 64 + ni * 16 + fq_ * 4;
          const float4 bb = *(const float4*)(bg + col);
          g[mi][ni][0] = sigmoidf_(g[mi][ni][0] + bb.x);
          g[mi][ni][1] = sigmoidf_(g[mi][ni][1] + bb.y);
          g[mi][ni][2] = sigmoidf_(g[mi][ni][2] + bb.z);
          g[mi][ni][3] = sigmoidf_(g[mi][ni][3] + bb.w);
        }
      }
      f32x4 br[4][4];
      zero_acc<4, 4>(br);
      gemm_core<4, 4>(Ab, lda, Wb, ldw, K, br, smem);
      {
        EPI_LOOP(4, 4) {
          const int row = r0 + wm_ * 64 + mi * 16 + fr_, col = c0 + wn_ * 64 + ni * 16 + fq_ * 4;
          u16* mp = p.MERGED() + (size_t)row * LDX + col;
          float a0 = g[mi][ni][0] * br[mi][ni][0], a1 = g[mi][ni][1] * br[mi][ni][1];
          float a2 = g[mi][ni][2] * br[mi][ni][2], a3 = g[mi][ni][3] * br[mi][ni][3];
          if (!first) {
            const uint2 old = *(const uint2*)mp;
            a0 += bflo(old.x); a1 += bfhi(old.x); a2 += bflo(old.y); a3 += bfhi(old.y);
          }
          uint2 o;
          o.x = pack2(a0, a1); o.y = pack2(a2, a3);
          *(uint2*)mp = o;
        }
      }
      first = false;
    }
  }
}

DI void phase_resgemm(const Params& p, const u16* A, int lda, const u16* W, int ldw, int K, char* smem) {
  int rt, ct;
  for (int it = 0; next_tile(it, 128, 4, 16, 4, rt, ct); ++it) {
    const int r0 = rt * 256, c0 = ct * 256;
    f32x4 acc[4][8];
    zero_acc<4, 8>(acc);
    gemm_core<4, 8>(A + (size_t)r0 * lda, lda, W + (size_t)c0 * ldw, ldw, K, acc, smem);
    EPI_LOOP(4, 8) {
      const int row = r0 + wm_ * 64 + mi * 16 + fr_, col = c0 + wn_ * 128 + ni * 16 + fq_ * 4;
      const uint2 xb = *(const uint2*)(p.XB() + (size_t)row * LDX + col);
      float4 o;
      o.x = DN_ALPHA * bflo(xb.x) + acc[mi][ni][0]; o.y = DN_ALPHA * bfhi(xb.x) + acc[mi][ni][1];
      o.z = DN_ALPHA * bflo(xb.y) + acc[mi][ni][2]; o.w = DN_ALPHA * bfhi(xb.y) + acc[mi][ni][3];
      *(float4*)(p.out + (size_t)row * 1024 + col) = o;
    }
  }
}

DI void phase_ff1(const Params& p, int l, char* smem) {
  int rt, ct;
  for (int it = 0; next_tile(it, 128, 16, 8, 8, rt, ct); ++it) {
    const int r0 = rt * 256, c0 = ct * 256;
    f32x4 acc[4][8];
    zero_acc<4, 8>(acc);
    gemm_core<4, 8>(p.XB() + (size_t)r0 * LDX, LDX, p.wf1(l) + (size_t)c0 * KP1024, KP1024, 1024, acc, smem);
    EPI_LOOP(4, 8) {
      const int row = r0 + wm_ * 64 + mi * 16 + fr_, col = c0 + wn_ * 128 + ni * 16 + fq_ * 4;
      float a0 = fmaxf(acc[mi][ni][0], 0.f), a1 = fmaxf(acc[mi][ni][1], 0.f), a2 = fmaxf(acc[mi][ni][2], 0.f), a3 = fmaxf(acc[mi][ni][3], 0.f);
      uint2 o;
      o.x = pack2(a0 * a0, a1 * a1); o.y = pack2(a2 * a2, a3 * a3);
      *(uint2*)(p.P() + (size_t)row * LDH + col) = o;
    }
  }
}

DI void dsa_kprep_item(const Params& p, int l, int it) {
  const int ln = ltid() & 63, w = ltid() >> 6;
  const float g0 = p.c_kv_norm_g[l * 128 + 2 * ln], g1 = p.c_kv_norm_g[l * 128 + 2 * ln + 1];
  const float kg = p.c_kidx_g[l * 64 + ln], kb = p.c_kidx_b[l * 64 + ln];
  for (int i = 0; i < 8; ++i) {
    const size_t tok = (size_t)it * 64 + w * 8 + i;
    const u16* pr = p.P() + tok * PC;
    const u32 v = *(const u32*)(pr + CKVc + 2 * ln);
    const float a = bflo(v), b = bfhi(v);
    float ss = a * a + b * b;
#pragma unroll
    for (int o = 32; o; o >>= 1) ss += __shfl_xor(ss, o);
    const float rs = rsqrtf(ss * (1.f / 128.f) + EPS);
    *(u32*)(p.CKV() + tok * 128 + 2 * ln) = pack2(a * rs * g0, b * rs * g1);
    const float k = bf2f(pr[CKI + ln]);
    float s = k;
#pragma unroll
    for (int o = 32; o; o >>= 1) s += __shfl_xor(s, o);
    const float mu = s * (1.f / 64.f);
    float q = (k - mu) * (k - mu);
#pragma unroll
    for (int o = 32; o; o >>= 1) q += __shfl_xor(q, o);
    p.KIDX()[tok * 64 + ln] = f2bf((k - mu) * rsqrtf(q * (1.f / 64.f) + EPS) * kg + kb);
    if (ln < 8) p.WIDX()[tok * 8 + ln] = bf2f(pr[CWI + ln]) * 0.04419417382f;
  }
}

DI void gdn_prep_item(const Params& p, int l, int it, char* smem0) {
  const int half_ = ltid() >> 8;
  const int cidx = it >> 1, h = (it & 1) * 2 + half_, n = cidx & 255;
  const size_t t0g = (size_t)cidx * 64;
  char* smem = smem0 + half_ * 69632;
  const int tid = ltid() & 255, ln = tid & 63, w = tid >> 6;
  char* qs = smem;
  char* ks = smem + 17408;
  char* vs = smem + 2 * 17408;
  float* Lm = (float*)(smem + 3 * 17408);
  float* gcs = Lm + 4096;
  float* bts = gcs + 64;
  float* egs = bts + 64;
  u16* proj = p.P();
  {
    const int c = tid & 127, rh = tid >> 7;
    uint4 st[12];
#pragma unroll
    for (int part = 0; part < 3; ++part)
#pragma unroll
      for (int i = 0; i < 4; ++i) {
        const int piece = tid + 256 * i, row = piece >> 4, ch = piece & 15;
        st[part * 4 + i] = *(const uint4*)(proj + (t0g + row) * PC + BQ + part * 512 + h * 128 + ch * 8);
      }
    float hx[9];
#pragma unroll
    for (int i = 0; i < 9; ++i) hx[i] = 0.f;
    if (rh == 0 && n != 0) {
#pragma unroll
      for (int part = 0; part < 3; ++part) {
        const u16* hp = p.HALO() + ((size_t)(cidx - 1) * 3) * 1536 + part * 512 + h * 128 + c;
        hx[part * 3 + 0] = bf2f(hp[0]); hx[part * 3 + 1] = bf2f(hp[1536]); hx[part * 3 + 2] = bf2f(hp[2 * 1536]);
      }
    }
#pragma unroll
    for (int part = 0; part < 3; ++part)
#pragma unroll
      for (int i = 0; i < 4; ++i) {
        const int piece = tid + 256 * i, row = piece >> 4, ch = piece & 15;
        char* dst = (part == 0 ? qs : (part == 1 ? ks : vs));
        *(uint4*)(dst + row * 272 + ch * 16) = st[part * 4 + i];
      }
    __syncthreads();
    if (rh == 1) {
#pragma unroll
      for (int part = 0; part < 3; ++part) {
        const char* src = (part == 0 ? qs : (part == 1 ? ks : vs));
        hx[part * 3 + 0] = bf2f(*(const u16*)(src + 29 * 272 + c * 2));
        hx[part * 3 + 1] = bf2f(*(const u16*)(src + 30 * 272 + c * 2));
        hx[part * 3 + 2] = bf2f(*(const u16*)(src + 31 * 272 + c * 2));
      }
    }
    __syncthreads();
#pragma unroll
    for (int part = 0; part < 3; ++part) {
      const int wch = part * 512 + h * 128 + c;
      const float* cw = p.b_conv_w + (size_t)l * 4 * 1536 + wch;
      const float w0 = cw[0], w1 = cw[1536], w2 = cw[2 * 1536], w3 = cw[3 * 1536];
      float xm3 = hx[part * 3 + 0], xm2 = hx[part * 3 + 1], xm1 = hx[part * 3 + 2];
      char* dst = (part == 0 ? qs : (part == 1 ? ks : vs));
#pragma unroll 8
      for (int i = 0; i < 32; ++i) {
        const int r = rh * 32 + i;
        u16* px = (u16*)(dst + r * 272 + c * 2);
        const float x = bf2f(*px);
        const float y = w0 * xm3 + w1 * xm2 + w2 * xm1 + w3 * x;
        xm3 = xm2; xm2 = xm1; xm1 = x;
        *px = f2bf(siluf_(y));
      }
    }
  }
  if (w == 0) {
    const float a = bf2f(proj[(t0g + ln) * PC + BA + h]) + p.b_dt_bias[l * 4 + h];
    const float ea = __expf(a);
    const float sp = (a > 20.f) ? a : ((ea < 0.01f) ? ea * (1.f - ea * (0.5f - ea * 0.333333333f)) : __logf(1.f + ea));
    float g = -__expf(p.b_a_log[l * 4 + h]) * sp;
#pragma unroll
    for (int o = 1; o < 64; o <<= 1) { float t = __shfl_up(g, o); if (ln >= o) g += t; }
    gcs[ln] = g;
    egs[ln] = __expf(g);
    bts[ln] = sigmoidf_(bf2f(proj[(t0g + ln) * PC + BB + h]));
  }
  __syncthreads();
  {
    const int row = tid >> 2, qr = tid & 3;
#pragma unroll
    for (int part = 0; part < 2; ++part) {
      char* base = (part == 0 ? qs : ks) + row * 272 + qr * 64;
      uint4 v[4];
      float ss = 0.f;
#pragma unroll
      for (int i = 0; i < 4; ++i) {
        v[i] = *(uint4*)(base + i * 16);
        float a;
        a = bflo(v[i].x); ss += a * a; a = bfhi(v[i].x); ss += a * a; a = bflo(v[i].y); ss += a * a; a = bfhi(v[i].y); ss += a * a;
        a = bflo(v[i].z); ss += a * a; a = bfhi(v[i].z); ss += a * a; a = bflo(v[i].w); ss += a * a; a = bfhi(v[i].w); ss += a * a;
      }
      ss += __shfl_xor(ss, 1);
      ss += __shfl_xor(ss, 2);
      const float rs = rsqrtf(ss + EPS) * (part == 0 ? 0.08838834764f : 1.f);
#pragma unroll
      for (int i = 0; i < 4; ++i) {
        uint4 o;
        o.x = pack2(bflo(v[i].x) * rs, bfhi(v[i].x) * rs); o.y = pack2(bflo(v[i].y) * rs, bfhi(v[i].y) * rs);
        o.z = pack2(bflo(v[i].z) * rs, bfhi(v[i].z) * rs); o.w = pack2(bflo(v[i].w) * rs, bfhi(v[i].w) * rs);
        *(uint4*)(base + i * 16) = o;
      }
    }
  }
  __syncthreads();
  {
    const int fr = ln & 15, fq = ln >> 4;
    f32x4 kk[4], qk[4];
#pragma unroll
    for (int nt = 0; nt < 4; ++nt) { kk[nt] = f32x4{0, 0, 0, 0}; qk[nt] = f32x4{0, 0, 0, 0}; }
#pragma unroll
    for (int s = 0; s < 4; ++s) {
      const bf16x8 ak = *(const bf16x8*)(ks + (16 * w + fr) * 272 + (32 * s + 8 * fq) * 2);
      const bf16x8 aq = *(const bf16x8*)(qs + (16 * w + fr) * 272 + (32 * s + 8 * fq) * 2);
#pragma unroll
      for (int nt = 0; nt < 4; ++nt) {
        const bf16x8 bk = *(const bf16x8*)(ks + (16 * nt + fr) * 272 + (32 * s + 8 * fq) * 2);
        kk[nt] = mfma16(ak, bk, kk[nt]);
        qk[nt] = mfma16(aq, bk, qk[nt]);
      }
    }
#pragma unroll
    for (int nt = 0; nt < 4; ++nt)
#pragma unroll
      for (int jj = 0; jj < 4; ++jj) {
        const int i = 16 * w + 4 * fq + jj, j = 16 * nt + fr;
        const float dec = (i >= j) ? __expf(gcs[i] - gcs[j]) : 0.f;
        Lm[i * 64 + j] = (i > j) ? bts[i] * kk[nt][jj] * dec : 0.f;
        p.ATT()[(t0g + i) * 256 + h * 64 + j] = f2bf((i >= j) ? qk[nt][jj] * dec : 0.f);
      }
  }
  __syncthreads();
  {
    const int c = tid;
    const bool isu = c < 128;
    const char* src = isu ? (vs + c * 2) : (ks + (c - 128) * 2);
    const float wsel = isu ? 0.f : 1.f;
    float x[64];
#pragma unroll
    for (int i = 0; i < 64; ++i) {
      float a = bf2f(*(const u16*)(src + i * 272)) * bts[i] * fmaf(egs[i] - 1.f, wsel, 1.f);
      const float* Lr = Lm + i * 64;
#pragma unroll
      for (int j = 0; j < i; ++j) a -= Lr[j] * x[j];
      x[i] = a;
      asm volatile("" ::: "memory");
    }
    if (isu) {
      u32 pk[32];
#pragma unroll
      for (int pos = 0; pos < 64; pos += 2) {
        const int hh = pos >> 5, Tt = (pos >> 4) & 1, ii = pos & 15;
        const int r0 = 32 * Tt + (ii & 3) + 8 * (ii >> 2) + 4 * hh;
        const int i1 = ii + 1;
        const int r1 = 32 * Tt + (i1 & 3) + 8 * (i1 >> 2) + 4 * hh;
        pk[pos >> 1] = pack2(x[r0], x[r1]);
      }
      char* dst = (char*)proj + ((t0g + (c >> 1)) * PC + BV + h * 128) * 2 + (c & 1) * 128;
#pragma unroll
      for (int i = 0; i < 8; ++i) *(uint4*)(dst + i * 16) = uint4{pk[4 * i], pk[4 * i + 1], pk[4 * i + 2], pk[4 * i + 3]};
    } else {
#pragma unroll
      for (int i = 0; i < 64; ++i) proj[(t0g + i) * PC + BK_ + h * 128 + (c - 128)] = f2bf(x[i]);
    }
  }
  {
    const float glast = gcs[63];
#pragma unroll
    for (int i = 0; i < 4; ++i) {
      const int piece = tid + 256 * i, row = piece >> 4, ch = piece & 15;
      const uint4 v = *(const uint4*)(qs + row * 272 + ch * 16);
      const float e = egs[row];
      uint4 o;
      o.x = pack2(bflo(v.x) * e, bfhi(v.x) * e); o.y = pack2(bflo(v.y) * e, bfhi(v.y) * e);
      o.z = pack2(bflo(v.z) * e, bfhi(v.z) * e); o.w = pack2(bflo(v.w) * e, bfhi(v.w) * e);
      *(uint4*)(proj + (t0g + row) * PC + BQ + h * 128 + ch * 8) = o;
    }
    const int d = tid & 127, half = tid >> 7;
    u32 pk[16];
#pragma unroll
    for (int i = 0; i < 16; ++i) {
      const int r0 = half * 32 + 2 * i;
      const float a = bf2f(*(const u16*)(ks + r0 * 272 + d * 2)) * __expf(glast - gcs[r0]);
      const float b = bf2f(*(const u16*)(ks + (r0 + 1) * 272 + d * 2)) * __expf(glast - gcs[r0 + 1]);
      pk[i] = pack2(a, b);
    }
    u16* dst = p.KDT() + (((size_t)cidx * 4 + h) * 128 + d) * 64 + half * 32;
#pragma unroll
    for (int i = 0; i < 4; ++i) *(uint4*)(dst + i * 8) = uint4{pk[4 * i], pk[4 * i + 1], pk[4 * i + 2], pk[4 * i + 3]};
    if (tid == 0) p.GL()[cidx * 4 + h] = egs[63];
  }
  __syncthreads();
}

DI void gdn_rec_item(const Params& p, int l, int bh, char* smem, bool wr) {
  const int b = bh >> 2, h = bh & 3;
  const int tid = ltid(), ln = tid & 63, w = tid >> 6, hh = ln >> 5, c31 = ln & 31;
  const bool is_comp = w < 4;
  constexpr int BUFB = 59904;
  float* Ot = (float*)(smem + 2 * BUFB);
  u16* proj = p.P();
  const float* ng = p.b_norm_g + l * 128;
  const int lt = tid & 255;
#define LD_AQ(i, n_)                                                                                      \
  {                                                                                                       \
    const size_t t0g_ = ((size_t)b * 256 + (n_)) * 64;                                                    \
    const int piece = ltv + 256 * i, row = piece >> 4, ch = piece & 15;                                   \
    la##i = *(const uint4*)(proj + (t0g_ + row) * PC + BK_ + h * 128 + ch * 8);                           \
    lq##i = *(const uint4*)(proj + (t0g_ + row) * PC + BQ + h * 128 + ch * 8);                            \
  }
#define LD_K(i, n_)                                                                                       \
  {                                                                                                       \
    const int piece = ltv + 256 * i, row2 = piece >> 3, ch2 = piece & 7;                                  \
    lk##i = *(const uint4*)(p.KDT() + ((((size_t)b * 256 + (n_)) * 4 + h) * 128 + row2) * 64 + ch2 * 8);  \
  }
#define LD_T(i, n_)                                                                                       \
  {                                                                                                       \
    const size_t t0g_ = ((size_t)b * 256 + (n_)) * 64;                                                    \
    const int piece = ltv + 256 * i, row = piece >> 3, ch = piece & 7;                                     \
    lt##i = *(const uint4*)(p.ATT() + (t0g_ + row) * 256 + h * 64 + ch * 8);                              \
  }
#define LD_R1(n_) { LD_AQ(0, n_) LD_AQ(1, n_) LD_AQ(2, n_) LD_AQ(3, n_) }
#define LD_R2(n_) { LD_K(0, n_) LD_K(1, n_) LD_K(2, n_) LD_K(3, n_) LD_T(0, n_) LD_T(1, n_) }
#define ST_AQ(i, buf_)                                                                                    \
  {                                                                                                       \
    char* Wm_ = smem + (buf_) * BUFB; char* Qd_ = Wm_ + 16896;                                            \
    const int piece = ltv + 256 * i, row = piece >> 4, ch = piece & 15;                                   \
    *(uint2*)(Wm_ + row * 264 + ch * 16) = uint2{la##i.x, la##i.y}; *(uint2*)(Wm_ + row * 264 + ch * 16 + 8) = uint2{la##i.z, la##i.w}; \
    *(uint2*)(Qd_ + row * 264 + ch * 16) = uint2{lq##i.x, lq##i.y}; *(uint2*)(Qd_ + row * 264 + ch * 16 + 8) = uint2{lq##i.z, lq##i.w}; \
  }
#define ST_K(i, buf_)                                                                                     \
  {                                                                                                       \
    char* Kt_ = smem + (buf_) * BUFB + 2 * 16896;                                                         \
    const int piece = ltv + 256 * i, row2 = piece >> 3, ch2 = piece & 7;                                  \
    *(uint2*)(Kt_ + row2 * 136 + ch2 * 16) = uint2{lk##i.x, lk##i.y}; *(uint2*)(Kt_ + row2 * 136 + ch2 * 16 + 8) = uint2{lk##i.z, lk##i.w}; \
  }
#define ST_T(i, buf_)                                                                                     \
  {                                                                                                       \
    char* At_ = smem + (buf_) * BUFB + 2 * 16896 + 17408;                                                 \
    const int piece = ltv + 256 * i, row = piece >> 3, ch = piece & 7;                                     \
    *(uint2*)(At_ + row * 136 + ch * 16) = uint2{lt##i.x, lt##i.y}; *(uint2*)(At_ + row * 136 + ch * 16 + 8) = uint2{lt##i.z, lt##i.w}; \
  }
#define ST_R1(buf_) { ST_AQ(0, buf_) ST_AQ(1, buf_) ST_AQ(2, buf_) ST_AQ(3, buf_) }
#define ST_R2(buf_) { ST_K(0, buf_) ST_K(1, buf_) ST_K(2, buf_) ST_K(3, buf_) ST_T(0, buf_) ST_T(1, buf_) }
#define LD_Z(n_)                                                                                          \
  {                                                                                                       \
    const u16* zp_ = proj + (((size_t)b * 256 + (n_)) * 64 + nrow) * PC + BZ + h * 128 + nqr * 32;        \
    lz0 = *(const uint4*)(zp_); lz1 = *(const uint4*)(zp_ + 8); lz2 = *(const uint4*)(zp_ + 16); lz3 = *(const uint4*)(zp_ + 24); \
  }
  f32x16 S[4];
#pragma unroll
  for (int i = 0; i < 4; ++i)
#pragma unroll
    for (int j = 0; j < 16; ++j) S[i][j] = 0.f;
  const int e = 32 * w + c31;
  uint4 un0, un1, un2, un3;
  float gln = 0.f;
#define LD_U(n_)                                                                                          \
  {                                                                                                       \
    const uint4* up_ = (const uint4*)((const char*)proj + ((((size_t)b * 256 + (n_)) * 64 + (e >> 1)) * PC + BV + h * 128) * 2 + (e & 1) * 128 + hh * 64); \
    un0 = up_[0]; un1 = up_[1]; un2 = up_[2]; un3 = up_[3];                                               \
    gln = p.GL()[((size_t)b * 256 + (n_)) * 4 + h];                                                       \
  }
  if (!is_comp) {
    const int ltv = lt;
    uint4 la0, la1, la2, la3, lq0, lq1, lq2, lq3, lk0, lk1, lk2, lk3, lt0, lt1;
    LD_R1(0) LD_R2(0)
    ST_R1(0) ST_R2(0)
  } else {
    LD_U(0)
  }
  for (int n = 0; n < 256; ++n) {
    f32x16 o[2];
    __syncthreads();
    if (is_comp) {
      int lnv = ln;
      asm volatile("" : "+v"(lnv));
      const int hh = lnv >> 5, c31 = lnv & 31;
      const char* Wm = smem + (n & 1) * BUFB;
      const char* Qd = Wm + 16896;
      const char* Kt = Wm + 2 * 16896;
      const char* At = Kt + 17408;
      f32x16 ws[2];
#pragma unroll
      for (int i = 0; i < 2; ++i)
#pragma unroll
        for (int j = 0; j < 16; ++j) { ws[i][j] = 0.f; o[i][j] = 0.f; }
#pragma unroll
      for (int Tt = 0; Tt < 4; ++Tt)
#pragma unroll
        for (int s = 0; s < 2; ++s) {
          const int kb = 32 * Tt + 16 * s;
          const bf16x8 sps = pack8(S[Tt], s);
#pragma unroll
          for (int Tc = 0; Tc < 2; ++Tc) {
            ws[Tc] = mfma32(afrag_perm(Wm, 32 * Tc + c31, 264, kb, hh), sps, ws[Tc]);
            o[Tc] = mfma32(afrag_perm(Qd, 32 * Tc + c31, 264, kb, hh), sps, o[Tc]);
          }
        }
      f32x16 vn[2];
      vn[0][0] = bflo(un0.x) - ws[0][0]; vn[0][1] = bfhi(un0.x) - ws[0][1]; vn[0][2] = bflo(un0.y) - ws[0][2]; vn[0][3] = bfhi(un0.y) - ws[0][3];
      vn[0][4] = bflo(un0.z) - ws[0][4]; vn[0][5] = bfhi(un0.z) - ws[0][5]; vn[0][6] = bflo(un0.w) - ws[0][6]; vn[0][7] = bfhi(un0.w) - ws[0][7];
      vn[0][8] = bflo(un1.x) - ws[0][8]; vn[0][9] = bfhi(un1.x) - ws[0][9]; vn[0][10] = bflo(un1.y) - ws[0][10]; vn[0][11] = bfhi(un1.y) - ws[0][11];
      vn[0][12] = bflo(un1.z) - ws[0][12]; vn[0][13] = bfhi(un1.z) - ws[0][13]; vn[0][14] = bflo(un1.w) - ws[0][14]; vn[0][15] = bfhi(un1.w) - ws[0][15];
      vn[1][0] = bflo(un2.x) - ws[1][0]; vn[1][1] = bfhi(un2.x) - ws[1][1]; vn[1][2] = bflo(un2.y) - ws[1][2]; vn[1][3] = bfhi(un2.y) - ws[1][3];
      vn[1][4] = bflo(un2.z) - ws[1][4]; vn[1][5] = bfhi(un2.z) - ws[1][5]; vn[1][6] = bflo(un2.w) - ws[1][6]; vn[1][7] = bfhi(un2.w) - ws[1][7];
      vn[1][8] = bflo(un3.x) - ws[1][8]; vn[1][9] = bfhi(un3.x) - ws[1][9]; vn[1][10] = bflo(un3.y) - ws[1][10]; vn[1][11] = bfhi(un3.y) - ws[1][11];
      vn[1][12] = bflo(un3.z) - ws[1][12]; vn[1][13] = bfhi(un3.z) - ws[1][13]; vn[1][14] = bflo(un3.w) - ws[1][14]; vn[1][15] = bfhi(un3.w) - ws[1][15];
      const float gl = gln;
      if (n + 1 < 256) LD_U(n + 1)
      bf16x8 vp[2][2];
#pragma unroll
      for (int Tc = 0; Tc < 2; ++Tc) { vp[Tc][0] = pack8(vn[Tc], 0); vp[Tc][1] = pack8(vn[Tc], 1); }
#pragma unroll
      for (int s = 0; s < 2; ++s) {
        o[0] = mfma32(afrag_perm(At, c31, 136, 16 * s, hh), vp[0][s], o[0]);
        o[1] = mfma32(afrag_perm(At, 32 + c31, 136, 16 * s, hh), vp[0][s], o[1]);
        o[1] = mfma32(afrag_perm(At, 32 + c31, 136, 32 + 16 * s, hh), vp[1][s], o[1]);
      }
#pragma unroll
      for (int Tt = 0; Tt < 4; ++Tt)
#pragma unroll
        for (int j = 0; j < 16; ++j) S[Tt][j] *= gl;
#pragma unroll
      for (int Tc = 0; Tc < 2; ++Tc)
#pragma unroll
        for (int s = 0; s < 2; ++s)
#pragma unroll
          for (int Tt = 0; Tt < 4; ++Tt)
            S[Tt] = mfma32(afrag_perm(Kt, 32 * Tt + c31, 136, 32 * Tc + 16 * s, hh), vp[Tc][s], S[Tt]);
    } else {
      int ltv = lt;
      asm volatile("" : "+v"(ltv));
      const int nrow = ltv >> 2, nqr = ltv & 3;
      const int nn = (n + 1 < 256) ? n + 1 : 255;
      {
        uint4 la0, la1, la2, la3, lq0, lq1, lq2, lq3;
        LD_R1(nn)
        ST_R1((n + 1) & 1)
      }
      uint4 lz0, lz1, lz2, lz3;
      {
        uint4 lk0, lk1, lk2, lk3, lt0, lt1;
        LD_R2(nn)
        const int nz = (n > 0) ? n - 1 : 0;
        LD_Z(nz)
        ST_R2((n + 1) & 1)
      }
      if (n > 0) {
        const float* orow = Ot + nrow * 132 + nqr * 32;
        float ss = 0.f;
#pragma unroll
        for (int i = 0; i < 8; ++i) {
          const float4 v = *(const float4*)(orow + 4 * i);
          ss += v.x * v.x + v.y * v.y + v.z * v.z + v.w * v.w;
        }
        ss += __shfl_xor(ss, 1);
        ss += __shfl_xor(ss, 2);
        const float rs = rsqrtf(ss * (1.f / 128.f) + EPS);
        u16* zp = proj + (((size_t)b * 256 + (n - 1)) * 64 + nrow) * PC + BZ + h * 128 + nqr * 32;
        const float* gg = ng + nqr * 32;
#define GN1(i, Z)                                                                                          \
        {                                                                                                  \
          const float4 oa = *(const float4*)(orow + 8 * i), ob = *(const float4*)(orow + 8 * i + 4);       \
          uint4 r;                                                                                         \
          r.x = pack2(oa.x * rs * gg[8 * i + 0] * siluf_(bflo(Z.x)), oa.y * rs * gg[8 * i + 1] * siluf_(bfhi(Z.x))); \
          r.y = pack2(oa.z * rs * gg[8 * i + 2] * siluf_(bflo(Z.y)), oa.w * rs * gg[8 * i + 3] * siluf_(bfhi(Z.y))); \
          r.z = pack2(ob.x * rs * gg[8 * i + 4] * siluf_(bflo(Z.z)), ob.y * rs * gg[8 * i + 5] * siluf_(bfhi(Z.z))); \
          r.w = pack2(ob.z * rs * gg[8 * i + 6] * siluf_(bflo(Z.w)), ob.w * rs * gg[8 * i + 7] * siluf_(bfhi(Z.w))); \
          if (wr) *(uint4*)(zp + 8 * i) = r;                                                               \
        }
        GN1(0, lz0) GN1(1, lz1) GN1(2, lz2) GN1(3, lz3)
      }
    }
    __syncthreads();
    if (is_comp) {
#pragma unroll
      for (int Tc = 0; Tc < 2; ++Tc)
#pragma unroll
        for (int j = 0; j < 16; ++j) Ot[(32 * Tc + crow(j, hh)) * 132 + e] = o[Tc][j];
    }
  }
  __syncthreads();
  if (!is_comp) {
    const int n = 256;
    const int nrow = lt >> 2, nqr = lt & 3;
    uint4 lz0, lz1, lz2, lz3;
    LD_Z(255)
    const float* orow = Ot + nrow * 132 + nqr * 32;
    float ss = 0.f;
#pragma unroll
    for (int i = 0; i < 8; ++i) {
      const float4 v = *(const float4*)(orow + 4 * i);
      ss += v.x * v.x + v.y * v.y + v.z * v.z + v.w * v.w;
    }
    ss += __shfl_xor(ss, 1);
    ss += __shfl_xor(ss, 2);
    const float rs = rsqrtf(ss * (1.f / 128.f) + EPS);
    u16* zp = proj + (((size_t)b * 256 + (n - 1)) * 64 + nrow) * PC + BZ + h * 128 + nqr * 32;
    const float* gg = ng + nqr * 32;
    GN1(0, lz0) GN1(1, lz1) GN1(2, lz2) GN1(3, lz3)
  }
#undef GN1
#undef LD_AQ
#undef LD_K
#undef LD_R1
#undef LD_R2
#undef LD_T
#undef ST_AQ
#undef ST_K
#undef ST_R1
#undef ST_R2
#undef ST_T
#undef LD_Z
#undef LD_U
  __syncthreads();
}

DI void diff_item(const Params& p, int l, int qt, int bh, char* smem) {
  const int b = bh >> 2, h = bh & 3;
  const int tid = ltid(), ln = tid & 63, w = tid >> 6, hh = ln >> 5, c31 = ln & 31;
  const int st = w & 3, c = w >> 2;
  const size_t tokbase = (size_t)b * T;
  const int qb = qt * 128 + 32 * st + c31;
  u16* proj = p.P();
  bf16x8 qf[4];
  {
    const u16* qrow = proj + (tokbase + qb) * PC + AQ + h * 128 + c * 64 + 8 * hh;
#pragma unroll
    for (int s = 0; s < 4; ++s) qf[s] = *(const bf16x8*)(qrow + 16 * s);
  }
  f32x16 O[4];
  float mrun, lrun;
  const float sc = 0.125f * 1.44269504089f;
  char* Ks = smem;
  char* Vs = smem + 17408;
  uint4 rk0, rk1, rv0, rv1;
  const int srow = tid >> 4, sch = tid & 15;
#define DLOAD1(i, kt)                                                                \
  {                                                                                  \
    const u16* base = proj + (tokbase + (kt) * 64 + srow + 32 * i) * PC + h * 128 + sch * 8; \
    rk##i = *(const uint4*)(base + AK);                                              \
    rv##i = *(const uint4*)(base + AV);                                              \
  }
#define DLOAD(kt) { DLOAD1(0, kt) DLOAD1(1, kt) }
#define DSTORE1(i)                                                \
  *(uint4*)(Ks + (srow + 32 * i) * 272 + sch * 16) = rk##i;       \
  *(uint4*)(Vs + (srow + 32 * i) * 320 + sch * 16) = rv##i;
  const int nkt = 2 * qt + 2;
#pragma unroll 1
  for (int rep = 0; rep < DUP_DIFF; ++rep) {
#pragma unroll
  for (int i = 0; i < 4; ++i)
#pragma unroll
    for (int j = 0; j < 16; ++j) O[i][j] = 0.f;
  mrun = -INFINITY; lrun = 0.f;
  DLOAD(0);
  for (int kt = 0; kt < nkt; ++kt) {
    __syncthreads();
    DSTORE1(0) DSTORE1(1)
    __syncthreads();
    if (kt + 1 < nkt) { DLOAD(kt + 1); }
    if (kt * 64 > qt * 128 + 32 * st + 31) continue;
    f32x16 sa[2];
#pragma unroll
    for (int k2 = 0; k2 < 2; ++k2) {
#pragma unroll
      for (int j = 0; j < 16; ++j) sa[k2][j] = 0.f;
#pragma unroll
      for (int s = 0; s < 4; ++s)
        sa[k2] = mfma32(*(const bf16x8*)(Ks + (32 * k2 + c31) * 272 + (c * 64 + 16 * s + 8 * hh) * 2), qf[s], sa[k2]);
    }
    if (kt >= 2 * qt) {
#pragma unroll
      for (int k2 = 0; k2 < 2; ++k2)
#pragma unroll
        for (int j = 0; j < 16; ++j)
          if (kt * 64 + 32 * k2 + crow(j, hh) > qb) sa[k2][j] = -INFINITY;
    }
    float tmax = sa[0][0];
#pragma unroll
    for (int k2 = 0; k2 < 2; ++k2)
#pragma unroll
      for (int j = 0; j < 16; ++j) tmax = fmaxf(tmax, sa[k2][j]);
    tmax = xhalf_max(tmax);
    const float mnew = fmaxf(mrun, tmax * sc);
    const float alpha = __builtin_amdgcn_exp2f(mrun - mnew);
    mrun = mnew;
    float psum = 0.f;
#pragma unroll
    for (int k2 = 0; k2 < 2; ++k2)
#pragma unroll
      for (int j = 0; j < 16; ++j) { const float pv = __builtin_amdgcn_exp2f(sa[k2][j] * sc - mnew); sa[k2][j] = pv; psum += pv; }
    lrun = lrun * alpha + psum;
    if (__any(alpha != 1.f)) {
#pragma unroll
      for (int i = 0; i < 4; ++i)
#pragma unroll
        for (int j = 0; j < 16; ++j) O[i][j] *= alpha;
    }
#pragma unroll
    for (int k2 = 0; k2 < 2; ++k2)
#pragma unroll
      for (int s2 = 0; s2 < 2; ++s2) {
        const bf16x8 pp = pack8(sa[k2], s2);
        bf16x8 vf[4];
        trfrag4<320>(Vs, 32 * k2 + 16 * s2, ln, vf);
#pragma unroll
        for (int mt = 0; mt < 4; ++mt) O[mt] = mfma32(vf[mt], pp, O[mt]);
      }
  }
  }
#undef DLOAD
#undef DLOAD1
#undef DSTORE1
  __syncthreads();
  const float ltot = xhalf_sum(lrun);
  const float inv = 1.f / ltot;
  float* xch = (float*)smem + st * 32 * 132;
  if (c == 1) {
#pragma unroll
    for (int mt = 0; mt < 4; ++mt)
#pragma unroll
      for (int i4 = 0; i4 < 4; ++i4)
        *(float4*)(xch + c31 * 132 + 32 * mt + 8 * i4 + 4 * hh) =
            float4{O[mt][4 * i4] * inv, O[mt][4 * i4 + 1] * inv, O[mt][4 * i4 + 2] * inv, O[mt][4 * i4 + 3] * inv};
  }
  __syncthreads();
  if (c == 0) {
    const float lam = p.LAM()[l], oml = 1.f - p.LAM()[2 + l];
    float ss = 0.f;
#pragma unroll
    for (int mt = 0; mt < 4; ++mt)
#pragma unroll
      for (int i4 = 0; i4 < 4; ++i4) {
        const float4 o1 = *(const float4*)(xch + c31 * 132 + 32 * mt + 8 * i4 + 4 * hh);
        float d;
        d = O[mt][4 * i4] * inv - lam * o1.x; O[mt][4 * i4] = d; ss += d * d;
        d = O[mt][4 * i4 + 1] * inv - lam * o1.y; O[mt][4 * i4 + 1] = d; ss += d * d;
        d = O[mt][4 * i4 + 2] * inv - lam * o1.z; O[mt][4 * i4 + 2] = d; ss += d * d;
        d = O[mt][4 * i4 + 3] * inv - lam * o1.w; O[mt][4 * i4 + 3] = d; ss += d * d;
      }
    ss = xhalf_sum(ss);
    const float rs = rsqrtf(ss * (1.f / 128.f) + EPS) * oml;
    const float* sg = p.a_subln_g + l * 128;
    int qb_e = qb;
    asm volatile("" : "+v"(qb_e));
    u16* orow = proj + (tokbase + qb_e) * PC + AQ + h * 128;
#pragma unroll
    for (int mt = 0; mt < 4; ++mt)
#pragma unroll
      for (int i4 = 0; i4 < 4; ++i4) {
        const int dv = 32 * mt + 8 * i4 + 4 * hh;
        const float4 gg = *(const float4*)(sg + dv);
        uint2 o;
        o.x = pack2(O[mt][4 * i4] * rs * gg.x, O[mt][4 * i4 + 1] * rs * gg.y);
        o.y = pack2(O[mt][4 * i4 + 2] * rs * gg.z, O[mt][4 * i4 + 3] * rs * gg.w);
        *(uint2*)(orow + dv) = o;
      }
  }
  __syncthreads();
}

DI u32 mono_key(float f) { u32 u = __float_as_uint(f); return (u & 0x80000000u) ? ~u : (u | 0x80000000u); }

constexpr int DCAP = 640;
DI u32 dsa_prune(u32* ck, u16* ci, int cnt, u32 tau_old, bool exact, int ln, int& newcnt) {
  u32 kv[10];
  u16 iv[10];
  u32 mx = 0u;
#pragma unroll
  for (int j = 0; j < 10; ++j) {
    const int pos = ln + 64 * j;
    const bool vd = pos < cnt;
    kv[j] = vd ? ck[pos] : 0u;
    iv[j] = vd ? ci[pos] : (u16)0;
    mx = max(mx, kv[j]);
  }
#pragma unroll
  for (int o = 32; o; o >>= 1) mx = max(mx, (u32)__shfl_xor((int)mx, o));
  u32 L = tau_old + 1u, H = mx + 1u;
  int curL = cnt;
  while ((exact || curL > 384) && (H - L) > 1u) {
    const u32 mid = L + ((H - L) >> 1);
    int c = 0;
#pragma unroll
    for (int j = 0; j < 10; ++j) c += __popcll(__ballot(kv[j] >= mid));
    if (c >= 256) { L = mid; curL = c; } else H = mid;
  }
  int ngt = 0;
#pragma unroll
  for (int j = 0; j < 10; ++j) ngt += __popcll(__ballot(kv[j] > L));
  const int target = (!exact && curL <= 384) ? curL : 256;
  const int need = target - ngt;
  int run_gt = 0, run_eq = 0;
#pragma unroll
  for (int j = 0; j < 10; ++j) {
    const bool gt = kv[j] > L, eq = (kv[j] == L);
    const u64 mg = __ballot(gt), me = __ballot(eq);
    const int pg = run_gt + (int)lane_lt_cnt(mg), pe = run_eq + (int)lane_lt_cnt(me);
    if (gt) { ck[pg] = kv[j]; ci[pg] = iv[j]; }
    else if (eq && pe < need) { ck[ngt + pe] = kv[j]; ci[ngt + pe] = iv[j]; }
    run_gt += __popcll(mg);
    run_eq += __popcll(me);
  }
  newcnt = target;
  return L;
}

DI void dsa_item(const Params& p, int l, int tile32, int b, char* smem) {
  const int tid = ltid(), ln = tid & 63, w = tid >> 6, hh = ln >> 5, c31 = ln & 31;
  const int t0 = tile32 * 32 + 4 * w;
  const size_t tokbase = (size_t)b * T;
  u16* QX = (u16*)p.out;
  char* wl = smem + w * 17408;
  u32* ckey = (u32*)wl;
  u16* cidx = (u16*)(wl + 10240);
  u16* ifin = (u16*)(wl + 15360);
  char* tile = wl;
  int cnt0 = 0, cnt1 = 0, cnt2 = 0, cnt3 = 0;
  {
    bf16x8 qa[4];
    {
      const int r = c31, ql = 2 * ((r >> 2) & 1) + (r & 1), hd = ((r & 3) >> 1) + 2 * (r >> 3);
      const u16* qrow = QX + (tokbase + t0 + ql) * LDQ + 1024 + hd * 64 + 8 * hh;
#pragma unroll
      for (int s = 0; s < 4; ++s) qa[s] = *(const bf16x8*)(qrow + 16 * s);
    }
    typedef float f32x2 __attribute__((ext_vector_type(2)));
    f32x2 wq2[8];
    {
      const float4* wi = (const float4*)(p.WIDX() + (tokbase + t0 + 2 * hh) * 8);
      const float4 a0 = wi[0], a1 = wi[1], b0 = wi[2], b1 = wi[3];
      wq2[0] = f32x2{a0.x, b0.x}; wq2[1] = f32x2{a0.y, b0.y}; wq2[2] = f32x2{a0.z, b0.z}; wq2[3] = f32x2{a0.w, b0.w};
      wq2[4] = f32x2{a1.x, b1.x}; wq2[5] = f32x2{a1.y, b1.y}; wq2[6] = f32x2{a1.z, b1.z}; wq2[7] = f32x2{a1.w, b1.w};
    }
    const int qpos0 = t0 + 2 * hh;
    const int nkt = ((t0 + 3) >> 5) + 1;
    const u32 lmask = (1u << c31) - 1u;
#pragma unroll 1
    for (int rep = 0; rep < DUP_DSA1; ++rep) {
    cnt0 = cnt1 = cnt2 = cnt3 = 0;
    u32 tau0 = 0u, tau1 = 0u, tau2 = 0u, tau3 = 0u;
    bf16x8 kn[4][4];
    {
#pragma unroll
      for (int t = 0; t < 4; ++t) {
        const u16* krow = p.KIDX() + (tokbase + t * 32 + c31) * 64 + 8 * hh;
#pragma unroll
        for (int s = 0; s < 4; ++s) kn[t][s] = *(const bf16x8*)(krow + 16 * s);
      }
    }
    const int ngrp = (nkt + 3) >> 2;
    for (int g = 0; g <= ngrp; ++g) {
      const int lim = (g < ngrp) ? (DCAP - 128) : 256;
      for (;;) {
        const int q = (cnt0 > lim) ? 0 : (cnt1 > lim) ? 1 : (cnt2 > lim) ? 2 : (cnt3 > lim) ? 3 : -1;
        if (q < 0) break;
        const int c = (q == 0) ? cnt0 : (q == 1) ? cnt1 : (q == 2) ? cnt2 : cnt3;
        const u32 to = (q == 0) ? tau0 : (q == 1) ? tau1 : (q == 2) ? tau2 : tau3;
        int nc;
        const u32 t = dsa_prune(ckey + q * DCAP, cidx + q * DCAP, c, to, g == ngrp, ln, nc);
        if (q == 0) { cnt0 = nc; tau0 = t; } else if (q == 1) { cnt1 = nc; tau1 = t; }
        else if (q == 2) { cnt2 = nc; tau2 = t; } else { cnt3 = nc; tau3 = t; }
      }
      if (g == ngrp) break;
      bf16x8 kc[4][4];
#pragma unroll
      for (int t = 0; t < 4; ++t)
#pragma unroll
        for (int s = 0; s < 4; ++s) kc[t][s] = kn[t][s];
      if (g + 1 < ngrp) {
#pragma unroll
        for (int t = 0; t < 4; ++t) {
          const u16* krow = p.KIDX() + (tokbase + (g + 1) * 128 + t * 32 + c31) * 64 + 8 * hh;
#pragma unroll
          for (int s = 0; s < 4; ++s) kn[t][s] = *(const bf16x8*)(krow + 16 * s);
        }
      }
      const u32 tauA = hh ? tau2 : tau0, tauB = hh ? tau3 : tau1;
#pragma unroll
      for (int t = 0; t < 4; ++t) {
        const int key = (g * 4 + t) * 32 + c31;
        f32x16 acc;
#pragma unroll
        for (int j = 0; j < 16; ++j) acc[j] = 0.f;
#pragma unroll
        for (int s = 0; s < 4; ++s) acc = mfma32(qa[s], kc[t][s], acc);
        f32x2 ss2 = f32x2{0.f, 0.f};
#pragma unroll
        for (int hq = 0; hq < 8; ++hq) {
          const f32x2 rr = f32x2{__builtin_amdgcn_fmed3f(acc[2 * hq], 0.f, 3.0e38f), __builtin_amdgcn_fmed3f(acc[2 * hq + 1], 0.f, 3.0e38f)};
          ss2 = __builtin_elementwise_fma(wq2[hq], rr, ss2);
        }
        const float s0 = ss2.x, s1 = ss2.y;
        const u32 k0 = mono_key(s0), k1 = mono_key(s1);
        const bool c0 = (key <= qpos0) && (k0 > tauA), c1 = (key <= qpos0 + 1) && (k1 > tauB);
        const u64 m0 = __ballot(c0), m1 = __ballot(c1);
        if (m0 | m1) {
          const u32 h0 = hh ? (u32)(m0 >> 32) : (u32)m0, h1 = hh ? (u32)(m1 >> 32) : (u32)m1;
          const int pA = (hh ? cnt2 : cnt0) + __popc(h0 & lmask), pB = (hh ? cnt3 : cnt1) + __popc(h1 & lmask);
          if (c0) { ckey[(2 * hh) * DCAP + pA] = k0; cidx[(2 * hh) * DCAP + pA] = (u16)key; }
          if (c1) { ckey[(2 * hh + 1) * DCAP + pB] = k1; cidx[(2 * hh + 1) * DCAP + pB] = (u16)key; }
          cnt0 += __popc((u32)m0); cnt2 += __popc((u32)(m0 >> 32));
          cnt1 += __popc((u32)m1); cnt3 += __popc((u32)(m1 >> 32));
        }
      }
    }
#pragma unroll
    for (int qq = 0; qq < 4; ++qq) {
      const int cq = (qq == 0) ? cnt0 : (qq == 1) ? cnt1 : (qq == 2) ? cnt2 : cnt3;
#pragma unroll
      for (int j = 0; j < 4; ++j) {
        const int pos = ln + 64 * j;
        ifin[qq * 256 + pos] = (pos < cq) ? cidx[qq * DCAP + pos] : (u16)0;
      }
    }
    }
  }
  const float sc = 0.125f * 1.44269504089f;
#pragma unroll 1
  for (int rep2 = 0; rep2 < DUP_DSA2; ++rep2)
#pragma unroll 1
  for (int qq = 0; qq < 4; ++qq) {
    const int nsel = (qq == 0) ? cnt0 : (qq == 1) ? cnt1 : (qq == 2) ? cnt2 : cnt3;
    const size_t tq = tokbase + t0 + qq;
    bf16x8 qf[8];
    {
      const u16* qab = QX + tq * LDQ + (c31 & 7) * 128 + 8 * hh;
#pragma unroll
      for (int s = 0; s < 8; ++s) qf[s] = *(const bf16x8*)(qab + 16 * s);
    }
    f32x16 O[4];
#pragma unroll
    for (int i = 0; i < 4; ++i)
#pragma unroll
      for (int j = 0; j < 16; ++j) O[i][j] = 0.f;
    float mrun = -INFINITY, lrun = 0.f;
    const int ntile = (nsel + 31) >> 5;
    uint4 gr0, gr1, gr2, gr3, gr4, gr5, gr6, gr7;
#define GGATHER1(i, tt_)                                                                     \
    {                                                                                        \
      const int piece = ln + 64 * i, row = piece >> 4, ch = piece & 15;                      \
      const int idx = ifin[qq * 256 + (tt_) * 32 + row];                                     \
      gr##i = *(const uint4*)(p.CKV() + (tokbase + idx) * 128 + ch * 8);                     \
    }
#define GGATHER(tt_) { GGATHER1(0, tt_) GGATHER1(1, tt_) GGATHER1(2, tt_) GGATHER1(3, tt_) GGATHER1(4, tt_) GGATHER1(5, tt_) GGATHER1(6, tt_) GGATHER1(7, tt_) }
#define GSTORE1(i) { const int piece = ln + 64 * i, row = piece >> 4, ch = piece & 15; *(uint4*)(tile + row * 272 + ch * 16) = gr##i; }
    if (ntile > 0) GGATHER(0)
    for (int tt = 0; tt < ntile; ++tt) {
      GSTORE1(0) GSTORE1(1) GSTORE1(2) GSTORE1(3) GSTORE1(4) GSTORE1(5) GSTORE1(6) GSTORE1(7)
      if (tt + 1 < ntile) GGATHER(tt + 1)
      __builtin_amdgcn_fence(__ATOMIC_RELEASE, "wavefront");
      f32x16 sa;
#pragma unroll
      for (int j = 0; j < 16; ++j) sa[j] = 0.f;
#pragma unroll
      for (int s = 0; s < 8; ++s) sa = mfma32(*(const bf16x8*)(tile + c31 * 272 + (16 * s + 8 * hh) * 2), qf[s], sa);
      float tmax = -INFINITY;
#pragma unroll
      for (int j = 0; j < 16; ++j) {
        if (tt * 32 + crow(j, hh) >= nsel) sa[j] = -INFINITY;
        tmax = fmaxf(tmax, sa[j]);
      }
      tmax = xhalf_max(tmax);
      const float mnew = fmaxf(mrun, tmax * sc);
      const float alpha = __builtin_amdgcn_exp2f(mrun - mnew);
      mrun = mnew;
      float psum = 0.f;
#pragma unroll
      for (int j = 0; j < 16; ++j) { const float pv = __builtin_amdgcn_exp2f(sa[j] * sc - mnew); sa[j] = pv; psum += pv; }
      lrun = lrun * alpha + psum;
#pragma unroll
      for (int i = 0; i < 4; ++i)
#pragma unroll
        for (int j = 0; j < 16; ++j) O[i][j] *= alpha;
#pragma unroll
      for (int s2 = 0; s2 < 2; ++s2) {
        const bf16x8 pp = pack8(sa, s2);
        bf16x8 vf[4];
        trfrag4<272>(tile, 16 * s2, ln, vf);
#pragma unroll
        for (int mt = 0; mt < 4; ++mt) O[mt] = mfma32(vf[mt], pp, O[mt]);
      }
      __builtin_amdgcn_fence(__ATOMIC_ACQ_REL, "wavefront");
    }
#undef GGATHER1
#undef GGATHER
#undef GSTORE1
    const float ltot = xhalf_sum(lrun);
    const float inv = 1.f / ltot;
    if (c31 < 8 && rep2 == DUP_DSA2 - 1) {
      u16* orow = QX + tq * LDQ + c31 * 128;
#pragma unroll
      for (int mt = 0; mt < 4; ++mt)
#pragma unroll
        for (int i4 = 0; i4 < 4; ++i4) {
          uint2 o;
          o.x = pack2(O[mt][4 * i4] * inv, O[mt][4 * i4 + 1] * inv);
          o.y = pack2(O[mt][4 * i4 + 2] * inv, O[mt][4 * i4 + 3] * inv);
          *(uint2*)(orow + 32 * mt + 8 * i4 + 4 * hh) = o;
        }
    }
  }
  __syncthreads();
}

DI void phase_prep(const Params& p, int l, char* smem) {
  if (EN_C) {
    int rt, ct;
    for (int it = 0; next_tile(it, 128, 6, 32, 2, rt, ct); ++it) qx_tile(p, l, rt, ct, smem);
  }
  const int n_gdn = EN_B ? 1024 : 0, n_kp = EN_C ? 512 : 0;
  for (int t = lbid(); t < n_gdn + n_kp; t += lgdim()) {
    if (t < n_gdn) gdn_prep_item(p, l, t, smem);
    else dsa_kprep_item(p, l, t - n_gdn);
  }
}

DI int xcc_id() { return (int)(__builtin_amdgcn_s_getreg((3 << 11) | 20) & 0x7u); }

DI void phase_mixers(const Params& p, int l, char* smem) {
  __shared__ int s_item;
  const int x0 = xcc_id();
  int xs = x0;
  for (;;) {
    __syncthreads();
    {
      int qi = l * 8 + xs;
      asm volatile("" : "+s"(qi));
      if (ltid() == 0) s_item = (int)atomicAdd(p.CNT() + qi, 1u);
    }
    __syncthreads();
    const int it = s_item;
    const int n_gdn = EN_B ? 1 : 0;
    if (it >= n_gdn + 256) {
      xs = (xs + 1) & 7;
      if (xs == x0) break;
      continue;
    }
    const int x = xs;
    if (it < n_gdn) {
#pragma unroll 1
      for (int rep = 0; rep < DUP_GDN; ++rep) gdn_rec_item(p, l, x, smem, rep == DUP_GDN - 1);
    }
    else {
      const int j = it - n_gdn, k = j >> 1;
      if ((j & 1) == 0) { if (EN_A) diff_item(p, l, 127 - k, x, smem); }
      else { if (EN_C) dsa_item(p, l, 511 - (k * 4 + (x >> 1)), x & 1, smem); }
    }
  }
}

DI void run_phase(const Params& p, int ph, char* smem) {
  if (ph == 0) { phase0(p, smem); return; }
  const int l = (ph - 1) / 9, s = (ph - 1) % 9;
  switch (s) {
    case 0: phase_inproj(p, l, smem); break;
    case 1: phase_prep(p, l, smem); break;
    case 2: phase_mixers(p, l, smem); break;
    case 3: phase_merge(p, l, smem); break;
    case 4: phase_resgemm(p, p.MERGED(), LDX, p.wo(l), KP1024, 1024, smem); break;
    case 5: ln_phase(p.out, p.ln1_g + l * 1024, p.ln1_b + l * 1024, p.XB(), nullptr); break;
    case 6: phase_ff1(p, l, smem); break;
    case 7: phase_resgemm(p, p.P(), LDH, p.wf2(l), KP4096, 4096, smem); break;
    case 8: ln_phase(p.out, p.ln2_g + l * 1024, p.ln2_b + l * 1024, (l == 1) ? nullptr : p.XB(), (l == 1) ? p.out : nullptr); break;
  }
}

constexpr int N_PHASES = 19;


DI u32 xb_ld(u32* p) { return __hip_atomic_load(p, __ATOMIC_RELAXED, __HIP_MEMORY_SCOPE_AGENT); }
DI u32 xb_add(u32* p, u32 v) { return __hip_atomic_fetch_add(p, v, __ATOMIC_RELAXED, __HIP_MEMORY_SCOPE_AGENT); }
DI void fast_sync(u32* bar, int x, const volatile int* st) {
  asm volatile("s_waitcnt vmcnt(0)" ::: "memory");
  __syncthreads();
  if (ltid() == 0) {
    __builtin_amdgcn_s_waitcnt(0);
    const u32 nloc = (u32)st[0], nx = (u32)st[1];
    const u32 old = xb_add(bar + 32 * (8 + x), 1u);
    const u32 gen = old / nloc;
    if (old + 1u == (gen + 1u) * nloc) {
      __builtin_amdgcn_fence(__ATOMIC_RELEASE, "agent");
      asm volatile("s_waitcnt vmcnt(0)" ::: "memory");
      const u32 og = xb_add(bar + 32 * 24, 1u);
      const u32 tg = og / nx;
      if (og + 1u == (tg + 1u) * nx) xb_add(bar + 32 * 25, 1u);
      else { while (xb_ld(bar + 32 * 25) == tg) __builtin_amdgcn_s_sleep(1); }
      __builtin_amdgcn_fence(__ATOMIC_ACQUIRE, "agent");
      xb_add(bar + 32 * (16 + x), 1u);
      asm volatile("s_waitcnt vmcnt(0)" ::: "memory");
    } else {
      while (xb_ld(bar + 32 * (16 + x)) == gen) __builtin_amdgcn_s_sleep(1);
      __builtin_amdgcn_fence(__ATOMIC_ACQUIRE, "agent");
      asm volatile("s_waitcnt vmcnt(0)" ::: "memory");
    }
  }
  __syncthreads();
}
#if COOP
DI void gsync() { cg::this_grid().sync(); }
__global__ void __launch_bounds__(512, 1) mega_kernel(Params p, int ph_begin, int ph_end) {
  __shared__ __attribute__((aligned(16))) char smem[SMEM_BYTES];
  __shared__ int xb_st[2];
  const int myx = xcc_id();
  if (ltid() == 0) (void)xb_add(p.BAR() + 32 * myx, 1u);
  for (int r = 0; r < REP0; ++r) { phase0(p, smem); cg::this_grid().sync(); }
  if (ltid() == 0) {
    int mine = 0, cnt = 0;
    for (int j = 0; j < 8; ++j) { const int c = (int)xb_ld(p.BAR() + 32 * j); cnt += (c > 0) ? 1 : 0; mine = (j == myx) ? c : mine; }
    xb_st[0] = mine > 0 ? mine : 1;
    xb_st[1] = cnt > 0 ? cnt : 1;
  }
  __syncthreads();
#define gsync() fast_sync(p.BAR(), myx, xb_st)
#pragma unroll 1
  for (int l = 0; l < 2; ++l) {
    for (int r = 0; r < REP1; ++r) { phase_inproj(p, l, smem); gsync(); }
    phase_prep(p, l, smem);
    gsync();
    phase_mixers(p, l, smem);
    gsync();
    for (int r = 0; r < REP2; ++r) { phase_merge(p, l, smem); gsync(); }
    for (int r = 0; r < REP3; ++r) { phase_resgemm(p, p.MERGED(), LDX, p.wo(l), KP1024, 1024, smem); gsync(); }
    for (int r = 0; r < REP4; ++r) { ln_phase(p.out, p.ln1_g + l * 1024, p.ln1_b + l * 1024, p.XB(), nullptr); gsync(); }
    for (int r = 0; r < REP5; ++r) { phase_ff1(p, l, smem); gsync(); }
    for (int r = 0; r < REP6; ++r) { phase_resgemm(p, p.P(), LDH, p.wf2(l), KP4096, 4096, smem); gsync(); }
    ln_phase(p.out, p.ln2_g + l * 1024, p.ln2_b + l * 1024, (l == 1) ? nullptr : p.XB(), (l == 1) ? p.out : nullptr);
    if (l == 0) gsync();
  }
}
#undef gsync
#else
__global__ void __launch_bounds__(512, 1) mega_kernel(Params p, int ph_begin, int ph_end) {
  __shared__ __attribute__((aligned(16))) char smem[SMEM_BYTES];
  for (int ph = ph_begin; ph < ph_end; ++ph) run_phase(p, ph, smem);
}
#endif

extern "C" void kernel_launch(void* const* d_in, const int* in_sizes, int n_in, void* d_out, int out_size,
                              void* d_ws, size_t ws_size, hipStream_t stream) {
  static int grid_blocks = 0;
  if (!grid_blocks) {
    int dev = 0, cus = 0, per_cu = 0;
    hipGetDevice(&dev);
    hipDeviceGetAttribute(&cus, hipDeviceAttributeMultiprocessorCount, dev);
    hipOccupancyMaxActiveBlocksPerMultiprocessor(&per_cu, mega_kernel, NTHR, 0);
    if (per_cu < 1) per_cu = 1;
    if (per_cu > 1) per_cu = 1;
    grid_blocks = cus * per_cu;
  }
  Params p{};
  const float** pf = (const float**)&p;
  for (int i = 0; i < 27; ++i) pf[i] = (const float*)d_in[i];
  p.out = (float*)d_out;
  p.ws = (char*)d_ws;
  if (WS_NEED > ws_size) { fprintf(stderr, "workspace too small: need %zu have %zu\n", (size_t)WS_NEED, ws_size); return; }
#if COOP
  hipMemsetAsync(p.ws + O_BAR, 0, 4096, stream);
  int b = 0, e = N_PHASES;
  void* args[] = {&p, &b, &e};
  hipError_t err = hipLaunchCooperativeKernel((void*)mega_kernel, dim3(grid_blocks), dim3(NTHR), args, 0, stream);
  if (err != hipSuccess) fprintf(stderr, "cooperative launch failed: %s (grid %d)\n", hipGetErrorString(err), grid_blocks);
#else
  for (int ph = 0; ph < N_PHASES; ++ph) mega_kernel<<<grid_blocks, NTHR, 0, stream>>>(p, ph, ph + 1);
#endif
}
```

```cpp
#include <hip/hip_runtime.h>
#include <hip/hip_cooperative_groups.h>
#include <cstdio>
namespace cg = cooperative_groups;

#ifndef COOP
#define COOP 1
#endif
#ifndef REP0
#define REP0 1
#define REP1 1
#define REP2 1
#define REP3 1
#define REP4 1
#define REP5 1
#define REP6 1
#endif
#ifndef DUP_GDN
#define DUP_GDN 1
#endif
#ifndef DUP_DIFF
#define DUP_DIFF 1
#endif
#ifndef DUP_DSA1
#define DUP_DSA1 1
#endif
#ifndef DUP_DSA2
#define DUP_DSA2 1
#endif
#ifndef EN_A
#define EN_A 1
#endif
#ifndef EN_B
#define EN_B 1
#endif
#ifndef EN_C
#define EN_C 1
#endif

typedef unsigned short u16;
typedef unsigned int u32;
typedef unsigned long long u64;
using bf16x8 = __attribute__((ext_vector_type(8))) short;
using s16x4 = __attribute__((ext_vector_type(4))) short;
using f32x4 = __attribute__((ext_vector_type(4))) float;
using f32x16 = __attribute__((ext_vector_type(16))) float;
#define DI __device__ __forceinline__

constexpr int NT = 32768, T = 16384, PC = 4048;
constexpr int AQ = 0, AK = 512, AV = 1024, BQ = 1536, BK_ = 2048, BV = 2560, BZ = 3072, BA = 3584, BB = 3588,
              CQ = 3592, CKVc = 3848, CKI = 3976, CWI = 4040, GATES = 4048;
constexpr float EPS = 1e-6f;
constexpr float DN_ALPHA = 1.41421356237f;
constexpr int NTHR = 512;
constexpr int SMEM_BYTES = 153600 + 512;

constexpr size_t al256(size_t x) { return (x + 255) & ~(size_t)255; }
constexpr int LDX = 1088, LDH = 4160, LDQ = 1600;
constexpr int KP1024 = 1088, KP512 = 576, KP256 = 320, KP4096 = 4160;
constexpr size_t SZ_WIN = al256((size_t)7120 * KP1024 * 2), SZ_WQX = al256((size_t)1536 * KP256 * 2), SZ_WBR = al256((size_t)1024 * KP512 * 2),
                 SZ_WBRC = al256((size_t)1024 * KP1024 * 2), SZ_WO = al256((size_t)1024 * KP1024 * 2), SZ_WF1 = al256((size_t)4096 * KP1024 * 2), SZ_WF2 = al256((size_t)1024 * KP4096 * 2);
constexpr size_t O_WIN = 0, O_WQX = O_WIN + SZ_WIN, O_WBRA = O_WQX + SZ_WQX, O_WBRB = O_WBRA + SZ_WBR, O_WBRC = O_WBRB + SZ_WBR,
                 O_WO = O_WBRC + SZ_WBRC, O_WF1 = O_WO + SZ_WO, O_WF2 = O_WF1 + SZ_WF1, LAYER_W = O_WF2 + SZ_WF2;
constexpr size_t O_P = 2 * LAYER_W, O_XB = O_P + (size_t)NT * LDH * 2, O_M = O_XB + (size_t)NT * LDX * 2;
constexpr size_t O_KDT = O_M, O_ATT = O_KDT + 33554432, O_HALO = O_ATT + 16777216, O_KIDX = O_HALO + 4718592, O_CKV = O_KIDX + 4194304,
                 O_MEND = O_CKV + 8388608 + 4194304;
constexpr size_t O_WIDX = O_MEND, O_GL = O_WIDX + (size_t)NT * 8 * 4, O_LAM = O_GL + 8192, O_CNT = O_LAM + 256, O_BAR = O_CNT + 256, WS_NEED = O_BAR + 4096;
static_assert(O_MEND - O_M >= (size_t)NT * LDX * 2, "merged alias");

struct Params {
  const float *x, *w_in, *b_gate, *a_lambda, *a_subln_g, *b_conv_w, *b_a_log, *b_dt_bias, *b_norm_g,
      *c_q_norm_g, *c_kv_norm_g, *c_kidx_g, *c_kidx_b, *c_w_uq, *c_w_qidx, *c_w_uk, *c_w_uv,
      *w_branch_a, *w_branch_b, *w_branch_c, *w_o, *ln1_g, *ln1_b, *w_ff1, *w_ff2, *ln2_g, *ln2_b;
  float* out;
  char* ws;
  __device__ __forceinline__ u16* win(int l) const { return (u16*)(ws + l * LAYER_W + O_WIN); }
  __device__ __forceinline__ u16* wqx(int l) const { return (u16*)(ws + l * LAYER_W + O_WQX); }
  __device__ __forceinline__ u16* wbra(int l) const { return (u16*)(ws + l * LAYER_W + O_WBRA); }
  __device__ __forceinline__ u16* wbrb(int l) const { return (u16*)(ws + l * LAYER_W + O_WBRB); }
  __device__ __forceinline__ u16* wbrc(int l) const { return (u16*)(ws + l * LAYER_W + O_WBRC); }
  __device__ __forceinline__ u16* wo(int l) const { return (u16*)(ws + l * LAYER_W + O_WO); }
  __device__ __forceinline__ u16* wf1(int l) const { return (u16*)(ws + l * LAYER_W + O_WF1); }
  __device__ __forceinline__ u16* wf2(int l) const { return (u16*)(ws + l * LAYER_W + O_WF2); }
  __device__ __forceinline__ u16* P() const { return (u16*)(ws + O_P); }
  __device__ __forceinline__ u16* XB() const { return (u16*)(ws + O_XB); }
  __device__ __forceinline__ u16* KDT() const { return (u16*)(ws + O_KDT); }
  __device__ __forceinline__ u16* ATT() const { return (u16*)(ws + O_ATT); }
  __device__ __forceinline__ u16* HALO() const { return (u16*)(ws + O_HALO); }
  __device__ __forceinline__ u16* KIDX() const { return (u16*)(ws + O_KIDX); }
  __device__ __forceinline__ u16* CKV() const { return (u16*)(ws + O_CKV); }
  __device__ __forceinline__ u16* MERGED() const { return (u16*)(ws + O_M); }
  __device__ __forceinline__ float* WIDX() const { return (float*)(ws + O_WIDX); }
  __device__ __forceinline__ float* GL() const { return (float*)(ws + O_GL); }
  __device__ __forceinline__ float* LAM() const { return (float*)(ws + O_LAM); }
  __device__ __forceinline__ u32* CNT() const { return (u32*)(ws + O_CNT); }
  __device__ __forceinline__ u32* BAR() const { return (u32*)(ws + O_BAR); }
};

DI int lbid() { int b = blockIdx.x; asm volatile("" : "+s"(b)); return b; }
DI int lgdim() { int b = gridDim.x; asm volatile("" : "+s"(b)); return b; }
DI int ltid() { int t = threadIdx.x; asm volatile("" : "+v"(t)); return t; }
DI u16 f2bf(float x) { u32 u = __float_as_uint(x); u += 0x7fffu + ((u >> 16) & 1u); return (u16)(u >> 16); }
DI float bf2f(u16 h) { return __uint_as_float(((u32)h) << 16); }
DI u32 pack2(float a, float b) { return (u32)f2bf(a) | ((u32)f2bf(b) << 16); }
DI float bflo(u32 v) { return __uint_as_float(v << 16); }
DI float bfhi(u32 v) { return __uint_as_float(v & 0xffff0000u); }
DI f32x4 mfma16(bf16x8 a, bf16x8 b, f32x4 c) { return __builtin_amdgcn_mfma_f32_16x16x32_bf16(a, b, c, 0, 0, 0); }
DI f32x16 mfma32(bf16x8 a, bf16x8 b, f32x16 c) { return __builtin_amdgcn_mfma_f32_32x32x16_bf16(a, b, c, 0, 0, 0); }
DI int crow(int i, int hh) { return (i & 3) + 8 * (i >> 2) + 4 * hh; }
DI float sigmoidf_(float x) { return 1.f / (1.f + __expf(-x)); }
DI float siluf_(float x) { return x / (1.f + __expf(-x)); }
DI float xhalf_max(float x) {
  const u32 u = __float_as_uint(x);
  const auto r = __builtin_amdgcn_permlane32_swap(u, u, false, false);
  return fmaxf(__uint_as_float(r[0]), __uint_as_float(r[1]));
}
DI float xhalf_sum(float x) {
  const u32 u = __float_as_uint(x);
  const auto r = __builtin_amdgcn_permlane32_swap(u, u, false, false);
  return __uint_as_float(r[0]) + __uint_as_float(r[1]);
}
DI u32 lane_lt_cnt(u64 m) { return __builtin_amdgcn_mbcnt_hi((u32)(m >> 32), __builtin_amdgcn_mbcnt_lo((u32)m, 0)); }

DI bf16x8 pack8(const f32x16& x, int s) {
  u32 p0, p1, p2, p3;
  if (s == 0) {
    asm volatile("v_cvt_pk_bf16_f32 %0, %4, %5\n\tv_cvt_pk_bf16_f32 %1, %6, %7\n\tv_cvt_pk_bf16_f32 %2, %8, %9\n\tv_cvt_pk_bf16_f32 %3, %10, %11\n\ts_nop 1"
                 : "=&v"(p0), "=&v"(p1), "=&v"(p2), "=&v"(p3)
                 : "v"(x[0]), "v"(x[1]), "v"(x[2]), "v"(x[3]), "v"(x[4]), "v"(x[5]), "v"(x[6]), "v"(x[7]));
  } else {
    asm volatile("v_cvt_pk_bf16_f32 %0, %4, %5\n\tv_cvt_pk_bf16_f32 %1, %6, %7\n\tv_cvt_pk_bf16_f32 %2, %8, %9\n\tv_cvt_pk_bf16_f32 %3, %10, %11\n\ts_nop 1"
                 : "=&v"(p0), "=&v"(p1), "=&v"(p2), "=&v"(p3)
                 : "v"(x[8]), "v"(x[9]), "v"(x[10]), "v"(x[11]), "v"(x[12]), "v"(x[13]), "v"(x[14]), "v"(x[15]));
  }
  typedef u32 u32x4 __attribute__((ext_vector_type(4)));
  u32x4 v = {p0, p1, p2, p3};
  return __builtin_bit_cast(bf16x8, v);
}
DI bf16x8 afrag_perm(const char* base, int row, int stride, int kbase, int hh) {
  const char* pr = base + row * stride + (kbase + 4 * hh) * 2;
  s16x4 lo = *(const s16x4*)pr;
  s16x4 hi = *(const s16x4*)(pr + 16);
  return __builtin_shufflevector(lo, hi, 0, 1, 2, 3, 4, 5, 6, 7);
}
DI bf16x8 trfrag(const char* img, int stride, int krow0, int col0, int ln) {
  const int hh = ln >> 5, chalf = (ln >> 4) & 1, q4 = (ln & 15) >> 2, p4 = ln & 3;
  u32 a = (u32)(size_t)(img + (krow0 + 4 * hh + q4) * stride + (col0 + 16 * chalf + 4 * p4) * 2);
  s16x4 lo, hi;
  asm volatile("ds_read_b64_tr_b16 %0, %2\n\tds_read_b64_tr_b16 %1, %3\n\ts_waitcnt lgkmcnt(0)"
               : "=&v"(lo), "=&v"(hi) : "v"(a), "v"(a + 8 * stride) : "memory");
  return __builtin_shufflevector(lo, hi, 0, 1, 2, 3, 4, 5, 6, 7);
}

template <int STRIDE>
DI void trfrag4(const char* img, int krow0, int ln, bf16x8 (&f)[4]) {
  const int hh = ln >> 5, chalf = (ln >> 4) & 1, q4 = (ln & 15) >> 2, p4 = ln & 3;
  const u32 a = (u32)(size_t)(img + (krow0 + 4 * hh + q4) * STRIDE + (16 * chalf + 4 * p4) * 2);
  s16x4 l0, h0, l1, h1, l2, h2, l3, h3;
  asm volatile(
      "ds_read_b64_tr_b16 %0, %8\n\tds_read_b64_tr_b16 %1, %8 offset:%9\n\t"
      "ds_read_b64_tr_b16 %2, %8 offset:64\n\tds_read_b64_tr_b16 %3, %8 offset:%10\n\t"
      "ds_read_b64_tr_b16 %4, %8 offset:128\n\tds_read_b64_tr_b16 %5, %8 offset:%11\n\t"
      "ds_read_b64_tr_b16 %6, %8 offset:192\n\tds_read_b64_tr_b16 %7, %8 offset:%12\n\t"
      "s_waitcnt lgkmcnt(0)"
      : "=&v"(l0), "=&v"(h0), "=&v"(l1), "=&v"(h1), "=&v"(l2), "=&v"(h2), "=&v"(l3), "=&v"(h3)
      : "v"(a), "i"(8 * STRIDE), "i"(8 * STRIDE + 64), "i"(8 * STRIDE + 128), "i"(8 * STRIDE + 192)
      : "memory");
  f[0] = __builtin_shufflevector(l0, h0, 0, 1, 2, 3, 4, 5, 6, 7);
  f[1] = __builtin_shufflevector(l1, h1, 0, 1, 2, 3, 4, 5, 6, 7);
  f[2] = __builtin_shufflevector(l2, h2, 0, 1, 2, 3, 4, 5, 6, 7);
  f[3] = __builtin_shufflevector(l3, h3, 0, 1, 2, 3, 4, 5, 6, 7);
}

template <int MT, int NT>
DI void gemm_core(const u16* __restrict__ A, int lda, const u16* __restrict__ B, int ldb, int K,
                  f32x4 (&acc)[MT][NT], char* smem) {
  constexpr int BM = 64 * MT, BN = 32 * NT;
  constexpr int ASZ = BM * 128, BSZ = BN * 128, BUF = ASZ + BSZ;
  constexpr int NA = BM / 64, NB = BN / 64;
  const int tid = ltid(), l = tid & 63, w = tid >> 6, wm = w >> 1, wn = w & 1;
  const int fr = l & 15, fq = l >> 4;
  uint4 ra0, ra1, ra2, ra3, rb0, rb1, rb2, rb3;
  const int nk = K >> 6;
  const int srow = tid >> 3, sch = tid & 7;
  const int ssw = sch ^ ((srow >> 1) & 7);
  const int fsw = (fr >> 1) & 7;
#define GL1(i, kt)                                                                                        \
  if (NA > i) ra##i = *(const uint4*)(A + (size_t)(srow + 64 * i) * lda + (kt) * 64 + sch * 8);           \
  if (NB > i) rb##i = *(const uint4*)(B + (size_t)(srow + 64 * i) * ldb + (kt) * 64 + sch * 8);
#define GLOAD(kt) { GL1(0, kt) GL1(1, kt) GL1(2, kt) GL1(3, kt) }
#define SS1(i)                                                                   \
  if (NA > i) *(uint4*)(as_ + (srow + 64 * i) * 128 + ssw * 16) = ra##i;         \
  if (NB > i) *(uint4*)(bs_ + (srow + 64 * i) * 128 + ssw * 16) = rb##i;
#define SSTORE(buf)                              \
  {                                              \
    char* as_ = smem + (buf) * BUF;              \
    char* bs_ = as_ + ASZ;                       \
    SS1(0) SS1(1) SS1(2) SS1(3)                  \
  }
  GLOAD(0);
  SSTORE(0);
  GLOAD(((1 < nk) ? 1 : 0));
#pragma unroll 1
  for (int kt = 0; kt < nk; ++kt) {
    __syncthreads();
    SSTORE((kt + 1) & 1);
    { const int kn_ = (kt + 2 < nk) ? kt + 2 : nk - 1; GLOAD(kn_); }
    const char* as = smem + (kt & 1) * BUF;
    const char* bs = as + ASZ;
#pragma unroll
    for (int kk = 0; kk < 2; ++kk) {
      bf16x8 xf[MT], wf[NT];
#pragma unroll
      for (int mi = 0; mi < MT; ++mi)
        xf[mi] = *(const bf16x8*)(as + (wm * (MT * 16) + mi * 16 + fr) * 128 + (((kk * 4 + fq) ^ fsw) * 16));
#pragma unroll
      for (int ni = 0; ni < NT; ++ni)
        wf[ni] = *(const bf16x8*)(bs + (wn * (NT * 16) + ni * 16 + fr) * 128 + (((kk * 4 + fq) ^ fsw) * 16));
      __builtin_amdgcn_s_setprio(1);
#pragma unroll
      for (int mi = 0; mi < MT; ++mi)
#pragma unroll
        for (int ni = 0; ni < NT; ++ni) acc[mi][ni] = mfma16(wf[ni], xf[mi], acc[mi][ni]);
      __builtin_amdgcn_s_setprio(0);
    }
  }
  __syncthreads();
#undef GLOAD
#undef SSTORE
#undef GL1
#undef SS1
}
template <int MT, int NT>
DI void zero_acc(f32x4 (&acc)[MT][NT]) {
#pragma unroll
  for (int i = 0; i < MT; ++i)
#pragma unroll
    for (int j = 0; j < NT; ++j) acc[i][j] = f32x4{0.f, 0.f, 0.f, 0.f};
}


DI bool next_tile(int it, int RT, int CT, int PR, int PCc, int& rt, int& ct) {
  const int bid = lbid(), x = bid & 7, j = bid >> 3, J = lgdim() >> 3;
  const int u = j + it * J;
  const int pcols = CT / PCc, npatch = (RT / PR) * pcols;
  const int pid = (u >> 6) * 8 + x;
  if (pid >= npatch) return false;
  const int w = u & 63, pr = pid / pcols, pc = pid - pr * pcols;
  rt = pr * PR + w / PCc;
  ct = pc * PCc + w % PCc;
  return true;
}
DI void transpose_job(const float* __restrict__ src, int K, int N, u16* __restrict__ dst, int ldd, const float* kscale, char* smem) {
  float(*tile)[65] = (float(*)[65])smem;
  const int ntn = (N + 63) >> 6, ntk = K >> 6, tid = ltid();
  for (int t = lbid(); t < ntn * ntk; t += lgdim()) {
    const int tk = t / ntn, tn = t % ntn, k0 = tk * 64, n0 = tn * 64;
    {
      const int n = tid & 63, kb = tid >> 6;
      for (int i = 0; i < 8; ++i) {
        const int k = kb + 8 * i;
        float v = (n0 + n < N) ? src[(size_t)(k0 + k) * N + n0 + n] : 0.f;
        if (kscale) v *= kscale[k0 + k];
        tile[k][n] = v;
      }
    }
    __syncthreads();
    {
      const int n = tid >> 3, kc = tid & 7;
      if (n0 + n < N) {
        uint4 o;
        o.x = pack2(tile[kc * 8 + 0][n], tile[kc * 8 + 1][n]); o.y = pack2(tile[kc * 8 + 2][n], tile[kc * 8 + 3][n]);
        o.z = pack2(tile[kc * 8 + 4][n], tile[kc * 8 + 5][n]); o.w = pack2(tile[kc * 8 + 6][n], tile[kc * 8 + 7][n]);
        *(uint4*)(dst + (size_t)(n0 + n) * ldd + k0 + kc * 8) = o;
      }
    }
    __syncthreads();
  }
}

DI void phase0(const Params& p, char* smem) {
  const size_t gtid = (size_t)lbid() * NTHR + ltid(), gsz = (size_t)lgdim() * NTHR;
  for (int l = 0; l < 2; ++l) {
    transpose_job(p.w_in + (size_t)l * 1024 * 7120, 1024, 7120, p.win(l), KP1024, nullptr, smem);
    transpose_job(p.w_branch_a + (size_t)l * 512 * 1024, 512, 1024, p.wbra(l), KP512, nullptr, smem);
    transpose_job(p.w_branch_b + (size_t)l * 512 * 1024, 512, 1024, p.wbrb(l), KP512, nullptr, smem);
    transpose_job(p.w_o + (size_t)l * 1024 * 1024, 1024, 1024, p.wo(l), KP1024, nullptr, smem);
    transpose_job(p.w_ff1 + (size_t)l * 1024 * 4096, 1024, 4096, p.wf1(l), KP1024, nullptr, smem);
    transpose_job(p.w_ff2 + (size_t)l * 4096 * 1024, 4096, 1024, p.wf2(l), KP4096, nullptr, smem);
    transpose_job(p.c_w_qidx + (size_t)l * 256 * 512, 256, 512, p.wqx(l) + 1024 * KP256, KP256, p.c_q_norm_g + l * 256, smem);
    {
      const float* uq = p.c_w_uq + (size_t)l * 256 * 512;
      const float* uk = p.c_w_uk + (size_t)l * 128 * 512;
      const float* g = p.c_q_norm_g + l * 256;
      for (size_t e = gtid; e < 1024 * 256; e += gsz) {
        const int n = (int)(e >> 8), k = (int)(e & 255), h = n >> 7, r2 = n & 127;
        const float4* a = (const float4*)(uq + (k * 8 + h) * 64);
        const float4* b = (const float4*)(uk + (r2 * 8 + h) * 64);
        float s = 0.f;
        for (int d = 0; d < 16; ++d) { float4 x = a[d], y = b[d]; s += x.x * y.x + x.y * y.y + x.z * y.z + x.w * y.w; }
        p.wqx(l)[(size_t)n * KP256 + k] = f2bf(s * g[k]);
      }
    }
    {
      const float* uv = p.c_w_uv + (size_t)l * 128 * 512;
      const float* bc = p.w_branch_c + (size_t)l * 512 * 1024;
      for (size_t e = gtid; e < 1024 * 256; e += gsz) {
        const int k = (int)(e >> 8), n4 = (int)(e & 255) * 4, h = k >> 7, r = k & 127;
        const float* a = uv + (r * 8 + h) * 64;
        const float* b = bc + (size_t)(h * 64) * 1024 + n4;
        float4 acc4 = float4{0.f, 0.f, 0.f, 0.f};
#pragma unroll 8
        for (int d = 0; d < 64; ++d) {
          const float4 v = *(const float4*)(b + (size_t)d * 1024);
          const float ad = a[d];
          acc4.x += ad * v.x; acc4.y += ad * v.y; acc4.z += ad * v.z; acc4.w += ad * v.w;
        }
        u16* dst = p.wbrc(l) + (size_t)n4 * KP1024 + k;
        dst[0] = f2bf(acc4.x); dst[KP1024] = f2bf(acc4.y); dst[2 * KP1024] = f2bf(acc4.z); dst[3 * KP1024] = f2bf(acc4.w);
      }
    }
  }
  for (size_t e = gtid; e < (size_t)NT * 1024 / 8; e += gsz) {
    const float4 a = ((const float4*)p.x)[2 * e], b = ((const float4*)p.x)[2 * e + 1];
    uint4 o;
    o.x = pack2(a.x, a.y); o.y = pack2(a.z, a.w); o.z = pack2(b.x, b.y); o.w = pack2(b.z, b.w);
    *(uint4*)(p.XB() + (e >> 7) * LDX + (e & 127) * 8) = o;
  }
  if (gtid < 2) {
    const int l = (int)gtid;
    const float* lp = p.a_lambda + l * 256;
    float s1 = 0.f, s2 = 0.f;
    for (int i = 0; i < 64; ++i) { s1 += lp[i] * lp[64 + i]; s2 += lp[128 + i] * lp[192 + i]; }
    const float lam_init = 0.8f - 0.6f * expf(-0.3f * l);
    p.LAM()[l] = expf(s1) - expf(s2) + lam_init;
    p.LAM()[2 + l] = lam_init;
    for (int i = 0; i < 8; ++i) p.CNT()[l * 8 + i] = 0;
  }
}

DI void ln_phase(const float* S, const float* __restrict__ g, const float* __restrict__ b, u16* XBo, float* fout) {
  const int l = ltid() & 63;
  const int wave = lbid() * 8 + (ltid() >> 6), nw = lgdim() * 8;
  for (int row = wave; row < NT; row += nw) {
    float4 v[4];
    float s = 0.f;
#pragma unroll
    for (int i = 0; i < 4; ++i) { v[i] = *(const float4*)(S + (size_t)row * 1024 + i * 256 + l * 4); s += v[i].x + v[i].y + v[i].z + v[i].w; }
#pragma unroll
    for (int o = 32; o; o >>= 1) s += __shfl_xor(s, o);
    const float mu = s * (1.f / 1024.f);
    float q = 0.f;
#pragma unroll
    for (int i = 0; i < 4; ++i) { float a = v[i].x - mu, bb = v[i].y - mu, c = v[i].z - mu, d = v[i].w - mu; q += a * a + bb * bb + c * c + d * d; }
#pragma unroll
    for (int o = 32; o; o >>= 1) q += __shfl_xor(q, o);
    const float rs = rsqrtf(q * (1.f / 1024.f) + EPS);
#pragma unroll
    for (int i = 0; i < 4; ++i) {
      const int c = i * 256 + l * 4;
      const float4 gg = *(const float4*)(g + c), bb = *(const float4*)(b + c);
      float4 y;
      y.x = (v[i].x - mu) * rs * gg.x + bb.x; y.y = (v[i].y - mu) * rs * gg.y + bb.y;
      y.z = (v[i].z - mu) * rs * gg.z + bb.z; y.w = (v[i].w - mu) * rs * gg.w + bb.w;
      if (fout) *(float4*)(fout + (size_t)row * 1024 + c) = y;
      if (XBo) { uint2 o; o.x = pack2(y.x, y.y); o.y = pack2(y.z, y.w); *(uint2*)(XBo + (size_t)row * LDX + c) = o; }
    }
  }
}

#define EPI_LOOP(MT_, NT_)                                                \
  const int l_ = ltid() & 63, w_ = ltid() >> 6;                           \
  const int wm_ = w_ >> 1, wn_ = w_ & 1, fr_ = l_ & 15, fq_ = l_ >> 4;    \
  _Pragma("unroll") for (int mi = 0; mi < MT_; ++mi)                      \
  _Pragma("unroll") for (int ni = 0; ni < NT_; ++ni)

DI void phase_inproj(const Params& p, int l, char* smem) {
  int rt, ct;
  for (int it = 0; next_tile(it, 128, 16, 8, 8, rt, ct); ++it) {
    const int r0 = rt * 256, c0 = ct * 256;
    f32x4 acc[4][8];
    zero_acc<4, 8>(acc);
    gemm_core<4, 8>(p.XB() + (size_t)r0 * LDX, LDX, p.win(l) + (size_t)c0 * KP1024, KP1024, 1024, acc, smem);
    EPI_LOOP(4, 8) {
      const int row = r0 + wm_ * 64 + mi * 16 + fr_, col = c0 + wn_ * 128 + ni * 16 + fq_ * 4;
      if (col < PC) {
        uint2 o;
        o.x = pack2(acc[mi][ni][0], acc[mi][ni][1]); o.y = pack2(acc[mi][ni][2], acc[mi][ni][3]);
        *(uint2*)(p.P() + (size_t)row * PC + col) = o;
        if (col >= BQ && col < BZ && (row & 63) >= 61)
          *(uint2*)(p.HALO() + ((size_t)(row >> 6) * 3 + ((row & 63) - 61)) * 1536 + (col - BQ)) = o;
      }
    }
  }
}

DI void qx_tile(const Params& p, int l, int rt, int ct, char* smem) {
  const int r0 = rt * 256, c0 = ct * 256;
  float* rsv = (float*)(smem + 147456);
  {
    const int row = ltid() >> 1, half = ltid() & 1;
    const uint4* src = (const uint4*)(p.P() + (size_t)(r0 + row) * PC + CQ + half * 128);
    float ss = 0.f;
    for (int i = 0; i < 16; ++i) {
      uint4 v = src[i];
      float a;
      a = bflo(v.x); ss += a * a; a = bfhi(v.x); ss += a * a; a = bflo(v.y); ss += a * a; a = bfhi(v.y); ss += a * a;
      a = bflo(v.z); ss += a * a; a = bfhi(v.z); ss += a * a; a = bflo(v.w); ss += a * a; a = bfhi(v.w); ss += a * a;
    }
    ss += __shfl_xor(ss, 1);
    if (!half) rsv[row] = rsqrtf(ss * (1.f / 256.f) + EPS);
  }
  f32x4 acc[4][8];
  zero_acc<4, 8>(acc);
  gemm_core<4, 8>(p.P() + (size_t)r0 * PC + CQ, PC, p.wqx(l) + (size_t)c0 * KP256, KP256, 256, acc, smem);
  u16* QX = (u16*)p.out;
  EPI_LOOP(4, 8) {
    const int rl = wm_ * 64 + mi * 16 + fr_, col = c0 + wn_ * 128 + ni * 16 + fq_ * 4;
    const float rs = rsv[rl];
    uint2 o;
    o.x = pack2(acc[mi][ni][0] * rs, acc[mi][ni][1] * rs); o.y = pack2(acc[mi][ni][2] * rs, acc[mi][ni][3] * rs);
    *(uint2*)(QX + (size_t)(r0 + rl) * LDQ + col) = o;
  }
  __syncthreads();
}

DI void phase_merge(const Params& p, int l, char* smem) {
  const u16* QX = (const u16*)p.out;
  int rt, ct;
  for (int it = 0; next_tile(it, 128, 8, 8, 8, rt, ct); ++it) {
    const int r0 = rt * 256, c0 = ct * 128;
    bool first = true;
#pragma unroll 1
    for (int j = 0; j < 3; ++j) {
      if ((j == 0 && !EN_A) || (j == 1 && !EN_B) || (j == 2 && !EN_C)) continue;
      const u16* Ab; const u16* Wb; int lda, K;
      int ldw;
      if (j == 0) { Ab = p.P() + (size_t)r0 * PC + AQ; lda = PC; Wb = p.wbra(l) + (size_t)c0 * KP512; K = 512; ldw = KP512; }
      else if (j == 1) { Ab = p.P() + (size_t)r0 * PC + BZ; lda = PC; Wb = p.wbrb(l) + (size_t)c0 * KP512; K = 512; ldw = KP512; }
      else { Ab = QX + (size_t)r0 * LDQ; lda = LDQ; Wb = p.wbrc(l) + (size_t)c0 * KP1024; K = 1024; ldw = KP1024; }
      f32x4 g[4][4];
      zero_acc<4, 4>(g);
      gemm_core<4, 4>(p.XB() + (size_t)r0 * LDX, LDX, p.win(l) + (size_t)(GATES + j * 1024 + c0) * KP1024, KP1024, 1024, g, smem);
      const float* bg = p.b_gate + l * 3072 + j * 1024;
      {
        EPI_LOOP(4, 4) {
          const int col = c0 + wn_ * 64 + ni * 16 + fq_ * 4;
          const float4 bb = *(const float4*)(bg + col);
          g[mi][ni][0] = sigmoidf_(g[mi][ni][0] + bb.x);
          g[mi][ni][1] = sigmoidf_(g[mi][ni][1] + bb.y);
          g[mi][ni][2] = sigmoidf_(g[mi][ni][2] + bb.z);
          g[mi][ni][3] = sigmoidf_(g[mi][ni][3] + bb.w);
        }
      }
      f32x4 br[4][4];
      zero_acc<4, 4>(br);
      gemm_core<4, 4>(Ab, lda, Wb, ldw, K, br, smem);
      {
        EPI_LOOP(4, 4) {
          const int row = r0 + wm_ * 64 + mi * 16 + fr_, col = c0 + wn_ * 64 + ni * 16 + fq_ * 4;
          u16* mp = p.MERGED() + (size_t)row * LDX + col;
          float a0 = g[mi][ni][0] * br[mi][ni][0], a1 = g[mi][ni][1] * br[mi][ni][1];
          float a2 = g[mi][ni][2] * br[mi][ni][2], a3 = g[mi][ni][3] * br[mi][ni][3];
          if (!first) {
            const uint2 old = *(const uint2*)mp;
            a0 += bflo(old.x); a1 += bfhi(old.x); a2 += bflo(old.y); a3 += bfhi(old.y);
          }
          uint2 o;
          o.x = pack2(a0, a1); o.y = pack2(a2, a3);
          *(uint2*)mp = o;
        }
      }
      first = false;
    }
  }
}

DI void phase_resgemm(const Params& p, const u16* A, int lda, const u16* W, int ldw, int K, char* smem) {
  int rt, ct;
  for (int it = 0; next_tile(it, 128, 4, 16, 4, rt, ct); ++it) {
    const int r0 = rt * 256, c0 = ct * 256;
    f32x4 acc[4][8];
    zero_acc<4, 8>(acc);
    gemm_core<4, 8>(A + (size_t)r0 * lda, lda, W + (size_t)c0 * ldw, ldw, K, acc, smem);
    EPI_LOOP(4, 8) {
      const int row = r0 + wm_ * 64 + mi * 16 + fr_, col = c0 + wn_ * 128 + ni * 16 + fq_ * 4;
      const uint2 xb = *(const uint2*)(p.XB() + (size_t)row * LDX + col);
      float4 o;
      o.x = DN_ALPHA * bflo(xb.x) + acc[mi][ni][0]; o.y = DN_ALPHA * bfhi(xb.x) + acc[mi][ni][1];
      o.z = DN_ALPHA * bflo(xb.y) + acc[mi][ni][2]; o.w = DN_ALPHA * bfhi(xb.y) + acc[mi][ni][3];
      *(float4*)(p.out + (size_t)row * 1024 + col) = o;
    }
  }
}

DI void phase_ff1(const Params& p, int l, char* smem) {
  int rt, ct;
  for (int it = 0; next_tile(it, 128, 16, 8, 8, rt, ct); ++it) {
    const int r0 = rt * 256, c0 = ct * 256;
    f32x4 acc[4][8];
    zero_acc<4, 8>(acc);
    gemm_core<4, 8>(p.XB() + (size_t)r0 * LDX, LDX, p.wf1(l) + (size_t)c0 * KP1024, KP1024, 1024, acc, smem);
    EPI_LOOP(4, 8) {
      const int row = r0 + wm_ * 64 + mi * 16 + fr_, col = c0 + wn_ * 128 + ni * 16 + fq_ * 4;
      float a0 = fmaxf(acc[mi][ni][0], 0.f), a1 = fmaxf(acc[mi][ni][1], 0.f), a2 = fmaxf(acc[mi][ni][2], 0.f), a3 = fmaxf(acc[mi][ni][3], 0.f);
      uint2 o;
      o.x = pack2(a0 * a0, a1 * a1); o.y = pack2(a2 * a2, a3 * a3);
      *(uint2*)(p.P() + (size_t)row * LDH + col) = o;
    }
  }
}

DI void dsa_kprep_item(const Params& p, int l, int it) {
  const int ln = ltid() & 63, w = ltid() >> 6;
  const float g0 = p.c_kv_norm_g[l * 128 + 2 * ln], g1 = p.c_kv_norm_g[l * 128 + 2 * ln + 1];
  const float kg = p.c_kidx_g[l * 64 + ln], kb = p.c_kidx_b[l * 64 + ln];
  for (int i = 0; i < 8; ++i) {
    const size_t tok = (size_t)it * 64 + w * 8 + i;
    const u16* pr = p.P() + tok * PC;
    const u32 v = *(const u32*)(pr + CKVc + 2 * ln);
    const float a = bflo(v), b = bfhi(v);
    float ss = a * a + b * b;
#pragma unroll
    for (int o = 32; o; o >>= 1) ss += __shfl_xor(ss, o);
    const float rs = rsqrtf(ss * (1.f / 128.f) + EPS);
    *(u32*)(p.CKV() + tok * 128 + 2 * ln) = pack2(a * rs * g0, b * rs * g1);
    const float k = bf2f(pr[CKI + ln]);
    float s = k;
#pragma unroll
    for (int o = 32; o; o >>= 1) s += __shfl_xor(s, o);
    const float mu = s * (1.f / 64.f);
    float q = (k - mu) * (k - mu);
#pragma unroll
    for (int o = 32; o; o >>= 1) q += __shfl_xor(q, o);
    p.KIDX()[tok * 64 + ln] = f2bf((k - mu) * rsqrtf(q * (1.f / 64.f) + EPS) * kg + kb);
    if (ln < 8) p.WIDX()[tok * 8 + ln] = bf2f(pr[CWI + ln]) * 0.04419417382f;
  }
}

DI void gdn_prep_item(const Params& p, int l, int it, char* smem0) {
  const int half_ = ltid() >> 8;
  const int cidx = it >> 1, h = (it & 1) * 2 + half_, n = cidx & 255;
  const size_t t0g = (size_t)cidx * 64;
  char* smem = smem0 + half_ * 69632;
  const int tid = ltid() & 255, ln = tid & 63, w = tid >> 6;
  char* qs = smem;
  char* ks = smem + 17408;
  char* vs = smem + 2 * 17408;
  float* Lm = (float*)(smem + 3 * 17408);
  float* gcs = Lm + 4096;
  float* bts = gcs + 64;
  float* egs = bts + 64;
  u16* proj = p.P();
  {
    const int c = tid & 127, rh = tid >> 7;
    uint4 st[12];
#pragma unroll
    for (int part = 0; part < 3; ++part)
#pragma unroll
      for (int i = 0; i < 4; ++i) {
        const int piece = tid + 256 * i, row = piece >> 4, ch = piece & 15;
        st[part * 4 + i] = *(const uint4*)(proj + (t0g + row) * PC + BQ + part * 512 + h * 128 + ch * 8);
      }
    float hx[9];
#pragma unroll
    for (int i = 0; i < 9; ++i) hx[i] = 0.f;
    if (rh == 0 && n != 0) {
#pragma unroll
      for (int part = 0; part < 3; ++part) {
        const u16* hp = p.HALO() + ((size_t)(cidx - 1) * 3) * 1536 + part * 512 + h * 128 + c;
        hx[part * 3 + 0] = bf2f(hp[0]); hx[part * 3 + 1] = bf2f(hp[1536]); hx[part * 3 + 2] = bf2f(hp[2 * 1536]);
      }
    }
#pragma unroll
    for (int part = 0; part < 3; ++part)
#pragma unroll
      for (int i = 0; i < 4; ++i) {
        const int piece = tid + 256 * i, row = piece >> 4, ch = piece & 15;
        char* dst = (part == 0 ? qs : (part == 1 ? ks : vs));
        *(uint4*)(dst + row * 272 + ch * 16) = st[part * 4 + i];
      }
    __syncthreads();
    if (rh == 1) {
#pragma unroll
      for (int part = 0; part < 3; ++part) {
        const char* src = (part == 0 ? qs : (part == 1 ? ks : vs));
        hx[part * 3 + 0] = bf2f(*(const u16*)(src + 29 * 272 + c * 2));
        hx[part * 3 + 1] = bf2f(*(const u16*)(src + 30 * 272 + c * 2));
        hx[part * 3 + 2] = bf2f(*(const u16*)(src + 31 * 272 + c * 2));
      }
    }
    __syncthreads();
#pragma unroll
    for (int part = 0; part < 3; ++part) {
      const int wch = part * 512 + h * 128 + c;
      const float* cw = p.b_conv_w + (size_t)l * 4 * 1536 + wch;
      const float w0 = cw[0], w1 = cw[1536], w2 = cw[2 * 1536], w3 = cw[3 * 1536];
      float xm3 = hx[part * 3 + 0], xm2 = hx[part * 3 + 1], xm1 = hx[part * 3 + 2];
      char* dst = (part == 0 ? qs : (part == 1 ? ks : vs));
#pragma unroll 8
      for (int i = 0; i < 32; ++i) {
        const int r = rh * 32 + i;
        u16* px = (u16*)(dst + r * 272 + c * 2);
        const float x = bf2f(*px);
        const float y = w0 * xm3 + w1 * xm2 + w2 * xm1 + w3 * x;
        xm3 = xm2; xm2 = xm1; xm1 = x;
        *px = f2bf(siluf_(y));
      }
    }
  }
  if (w == 0) {
    const float a = bf2f(proj[(t0g + ln) * PC + BA + h]) + p.b_dt_bias[l * 4 + h];
    const float ea = __expf(a);
    const float sp = (a > 20.f) ? a : ((ea < 0.01f) ? ea * (1.f - ea * (0.5f - ea * 0.333333333f)) : __logf(1.f + ea));
    float g = -__expf(p.b_a_log[l * 4 + h]) * sp;
#pragma unroll
    for (int o = 1; o < 64; o <<= 1) { float t = __shfl_up(g, o); if (ln >= o) g += t; }
    gcs[ln] = g;
    egs[ln] = __expf(g);
    bts[ln] = sigmoidf_(bf2f(proj[(t0g + ln) * PC + BB + h]));
  }
  __syncthreads();
  {
    const int row = tid >> 2, qr = tid & 3;
#pragma unroll
    for (int part = 0; part < 2; ++part) {
      char* base = (part == 0 ? qs : ks) + row * 272 + qr * 64;
      uint4 v[4];
      float ss = 0.f;
#pragma unroll
      for (int i = 0; i < 4; ++i) {
        v[i] = *(uint4*)(base + i * 16);
        float a;
        a = bflo(v[i].x); ss += a * a; a = bfhi(v[i].x); ss += a * a; a = bflo(v[i].y); ss += a * a; a = bfhi(v[i].y); ss += a * a;
        a = bflo(v[i].z); ss += a * a; a = bfhi(v[i].z); ss += a * a; a = bflo(v[i].w); ss += a * a; a = bfhi(v[i].w); ss += a * a;
      }
      ss += __shfl_xor(ss, 1);
      ss += __shfl_xor(ss, 2);
      const float rs = rsqrtf(ss + EPS) * (part == 0 ? 0.08838834764f : 1.f);
#pragma unroll
      for (int i = 0; i < 4; ++i) {
        uint4 o;
        o.x = pack2(bflo(v[i].x) * rs, bfhi(v[i].x) * rs); o.y = pack2(bflo(v[i].y) * rs, bfhi(v[i].y) * rs);
        o.z = pack2(bflo(v[i].z) * rs, bfhi(v[i].z) * rs); o.w = pack2(bflo(v[i].w) * rs, bfhi(v[i].w) * rs);
        *(uint4*)(base + i * 16) = o;
      }
    }
  }
  __syncthreads();
  {
    const int fr = ln & 15, fq = ln >> 4;
    f32x4 kk[4], qk[4];
#pragma unroll
    for (int nt = 0; nt < 4; ++nt) { kk[nt] = f32x4{0, 0, 0, 0}; qk[nt] = f32x4{0, 0, 0, 0}; }
#pragma unroll
    for (int s = 0; s < 4; ++s) {
      const bf16x8 ak = *(const bf16x8*)(ks + (16 * w + fr) * 272 + (32 * s + 8 * fq) * 2);
      const bf16x8 aq = *(const bf16x8*)(qs + (16 * w + fr) * 272 + (32 * s + 8 * fq) * 2);
#pragma unroll
      for (int nt = 0; nt < 4; ++nt) {
        const bf16x8 bk = *(const bf16x8*)(ks + (16 * nt + fr) * 272 + (32 * s + 8 * fq) * 2);
        kk[nt] = mfma16(ak, bk, kk[nt]);
        qk[nt] = mfma16(aq, bk, qk[nt]);
      }
    }
#pragma unroll
    for (int nt = 0; nt < 4; ++nt)
#pragma unroll
      for (int jj = 0; jj < 4; ++jj) {
        const int i = 16 * w + 4 * fq + jj, j = 16 * nt + fr;
        const float dec = (i >= j) ? __expf(gcs[i] - gcs[j]) : 0.f;
        Lm[i * 64 + j] = (i > j) ? bts[i] * kk[nt][jj] * dec : 0.f;
        p.ATT()[(t0g + i) * 256 + h * 64 + j] = f2bf((i >= j) ? qk[nt][jj] * dec : 0.f);
      }
  }
  __syncthreads();
  {
    const int c = tid;
    const bool isu = c < 128;
    const char* src = isu ? (vs + c * 2) : (ks + (c - 128) * 2);
    const float wsel = isu ? 0.f : 1.f;
    float x[64];
#pragma unroll
    for (int i = 0; i < 64; ++i) {
      float a = bf2f(*(const u16*)(src + i * 272)) * bts[i] * fmaf(egs[i] - 1.f, wsel, 1.f);
      const float* Lr = Lm + i * 64;
#pragma unroll
      for (int j = 0; j < i; ++j) a -= Lr[j] * x[j];
      x[i] = a;
      asm volatile("" ::: "memory");
    }
    if (isu) {
      u32 pk[32];
#pragma unroll
      for (int pos = 0; pos < 64; pos += 2) {
        const int hh = pos >> 5, Tt = (pos >> 4) & 1, ii = pos & 15;
        const int r0 = 32 * Tt + (ii & 3) + 8 * (ii >> 2) + 4 * hh;
        const int i1 = ii + 1;
        const int r1 = 32 * Tt + (i1 & 3) + 8 * (i1 >> 2) + 4 * hh;
        pk[pos >> 1] = pack2(x[r0], x[r1]);
      }
      char* dst = (char*)proj + ((t0g + (c >> 1)) * PC + BV + h * 128) * 2 + (c & 1) * 128;
#pragma unroll
      for (int i = 0; i < 8; ++i) *(uint4*)(dst + i * 16) = uint4{pk[4 * i], pk[4 * i + 1], pk[4 * i + 2], pk[4 * i + 3]};
    } else {
#pragma unroll
      for (int i = 0; i < 64; ++i) proj[(t0g + i) * PC + BK_ + h * 128 + (c - 128)] = f2bf(x[i]);
    }
  }
  {
    const float glast = gcs[63];
#pragma unroll
    for (int i = 0; i < 4; ++i) {
      const int piece = tid + 256 * i, row = piece >> 4, ch = piece & 15;
      const uint4 v = *(const uint4*)(qs + row * 272 + ch * 16);
      const float e = egs[row];
      uint4 o;
      o.x = pack2(bflo(v.x) * e, bfhi(v.x) * e); o.y = pack2(bflo(v.y) * e, bfhi(v.y) * e);
      o.z = pack2(bflo(v.z) * e, bfhi(v.z) * e); o.w = pack2(bflo(v.w) * e, bfhi(v.w) * e);
      *(uint4*)(proj + (t0g + row) * PC + BQ + h * 128 + ch * 8) = o;
    }
    const int d = tid & 127, half = tid >> 7;
    u32 pk[16];
#pragma unroll
    for (int i = 0; i < 16; ++i) {
      const int r0 = half * 32 + 2 * i;
      const float a = bf2f(*(const u16*)(ks + r0 * 272 + d * 2)) * __expf(glast - gcs[r0]);
      const float b = bf2f(*(const u16*)(ks + (r0 + 1) * 272 + d * 2)) * __expf(glast - gcs[r0 + 1]);
      pk[i] = pack2(a, b);
    }
    u16* dst = p.KDT() + (((size_t)cidx * 4 + h) * 128 + d) * 64 + half * 32;
#pragma unroll
    for (int i = 0; i < 4; ++i) *(uint4*)(dst + i * 8) = uint4{pk[4 * i], pk[4 * i + 1], pk[4 * i + 2], pk[4 * i + 3]};
    if (tid == 0) p.GL()[cidx * 4 + h] = egs[63];
  }
  __syncthreads();
}

DI void gdn_rec_item(const Params& p, int l, int bh, char* smem, bool wr) {
  const int b = bh >> 2, h = bh & 3;
  const int tid = ltid(), ln = tid & 63, w = tid >> 6, hh = ln >> 5, c31 = ln & 31;
  const bool is_comp = w < 4;
  constexpr int BUFB = 59904;
  float* Ot = (float*)(smem + 2 * BUFB);
  u16* proj = p.P();
  const float* ng = p.b_norm_g + l * 128;
  const int lt = tid & 255;
#define LD_AQ(i, n_)                                                                                      \
  {                                                                                                       \
    const size_t t0g_ = ((size_t)b * 256 + (n_)) * 64;                                                    \
    const int piece = ltv + 256 * i, row = piece >> 4, ch = piece & 15;                                   \
    la##i = *(const uint4*)(proj + (t0g_ + row) * PC + BK_ + h * 128 + ch * 8);                           \
    lq##i = *(const uint4*)(proj + (t0g_ + row) * PC + BQ + h * 128 + ch * 8);                            \
  }
#define LD_K(i, n_)                                                                                       \
  {                                                                                                       \
    const int piece = ltv + 256 * i, row2 = piece >> 3, ch2 = piece & 7;                                  \
    lk##i = *(const uint4*)(p.KDT() + ((((size_t)b * 256 + (n_)) * 4 + h) * 128 + row2) * 64 + ch2 * 8);  \
  }
#define LD_T(i, n_)                                                                                       \
  {                                                                                                       \
    const size_t t0g_ = ((size_t)b * 256 + (n_)) * 64;                                                    \
    const int piece = ltv + 256 * i, row = piece >> 3, ch = piece & 7;                                     \
    lt##i = *(const uint4*)(p.ATT() + (t0g_ + row) * 256 + h * 64 + ch * 8);                              \
  }
#define LD_R1(n_) { LD_AQ(0, n_) LD_AQ(1, n_) LD_AQ(2, n_) LD_AQ(3, n_) }
#define LD_R2(n_) { LD_K(0, n_) LD_K(1, n_) LD_K(2, n_) LD_K(3, n_) LD_T(0, n_) LD_T(1, n_) }
#define ST_AQ(i, buf_)                                                                                    \
  {                                                                                                       \
    char* Wm_ = smem + (buf_) * BUFB; char* Qd_ = Wm_ + 16896;                                            \
    const int piece = ltv + 256 * i, row = piece >> 4, ch = piece & 15;                                   \
    *(uint2*)(Wm_ + row * 264 + ch * 16) = uint2{la##i.x, la##i.y}; *(uint2*)(Wm_ + row * 264 + ch * 16 + 8) = uint2{la##i.z, la##i.w}; \
    *(uint2*)(Qd_ + row * 264 + ch * 16) = uint2{lq##i.x, lq##i.y}; *(uint2*)(Qd_ + row * 264 + ch * 16 + 8) = uint2{lq##i.z, lq##i.w}; \
  }
#define ST_K(i, buf_)                                                                                     \
  {                                                                                                       \
    char* Kt_ = smem + (buf_) * BUFB + 2 * 16896;                                                         \
    const int piece = ltv + 256 * i, row2 = piece >> 3, ch2 = piece & 7;                                  \
    *(uint2*)(Kt_ + row2 * 136 + ch2 * 16) = uint2{lk##i.x, lk##i.y}; *(uint2*)(Kt_ + row2 * 136 + ch2 * 16 + 8) = uint2{lk##i.z, lk##i.w}; \
  }
#define ST_T(i, buf_)                                                                                     \
  {                                                                                                       \
    char* At_ = smem + (buf_) * BUFB + 2 * 16896 + 17408;                                                 \
    const int piece = ltv + 256 * i, row = piece >> 3, ch = piece & 7;                                     \
    *(uint2*)(At_ + row * 136 + ch * 16) = uint2{lt##i.x, lt##i.y}; *(uint2*)(At_ + row * 136 + ch * 16 + 8) = uint2{lt##i.z, lt##i.w}; \
  }
#define ST_R1(buf_) { ST_AQ(0, buf_) ST_AQ(1, buf_) ST_AQ(2, buf_) ST_AQ(3, buf_) }
#define ST_R2(buf_) { ST_K(0, buf_) ST_K(1, buf_) ST_K(2, buf_) ST_K(3, buf_) ST_T(0, buf_) ST_T(1, buf_) }
#define LD_Z(n_)                                                                                          \
  {                                                                                                       \
    const u16* zp_ = proj + (((size_t)b * 256 + (n_)) * 64 + nrow) * PC + BZ + h * 128 + nqr * 32;        \
    lz0 = *(const uint4*)(zp_); lz1 = *(const uint4*)(zp_ + 8); lz2 = *(const uint4*)(zp_ + 16); lz3 = *(const uint4*)(zp_ + 24); \
  }
  f32x16 S[4];
#pragma unroll
  for (int i = 0; i < 4; ++i)
#pragma unroll
    for (int j = 0; j < 16; ++j) S[i][j] = 0.f;
  const int e = 32 * w + c31;
  uint4 un0, un1, un2, un3;
  float gln = 0.f;
#define LD_U(n_)                                                                                          \
  {                                                                                                       \
    const uint4* up_ = (const uint4*)((const char*)proj + ((((size_t)b * 256 + (n_)) * 64 + (e >> 1)) * PC + BV + h * 128) * 2 + (e & 1) * 128 + hh * 64); \
    un0 = up_[0]; un1 = up_[1]; un2 = up_[2]; un3 = up_[3];                                               \
    gln = p.GL()[((size_t)b * 256 + (n_)) * 4 + h];                                                       \
  }
  if (!is_comp) {
    const int ltv = lt;
    uint4 la0, la1, la2, la3, lq0, lq1, lq2, lq3, lk0, lk1, lk2, lk3, lt0, lt1;
    LD_R1(0) LD_R2(0)
    ST_R1(0) ST_R2(0)
  } else {
    LD_U(0)
  }
  for (int n = 0; n < 256; ++n) {
    f32x16 o[2];
    __syncthreads();
    if (is_comp) {
      int lnv = ln;
      asm volatile("" : "+v"(lnv));
      const int hh = lnv >> 5, c31 = lnv & 31;
      const char* Wm = smem + (n & 1) * BUFB;
      const char* Qd = Wm + 16896;
      const char* Kt = Wm + 2 * 16896;
      const char* At = Kt + 17408;
      f32x16 ws[2];
#pragma unroll
      for (int i = 0; i < 2; ++i)
#pragma unroll
        for (int j = 0; j < 16; ++j) { ws[i][j] = 0.f; o[i][j] = 0.f; }
#pragma unroll
      for (int Tt = 0; Tt < 4; ++Tt)
#pragma unroll
        for (int s = 0; s < 2; ++s) {
          const int kb = 32 * Tt + 16 * s;
          const bf16x8 sps = pack8(S[Tt], s);
#pragma unroll
          for (int Tc = 0; Tc < 2; ++Tc) {
            ws[Tc] = mfma32(afrag_perm(Wm, 32 * Tc + c31, 264, kb, hh), sps, ws[Tc]);
            o[Tc] = mfma32(afrag_perm(Qd, 32 * Tc + c31, 264, kb, hh), sps, o[Tc]);
          }
        }
      f32x16 vn[2];
      vn[0][0] = bflo(un0.x) - ws[0][0]; vn[0][1] = bfhi(un0.x) - ws[0][1]; vn[0][2] = bflo(un0.y) - ws[0][2]; vn[0][3] = bfhi(un0.y) - ws[0][3];
      vn[0][4] = bflo(un0.z) - ws[0][4]; vn[0][5] = bfhi(un0.z) - ws[0][5]; vn[0][6] = bflo(un0.w) - ws[0][6]; vn[0][7] = bfhi(un0.w) - ws[0][7];
      vn[0][8] = bflo(un1.x) - ws[0][8]; vn[0][9] = bfhi(un1.x) - ws[0][9]; vn[0][10] = bflo(un1.y) - ws[0][10]; vn[0][11] = bfhi(un1.y) - ws[0][11];
      vn[0][12] = bflo(un1.z) - ws[0][12]; vn[0][13] = bfhi(un1.z) - ws[0][13]; vn[0][14] = bflo(un1.w) - ws[0][14]; vn[0][15] = bfhi(un1.w) - ws[0][15];
      vn[1][0] = bflo(un2.x) - ws[1][0]; vn[1][1] = bfhi(un2.x) - ws[1][1]; vn[1][2] = bflo(un2.y) - ws[1][2]; vn[1][3] = bfhi(un2.y) - ws[1][3];
      vn[1][4] = bflo(un2.z) - ws[1][4]; vn[1][5] = bfhi(un2.z) - ws[1][5]; vn[1][6] = bflo(un2.w) - ws[1][6]; vn[1][7] = bfhi(un2.w) - ws[1][7];
      vn[1][8] = bflo(un3.x) - ws[1][8]; vn[1][9] = bfhi(un3.x) - ws[1][9]; vn[1][10] = bflo(un3.y) - ws[1][10]; vn[1][11] = bfhi(un3.y) - ws[1][11];
      vn[1][12] = bflo(un3.z) - ws[1][12]; vn[1][13] = bfhi(un3.z) - ws[1][13]; vn[1][14] = bflo(un3.w) - ws[1][14]; vn[1][15] = bfhi(un3.w) - ws[1][15];
      const float gl = gln;
      if (n + 1 < 256) LD_U(n + 1)
      bf16x8 vp[2][2];
#pragma unroll
      for (int Tc = 0; Tc < 2; ++Tc) { vp[Tc][0] = pack8(vn[Tc], 0); vp[Tc][1] = pack8(vn[Tc], 1); }
#pragma unroll
      for (int s = 0; s < 2; ++s) {
        o[0] = mfma32(afrag_perm(At, c31, 136, 16 * s, hh), vp[0][s], o[0]);
        o[1] = mfma32(afrag_perm(At, 32 + c31, 136, 16 * s, hh), vp[0][s], o[1]);
        o[1] = mfma32(afrag_perm(At, 32 + c31, 136, 32 + 16 * s, hh), vp[1][s], o[1]);
      }
#pragma unroll
      for (int Tt = 0; Tt < 4; ++Tt)
#pragma unroll
        for (int j = 0; j < 16; ++j) S[Tt][j] *= gl;
#pragma unroll
      for (int Tc = 0; Tc < 2; ++Tc)
#pragma unroll
        for (int s = 0; s < 2; ++s)
#pragma unroll
          for (int Tt = 0; Tt < 4; ++Tt)
            S[Tt] = mfma32(afrag_perm(Kt, 32 * Tt + c31, 136, 32 * Tc + 16 * s, hh), vp[Tc][s], S[Tt]);
    } else {
      int ltv = lt;
      asm volatile("" : "+v"(ltv));
      const int nrow = ltv >> 2, nqr = ltv & 3;
      const int nn = (n + 1 < 256) ? n + 1 : 255;
      {
        uint4 la0, la1, la2, la3, lq0, lq1, lq2, lq3;
        LD_R1(nn)
        ST_R1((n + 1) & 1)
      }
      uint4 lz0, lz1, lz2, lz3;
      {
        uint4 lk0, lk1, lk2, lk3, lt0, lt1;
        LD_R2(nn)
        const int nz = (n > 0) ? n - 1 : 0;
        LD_Z(nz)
        ST_R2((n + 1) & 1)
      }
      if (n > 0) {
        const float* orow = Ot + nrow * 132 + nqr * 32;
        float ss = 0.f;
#pragma unroll
        for (int i = 0; i < 8; ++i) {
          const float4 v = *(const float4*)(orow + 4 * i);
          ss += v.x * v.x + v.y * v.y + v.z * v.z + v.w * v.w;
        }
        ss += __shfl_xor(ss, 1);
        ss += __shfl_xor(ss, 2);
        const float rs = rsqrtf(ss * (1.f / 128.f) + EPS);
        u16* zp = proj + (((size_t)b * 256 + (n - 1)) * 64 + nrow) * PC + BZ + h * 128 + nqr * 32;
        const float* gg = ng + nqr * 32;
#define GN1(i, Z)                                                                                          \
        {                                                                                                  \
          const float4 oa = *(const float4*)(orow + 8 * i), ob = *(const float4*)(orow + 8 * i + 4);       \
          uint4 r;                                                                                         \
          r.x = pack2(oa.x * rs * gg[8 * i + 0] * siluf_(bflo(Z.x)), oa.y * rs * gg[8 * i + 1] * siluf_(bfhi(Z.x))); \
          r.y = pack2(oa.z * rs * gg[8 * i + 2] * siluf_(bflo(Z.y)), oa.w * rs * gg[8 * i + 3] * siluf_(bfhi(Z.y))); \
          r.z = pack2(ob.x * rs * gg[8 * i + 4] * siluf_(bflo(Z.z)), ob.y * rs * gg[8 * i + 5] * siluf_(bfhi(Z.z))); \
          r.w = pack2(ob.z * rs * gg[8 * i + 6] * siluf_(bflo(Z.w)), ob.w * rs * gg[8 * i + 7] * siluf_(bfhi(Z.w))); \
          if (wr) *(uint4*)(zp + 8 * i) = r;                                                               \
        }
        GN1(0, lz0) GN1(1, lz1) GN1(2, lz2) GN1(3, lz3)
      }
    }
    __syncthreads();
    if (is_comp) {
#pragma unroll
      for (int Tc = 0; Tc < 2; ++Tc)
#pragma unroll
        for (int j = 0; j < 16; ++j) Ot[(32 * Tc + crow(j, hh)) * 132 + e] = o[Tc][j];
    }
  }
  __syncthreads();
  if (!is_comp) {
    const int n = 256;
    const int nrow = lt >> 2, nqr = lt & 3;
    uint4 lz0, lz1, lz2, lz3;
    LD_Z(255)
    const float* orow = Ot + nrow * 132 + nqr * 32;
    float ss = 0.f;
#pragma unroll
    for (int i = 0; i < 8; ++i) {
      const float4 v = *(const float4*)(orow + 4 * i);
      ss += v.x * v.x + v.y * v.y + v.z * v.z + v.w * v.w;
    }
    ss += __shfl_xor(ss, 1);
    ss += __shfl_xor(ss, 2);
    const float rs = rsqrtf(ss * (1.f / 128.f) + EPS);
    u16* zp = proj + (((size_t)b * 256 + (n - 1)) * 64 + nrow) * PC + BZ + h * 128 + nqr * 32;
    const float* gg = ng + nqr * 32;
    GN1(0, lz0) GN1(1, lz1) GN1(2, lz2) GN1(3, lz3)
  }
#undef GN1
#undef LD_AQ
#undef LD_K
#undef LD_R1
#undef LD_R2
#undef LD_T
#undef ST_AQ
#undef ST_K
#undef ST_R1
#undef ST_R2
#undef ST_T
#undef LD_Z
#undef LD_U
  __syncthreads();
}

DI void diff_item(const Params& p, int l, int qt, int bh, char* smem) {
  const int b = bh >> 2, h = bh & 3;
  const int tid = ltid(), ln = tid & 63, w = tid >> 6, hh = ln >> 5, c31 = ln & 31;
  const int st = w & 3, c = w >> 2;
  const size_t tokbase = (size_t)b * T;
  const int qb = qt * 128 + 32 * st + c31;
  u16* proj = p.P();
  bf16x8 qf[4];
  {
    const u16* qrow = proj + (tokbase + qb) * PC + AQ + h * 128 + c * 64 + 8 * hh;
#pragma unroll
    for (int s = 0; s < 4; ++s) qf[s] = *(const bf16x8*)(qrow + 16 * s);
  }
  f32x16 O[4];
  float mrun, lrun;
  const float sc = 0.125f * 1.44269504089f;
  char* Ks = smem;
  char* Vs = smem + 17408;
  uint4 rk0, rk1, rv0, rv1;
  const int srow = tid >> 4, sch = tid & 15;
#define DLOAD1(i, kt)                                                                \
  {                                                                                  \
    const u16* base = proj + (tokbase + (kt) * 64 + srow + 32 * i) * PC + h * 128 + sch * 8; \
    rk##i = *(const uint4*)(base + AK);                                              \
    rv##i = *(const uint4*)(base + AV);                                              \
  }
#define DLOAD(kt) { DLOAD1(0, kt) DLOAD1(1, kt) }
#define DSTORE1(i)                                                \
  *(uint4*)(Ks + (srow + 32 * i) * 272 + sch * 16) = rk##i;       \
  *(uint4*)(Vs + (srow + 32 * i) * 320 + sch * 16) = rv##i;
  const int nkt = 2 * qt + 2;
#pragma unroll 1
  for (int rep = 0; rep < DUP_DIFF; ++rep) {
#pragma unroll
  for (int i = 0; i < 4; ++i)
#pragma unroll
    for (int j = 0; j < 16; ++j) O[i][j] = 0.f;
  mrun = -INFINITY; lrun = 0.f;
  DLOAD(0);
  for (int kt = 0; kt < nkt; ++kt) {
    __syncthreads();
    DSTORE1(0) DSTORE1(1)
    __syncthreads();
    if (kt + 1 < nkt) { DLOAD(kt + 1); }
    if (kt * 64 > qt * 128 + 32 * st + 31) continue;
    f32x16 sa[2];
#pragma unroll
    for (int k2 = 0; k2 < 2; ++k2) {
#pragma unroll
      for (int j = 0; j < 16; ++j) sa[k2][j] = 0.f;
#pragma unroll
      for (int s = 0; s < 4; ++s)
        sa[k2] = mfma32(*(const bf16x8*)(Ks + (32 * k2 + c31) * 272 + (c * 64 + 16 * s + 8 * hh) * 2), qf[s], sa[k2]);
    }
    if (kt >= 2 * qt) {
#pragma unroll
      for (int k2 = 0; k2 < 2; ++k2)
#pragma unroll
        for (int j = 0; j < 16; ++j)
          if (kt * 64 + 32 * k2 + crow(j, hh) > qb) sa[k2][j] = -INFINITY;
    }
    float tmax = sa[0][0];
#pragma unroll
    for (int k2 = 0; k2 < 2; ++k2)
#pragma unroll
      for (int j = 0; j < 16; ++j) tmax = fmaxf(tmax, sa[k2][j]);
    tmax = xhalf_max(tmax);
    const float cand = tmax * sc;
    if (__any(cand > mrun + 8.f)) {
      const float mnew = fmaxf(mrun, cand);
      const float alpha = __builtin_amdgcn_exp2f(mrun - mnew);
      mrun = mnew;
      lrun *= alpha;
#pragma unroll
      for (int i = 0; i < 4; ++i)
#pragma unroll
        for (int j = 0; j < 16; ++j) O[i][j] *= alpha;
    }
    float psum = 0.f;
#pragma unroll
    for (int k2 = 0; k2 < 2; ++k2)
#pragma unroll
      for (int j = 0; j < 16; ++j) { const float pv = __builtin_amdgcn_exp2f(sa[k2][j] * sc - mrun); sa[k2][j] = pv; psum += pv; }
    lrun += psum;
#pragma unroll
    for (int k2 = 0; k2 < 2; ++k2)
#pragma unroll
      for (int s2 = 0; s2 < 2; ++s2) {
        const bf16x8 pp = pack8(sa[k2], s2);
        bf16x8 vf[4];
        trfrag4<320>(Vs, 32 * k2 + 16 * s2, ln, vf);
#pragma unroll
        for (int mt = 0; mt < 4; ++mt) O[mt] = mfma32(vf[mt], pp, O[mt]);
      }
  }
  }
#undef DLOAD
#undef DLOAD1
#undef DSTORE1
  __syncthreads();
  const float ltot = xhalf_sum(lrun);
  const float inv = 1.f / ltot;
  float* xch = (float*)smem + st * 32 * 132;
  if (c == 1) {
#pragma unroll
    for (int mt = 0; mt < 4; ++mt)
#pragma unroll
      for (int i4 = 0; i4 < 4; ++i4)
        *(float4*)(xch + c31 * 132 + 32 * mt + 8 * i4 + 4 * hh) =
            float4{O[mt][4 * i4] * inv, O[mt][4 * i4 + 1] * inv, O[mt][4 * i4 + 2] * inv, O[mt][4 * i4 + 3] * inv};
  }
  __syncthreads();
  if (c == 0) {
    const float lam = p.LAM()[l], oml = 1.f - p.LAM()[2 + l];
    float ss = 0.f;
#pragma unroll
    for (int mt = 0; mt < 4; ++mt)
#pragma unroll
      for (int i4 = 0; i4 < 4; ++i4) {
        const float4 o1 = *(const float4*)(xch + c31 * 132 + 32 * mt + 8 * i4 + 4 * hh);
        float d;
        d = O[mt][4 * i4] * inv - lam * o1.x; O[mt][4 * i4] = d; ss += d * d;
        d = O[mt][4 * i4 + 1] * inv - lam * o1.y; O[mt][4 * i4 + 1] = d; ss += d * d;
        d = O[mt][4 * i4 + 2] * inv - lam * o1.z; O[mt][4 * i4 + 2] = d; ss += d * d;
        d = O[mt][4 * i4 + 3] * inv - lam * o1.w; O[mt][4 * i4 + 3] = d; ss += d * d;
      }
    ss = xhalf_sum(ss);
    const float rs = rsqrtf(ss * (1.f / 128.f) + EPS) * oml;
    const float* sg = p.a_subln_g + l * 128;
    int qb_e = qb;
    asm volatile("" : "+v"(qb_e));
    u16* orow = proj + (tokbase + qb_e) * PC + AQ + h * 128;
#pragma unroll
    for (int mt = 0; mt < 4; ++mt)
#pragma unroll
      for (int i4 = 0; i4 < 4; ++i4) {
        const int dv = 32 * mt + 8 * i4 + 4 * hh;
        const float4 gg = *(const float4*)(sg + dv);
        uint2 o;
        o.x = pack2(O[mt][4 * i4] * rs * gg.x, O[mt][4 * i4 + 1] * rs * gg.y);
        o.y = pack2(O[mt][4 * i4 + 2] * rs * gg.z, O[mt][4 * i4 + 3] * rs * gg.w);
        *(uint2*)(orow + dv) = o;
      }
  }
  __syncthreads();
}

DI u32 mono_key(float f) { u32 u = __float_as_uint(f); return (u & 0x80000000u) ? ~u : (u | 0x80000000u); }

constexpr int DCAP = 640;
DI u32 dsa_prune(u32* ck, u16* ci, int cnt, u32 tau_old, bool exact, int ln, int& newcnt) {
  u32 kv[10];
  u16 iv[10];
  u32 mx = 0u;
#pragma unroll
  for (int j = 0; j < 10; ++j) {
    const int pos = ln + 64 * j;
    const bool vd = pos < cnt;
    kv[j] = vd ? ck[pos] : 0u;
    iv[j] = vd ? ci[pos] : (u16)0;
    mx = max(mx, kv[j]);
  }
#pragma unroll
  for (int o = 32; o; o >>= 1) mx = max(mx, (u32)__shfl_xor((int)mx, o));
  u32 L = tau_old + 1u, H = mx + 1u;
  int curL = cnt;
  while ((exact || curL > 384) && (H - L) > 1u) {
    const u32 mid = L + ((H - L) >> 1);
    int c = 0;
#pragma unroll
    for (int j = 0; j < 10; ++j) c += __popcll(__ballot(kv[j] >= mid));
    if (c >= 256) { L = mid; curL = c; } else H = mid;
  }
  int ngt = 0;
#pragma unroll
  for (int j = 0; j < 10; ++j) ngt += __popcll(__ballot(kv[j] > L));
  const int target = (!exact && curL <= 384) ? curL : 256;
  const int need = target - ngt;
  int run_gt = 0, run_eq = 0;
#pragma unroll
  for (int j = 0; j < 10; ++j) {
    const bool gt = kv[j] > L, eq = (kv[j] == L);
    const u64 mg = __ballot(gt), me = __ballot(eq);
    const int pg = run_gt + (int)lane_lt_cnt(mg), pe = run_eq + (int)lane_lt_cnt(me);
    if (gt) { ck[pg] = kv[j]; ci[pg] = iv[j]; }
    else if (eq && pe < need) { ck[ngt + pe] = kv[j]; ci[ngt + pe] = iv[j]; }
    run_gt += __popcll(mg);
    run_eq += __popcll(me);
  }
  newcnt = target;
  return L;
}

DI void dsa_item(const Params& p, int l, int tile32, int b, char* smem) {
  const int tid = ltid(), ln = tid & 63, w = tid >> 6, hh = ln >> 5, c31 = ln & 31;
  const int t0 = tile32 * 32 + 4 * w;
  const size_t tokbase = (size_t)b * T;
  u16* QX = (u16*)p.out;
  char* wl = smem + w * 17408;
  u32* ckey = (u32*)wl;
  u16* cidx = (u16*)(wl + 10240);
  u16* ifin = (u16*)(wl + 15360);
  char* tile = wl;
  int cnt0 = 0, cnt1 = 0, cnt2 = 0, cnt3 = 0;
  {
    bf16x8 qa[4];
    {
      const int r = c31, ql = 2 * ((r >> 2) & 1) + (r & 1), hd = ((r & 3) >> 1) + 2 * (r >> 3);
      const u16* qrow = QX + (tokbase + t0 + ql) * LDQ + 1024 + hd * 64 + 8 * hh;
#pragma unroll
      for (int s = 0; s < 4; ++s) qa[s] = *(const bf16x8*)(qrow + 16 * s);
    }
    typedef float f32x2 __attribute__((ext_vector_type(2)));
    f32x2 wq2[8];
    {
      const float4* wi = (const float4*)(p.WIDX() + (tokbase + t0 + 2 * hh) * 8);
      const float4 a0 = wi[0], a1 = wi[1], b0 = wi[2], b1 = wi[3];
      wq2[0] = f32x2{a0.x, b0.x}; wq2[1] = f32x2{a0.y, b0.y}; wq2[2] = f32x2{a0.z, b0.z}; wq2[3] = f32x2{a0.w, b0.w};
      wq2[4] = f32x2{a1.x, b1.x}; wq2[5] = f32x2{a1.y, b1.y}; wq2[6] = f32x2{a1.z, b1.z}; wq2[7] = f32x2{a1.w, b1.w};
    }
    const int qpos0 = t0 + 2 * hh;
    const int nkt = ((t0 + 3) >> 5) + 1;
    const u32 lmask = (1u << c31) - 1u;
#pragma unroll 1
    for (int rep = 0; rep < DUP_DSA1; ++rep) {
    cnt0 = cnt1 = cnt2 = cnt3 = 0;
    u32 tau0 = 0u, tau1 = 0u, tau2 = 0u, tau3 = 0u;
    bf16x8 kn[4][4];
    {
#pragma unroll
      for (int t = 0; t < 4; ++t) {
        const u16* krow = p.KIDX() + (tokbase + t * 32 + c31) * 64 + 8 * hh;
#pragma unroll
        for (int s = 0; s < 4; ++s) kn[t][s] = *(const bf16x8*)(krow + 16 * s);
      }
    }
    const int ngrp = (nkt + 3) >> 2;
    for (int g = 0; g <= ngrp; ++g) {
      const int lim = (g < ngrp) ? (DCAP - 128) : 256;
      for (;;) {
        const int q = (cnt0 > lim) ? 0 : (cnt1 > lim) ? 1 : (cnt2 > lim) ? 2 : (cnt3 > lim) ? 3 : -1;
        if (q < 0) break;
        const int c = (q == 0) ? cnt0 : (q == 1) ? cnt1 : (q == 2) ? cnt2 : cnt3;
        const u32 to = (q == 0) ? tau0 : (q == 1) ? tau1 : (q == 2) ? tau2 : tau3;
        int nc;
        const u32 t = dsa_prune(ckey + q * DCAP, cidx + q * DCAP, c, to, g == ngrp, ln, nc);
        if (q == 0) { cnt0 = nc; tau0 = t; } else if (q == 1) { cnt1 = nc; tau1 = t; }
        else if (q == 2) { cnt2 = nc; tau2 = t; } else { cnt3 = nc; tau3 = t; }
      }
      if (g == ngrp) break;
      bf16x8 kc[4][4];
#pragma unroll
      for (int t = 0; t < 4; ++t)
#pragma unroll
        for (int s = 0; s < 4; ++s) kc[t][s] = kn[t][s];
      if (g + 1 < ngrp) {
#pragma unroll
        for (int t = 0; t < 4; ++t) {
          const u16* krow = p.KIDX() + (tokbase + (g + 1) * 128 + t * 32 + c31) * 64 + 8 * hh;
#pragma unroll
          for (int s = 0; s < 4; ++s) kn[t][s] = *(const bf16x8*)(krow + 16 * s);
        }
      }
      const u32 tauA = hh ? tau2 : tau0, tauB = hh ? tau3 : tau1;
#pragma unroll
      for (int t = 0; t < 4; ++t) {
        const int key = (g * 4 + t) * 32 + c31;
        f32x16 acc;
#pragma unroll
        for (int j = 0; j < 16; ++j) acc[j] = 0.f;
#pragma unroll
        for (int s = 0; s < 4; ++s) acc = mfma32(qa[s], kc[t][s], acc);
        f32x2 ss2 = f32x2{0.f, 0.f};
#pragma unroll
        for (int hq = 0; hq < 8; ++hq) {
          const f32x2 rr = f32x2{__builtin_amdgcn_fmed3f(acc[2 * hq], 0.f, 3.0e38f), __builtin_amdgcn_fmed3f(acc[2 * hq + 1], 0.f, 3.0e38f)};
          ss2 = __builtin_elementwise_fma(wq2[hq], rr, ss2);
        }
        const float s0 = ss2.x, s1 = ss2.y;
        const u32 k0 = mono_key(s0), k1 = mono_key(s1);
        const bool c0 = (key <= qpos0) && (k0 > tauA), c1 = (key <= qpos0 + 1) && (k1 > tauB);
        const u64 m0 = __ballot(c0), m1 = __ballot(c1);
        if (m0 | m1) {
          const u32 h0 = hh ? (u32)(m0 >> 32) : (u32)m0, h1 = hh ? (u32)(m1 >> 32) : (u32)m1;
          const int pA = (hh ? cnt2 : cnt0) + __popc(h0 & lmask), pB = (hh ? cnt3 : cnt1) + __popc(h1 & lmask);
          if (c0) { ckey[(2 * hh) * DCAP + pA] = k0; cidx[(2 * hh) * DCAP + pA] = (u16)key; }
          if (c1) { ckey[(2 * hh + 1) * DCAP + pB] = k1; cidx[(2 * hh + 1) * DCAP + pB] = (u16)key; }
          cnt0 += __popc((u32)m0); cnt2 += __popc((u32)(m0 >> 32));
          cnt1 += __popc((u32)m1); cnt3 += __popc((u32)(m1 >> 32));
        }
      }
    }
#pragma unroll
    for (int qq = 0; qq < 4; ++qq) {
      const int cq = (qq == 0) ? cnt0 : (qq == 1) ? cnt1 : (qq == 2) ? cnt2 : cnt3;
#pragma unroll
      for (int j = 0; j < 4; ++j) {
        const int pos = ln + 64 * j;
        ifin[qq * 256 + pos] = (pos < cq) ? cidx[qq * DCAP + pos] : (u16)0;
      }
    }
    }
  }
  const float sc = 0.125f * 1.44269504089f;
#pragma unroll 1
  for (int rep2 = 0; rep2 < DUP_DSA2; ++rep2)
#pragma unroll 1
  for (int qq = 0; qq < 4; ++qq) {
    const int nsel = (qq == 0) ? cnt0 : (qq == 1) ? cnt1 : (qq == 2) ? cnt2 : cnt3;
    const size_t tq = tokbase + t0 + qq;
    bf16x8 qf[8];
    {
      const u16* qab = QX + tq * LDQ + (c31 & 7) * 128 + 8 * hh;
#pragma unroll
      for (int s = 0; s < 8; ++s) qf[s] = *(const bf16x8*)(qab + 16 * s);
    }
    f32x16 O[4];
#pragma unroll
    for (int i = 0; i < 4; ++i)
#pragma unroll
      for (int j = 0; j < 16; ++j) O[i][j] = 0.f;
    float mrun = -INFINITY, lrun = 0.f;
    const int ntile = (nsel + 31) >> 5;
    uint4 gr0, gr1, gr2, gr3, gr4, gr5, gr6, gr7;
#define GGATHER1(i, tt_)                                                                     \
    {                                                                                        \
      const int piece = ln + 64 * i, row = piece >> 4, ch = piece & 15;                      \
      const int idx = ifin[qq * 256 + (tt_) * 32 + row];                                     \
      gr##i = *(const uint4*)(p.CKV() + (tokbase + idx) * 128 + ch * 8);                     \
    }
#define GGATHER(tt_) { GGATHER1(0, tt_) GGATHER1(1, tt_) GGATHER1(2, tt_) GGATHER1(3, tt_) GGATHER1(4, tt_) GGATHER1(5, tt_) GGATHER1(6, tt_) GGATHER1(7, tt_) }
#define GSTORE1(i) { const int piece = ln + 64 * i, row = piece >> 4, ch = piece & 15; *(uint4*)(tile + row * 272 + ch * 16) = gr##i; }
    if (ntile > 0) GGATHER(0)
    for (int tt = 0; tt < ntile; ++tt) {
      GSTORE1(0) GSTORE1(1) GSTORE1(2) GSTORE1(3) GSTORE1(4) GSTORE1(5) GSTORE1(6) GSTORE1(7)
      if (tt + 1 < ntile) GGATHER(tt + 1)
      __builtin_amdgcn_fence(__ATOMIC_RELEASE, "wavefront");
      f32x16 sa;
#pragma unroll
      for (int j = 0; j < 16; ++j) sa[j] = 0.f;
#pragma unroll
      for (int s = 0; s < 8; ++s) sa = mfma32(*(const bf16x8*)(tile + c31 * 272 + (16 * s + 8 * hh) * 2), qf[s], sa);
      float tmax = -INFINITY;
#pragma unroll
      for (int j = 0; j < 16; ++j) {
        if (tt * 32 + crow(j, hh) >= nsel) sa[j] = -INFINITY;
        tmax = fmaxf(tmax, sa[j]);
      }
      tmax = xhalf_max(tmax);
      const float mnew = fmaxf(mrun, tmax * sc);
      const float alpha = __builtin_amdgcn_exp2f(mrun - mnew);
      mrun = mnew;
      float psum = 0.f;
#pragma unroll
      for (int j = 0; j < 16; ++j) { const float pv = __builtin_amdgcn_exp2f(sa[j] * sc - mnew); sa[j] = pv; psum += pv; }
      lrun = lrun * alpha + psum;
#pragma unroll
      for (int i = 0; i < 4; ++i)
#pragma unroll
        for (int j = 0; j < 16; ++j) O[i][j] *= alpha;
#pragma unroll
      for (int s2 = 0; s2 < 2; ++s2) {
        const bf16x8 pp = pack8(sa, s2);
        bf16x8 vf[4];
        trfrag4<272>(tile, 16 * s2, ln, vf);
#pragma unroll
        for (int mt = 0; mt < 4; ++mt) O[mt] = mfma32(vf[mt], pp, O[mt]);
      }
      __builtin_amdgcn_fence(__ATOMIC_ACQ_REL, "wavefront");
    }
#undef GGATHER1
#undef GGATHER
#undef GSTORE1
    const float ltot = xhalf_sum(lrun);
    const float inv = 1.f / ltot;
    if (c31 < 8 && rep2 == DUP_DSA2 - 1) {
      u16* orow = QX + tq * LDQ + c31 * 128;
#pragma unroll
      for (int mt = 0; mt < 4; ++mt)
#pragma unroll
        for (int i4 = 0; i4 < 4; ++i4) {
          uint2 o;
          o.x = pack2(O[mt][4 * i4] * inv, O[mt][4 * i4 + 1] * inv);
          o.y = pack2(O[mt][4 * i4 + 2] * inv, O[mt][4 * i4 + 3] * inv);
          *(uint2*)(orow + 32 * mt + 8 * i4 + 4 * hh) = o;
        }
    }
  }
  __syncthreads();
}

DI void phase_prep(const Params& p, int l, char* smem) {
  if (EN_C) {
    int rt, ct;
    for (int it = 0; next_tile(it, 128, 6, 32, 2, rt, ct); ++it) qx_tile(p, l, rt, ct, smem);
  }
  const int n_gdn = EN_B ? 1024 : 0, n_kp = EN_C ? 512 : 0;
  for (int t = lbid(); t < n_gdn + n_kp; t += lgdim()) {
    if (t < n_gdn) gdn_prep_item(p, l, t, smem);
    else dsa_kprep_item(p, l, t - n_gdn);
  }
}

DI int xcc_id() { return (int)(__builtin_amdgcn_s_getreg((3 << 11) | 20) & 0x7u); }

DI void phase_mixers(const Params& p, int l, char* smem) {
  __shared__ int s_item;
  const int x0 = xcc_id();
  int xs = x0;
  for (;;) {
    __syncthreads();
    {
      int qi = l * 8 + xs;
      asm volatile("" : "+s"(qi));
      if (ltid() == 0) s_item = (int)atomicAdd(p.CNT() + qi, 1u);
    }
    __syncthreads();
    const int it = s_item;
    const int n_gdn = EN_B ? 1 : 0;
    if (it >= n_gdn + 256) {
      xs = (xs + 1) & 7;
      if (xs == x0) break;
      continue;
    }
    const int x = xs;
    if (it < n_gdn) {
#pragma unroll 1
      for (int rep = 0; rep < DUP_GDN; ++rep) gdn_rec_item(p, l, x, smem, rep == DUP_GDN - 1);
    }
    else {
      const int j = it - n_gdn, k = j >> 1;
      if ((j & 1) == 0) { if (EN_A) diff_item(p, l, 127 - k, x, smem); }
      else { if (EN_C) dsa_item(p, l, 511 - (k * 4 + (x >> 1)), x & 1, smem); }
    }
  }
}

DI void run_phase(const Params& p, int ph, char* smem) {
  if (ph == 0) { phase0(p, smem); return; }
  const int l = (ph - 1) / 9, s = (ph - 1) % 9;
  switch (s) {
    case 0: phase_inproj(p, l, smem); break;
    case 1: phase_prep(p, l, smem); break;
    case 2: phase_mixers(p, l, smem); break;
    case 3: phase_merge(p, l, smem); break;
    case 4: phase_resgemm(p, p.MERGED(), LDX, p.wo(l), KP1024, 1024, smem); break;
    case 5: ln_phase(p.out, p.ln1_g + l * 1024, p.ln1_b + l * 1024, p.XB(), nullptr); break;
    case 6: phase_ff1(p, l, smem); break;
    case 7: phase_resgemm(p, p.P(), LDH, p.wf2(l), KP4096, 4096, smem); break;
    case 8: ln_phase(p.out, p.ln2_g + l * 1024, p.ln2_b + l * 1024, (l == 1) ? nullptr : p.XB(), (l == 1) ? p.out : nullptr); break;
  }
}

constexpr int N_PHASES = 19;


DI u32 xb_ld(u32* p) { return __hip_atomic_load(p, __ATOMIC_RELAXED, __HIP_MEMORY_SCOPE_AGENT); }
DI u32 xb_add(u32* p, u32 v) { return __hip_atomic_fetch_add(p, v, __ATOMIC_RELAXED, __HIP_MEMORY_SCOPE_AGENT); }
DI void fast_sync(u32* bar, int x, const volatile int* st) {
  asm volatile("s_waitcnt vmcnt(0)" ::: "memory");
  __syncthreads();
  if (ltid() == 0) {
    __builtin_amdgcn_s_waitcnt(0);
    const u32 nloc = (u32)st[0], nx = (u32)st[1];
    const u32 old = xb_add(bar + 32 * (8 + x), 1u);
    const u32 gen = old / nloc;
    if (old + 1u == (gen + 1u) * nloc) {
      __builtin_amdgcn_fence(__ATOMIC_RELEASE, "agent");
      asm volatile("s_waitcnt vmcnt(0)" ::: "memory");
      const u32 og = xb_add(bar + 32 * 24, 1u);
      const u32 tg = og / nx;
      if (og + 1u == (tg + 1u) * nx) xb_add(bar + 32 * 25, 1u);
      else { while (xb_ld(bar + 32 * 25) == tg) __builtin_amdgcn_s_sleep(1); }
      __builtin_amdgcn_fence(__ATOMIC_ACQUIRE, "agent");
      xb_add(bar + 32 * (16 + x), 1u);
      asm volatile("s_waitcnt vmcnt(0)" ::: "memory");
    } else {
      while (xb_ld(bar + 32 * (16 + x)) == gen) __builtin_amdgcn_s_sleep(1);
      __builtin_amdgcn_fence(__ATOMIC_ACQUIRE, "agent");
      asm volatile("s_waitcnt vmcnt(0)" ::: "memory");
    }
  }
  __syncthreads();
}
#if COOP
DI void gsync() { cg::this_grid().sync(); }
__global__ void __launch_bounds__(512, 1) mega_kernel(Params p, int ph_begin, int ph_end) {
  __shared__ __attribute__((aligned(16))) char smem[SMEM_BYTES];
  __shared__ int xb_st[2];
  const int myx = xcc_id();
  if (ltid() == 0) (void)xb_add(p.BAR() + 32 * myx, 1u);
  for (int r = 0; r < REP0; ++r) { phase0(p, smem); cg::this_grid().sync(); }
  if (ltid() == 0) {
    int mine = 0, cnt = 0;
    for (int j = 0; j < 8; ++j) { const int c = (int)xb_ld(p.BAR() + 32 * j); cnt += (c > 0) ? 1 : 0; mine = (j == myx) ? c : mine; }
    xb_st[0] = mine > 0 ? mine : 1;
    xb_st[1] = cnt > 0 ? cnt : 1;
  }
  __syncthreads();
#define gsync() fast_sync(p.BAR(), myx, xb_st)
#pragma unroll 1
  for (int l = 0; l < 2; ++l) {
    for (int r = 0; r < REP1; ++r) { phase_inproj(p, l, smem); gsync(); }
    phase_prep(p, l, smem);
    gsync();
    phase_mixers(p, l, smem);
    gsync();
    for (int r = 0; r < REP2; ++r) { phase_merge(p, l, smem); gsync(); }
    for (int r = 0; r < REP3; ++r) { phase_resgemm(p, p.MERGED(), LDX, p.wo(l), KP1024, 1024, smem); gsync(); }
    for (int r = 0; r < REP4; ++r) { ln_phase(p.out, p.ln1_g + l * 1024, p.ln1_b + l * 1024, p.XB(), nullptr); gsync(); }
    for (int r = 0; r < REP5; ++r) { phase_ff1(p, l, smem); gsync(); }
    for (int r = 0; r < REP6; ++r) { phase_resgemm(p, p.P(), LDH, p.wf2(l), KP4096, 4096, smem); gsync(); }
    ln_phase(p.out, p.ln2_g + l * 1024, p.ln2_b + l * 1024, (l == 1) ? nullptr : p.XB(), (l == 1) ? p.out : nullptr);
    if (l == 0) gsync();
  }
}
#undef gsync
#else
__global__ void __launch_bounds__(512, 1) mega_kernel(Params p, int ph_begin, int ph_end) {
  __shared__ __attribute__((aligned(16))) char smem[SMEM_BYTES];
  for (int ph = ph_begin; ph < ph_end; ++ph) run_phase(p, ph, smem);
}
#endif

extern "C" void kernel_launch(void* const* d_in, const int* in_sizes, int n_in, void* d_out, int out_size,
                              void* d_ws, size_t ws_size, hipStream_t stream) {
  static int grid_blocks = 0;
  if (!grid_blocks) {
    int dev = 0, cus = 0, per_cu = 0;
    hipGetDevice(&dev);
    hipDeviceGetAttribute(&cus, hipDeviceAttributeMultiprocessorCount, dev);
    hipOccupancyMaxActiveBlocksPerMultiprocessor(&per_cu, mega_kernel, NTHR, 0);
    if (per_cu < 1) per_cu = 1;
    if (per_cu > 1) per_cu = 1;
    grid_blocks = cus * per_cu;
  }
  Params p{};
  const float** pf = (const float**)&p;
  for (int i = 0; i < 27; ++i) pf[i] = (const float*)d_in[i];
  p.out = (float*)d_out;
  p.ws = (char*)d_ws;
  if (WS_NEED > ws_size) { fprintf(stderr, "workspace too small: need %zu have %zu\n", (size_t)WS_NEED, ws_size); return; }
#if COOP
  hipMemsetAsync(p.ws + O_BAR, 0, 4096, stream);
  int b = 0, e = N_PHASES;
  void* args[] = {&p, &b, &e};
  hipError_t err = hipLaunchCooperativeKernel((void*)mega_kernel, dim3(grid_blocks), dim3(NTHR), args, 0, stream);
  if (err != hipSuccess) fprintf(stderr, "cooperative launch failed: %s (grid %d)\n", hipGetErrorString(err), grid_blocks);
#else
  for (int ph = 0; ph < N_PHASES; ++ph) mega_kernel<<<grid_blocks, NTHR, 0, stream>>>(p, ph, ph + 1);
#endif
}
```

```cpp
#include <hip/hip_runtime.h>
#include <hip/hip_cooperative_groups.h>
#include <cstdio>
namespace cg = cooperative_groups;

#ifndef COOP
#define COOP 1
#endif
#ifndef REP0
#define REP0 1
#define REP1 1
#define REP2 1
#define REP3 1
#define REP4 1
#define REP5 1
#define REP6 1
#endif
#ifndef DUP_GDN
#define DUP_GDN 1
#endif
#ifndef DUP_DIFF
#define DUP_DIFF 1
#endif
#ifndef DUP_DSA1
#define DUP_DSA1 1
#endif
#ifndef DUP_DSA2
#define DUP_DSA2 1
#endif
#ifndef EN_A
#define EN_A 1
#endif
#ifndef EN_B
#define EN_B 1
#endif
#ifndef EN_C
#define EN_C 1
#endif

typedef unsigned short u16;
typedef unsigned int u32;
typedef unsigned long long u64;
using bf16x8 = __attribute__((ext_vector_type(8))) short;
using s16x4 = __attribute__((ext_vector_type(4))) short;
using f32x4 = __attribute__((ext_vector_type(4))) float;
using f32x16 = __attribute__((ext_vector_type(16))) float;
#define DI __device__ __forceinline__

constexpr int NT = 32768, T = 16384, PC = 4048;
constexpr int AQ = 0, AK = 512, AV = 1024, BQ = 1536, BK_ = 2048, BV = 2560, BZ = 3072, BA = 3584, BB = 3588,
              CQ = 3592, CKVc = 3848, CKI = 3976, CWI = 4040, GATES = 4048;
constexpr float EPS = 1e-6f;
constexpr float DN_ALPHA = 1.41421356237f;
constexpr int NTHR = 512;
constexpr int SMEM_BYTES = 153600 + 512;

constexpr size_t al256(size_t x) { return (x + 255) & ~(size_t)255; }
constexpr int LDX = 1088, LDH = 4160, LDQ = 1600;
constexpr int KP1024 = 1088, KP512 = 576, KP256 = 320, KP4096 = 4160;
constexpr size_t SZ_WIN = al256((size_t)7120 * KP1024 * 2), SZ_WQX = al256((size_t)1536 * KP256 * 2), SZ_WBR = al256((size_t)1024 * KP512 * 2),
                 SZ_WBRC = al256((size_t)1024 * KP1024 * 2), SZ_WO = al256((size_t)1024 * KP1024 * 2), SZ_WF1 = al256((size_t)4096 * KP1024 * 2), SZ_WF2 = al256((size_t)1024 * KP4096 * 2);
constexpr size_t O_WIN = 0, O_WQX = O_WIN + SZ_WIN, O_WBRA = O_WQX + SZ_WQX, O_WBRB = O_WBRA + SZ_WBR, O_WBRC = O_WBRB + SZ_WBR,
                 O_WO = O_WBRC + SZ_WBRC, O_WF1 = O_WO + SZ_WO, O_WF2 = O_WF1 + SZ_WF1, LAYER_W = O_WF2 + SZ_WF2;
constexpr size_t O_P = 2 * LAYER_W, O_XB = O_P + (size_t)NT * LDH * 2, O_M = O_XB + (size_t)NT * LDX * 2;
constexpr size_t O_KDT = O_M, O_ATT = O_KDT + 33554432, O_HALO = O_ATT + 16777216, O_KIDX = O_HALO + 4718592, O_CKV = O_KIDX + 4194304,
                 O_MEND = O_CKV + 8388608 + 4194304;
constexpr size_t O_WIDX = O_MEND, O_GL = O_WIDX + (size_t)NT * 8 * 4, O_LAM = O_GL + 8192, O_CNT = O_LAM + 256, O_BAR = O_CNT + 256, WS_NEED = O_BAR + 4096;
static_assert(O_MEND - O_M >= (size_t)NT * LDX * 2, "merged alias");

struct Params {
  const float *x, *w_in, *b_gate, *a_lambda, *a_subln_g, *b_conv_w, *b_a_log, *b_dt_bias, *b_norm_g,
      *c_q_norm_g, *c_kv_norm_g, *c_kidx_g, *c_kidx_b, *c_w_uq, *c_w_qidx, *c_w_uk, *c_w_uv,
      *w_branch_a, *w_branch_b, *w_branch_c, *w_o, *ln1_g, *ln1_b, *w_ff1, *w_ff2, *ln2_g, *ln2_b;
  float* out;
  char* ws;
  __device__ __forceinline__ u16* win(int l) const { return (u16*)(ws + l * LAYER_W + O_WIN); }
  __device__ __forceinline__ u16* wqx(int l) const { return (u16*)(ws + l * LAYER_W + O_WQX); }
  __device__ __forceinline__ u16* wbra(int l) const { return (u16*)(ws + l * LAYER_W + O_WBRA); }
  __device__ __forceinline__ u16* wbrb(int l) const { return (u16*)(ws + l * LAYER_W + O_WBRB); }
  __device__ __forceinline__ u16* wbrc(int l) const { return (u16*)(ws + l * LAYER_W + O_WBRC); }
  __device__ __forceinline__ u16* wo(int l) const { return (u16*)(ws + l * LAYER_W + O_WO); }
  __device__ __forceinline__ u16* wf1(int l) const { return (u16*)(ws + l * LAYER_W + O_WF1); }
  __device__ __forceinline__ u16* wf2(int l) const { return (u16*)(ws + l * LAYER_W + O_WF2); }
  __device__ __forceinline__ u16* P() const { return (u16*)(ws + O_P); }
  __device__ __forceinline__ u16* XB() const { return (u16*)(ws + O_XB); }
  __device__ __forceinline__ u16* KDT() const { return (u16*)(ws + O_KDT); }
  __device__ __forceinline__ u16* ATT() const { return (u16*)(ws + O_ATT); }
  __device__ __forceinline__ u16* HALO() const { return (u16*)(ws + O_HALO); }
  __device__ __forceinline__ u16* KIDX() const { return (u16*)(ws + O_KIDX); }
  __device__ __forceinline__ u16* CKV() const { return (u16*)(ws + O_CKV); }
  __device__ __forceinline__ u16* MERGED() const { return (u16*)(ws + O_M); }
  __device__ __forceinline__ float* WIDX() const { return (float*)(ws + O_WIDX); }
  __device__ __forceinline__ float* GL() const { return (float*)(ws + O_GL); }
  __device__ __forceinline__ float* LAM() const { return (float*)(ws + O_LAM); }
  __device__ __forceinline__ u32* CNT() const { return (u32*)(ws + O_CNT); }
  __device__ __forceinline__ u32* BAR() const { return (u32*)(ws + O_BAR); }
};

DI int lbid() { int b = blockIdx.x; asm volatile("" : "+s"(b)); return b; }
DI int lgdim() { int b = gridDim.x; asm volatile("" : "+s"(b)); return b; }
DI int ltid() { int t = threadIdx.x; asm volatile("" : "+v"(t)); return t; }
DI u16 f2bf(float x) { u32 u = __float_as_uint(x); u += 0x7fffu + ((u >> 16) & 1u); return (u16)(u >> 16); }
DI float bf2f(u16 h) { return __uint_as_float(((u32)h) << 16); }
DI u32 pack2(float a, float b) { return (u32)f2bf(a) | ((u32)f2bf(b) << 16); }
DI float bflo(u32 v) { return __uint_as_float(v << 16); }
DI float bfhi(u32 v) { return __uint_as_float(v & 0xffff0000u); }
DI f32x4 mfma16(bf16x8 a, bf16x8 b, f32x4 c) { return __builtin_amdgcn_mfma_f32_16x16x32_bf16(a, b, c, 0, 0, 0); }
DI f32x16 mfma32(bf16x8 a, bf16x8 b, f32x16 c) { return __builtin_amdgcn_mfma_f32_32x32x16_bf16(a, b, c, 0, 0, 0); }
DI int crow(int i, int hh) { return (i & 3) + 8 * (i >> 2) + 4 * hh; }
DI float sigmoidf_(float x) { return 1.f / (1.f + __expf(-x)); }
DI float siluf_(float x) { return x / (1.f + __expf(-x)); }
DI float xhalf_max(float x) {
  const u32 u = __float_as_uint(x);
  const auto r = __builtin_amdgcn_permlane32_swap(u, u, false, false);
  return fmaxf(__uint_as_float(r[0]), __uint_as_float(r[1]));
}
DI float xhalf_sum(float x) {
  const u32 u = __float_as_uint(x);
  const auto r = __builtin_amdgcn_permlane32_swap(u, u, false, false);
  return __uint_as_float(r[0]) + __uint_as_float(r[1]);
}
DI u32 lane_lt_cnt(u64 m) { return __builtin_amdgcn_mbcnt_hi((u32)(m >> 32), __builtin_amdgcn_mbcnt_lo((u32)m, 0)); }

DI bf16x8 pack8(const f32x16& x, int s) {
  u32 p0, p1, p2, p3;
  if (s == 0) {
    asm volatile("v_cvt_pk_bf16_f32 %0, %4, %5\n\tv_cvt_pk_bf16_f32 %1, %6, %7\n\tv_cvt_pk_bf16_f32 %2, %8, %9\n\tv_cvt_pk_bf16_f32 %3, %10, %11\n\ts_nop 1"
                 : "=&v"(p0), "=&v"(p1), "=&v"(p2), "=&v"(p3)
                 : "v"(x[0]), "v"(x[1]), "v"(x[2]), "v"(x[3]), "v"(x[4]), "v"(x[5]), "v"(x[6]), "v"(x[7]));
  } else {
    asm volatile("v_cvt_pk_bf16_f32 %0, %4, %5\n\tv_cvt_pk_bf16_f32 %1, %6, %7\n\tv_cvt_pk_bf16_f32 %2, %8, %9\n\tv_cvt_pk_bf16_f32 %3, %10, %11\n\ts_nop 1"
                 : "=&v"(p0), "=&v"(p1), "=&v"(p2), "=&v"(p3)
                 : "v"(x[8]), "v"(x[9]), "v"(x[10]), "v"(x[11]), "v"(x[12]), "v"(x[13]), "v"(x[14]), "v"(x[15]));
  }
  typedef u32 u32x4 __attribute__((ext_vector_type(4)));
  u32x4 v = {p0, p1, p2, p3};
  return __builtin_bit_cast(bf16x8, v);
}
DI bf16x8 afrag_perm(const char* base, int row, int stride, int kbase, int hh) {
  const char* pr = base + row * stride + (kbase + 4 * hh) * 2;
  s16x4 lo = *(const s16x4*)pr;
  s16x4 hi = *(const s16x4*)(pr + 16);
  return __builtin_shufflevector(lo, hi, 0, 1, 2, 3, 4, 5, 6, 7);
}
DI bf16x8 trfrag(const char* img, int stride, int krow0, int col0, int ln) {
  const int hh = ln >> 5, chalf = (ln >> 4) & 1, q4 = (ln & 15) >> 2, p4 = ln & 3;
  u32 a = (u32)(size_t)(img + (krow0 + 4 * hh + q4) * stride + (col0 + 16 * chalf + 4 * p4) * 2);
  s16x4 lo, hi;
  asm volatile("ds_read_b64_tr_b16 %0, %2\n\tds_read_b64_tr_b16 %1, %3\n\ts_waitcnt lgkmcnt(0)"
               : "=&v"(lo), "=&v"(hi) : "v"(a), "v"(a + 8 * stride) : "memory");
  return __builtin_shufflevector(lo, hi, 0, 1, 2, 3, 4, 5, 6, 7);
}

template <int STRIDE>
DI void trfrag4(const char* img, int krow0, int ln, bf16x8 (&f)[4]) {
  const int hh = ln >> 5, chalf = (ln >> 4) & 1, q4 = (ln & 15) >> 2, p4 = ln & 3;
  const u32 a = (u32)(size_t)(img + (krow0 + 4 * hh + q4) * STRIDE + (16 * chalf + 4 * p4) * 2);
  s16x4 l0, h0, l1, h1, l2, h2, l3, h3;
  asm volatile(
      "ds_read_b64_tr_b16 %0, %8\n\tds_read_b64_tr_b16 %1, %8 offset:%9\n\t"
      "ds_read_b64_tr_b16 %2, %8 offset:64\n\tds_read_b64_tr_b16 %3, %8 offset:%10\n\t"
      "ds_read_b64_tr_b16 %4, %8 offset:128\n\tds_read_b64_tr_b16 %5, %8 offset:%11\n\t"
      "ds_read_b64_tr_b16 %6, %8 offset:192\n\tds_read_b64_tr_b16 %7, %8 offset:%12\n\t"
      "s_waitcnt lgkmcnt(0)"
      : "=&v"(l0), "=&v"(h0), "=&v"(l1), "=&v"(h1), "=&v"(l2), "=&v"(h2), "=&v"(l3), "=&v"(h3)
      : "v"(a), "i"(8 * STRIDE), "i"(8 * STRIDE + 64), "i"(8 * STRIDE + 128), "i"(8 * STRIDE + 192)
      : "memory");
  f[0] = __builtin_shufflevector(l0, h0, 0, 1, 2, 3, 4, 5, 6, 7);
  f[1] = __builtin_shufflevector(l1, h1, 0, 1, 2, 3, 4, 5, 6, 7);
  f[2] = __builtin_shufflevector(l2, h2, 0, 1, 2, 3, 4, 5, 6, 7);
  f[3] = __builtin_shufflevector(l3, h3, 0, 1, 2, 3, 4, 5, 6, 7);
}

template <int MT, int NT>
DI void gemm_core(const u16* __restrict__ A, int lda, const u16* __restrict__ B, int ldb, int K,
                  f32x4 (&acc)[MT][NT], char* smem) {
  constexpr int BM = 64 * MT, BN = 32 * NT;
  constexpr int ASZ = BM * 128, BSZ = BN * 128, BUF = ASZ + BSZ;
  constexpr int NA = BM / 64, NB = BN / 64;
  const int tid = ltid(), l = tid & 63, w = tid >> 6, wm = w >> 1, wn = w & 1;
  const int fr = l & 15, fq = l >> 4;
  uint4 ra0, ra1, ra2, ra3, rb0, rb1, rb2, rb3;
  const int nk = K >> 6;
  const int srow = tid >> 3, sch = tid & 7;
  const int ssw = sch ^ ((srow >> 1) & 7);
  const int fsw = (fr >> 1) & 7;
#define GL1(i, kt)                                                                                        \
  if (NA > i) ra##i = *(const uint4*)(A + (size_t)(srow + 64 * i) * lda + (kt) * 64 + sch * 8);           \
  if (NB > i) rb##i = *(const uint4*)(B + (size_t)(srow + 64 * i) * ldb + (kt) * 64 + sch * 8);
#define GLOAD(kt) { GL1(0, kt) GL1(1, kt) GL1(2, kt) GL1(3, kt) }
#define SS1(i)                                                                   \
  if (NA > i) *(uint4*)(as_ + (srow + 64 * i) * 128 + ssw * 16) = ra##i;         \
  if (NB > i) *(uint4*)(bs_ + (srow + 64 * i) * 128 + ssw * 16) = rb##i;
#define SSTORE(buf)                              \
  {                                              \
    char* as_ = smem + (buf) * BUF;              \
    char* bs_ = as_ + ASZ;                       \
    SS1(0) SS1(1) SS1(2) SS1(3)                  \
  }
  GLOAD(0);
  SSTORE(0);
  GLOAD(((1 < nk) ? 1 : 0));
#pragma unroll 1
  for (int kt = 0; kt < nk; ++kt) {
    __syncthreads();
    SSTORE((kt + 1) & 1);
    { const int kn_ = (kt + 2 < nk) ? kt + 2 : nk - 1; GLOAD(kn_); }
    const char* as = smem + (kt & 1) * BUF;
    const char* bs = as + ASZ;
#pragma unroll
    for (int kk = 0; kk < 2; ++kk) {
      bf16x8 xf[MT], wf[NT];
#pragma unroll
      for (int mi = 0; mi < MT; ++mi)
        xf[mi] = *(const bf16x8*)(as + (wm * (MT * 16) + mi * 16 + fr) * 128 + (((kk * 4 + fq) ^ fsw) * 16));
#pragma unroll
      for (int ni = 0; ni < NT; ++ni)
        wf[ni] = *(const bf16x8*)(bs + (wn * (NT * 16) + ni * 16 + fr) * 128 + (((kk * 4 + fq) ^ fsw) * 16));
      __builtin_amdgcn_s_setprio(1);
#pragma unroll
      for (int mi = 0; mi < MT; ++mi)
#pragma unroll
        for (int ni = 0; ni < NT; ++ni) acc[mi][ni] = mfma16(wf[ni], xf[mi], acc[mi][ni]);
      __builtin_amdgcn_s_setprio(0);
    }
  }
  __syncthreads();
#undef GLOAD
#undef SSTORE
#undef GL1
#undef SS1
}
template <int MT, int NT>
DI void zero_acc(f32x4 (&acc)[MT][NT]) {
#pragma unroll
  for (int i = 0; i < MT; ++i)
#pragma unroll
    for (int j = 0; j < NT; ++j) acc[i][j] = f32x4{0.f, 0.f, 0.f, 0.f};
}


DI bool next_tile(int it, int RT, int CT, int PR, int PCc, int& rt, int& ct) {
  const int bid = lbid(), x = bid & 7, j = bid >> 3, J = lgdim() >> 3;
  const int u = j + it * J;
  const int pcols = CT / PCc, npatch = (RT / PR) * pcols;
  const int pid = (u >> 6) * 8 + x;
  if (pid >= npatch) return false;
  const int w = u & 63, pr = pid / pcols, pc = pid - pr * pcols;
  rt = pr * PR + w / PCc;
  ct = pc * PCc + w % PCc;
  return true;
}
DI void transpose_job(const float* __restrict__ src, int K, int N, u16* __restrict__ dst, int ldd, const float* kscale, char* smem) {
  float(*tile)[65] = (float(*)[65])smem;
  const int ntn = (N + 63) >> 6, ntk = K >> 6, tid = ltid();
  for (int t = lbid(); t < ntn * ntk; t += lgdim()) {
    const int tk = t / ntn, tn = t % ntn, k0 = tk * 64, n0 = tn * 64;
    {
      const int n = tid & 63, kb = tid >> 6;
      for (int i = 0; i < 8; ++i) {
        const int k = kb + 8 * i;
        float v = (n0 + n < N) ? src[(size_t)(k0 + k) * N + n0 + n] : 0.f;
        if (kscale) v *= kscale[k0 + k];
        tile[k][n] = v;
      }
    }
    __syncthreads();
    {
      const int n = tid >> 3, kc = tid & 7;
      if (n0 + n < N) {
        uint4 o;
        o.x = pack2(tile[kc * 8 + 0][n], tile[kc * 8 + 1][n]); o.y = pack2(tile[kc * 8 + 2][n], tile[kc * 8 + 3][n]);
        o.z = pack2(tile[kc * 8 + 4][n], tile[kc * 8 + 5][n]); o.w = pack2(tile[kc * 8 + 6][n], tile[kc * 8 + 7][n]);
        *(uint4*)(dst + (size_t)(n0 + n) * ldd + k0 + kc * 8) = o;
      }
    }
    __syncthreads();
  }
}

DI void phase0(const Params& p, char* smem) {
  const size_t gtid = (size_t)lbid() * NTHR + ltid(), gsz = (size_t)lgdim() * NTHR;
  for (int l = 0; l < 2; ++l) {
    transpose_job(p.w_in + (size_t)l * 1024 * 7120, 1024, 7120, p.win(l), KP1024, nullptr, smem);
    transpose_job(p.w_branch_a + (size_t)l * 512 * 1024, 512, 1024, p.wbra(l), KP512, nullptr, smem);
    transpose_job(p.w_branch_b + (size_t)l * 512 * 1024, 512, 1024, p.wbrb(l), KP512, nullptr, smem);
    transpose_job(p.w_o + (size_t)l * 1024 * 1024, 1024, 1024, p.wo(l), KP1024, nullptr, smem);
    transpose_job(p.w_ff1 + (size_t)l * 1024 * 4096, 1024, 4096, p.wf1(l), KP1024, nullptr, smem);
    transpose_job(p.w_ff2 + (size_t)l * 4096 * 1024, 4096, 1024, p.wf2(l), KP4096, nullptr, smem);
    transpose_job(p.c_w_qidx + (size_t)l * 256 * 512, 256, 512, p.wqx(l) + 1024 * KP256, KP256, p.c_q_norm_g + l * 256, smem);
    {
      const float* uq = p.c_w_uq + (size_t)l * 256 * 512;
      const float* uk = p.c_w_uk + (size_t)l * 128 * 512;
      const float* g = p.c_q_norm_g + l * 256;
      for (size_t e = gtid; e < 1024 * 256; e += gsz) {
        const int n = (int)(e >> 8), k = (int)(e & 255), h = n >> 7, r2 = n & 127;
        const float4* a = (const float4*)(uq + (k * 8 + h) * 64);
        const float4* b = (const float4*)(uk + (r2 * 8 + h) * 64);
        float s = 0.f;
        for (int d = 0; d < 16; ++d) { float4 x = a[d], y = b[d]; s += x.x * y.x + x.y * y.y + x.z * y.z + x.w * y.w; }
        p.wqx(l)[(size_t)n * KP256 + k] = f2bf(s * g[k]);
      }
    }
    {
      const float* uv = p.c_w_uv + (size_t)l * 128 * 512;
      const float* bc = p.w_branch_c + (size_t)l * 512 * 1024;
      for (size_t e = gtid; e < 1024 * 256; e += gsz) {
        const int k = (int)(e >> 8), n4 = (int)(e & 255) * 4, h = k >> 7, r = k & 127;
        const float* a = uv + (r * 8 + h) * 64;
        const float* b = bc + (size_t)(h * 64) * 1024 + n4;
        float4 acc4 = float4{0.f, 0.f, 0.f, 0.f};
#pragma unroll 8
        for (int d = 0; d < 64; ++d) {
          const float4 v = *(const float4*)(b + (size_t)d * 1024);
          const float ad = a[d];
          acc4.x += ad * v.x; acc4.y += ad * v.y; acc4.z += ad * v.z; acc4.w += ad * v.w;
        }
        u16* dst = p.wbrc(l) + (size_t)n4 * KP1024 + k;
        dst[0] = f2bf(acc4.x); dst[KP1024] = f2bf(acc4.y); dst[2 * KP1024] = f2bf(acc4.z); dst[3 * KP1024] = f2bf(acc4.w);
      }
    }
  }
  for (size_t e = gtid; e < (size_t)NT * 1024 / 8; e += gsz) {
    const float4 a = ((const float4*)p.x)[2 * e], b = ((const float4*)p.x)[2 * e + 1];
    uint4 o;
    o.x = pack2(a.x, a.y); o.y = pack2(a.z, a.w); o.z = pack2(b.x, b.y); o.w = pack2(b.z, b.w);
    *(uint4*)(p.XB() + (e >> 7) * LDX + (e & 127) * 8) = o;
  }
  if (gtid < 2) {
    const int l = (int)gtid;
    const float* lp = p.a_lambda + l * 256;
    float s1 = 0.f, s2 = 0.f;
    for (int i = 0; i < 64; ++i) { s1 += lp[i] * lp[64 + i]; s2 += lp[128 + i] * lp[192 + i]; }
    const float lam_init = 0.8f - 0.6f * expf(-0.3f * l);
    p.LAM()[l] = expf(s1) - expf(s2) + lam_init;
    p.LAM()[2 + l] = lam_init;
    for (int i = 0; i < 8; ++i) p.CNT()[l * 8 + i] = 0;
  }
}

DI void ln_phase(const float* S, const float* __restrict__ g, const float* __restrict__ b, u16* XBo, float* fout) {
  const int l = ltid() & 63;
  const int wave = lbid() * 8 + (ltid() >> 6), nw = lgdim() * 8;
  for (int row = wave; row < NT; row += nw) {
    float4 v[4];
    float s = 0.f;
#pragma unroll
    for (int i = 0; i < 4; ++i) { v[i] = *(const float4*)(S + (size_t)row * 1024 + i * 256 + l * 4); s += v[i].x + v[i].y + v[i].z + v[i].w; }
#pragma unroll
    for (int o = 32; o; o >>= 1) s += __shfl_xor(s, o);
    const float mu = s * (1.f / 1024.f);
    float q = 0.f;
#pragma unroll
    for (int i = 0; i < 4; ++i) { float a = v[i].x - mu, bb = v[i].y - mu, c = v[i].z - mu, d = v[i].w - mu; q += a * a + bb * bb + c * c + d * d; }
#pragma unroll
    for (int o = 32; o; o >>= 1) q += __shfl_xor(q, o);
    const float rs = rsqrtf(q * (1.f / 1024.f) + EPS);
#pragma unroll
    for (int i = 0; i < 4; ++i) {
      const int c = i * 256 + l * 4;
      const float4 gg = *(const float4*)(g + c), bb = *(const float4*)(b + c);
      float4 y;
      y.x = (v[i].x - mu) * rs * gg.x + bb.x; y.y = (v[i].y - mu) * rs * gg.y + bb.y;
      y.z = (v[i].z - mu) * rs * gg.z + bb.z; y.w = (v[i].w - mu) * rs * gg.w + bb.w;
      if (fout) *(float4*)(fout + (size_t)row * 1024 + c) = y;
      if (XBo) { uint2 o; o.x = pack2(y.x, y.y); o.y = pack2(y.z, y.w); *(uint2*)(XBo + (size_t)row * LDX + c) = o; }
    }
  }
}

#define EPI_LOOP(MT_, NT_)                                                \
  const int l_ = ltid() & 63, w_ = ltid() >> 6;                           \
  const int wm_ = w_ >> 1, wn_ = w_ & 1, fr_ = l_ & 15, fq_ = l_ >> 4;    \
  _Pragma("unroll") for (int mi = 0; mi < MT_; ++mi)                      \
  _Pragma("unroll") for (int ni = 0; ni < NT_; ++ni)

DI void phase_inproj(const Params& p, int l, char* smem) {
  int rt, ct;
  for (int it = 0; next_tile(it, 128, 16, 8, 8, rt, ct); ++it) {
    const int r0 = rt * 256, c0 = ct * 256;
    f32x4 acc[4][8];
    zero_acc<4, 8>(acc);
    gemm_core<4, 8>(p.XB() + (size_t)r0 * LDX, LDX, p.win(l) + (size_t)c0 * KP1024, KP1024, 1024, acc, smem);
    EPI_LOOP(4, 8) {
      const int row = r0 + wm_ * 64 + mi * 16 + fr_, col = c0 + wn_ * 128 + ni * 16 + fq_ * 4;
      if (col < PC) {
        uint2 o;
        o.x = pack2(acc[mi][ni][0], acc[mi][ni][1]); o.y = pack2(acc[mi][ni][2], acc[mi][ni][3]);
        *(uint2*)(p.P() + (size_t)row * PC + col) = o;
        if (col >= BQ && col < BZ && (row & 63) >= 61)
          *(uint2*)(p.HALO() + ((size_t)(row >> 6) * 3 + ((row & 63) - 61)) * 1536 + (col - BQ)) = o;
      }
    }
  }
}

DI void qx_tile(const Params& p, int l, int rt, int ct, char* smem) {
  const int r0 = rt * 256, c0 = ct * 256;
  float* rsv = (float*)(smem + 147456);
  {
    const int row = ltid() >> 1, half = ltid() & 1;
    const uint4* src = (const uint4*)(p.P() + (size_t)(r0 + row) * PC + CQ + half * 128);
    float ss = 0.f;
    for (int i = 0; i < 16; ++i) {
      uint4 v = src[i];
      float a;
      a = bflo(v.x); ss += a * a; a = bfhi(v.x); ss += a * a; a = bflo(v.y); ss += a * a; a = bfhi(v.y); ss += a * a;
      a = bflo(v.z); ss += a * a; a = bfhi(v.z); ss += a * a; a = bflo(v.w); ss += a * a; a = bfhi(v.w); ss += a * a;
    }
    ss += __shfl_xor(ss, 1);
    if (!half) rsv[row] = rsqrtf(ss * (1.f / 256.f) + EPS);
  }
  f32x4 acc[4][8];
  zero_acc<4, 8>(acc);
  gemm_core<4, 8>(p.P() + (size_t)r0 * PC + CQ, PC, p.wqx(l) + (size_t)c0 * KP256, KP256, 256, acc, smem);
  u16* QX = (u16*)p.out;
  EPI_LOOP(4, 8) {
    const int rl = wm_ * 64 + mi * 16 + fr_, col = c0 + wn_ * 128 + ni * 16 + fq_ * 4;
    const float rs = rsv[rl];
    uint2 o;
    o.x = pack2(acc[mi][ni][0] * rs, acc[mi][ni][1] * rs); o.y = pack2(acc[mi][ni][2] * rs, acc[mi][ni][3] * rs);
    *(uint2*)(QX + (size_t)(r0 + rl) * LDQ + col) = o;
  }
  __syncthreads();
}

DI void phase_merge(const Params& p, int l, char* smem) {
  const u16* QX = (const u16*)p.out;
  int rt, ct;
  for (int it = 0; next_tile(it, 128, 8, 8, 8, rt, ct); ++it) {
    const int r0 = rt * 256, c0 = ct * 128;
    bool first = true;
#pragma unroll 1
    for (int j = 0; j < 3; ++j) {
      if ((j == 0 && !EN_A) || (j == 1 && !EN_B) || (j == 2 && !EN_C)) continue;
      const u16* Ab; const u16* Wb; int lda, K;
      int ldw;
      if (j == 0) { Ab = p.P() + (size_t)r0 * PC + AQ; lda = PC; Wb = p.wbra(l) + (size_t)c0 * KP512; K = 512; ldw = KP512; }
      else if (j == 1) { Ab = p.P() + (size_t)r0 * PC + BZ; lda = PC; Wb = p.wbrb(l) + (size_t)c0 * KP512; K = 512; ldw = KP512; }
      else { Ab = QX + (size_t)r0 * LDQ; lda = LDQ; Wb = p.wbrc(l) + (size_t)c0 * KP1024; K = 1024; ldw = KP1024; }
      f32x4 g[4][4];
      zero_acc<4, 4>(g);
      gemm_core<4, 4>(p.XB() + (size_t)r0 * LDX, LDX, p.win(l) + (size_t)(GATES + j * 1024 + c0) * KP1024, KP1024, 1024, g, smem);
      const float* bg = p.b_gate + l * 3072 + j * 1024;
      {
        EPI_LOOP(4, 4) {
          const int col = c0 + wn_ * 64 + ni * 16 + fq_ * 4;
          const float4 bb = *(const float4*)(bg + col);
          g[mi][ni][0] = sigmoidf_(g[mi][ni][0] + bb.x);
          g[mi][ni][1] = sigmoidf_(g[mi][ni][1] + bb.y);
          g[mi][ni][2] = sigmoidf_(g[mi][ni][2] + bb.z);
          g[mi][ni][3] = sigmoidf_(g[mi][ni][3] + bb.w);
        }
      }
      f32x4 br[4][4];
      zero_acc<4, 4>(br);
      gemm_core<4, 4>(Ab, lda, Wb, ldw, K, br, smem);
      {
        EPI_LOOP(4, 4) {
          const int row = r0 + wm_ * 64 + mi * 16 + fr_, col = c0 + wn_ * 64 + ni * 16 + fq_ * 4;
          u16* mp = p.MERGED() + (size_t)row * LDX + col;
          float a0 = g[mi][ni][0] * br[mi][ni][0], a1 = g[mi][ni][1] * br[mi][ni][1];
          float a2 = g[mi][ni][2] * br[mi][ni][2], a3 = g[mi][ni][3] * br[mi][ni][3];
          if (!first) {
            const uint2 old = *(const uint2*)mp;
            a0 += bflo(old.x); a1 += bfhi(old.x); a2 += bflo(old.y); a3 += bfhi(old.y);
          }
          uint2 o;
          o.x = pack2(a0, a1); o.y = pack2(a2, a3);
          *(uint2*)mp = o;
        }
      }
      first = false;
    }
  }
}

DI void phase_resgemm(const Params& p, const u16* A, int lda, const u16* W, int ldw, int K, char* smem) {
  int rt, ct;
  for (int it = 0; next_tile(it, 128, 4, 16, 4, rt, ct); ++it) {
    const int r0 = rt * 256, c0 = ct * 256;
    f32x4 acc[4][8];
    zero_acc<4, 8>(acc);
    gemm_core<4, 8>(A + (size_t)r0 * lda, lda, W + (size_t)c0 * ldw, ldw, K, acc, smem);
    EPI_LOOP(4, 8) {
      const int row = r0 + wm_ * 64 + mi * 16 + fr_, col = c0 + wn_ * 128 + ni * 16 + fq_ * 4;
      const uint2 xb = *(const uint2*)(p.XB() + (size_t)row * LDX + col);
      float4 o;
      o.x = DN_ALPHA * bflo(xb.x) + acc[mi][ni][0]; o.y = DN_ALPHA * bfhi(xb.x) + acc[mi][ni][1];
      o.z = DN_ALPHA * bflo(xb.y) + acc[mi][ni][2]; o.w = DN_ALPHA * bfhi(xb.y) + acc[mi][ni][3];
      *(float4*)(p.out + (size_t)row * 1024 + col) = o;
    }
  }
}

DI void phase_ff1(const Params& p, int l, char* smem) {
  int rt, ct;
  for (int it = 0; next_tile(it, 128, 16, 8, 8, rt, ct); ++it) {
    const int r0 = rt * 256, c0 = ct * 256;
    f32x4 acc[4][8];
    zero_acc<4, 8>(acc);
    gemm_core<4, 8>(p.XB() + (size_t)r0 * LDX, LDX, p.wf1(l) + (size_t)c0 * KP1024, KP1024, 1024, acc, smem);
    EPI_LOOP(4, 8) {
      const int row = r0 + wm_ * 64 + mi * 16 + fr_, col = c0 + wn_ * 128 + ni * 16 + fq_ * 4;
      float a0 = fmaxf(acc[mi][ni][0], 0.f), a1 = fmaxf(acc[mi][ni][1], 0.f), a2 = fmaxf(acc[mi][ni][2], 0.f), a3 = fmaxf(acc[mi][ni][3], 0.f);
      uint2 o;
      o.x = pack2(a0 * a0, a1 * a1); o.y = pack2(a2 * a2, a3 * a3);
      *(uint2*)(p.P() + (size_t)row * LDH + col) = o;
    }
  }
}

DI void dsa_kprep_item(const Params& p, int l, int it) {
  const int ln = ltid() & 63, w = ltid() >> 6;
  const float g0 = p.c_kv_norm_g[l * 128 + 2 * ln], g1 = p.c_kv_norm_g[l * 128 + 2 * ln + 1];
  const float kg = p.c_kidx_g[l * 64 + ln], kb = p.c_kidx_b[l * 64 + ln];
  for (int i = 0; i < 8; ++i) {
    const size_t tok = (size_t)it * 64 + w * 8 + i;
    const u16* pr = p.P() + tok * PC;
    const u32 v = *(const u32*)(pr + CKVc + 2 * ln);
    const float a = bflo(v), b = bfhi(v);
    float ss = a * a + b * b;
#pragma unroll
    for (int o = 32; o; o >>= 1) ss += __shfl_xor(ss, o);
    const float rs = rsqrtf(ss * (1.f / 128.f) + EPS);
    *(u32*)(p.CKV() + tok * 128 + 2 * ln) = pack2(a * rs * g0, b * rs * g1);
    const float k = bf2f(pr[CKI + ln]);
    float s = k;
#pragma unroll
    for (int o = 32; o; o >>= 1) s += __shfl_xor(s, o);
    const float mu = s * (1.f / 64.f);
    float q = (k - mu) * (k - mu);
#pragma unroll
    for (int o = 32; o; o >>= 1) q += __shfl_xor(q, o);
    p.KIDX()[tok * 64 + ln] = f2bf((k - mu) * rsqrtf(q * (1.f / 64.f) + EPS) * kg + kb);
    if (ln < 8) p.WIDX()[tok * 8 + ln] = bf2f(pr[CWI + ln]) * 0.04419417382f;
  }
}

DI void gdn_prep_item(const Params& p, int l, int it, char* smem0) {
  const int half_ = ltid() >> 8;
  const int cidx = it >> 1, h = (it & 1) * 2 + half_, n = cidx & 255;
  const size_t t0g = (size_t)cidx * 64;
  char* smem = smem0 + half_ * 69632;
  const int tid = ltid() & 255, ln = tid & 63, w = tid >> 6;
  char* qs = smem;
  char* ks = smem + 17408;
  char* vs = smem + 2 * 17408;
  float* Lm = (float*)(smem + 3 * 17408);
  float* gcs = Lm + 4096;
  float* bts = gcs + 64;
  float* egs = bts + 64;
  u16* proj = p.P();
  {
    const int c = tid & 127, rh = tid >> 7;
    uint4 st[12];
#pragma unroll
    for (int part = 0; part < 3; ++part)
#pragma unroll
      for (int i = 0; i < 4; ++i) {
        const int piece = tid + 256 * i, row = piece >> 4, ch = piece & 15;
        st[part * 4 + i] = *(const uint4*)(proj + (t0g + row) * PC + BQ + part * 512 + h * 128 + ch * 8);
      }
    float hx[9];
#pragma unroll
    for (int i = 0; i < 9; ++i) hx[i] = 0.f;
    if (rh == 0 && n != 0) {
#pragma unroll
      for (int part = 0; part < 3; ++part) {
        const u16* hp = p.HALO() + ((size_t)(cidx - 1) * 3) * 1536 + part * 512 + h * 128 + c;
        hx[part * 3 + 0] = bf2f(hp[0]); hx[part * 3 + 1] = bf2f(hp[1536]); hx[part * 3 + 2] = bf2f(hp[2 * 1536]);
      }
    }
#pragma unroll
    for (int part = 0; part < 3; ++part)
#pragma unroll
      for (int i = 0; i < 4; ++i) {
        const int piece = tid + 256 * i, row = piece >> 4, ch = piece & 15;
        char* dst = (part == 0 ? qs : (part == 1 ? ks : vs));
        *(uint4*)(dst + row * 272 + ch * 16) = st[part * 4 + i];
      }
    __syncthreads();
    if (rh == 1) {
#pragma unroll
      for (int part = 0; part < 3; ++part) {
        const char* src = (part == 0 ? qs : (part == 1 ? ks : vs));
        hx[part * 3 + 0] = bf2f(*(const u16*)(src + 29 * 272 + c * 2));
        hx[part * 3 + 1] = bf2f(*(const u16*)(src + 30 * 272 + c * 2));
        hx[part * 3 + 2] = bf2f(*(const u16*)(src + 31 * 272 + c * 2));
      }
    }
    __syncthreads();
#pragma unroll
    for (int part = 0; part < 3; ++part) {
      const int wch = part * 512 + h * 128 + c;
      const float* cw = p.b_conv_w + (size_t)l * 4 * 1536 + wch;
      const float w0 = cw[0], w1 = cw[1536], w2 = cw[2 * 1536], w3 = cw[3 * 1536];
      float xm3 = hx[part * 3 + 0], xm2 = hx[part * 3 + 1], xm1 = hx[part * 3 + 2];
      char* dst = (part == 0 ? qs : (part == 1 ? ks : vs));
#pragma unroll 8
      for (int i = 0; i < 32; ++i) {
        const int r = rh * 32 + i;
        u16* px = (u16*)(dst + r * 272 + c * 2);
        const float x = bf2f(*px);
        const float y = w0 * xm3 + w1 * xm2 + w2 * xm1 + w3 * x;
        xm3 = xm2; xm2 = xm1; xm1 = x;
        *px = f2bf(siluf_(y));
      }
    }
  }
  if (w == 0) {
    const float a = bf2f(proj[(t0g + ln) * PC + BA + h]) + p.b_dt_bias[l * 4 + h];
    const float ea = __expf(a);
    const float sp = (a > 20.f) ? a : ((ea < 0.01f) ? ea * (1.f - ea * (0.5f - ea * 0.333333333f)) : __logf(1.f + ea));
    float g = -__expf(p.b_a_log[l * 4 + h]) * sp;
#pragma unroll
    for (int o = 1; o < 64; o <<= 1) { float t = __shfl_up(g, o); if (ln >= o) g += t; }
    gcs[ln] = g;
    egs[ln] = __expf(g);
    bts[ln] = sigmoidf_(bf2f(proj[(t0g + ln) * PC + BB + h]));
  }
  __syncthreads();
  {
    const int row = tid >> 2, qr = tid & 3;
#pragma unroll
    for (int part = 0; part < 2; ++part) {
      char* base = (part == 0 ? qs : ks) + row * 272 + qr * 64;
      uint4 v[4];
      float ss = 0.f;
#pragma unroll
      for (int i = 0; i < 4; ++i) {
        v[i] = *(uint4*)(base + i * 16);
        float a;
        a = bflo(v[i].x); ss += a * a; a = bfhi(v[i].x); ss += a * a; a = bflo(v[i].y); ss += a * a; a = bfhi(v[i].y); ss += a * a;
        a = bflo(v[i].z); ss += a * a; a = bfhi(v[i].z); ss += a * a; a = bflo(v[i].w); ss += a * a; a = bfhi(v[i].w); ss += a * a;
      }
      ss += __shfl_xor(ss, 1);
      ss += __shfl_xor(ss, 2);
      const float rs = rsqrtf(ss + EPS) * (part == 0 ? 0.08838834764f : 1.f);
#pragma unroll
      for (int i = 0; i < 4; ++i) {
        uint4 o;
        o.x = pack2(bflo(v[i].x) * rs, bfhi(v[i].x) * rs); o.y = pack2(bflo(v[i].y) * rs, bfhi(v[i].y) * rs);
        o.z = pack2(bflo(v[i].z) * rs, bfhi(v[i].z) * rs); o.w = pack2(bflo(v[i].w) * rs, bfhi(v[i].w) * rs);
        *(uint4*)(base + i * 16) = o;
      }
    }
  }
  __syncthreads();
  {
    const int fr = ln & 15, fq = ln >> 4;
    f32x4 kk[4], qk[4];
#pragma unroll
    for (int nt = 0; nt < 4; ++nt) { kk[nt] = f32x4{0, 0, 0, 0}; qk[nt] = f32x4{0, 0, 0, 0}; }
#pragma unroll
    for (int s = 0; s < 4; ++s) {
      const bf16x8 ak = *(const bf16x8*)(ks + (16 * w + fr) * 272 + (32 * s + 8 * fq) * 2);
      const bf16x8 aq = *(const bf16x8*)(qs + (16 * w + fr) * 272 + (32 * s + 8 * fq) * 2);
#pragma unroll
      for (int nt = 0; nt < 4; ++nt) {
        const bf16x8 bk = *(const bf16x8*)(ks + (16 * nt + fr) * 272 + (32 * s + 8 * fq) * 2);
        kk[nt] = mfma16(ak, bk, kk[nt]);
        qk[nt] = mfma16(aq, bk, qk[nt]);
      }
    }
#pragma unroll
    for (int nt = 0; nt < 4; ++nt)
#pragma unroll
      for (int jj = 0; jj < 4; ++jj) {
        const int i = 16 * w + 4 * fq + jj, j = 16 * nt + fr;
        const float dec = (i >= j) ? __expf(gcs[i] - gcs[j]) : 0.f;
        Lm[i * 64 + j] = (i > j) ? bts[i] * kk[nt][jj] * dec : 0.f;
        p.ATT()[(t0g + i) * 256 + h * 64 + j] = f2bf((i >= j) ? qk[nt][jj] * dec : 0.f);
      }
  }
  __syncthreads();
  {
    const int c = tid;
    const bool isu = c < 128;
    const char* src = isu ? (vs + c * 2) : (ks + (c - 128) * 2);
    const float wsel = isu ? 0.f : 1.f;
    float x[64];
#pragma unroll
    for (int i = 0; i < 64; ++i) {
      float a = bf2f(*(const u16*)(src + i * 272)) * bts[i] * fmaf(egs[i] - 1.f, wsel, 1.f);
      const float* Lr = Lm + i * 64;
#pragma unroll
      for (int j = 0; j < i; ++j) a -= Lr[j] * x[j];
      x[i] = a;
      asm volatile("" ::: "memory");
    }
    if (isu) {
      u32 pk[32];
#pragma unroll
      for (int pos = 0; pos < 64; pos += 2) {
        const int hh = pos >> 5, Tt = (pos >> 4) & 1, ii = pos & 15;
        const int r0 = 32 * Tt + (ii & 3) + 8 * (ii >> 2) + 4 * hh;
        const int i1 = ii + 1;
        const int r1 = 32 * Tt + (i1 & 3) + 8 * (i1 >> 2) + 4 * hh;
        pk[pos >> 1] = pack2(x[r0], x[r1]);
      }
      char* dst = (char*)proj + ((t0g + (c >> 1)) * PC + BV + h * 128) * 2 + (c & 1) * 128;
#pragma unroll
      for (int i = 0; i < 8; ++i) *(uint4*)(dst + i * 16) = uint4{pk[4 * i], pk[4 * i + 1], pk[4 * i + 2], pk[4 * i + 3]};
    } else {
#pragma unroll
      for (int i = 0; i < 64; ++i) proj[(t0g + i) * PC + BK_ + h * 128 + (c - 128)] = f2bf(x[i]);
    }
  }
  {
    const float glast = gcs[63];
#pragma unroll
    for (int i = 0; i < 4; ++i) {
      const int piece = tid + 256 * i, row = piece >> 4, ch = piece & 15;
      const uint4 v = *(const uint4*)(qs + row * 272 + ch * 16);
      const float e = egs[row];
      uint4 o;
      o.x = pack2(bflo(v.x) * e, bfhi(v.x) * e); o.y = pack2(bflo(v.y) * e, bfhi(v.y) * e);
      o.z = pack2(bflo(v.z) * e, bfhi(v.z) * e); o.w = pack2(bflo(v.w) * e, bfhi(v.w) * e);
      *(uint4*)(proj + (t0g + row) * PC + BQ + h * 128 + ch * 8) = o;
    }
    const int d = tid & 127, half = tid >> 7;
    u32 pk[16];
#pragma unroll
    for (int i = 0; i < 16; ++i) {
      const int r0 = half * 32 + 2 * i;
      const float a = bf2f(*(const u16*)(ks + r0 * 272 + d * 2)) * __expf(glast - gcs[r0]);
      const float b = bf2f(*(const u16*)(ks + (r0 + 1) * 272 + d * 2)) * __expf(glast - gcs[r0 + 1]);
      pk[i] = pack2(a, b);
    }
    u16* dst = p.KDT() + (((size_t)cidx * 4 + h) * 128 + d) * 64 + half * 32;
#pragma unroll
    for (int i = 0; i < 4; ++i) *(uint4*)(dst + i * 8) = uint4{pk[4 * i], pk[4 * i + 1], pk[4 * i + 2], pk[4 * i + 3]};
    if (tid == 0) p.GL()[cidx * 4 + h] = egs[63];
  }
  __syncthreads();
}

DI void gdn_rec_item(const Params& p, int l, int bh, char* smem, bool wr) {
  const int b = bh >> 2, h = bh & 3;
  const int tid = ltid(), ln = tid & 63, w = tid >> 6, hh = ln >> 5, c31 = ln & 31;
  const bool is_comp = w < 4;
  constexpr int BUFB = 59904;
  float* Ot = (float*)(smem + 2 * BUFB);
  u16* proj = p.P();
  const float* ng = p.b_norm_g + l * 128;
  const int lt = tid & 255;
#define LD_AQ(i, n_)                                                                                      \
  {                                                                                                       \
    const size_t t0g_ = ((size_t)b * 256 + (n_)) * 64;                                                    \
    const int piece = ltv + 256 * i, row = piece >> 4, ch = piece & 15;                                   \
    la##i = *(const uint4*)(proj + (t0g_ + row) * PC + BK_ + h * 128 + ch * 8);                           \
    lq##i = *(const uint4*)(proj + (t0g_ + row) * PC + BQ + h * 128 + ch * 8);                            \
  }
#define LD_K(i, n_)                                                                                       \
  {                                                                                                       \
    const int piece = ltv + 256 * i, row2 = piece >> 3, ch2 = piece & 7;                                  \
    lk##i = *(const uint4*)(p.KDT() + ((((size_t)b * 256 + (n_)) * 4 + h) * 128 + row2) * 64 + ch2 * 8);  \
  }
#define LD_T(i, n_)                                                                                       \
  {                                                                                                       \
    const size_t t0g_ = ((size_t)b * 256 + (n_)) * 64;                                                    \
    const int piece = ltv + 256 * i, row = piece >> 3, ch = piece & 7;                                     \
    lt##i = *(const uint4*)(p.ATT() + (t0g_ + row) * 256 + h * 64 + ch * 8);                              \
  }
#define LD_R1(n_) { LD_AQ(0, n_) LD_AQ(1, n_) LD_AQ(2, n_) LD_AQ(3, n_) }
#define LD_R2(n_) { LD_K(0, n_) LD_K(1, n_) LD_K(2, n_) LD_K(3, n_) LD_T(0, n_) LD_T(1, n_) }
#define ST_AQ(i, buf_)                                                                                    \
  {                                                                                                       \
    char* Wm_ = smem + (buf_) * BUFB; char* Qd_ = Wm_ + 16896;                                            \
    const int piece = ltv + 256 * i, row = piece >> 4, ch = piece & 15;                                   \
    *(uint2*)(Wm_ + row * 264 + ch * 16) = uint2{la##i.x, la##i.y}; *(uint2*)(Wm_ + row * 264 + ch * 16 + 8) = uint2{la##i.z, la##i.w}; \
    *(uint2*)(Qd_ + row * 264 + ch * 16) = uint2{lq##i.x, lq##i.y}; *(uint2*)(Qd_ + row * 264 + ch * 16 + 8) = uint2{lq##i.z, lq##i.w}; \
  }
#define ST_K(i, buf_)                                                                                     \
  {                                                                                                       \
    char* Kt_ = smem + (buf_) * BUFB + 2 * 16896;                                                         \
    const int piece = ltv + 256 * i, row2 = piece >> 3, ch2 = piece & 7;                                  \
    *(uint2*)(Kt_ + row2 * 136 + ch2 * 16) = uint2{lk##i.x, lk##i.y}; *(uint2*)(Kt_ + row2 * 136 + ch2 * 16 + 8) = uint2{lk##i.z, lk##i.w}; \
  }
#define ST_T(i, buf_)                                                                                     \
  {                                                                                                       \
    char* At_ = smem + (buf_) * BUFB + 2 * 16896 + 17408;                                                 \
    const int piece = ltv + 256 * i, row = piece >> 3, ch = piece & 7;                                     \
    *(uint2*)(At_ + row * 136 + ch * 16) = uint2{lt##i.x, lt##i.y}; *(uint2*)(At_ + row * 136 + ch * 16 + 8) = uint2{lt##i.z, lt##i.w}; \
  }
#define ST_R1(buf_) { ST_AQ(0, buf_) ST_AQ(1, buf_) ST_AQ(2, buf_) ST_AQ(3, buf_) }
#define ST_R2(buf_) { ST_K(0, buf_) ST_K(1, buf_) ST_K(2, buf_) ST_K(3, buf_) ST_T(0, buf_) ST_T(1, buf_) }
#define LD_Z(n_)                                                                                          \
  {                                                                                                       \
    const u16* zp_ = proj + (((size_t)b * 256 + (n_)) * 64 + nrow) * PC + BZ + h * 128 + nqr * 32;        \
    lz0 = *(const uint4*)(zp_); lz1 = *(const uint4*)(zp_ + 8); lz2 = *(const uint4*)(zp_ + 16); lz3 = *(const uint4*)(zp_ + 24); \
  }
  f32x16 S[4];
#pragma unroll
  for (int i = 0; i < 4; ++i)
#pragma unroll
    for (int j = 0; j < 16; ++j) S[i][j] = 0.f;
  const int e = 32 * w + c31;
  uint4 un0, un1, un2, un3;
  float gln = 0.f;
#define LD_U(n_)                                                                                          \
  {                                                                                                       \
    const uint4* up_ = (const uint4*)((const char*)proj + ((((size_t)b * 256 + (n_)) * 64 + (e >> 1)) * PC + BV + h * 128) * 2 + (e & 1) * 128 + hh * 64); \
    un0 = up_[0]; un1 = up_[1]; un2 = up_[2]; un3 = up_[3];                                               \
    gln = p.GL()[((size_t)b * 256 + (n_)) * 4 + h];                                                       \
  }
  if (!is_comp) {
    const int ltv = lt;
    uint4 la0, la1, la2, la3, lq0, lq1, lq2, lq3, lk0, lk1, lk2, lk3, lt0, lt1;
    LD_R1(0) LD_R2(0)
    ST_R1(0) ST_R2(0)
  } else {
    LD_U(0)
  }
  for (int n = 0; n < 256; ++n) {
    f32x16 o[2];
    __syncthreads();
    if (is_comp) {
      int lnv = ln;
      asm volatile("" : "+v"(lnv));
      const int hh = lnv >> 5, c31 = lnv & 31;
      const char* Wm = smem + (n & 1) * BUFB;
      const char* Qd = Wm + 16896;
      const char* Kt = Wm + 2 * 16896;
      const char* At = Kt + 17408;
      f32x16 ws[2];
#pragma unroll
      for (int i = 0; i < 2; ++i)
#pragma unroll
        for (int j = 0; j < 16; ++j) { ws[i][j] = 0.f; o[i][j] = 0.f; }
#pragma unroll
      for (int Tt = 0; Tt < 4; ++Tt)
#pragma unroll
        for (int s = 0; s < 2; ++s) {
          const int kb = 32 * Tt + 16 * s;
          const bf16x8 sps = pack8(S[Tt], s);
#pragma unroll
          for (int Tc = 0; Tc < 2; ++Tc) {
            ws[Tc] = mfma32(afrag_perm(Wm, 32 * Tc + c31, 264, kb, hh), sps, ws[Tc]);
            o[Tc] = mfma32(afrag_perm(Qd, 32 * Tc + c31, 264, kb, hh), sps, o[Tc]);
          }
        }
      f32x16 vn[2];
      vn[0][0] = bflo(un0.x) - ws[0][0]; vn[0][1] = bfhi(un0.x) - ws[0][1]; vn[0][2] = bflo(un0.y) - ws[0][2]; vn[0][3] = bfhi(un0.y) - ws[0][3];
      vn[0][4] = bflo(un0.z) - ws[0][4]; vn[0][5] = bfhi(un0.z) - ws[0][5]; vn[0][6] = bflo(un0.w) - ws[0][6]; vn[0][7] = bfhi(un0.w) - ws[0][7];
      vn[0][8] = bflo(un1.x) - ws[0][8]; vn[0][9] = bfhi(un1.x) - ws[0][9]; vn[0][10] = bflo(un1.y) - ws[0][10]; vn[0][11] = bfhi(un1.y) - ws[0][11];
      vn[0][12] = bflo(un1.z) - ws[0][12]; vn[0][13] = bfhi(un1.z) - ws[0][13]; vn[0][14] = bflo(un1.w) - ws[0][14]; vn[0][15] = bfhi(un1.w) - ws[0][15];
      vn[1][0] = bflo(un2.x) - ws[1][0]; vn[1][1] = bfhi(un2.x) - ws[1][1]; vn[1][2] = bflo(un2.y) - ws[1][2]; vn[1][3] = bfhi(un2.y) - ws[1][3];
      vn[1][4] = bflo(un2.z) - ws[1][4]; vn[1][5] = bfhi(un2.z) - ws[1][5]; vn[1][6] = bflo(un2.w) - ws[1][6]; vn[1][7] = bfhi(un2.w) - ws[1][7];
      vn[1][8] = bflo(un3.x) - ws[1][8]; vn[1][9] = bfhi(un3.x) - ws[1][9]; vn[1][10] = bflo(un3.y) - ws[1][10]; vn[1][11] = bfhi(un3.y) - ws[1][11];
      vn[1][12] = bflo(un3.z) - ws[1][12]; vn[1][13] = bfhi(un3.z) - ws[1][13]; vn[1][14] = bflo(un3.w) - ws[1][14]; vn[1][15] = bfhi(un3.w) - ws[1][15];
      const float gl = gln;
      if (n + 1 < 256) LD_U(n + 1)
      bf16x8 vp[2][2];
#pragma unroll
      for (int Tc = 0; Tc < 2; ++Tc) { vp[Tc][0] = pack8(vn[Tc], 0); vp[Tc][1] = pack8(vn[Tc], 1); }
#pragma unroll
      for (int s = 0; s < 2; ++s) {
        o[0] = mfma32(afrag_perm(At, c31, 136, 16 * s, hh), vp[0][s], o[0]);
        o[1] = mfma32(afrag_perm(At, 32 + c31, 136, 16 * s, hh), vp[0][s], o[1]);
        o[1] = mfma32(afrag_perm(At, 32 + c31, 136, 32 + 16 * s, hh), vp[1][s], o[1]);
      }
#pragma unroll
      for (int Tt = 0; Tt < 4; ++Tt)
#pragma unroll
        for (int j = 0; j < 16; ++j) S[Tt][j] *= gl;
#pragma unroll
      for (int Tc = 0; Tc < 2; ++Tc)
#pragma unroll
        for (int s = 0; s < 2; ++s)
#pragma unroll
          for (int Tt = 0; Tt < 4; ++Tt)
            S[Tt] = mfma32(afrag_perm(Kt, 32 * Tt + c31, 136, 32 * Tc + 16 * s, hh), vp[Tc][s], S[Tt]);
    } else {
      int ltv = lt;
      asm volatile("" : "+v"(ltv));
      const int nrow = ltv >> 2, nqr = ltv & 3;
      const int nn = (n + 1 < 256) ? n + 1 : 255;
      {
        uint4 la0, la1, la2, la3, lq0, lq1, lq2, lq3;
        LD_R1(nn)
        ST_R1((n + 1) & 1)
      }
      uint4 lz0, lz1, lz2, lz3;
      {
        uint4 lk0, lk1, lk2, lk3, lt0, lt1;
        LD_R2(nn)
        const int nz = (n > 0) ? n - 1 : 0;
        LD_Z(nz)
        ST_R2((n + 1) & 1)
      }
      if (n > 0) {
        const float* orow = Ot + nrow * 132 + nqr * 32;
        float ss = 0.f;
#pragma unroll
        for (int i = 0; i < 8; ++i) {
          const float4 v = *(const float4*)(orow + 4 * i);
          ss += v.x * v.x + v.y * v.y + v.z * v.z + v.w * v.w;
        }
        ss += __shfl_xor(ss, 1);
        ss += __shfl_xor(ss, 2);
        const float rs = rsqrtf(ss * (1.f / 128.f) + EPS);
        u16* zp = proj + (((size_t)b * 256 + (n - 1)) * 64 + nrow) * PC + BZ + h * 128 + nqr * 32;
        const float* gg = ng + nqr * 32;
#define GN1(i, Z)                                                                                          \
        {                                                                                                  \
          const float4 oa = *(const float4*)(orow + 8 * i), ob = *(const float4*)(orow + 8 * i + 4);       \
          uint4 r;                                                                                         \
          r.x = pack2(oa.x * rs * gg[8 * i + 0] * siluf_(bflo(Z.x)), oa.y * rs * gg[8 * i + 1] * siluf_(bfhi(Z.x))); \
          r.y = pack2(oa.z * rs * gg[8 * i + 2] * siluf_(bflo(Z.y)), oa.w * rs * gg[8 * i + 3] * siluf_(bfhi(Z.y))); \
          r.z = pack2(ob.x * rs * gg[8 * i + 4] * siluf_(bflo(Z.z)), ob.y * rs * gg[8 * i + 5] * siluf_(bfhi(Z.z))); \
          r.w = pack2(ob.z * rs * gg[8 * i + 6] * siluf_(bflo(Z.w)), ob.w * rs * gg[8 * i + 7] * siluf_(bfhi(Z.w))); \
          if (wr) *(uint4*)(zp + 8 * i) = r;                                                               \
        }
        GN1(0, lz0) GN1(1, lz1) GN1(2, lz2) GN1(3, lz3)
      }
    }
    __syncthreads();
    if (is_comp) {
#pragma unroll
      for (int Tc = 0; Tc < 2; ++Tc)
#pragma unroll
        for (int j = 0; j < 16; ++j) Ot[(32 * Tc + crow(j, hh)) * 132 + e] = o[Tc][j];
    }
  }
  __syncthreads();
  if (!is_comp) {
    const int n = 256;
    const int nrow = lt >> 2, nqr = lt & 3;
    uint4 lz0, lz1, lz2, lz3;
    LD_Z(255)
    const float* orow = Ot + nrow * 132 + nqr * 32;
    float ss = 0.f;
#pragma unroll
    for (int i = 0; i < 8; ++i) {
      const float4 v = *(const float4*)(orow + 4 * i);
      ss += v.x * v.x + v.y * v.y + v.z * v.z + v.w * v.w;
    }
    ss += __shfl_xor(ss, 1);
    ss += __shfl_xor(ss, 2);
    const float rs = rsqrtf(ss * (1.f / 128.f) + EPS);
    u16* zp = proj + (((size_t)b * 256 + (n - 1)) * 64 + nrow) * PC + BZ + h * 128 + nqr * 32;
    const float* gg = ng + nqr * 32;
    GN1(0, lz0) GN1(1, lz1) GN1(2, lz2) GN1(3, lz3)
  }
#undef GN1
#undef LD_AQ
#undef LD_K
#undef LD_R1
#undef LD_R2
#undef LD_T
#undef ST_AQ
#undef ST_K
#undef ST_R1
#undef ST_R2
#undef ST_T
#undef LD_Z
#undef LD_U
  __syncthreads();
}

DI void diff_item(const Params& p, int l, int qt, int bh, char* smem) {
  const int b = bh >> 2, h = bh & 3;
  const int tid = ltid(), ln = tid & 63, w = tid >> 6, hh = ln >> 5, c31 = ln & 31;
  const int st = w & 3, c = w >> 2;
  const size_t tokbase = (size_t)b * T;
  const int qb = qt * 128 + 32 * st + c31;
  u16* proj = p.P();
  bf16x8 qf[4];
  {
    const u16* qrow = proj + (tokbase + qb) * PC + AQ + h * 128 + c * 64 + 8 * hh;
#pragma unroll
    for (int s = 0; s < 4; ++s) qf[s] = *(const bf16x8*)(qrow + 16 * s);
  }
  f32x16 O[4];
  float mrun, lrun;
  const float sc = 0.125f * 1.44269504089f;
  char* Ks = smem;
  char* Vs = smem + 17408;
  uint4 rk0, rk1, rv0, rv1;
  const int srow = tid >> 4, sch = tid & 15;
#define DLOAD1(i, kt)                                                                \
  {                                                                                  \
    const u16* base = proj + (tokbase + (kt) * 64 + srow + 32 * i) * PC + h * 128 + sch * 8; \
    rk##i = *(const uint4*)(base + AK);                                              \
    rv##i = *(const uint4*)(base + AV);                                              \
  }
#define DLOAD(kt) { DLOAD1(0, kt) DLOAD1(1, kt) }
#define DSTORE1(i)                                                \
  *(uint4*)(Ks + (srow + 32 * i) * 272 + sch * 16) = rk##i;       \
  *(uint4*)(Vs + (srow + 32 * i) * 320 + sch * 16) = rv##i;
  const int nkt = 2 * qt + 2;
#pragma unroll 1
  for (int rep = 0; rep < DUP_DIFF; ++rep) {
#pragma unroll
  for (int i = 0; i < 4; ++i)
#pragma unroll
    for (int j = 0; j < 16; ++j) O[i][j] = 0.f;
  mrun = -INFINITY; lrun = 0.f;
  DLOAD(0);
  for (int kt = 0; kt < nkt; ++kt) {
    __syncthreads();
    DSTORE1(0) DSTORE1(1)
    __syncthreads();
    if (kt + 1 < nkt) { DLOAD(kt + 1); }
    if (kt * 64 > qt * 128 + 32 * st + 31) continue;
    f32x16 sa[2];
#pragma unroll
    for (int k2 = 0; k2 < 2; ++k2) {
#pragma unroll
      for (int j = 0; j < 16; ++j) sa[k2][j] = 0.f;
#pragma unroll
      for (int s = 0; s < 4; ++s)
        sa[k2] = mfma32(*(const bf16x8*)(Ks + (32 * k2 + c31) * 272 + (c * 64 + 16 * s + 8 * hh) * 2), qf[s], sa[k2]);
    }
    if (kt >= 2 * qt) {
#pragma unroll
      for (int k2 = 0; k2 < 2; ++k2)
#pragma unroll
        for (int j = 0; j < 16; ++j)
          if (kt * 64 + 32 * k2 + crow(j, hh) > qb) sa[k2][j] = -INFINITY;
    }
    float tmax = sa[0][0];
#pragma unroll
    for (int k2 = 0; k2 < 2; ++k2)
#pragma unroll
      for (int j = 0; j < 16; ++j) tmax = fmaxf(tmax, sa[k2][j]);
    tmax = xhalf_max(tmax);
    const float cand = tmax * sc;
    if (__any(cand > mrun + 8.f)) {
      const float mnew = fmaxf(mrun, cand);
      const float alpha = __builtin_amdgcn_exp2f(mrun - mnew);
      mrun = mnew;
      lrun *= alpha;
#pragma unroll
      for (int i = 0; i < 4; ++i)
#pragma unroll
        for (int j = 0; j < 16; ++j) O[i][j] *= alpha;
    }
    float psum = 0.f;
#pragma unroll
    for (int k2 = 0; k2 < 2; ++k2)
#pragma unroll
      for (int j = 0; j < 16; ++j) { const float pv = __builtin_amdgcn_exp2f(sa[k2][j] * sc - mrun); sa[k2][j] = pv; psum += pv; }
    lrun += psum;
#pragma unroll
    for (int k2 = 0; k2 < 2; ++k2)
#pragma unroll
      for (int s2 = 0; s2 < 2; ++s2) {
        const bf16x8 pp = pack8(sa[k2], s2);
        bf16x8 vf[4];
        trfrag4<320>(Vs, 32 * k2 + 16 * s2, ln, vf);
#pragma unroll
        for (int mt = 0; mt < 4; ++mt) O[mt] = mfma32(vf[mt], pp, O[mt]);
      }
  }
  }
#undef DLOAD
#undef DLOAD1
#undef DSTORE1
  __syncthreads();
  const float ltot = xhalf_sum(lrun);
  const float inv = 1.f / ltot;
  float* xch = (float*)smem + st * 32 * 132;
  if (c == 1) {
#pragma unroll
    for (int mt = 0; mt < 4; ++mt)
#pragma unroll
      for (int i4 = 0; i4 < 4; ++i4)
        *(float4*)(xch + c31 * 132 + 32 * mt + 8 * i4 + 4 * hh) =
            float4{O[mt][4 * i4] * inv, O[mt][4 * i4 + 1] * inv, O[mt][4 * i4 + 2] * inv, O[mt][4 * i4 + 3] * inv};
  }
  __syncthreads();
  if (c == 0) {
    const float lam = p.LAM()[l], oml = 1.f - p.LAM()[2 + l];
    float ss = 0.f;
#pragma unroll
    for (int mt = 0; mt < 4; ++mt)
#pragma unroll
      for (int i4 = 0; i4 < 4; ++i4) {
        const float4 o1 = *(const float4*)(xch + c31 * 132 + 32 * mt + 8 * i4 + 4 * hh);
        float d;
        d = O[mt][4 * i4] * inv - lam * o1.x; O[mt][4 * i4] = d; ss += d * d;
        d = O[mt][4 * i4 + 1] * inv - lam * o1.y; O[mt][4 * i4 + 1] = d; ss += d * d;
        d = O[mt][4 * i4 + 2] * inv - lam * o1.z; O[mt][4 * i4 + 2] = d; ss += d * d;
        d = O[mt][4 * i4 + 3] * inv - lam * o1.w; O[mt][4 * i4 + 3] = d; ss += d * d;
      }
    ss = xhalf_sum(ss);
    const float rs = rsqrtf(ss * (1.f / 128.f) + EPS) * oml;
    const float* sg = p.a_subln_g + l * 128;
    int qb_e = qb;
    asm volatile("" : "+v"(qb_e));
    u16* orow = proj + (tokbase + qb_e) * PC + AQ + h * 128;
#pragma unroll
    for (int mt = 0; mt < 4; ++mt)
#pragma unroll
      for (int i4 = 0; i4 < 4; ++i4) {
        const int dv = 32 * mt + 8 * i4 + 4 * hh;
        const float4 gg = *(const float4*)(sg + dv);
        uint2 o;
        o.x = pack2(O[mt][4 * i4] * rs * gg.x, O[mt][4 * i4 + 1] * rs * gg.y);
        o.y = pack2(O[mt][4 * i4 + 2] * rs * gg.z, O[mt][4 * i4 + 3] * rs * gg.w);
        *(uint2*)(orow + dv) = o;
      }
  }
  __syncthreads();
}

DI u32 mono_key(float f) { u32 u = __float_as_uint(f); return (u & 0x80000000u) ? ~u : (u | 0x80000000u); }

constexpr int DCAP = 640;
DI u32 dsa_prune(u32* ck, u16* ci, int cnt, u32 tau_old, bool exact, int ln, int& newcnt) {
  u32 kv[10];
  u16 iv[10];
  u32 mx = 0u;
#pragma unroll
  for (int j = 0; j < 10; ++j) {
    const int pos = ln + 64 * j;
    const bool vd = pos < cnt;
    kv[j] = vd ? ck[pos] : 0u;
    iv[j] = vd ? ci[pos] : (u16)0;
    mx = max(mx, kv[j]);
  }
#pragma unroll
  for (int o = 32; o; o >>= 1) mx = max(mx, (u32)__shfl_xor((int)mx, o));
  u32 L = tau_old + 1u, H = mx + 1u;
  int curL = cnt;
  while ((exact || curL > 384) && (H - L) > 1u) {
    const u32 mid = L + ((H - L) >> 1);
    int c = 0;
#pragma unroll
    for (int j = 0; j < 10; ++j) c += __popcll(__ballot(kv[j] >= mid));
    if (c >= 256) { L = mid; curL = c; } else H = mid;
  }
  int ngt = 0;
#pragma unroll
  for (int j = 0; j < 10; ++j) ngt += __popcll(__ballot(kv[j] > L));
  const int target = (!exact && curL <= 384) ? curL : 256;
  const int need = target - ngt;
  int run_gt = 0, run_eq = 0;
#pragma unroll
  for (int j = 0; j < 10; ++j) {
    const bool gt = kv[j] > L, eq = (kv[j] == L);
    const u64 mg = __ballot(gt), me = __ballot(eq);
    const int pg = run_gt + (int)lane_lt_cnt(mg), pe = run_eq + (int)lane_lt_cnt(me);
    if (gt) { ck[pg] = kv[j]; ci[pg] = iv[j]; }
    else if (eq && pe < need) { ck[ngt + pe] = kv[j]; ci[ngt + pe] = iv[j]; }
    run_gt += __popcll(mg);
    run_eq += __popcll(me);
  }
  newcnt = target;
  return L;
}

DI void dsa_item(const Params& p, int l, int tile32, int b, char* smem) {
  const int tid = ltid(), ln = tid & 63, w = tid >> 6, hh = ln >> 5, c31 = ln & 31;
  const int t0 = tile32 * 32 + 4 * w;
  const size_t tokbase = (size_t)b * T;
  u16* QX = (u16*)p.out;
  char* wl = smem + w * 17408;
  u32* ckey = (u32*)wl;
  u16* cidx = (u16*)(wl + 10240);
  u16* ifin = (u16*)(wl + 15360);
  char* tile = wl;
  int cnt0 = 0, cnt1 = 0, cnt2 = 0, cnt3 = 0;
  {
    bf16x8 qa[4];
    {
      const int r = c31, ql = 2 * ((r >> 2) & 1) + (r & 1), hd = ((r & 3) >> 1) + 2 * (r >> 3);
      const u16* qrow = QX + (tokbase + t0 + ql) * LDQ + 1024 + hd * 64 + 8 * hh;
#pragma unroll
      for (int s = 0; s < 4; ++s) qa[s] = *(const bf16x8*)(qrow + 16 * s);
    }
    typedef float f32x2 __attribute__((ext_vector_type(2)));
    f32x2 wq2[8];
    {
      const float4* wi = (const float4*)(p.WIDX() + (tokbase + t0 + 2 * hh) * 8);
      const float4 a0 = wi[0], a1 = wi[1], b0 = wi[2], b1 = wi[3];
      wq2[0] = f32x2{a0.x, b0.x}; wq2[1] = f32x2{a0.y, b0.y}; wq2[2] = f32x2{a0.z, b0.z}; wq2[3] = f32x2{a0.w, b0.w};
      wq2[4] = f32x2{a1.x, b1.x}; wq2[5] = f32x2{a1.y, b1.y}; wq2[6] = f32x2{a1.z, b1.z}; wq2[7] = f32x2{a1.w, b1.w};
    }
    const int qpos0 = t0 + 2 * hh;
    const int nkt = ((t0 + 3) >> 5) + 1;
    const u32 lmask = (1u << c31) - 1u;
#pragma unroll 1
    for (int rep = 0; rep < DUP_DSA1; ++rep) {
    cnt0 = cnt1 = cnt2 = cnt3 = 0;
    u32 tau0 = 0u, tau1 = 0u, tau2 = 0u, tau3 = 0u;
    bf16x8 kn[4][4];
    {
#pragma unroll
      for (int t = 0; t < 4; ++t) {
        const u16* krow = p.KIDX() + (tokbase + t * 32 + c31) * 64 + 8 * hh;
#pragma unroll
        for (int s = 0; s < 4; ++s) kn[t][s] = *(const bf16x8*)(krow + 16 * s);
      }
    }
    const int ngrp = (nkt + 3) >> 2;
    for (int g = 0; g <= ngrp; ++g) {
      const int lim = (g < ngrp) ? (DCAP - 128) : 256;
      for (;;) {
        const int q = (cnt0 > lim) ? 0 : (cnt1 > lim) ? 1 : (cnt2 > lim) ? 2 : (cnt3 > lim) ? 3 : -1;
        if (q < 0) break;
        const int c = (q == 0) ? cnt0 : (q == 1) ? cnt1 : (q == 2) ? cnt2 : cnt3;
        const u32 to = (q == 0) ? tau0 : (q == 1) ? tau1 : (q == 2) ? tau2 : tau3;
        int nc;
        const u32 t = dsa_prune(ckey + q * DCAP, cidx + q * DCAP, c, to, g == ngrp, ln, nc);
        if (q == 0) { cnt0 = nc; tau0 = t; } else if (q == 1) { cnt1 = nc; tau1 = t; }
        else if (q == 2) { cnt2 = nc; tau2 = t; } else { cnt3 = nc; tau3 = t; }
      }
      if (g == ngrp) break;
      bf16x8 kc[4][4];
#pragma unroll
      for (int t = 0; t < 4; ++t)
#pragma unroll
        for (int s = 0; s < 4; ++s) kc[t][s] = kn[t][s];
      if (g + 1 < ngrp) {
#pragma unroll
        for (int t = 0; t < 4; ++t) {
          const u16* krow = p.KIDX() + (tokbase + (g + 1) * 128 + t * 32 + c31) * 64 + 8 * hh;
#pragma unroll
          for (int s = 0; s < 4; ++s) kn[t][s] = *(const bf16x8*)(krow + 16 * s);
        }
      }
      const u32 tauA = hh ? tau2 : tau0, tauB = hh ? tau3 : tau1;
#pragma unroll
      for (int t = 0; t < 4; ++t) {
        const int key = (g * 4 + t) * 32 + c31;
        f32x16 acc;
#pragma unroll
        for (int j = 0; j < 16; ++j) acc[j] = 0.f;
#pragma unroll
        for (int s = 0; s < 4; ++s) acc = mfma32(qa[s], kc[t][s], acc);
        f32x2 ss2 = f32x2{0.f, 0.f};
#pragma unroll
        for (int hq = 0; hq < 8; ++hq) {
          const f32x2 rr = f32x2{__builtin_amdgcn_fmed3f(acc[2 * hq], 0.f, 3.0e38f), __builtin_amdgcn_fmed3f(acc[2 * hq + 1], 0.f, 3.0e38f)};
          ss2 = __builtin_elementwise_fma(wq2[hq], rr, ss2);
        }
        const float s0 = ss2.x, s1 = ss2.y;
        const u32 k0 = mono_key(s0), k1 = mono_key(s1);
        const bool c0 = (key <= qpos0) && (k0 > tauA), c1 = (key <= qpos0 + 1) && (k1 > tauB);
        const u64 m0 = __ballot(c0), m1 = __ballot(c1);
        if (m0 | m1) {
          const u32 h0 = hh ? (u32)(m0 >> 32) : (u32)m0, h1 = hh ? (u32)(m1 >> 32) : (u32)m1;
          const int pA = (hh ? cnt2 : cnt0) + __popc(h0 & lmask), pB = (hh ? cnt3 : cnt1) + __popc(h1 & lmask);
          if (c0) { ckey[(2 * hh) * DCAP + pA] = k0; cidx[(2 * hh) * DCAP + pA] = (u16)key; }
          if (c1) { ckey[(2 * hh + 1) * DCAP + pB] = k1; cidx[(2 * hh + 1) * DCAP + pB] = (u16)key; }
          cnt0 += __popc((u32)m0); cnt2 += __popc((u32)(m0 >> 32));
          cnt1 += __popc((u32)m1); cnt3 += __popc((u32)(m1 >> 32));
        }
      }
    }
#pragma unroll
    for (int qq = 0; qq < 4; ++qq) {
      const int cq = (qq == 0) ? cnt0 : (qq == 1) ? cnt1 : (qq == 2) ? cnt2 : cnt3;
#pragma unroll
      for (int j = 0; j < 4; ++j) {
        const int pos = ln + 64 * j;
        ifin[qq * 256 + pos] = (pos < cq) ? cidx[qq * DCAP + pos] : (u16)0;
      }
    }
    }
  }
  const float sc = 0.125f * 1.44269504089f;
#pragma unroll 1
  for (int rep2 = 0; rep2 < DUP_DSA2; ++rep2)
#pragma unroll 1
  for (int qq = 0; qq < 4; ++qq) {
    const int nsel = (qq == 0) ? cnt0 : (qq == 1) ? cnt1 : (qq == 2) ? cnt2 : cnt3;
    const size_t tq = tokbase + t0 + qq;
    bf16x8 qf[8];
    {
      const u16* qab = QX + tq * LDQ + (c31 & 7) * 128 + 8 * hh;
#pragma unroll
      for (int s = 0; s < 8; ++s) qf[s] = *(const bf16x8*)(qab + 16 * s);
    }
    f32x16 O[4];
#pragma unroll
    for (int i = 0; i < 4; ++i)
#pragma unroll
      for (int j = 0; j < 16; ++j) O[i][j] = 0.f;
    float mrun = -INFINITY, lrun = 0.f;
    const int ntile = (nsel + 31) >> 5;
    uint4 gr0, gr1, gr2, gr3, gr4, gr5, gr6, gr7;
#define GGATHER1(i, tt_)                                                                     \
    {                                                                                        \
      const int piece = ln + 64 * i, row = piece >> 4, ch = piece & 15;                      \
      const int idx = ifin[qq * 256 + (tt_) * 32 + row];                                     \
      gr##i = *(const uint4*)(p.CKV() + (tokbase + idx) * 128 + ch * 8);                     \
    }
#define GGATHER(tt_) { GGATHER1(0, tt_) GGATHER1(1, tt_) GGATHER1(2, tt_) GGATHER1(3, tt_) GGATHER1(4, tt_) GGATHER1(5, tt_) GGATHER1(6, tt_) GGATHER1(7, tt_) }
#define GSTORE1(i) { const int piece = ln + 64 * i, row = piece >> 4, ch = piece & 15; *(uint4*)(tile + row * 272 + ch * 16) = gr##i; }
    if (ntile > 0) GGATHER(0)
    for (int tt = 0; tt < ntile; ++tt) {
      GSTORE1(0) GSTORE1(1) GSTORE1(2) GSTORE1(3) GSTORE1(4) GSTORE1(5) GSTORE1(6) GSTORE1(7)
      if (tt + 1 < ntile) GGATHER(tt + 1)
      __builtin_amdgcn_fence(__ATOMIC_RELEASE, "wavefront");
      f32x16 sa;
#pragma unroll
      for (int j = 0; j < 16; ++j) sa[j] = 0.f;
#pragma unroll
      for (int s = 0; s < 8; ++s) sa = mfma32(*(const bf16x8*)(tile + c31 * 272 + (16 * s + 8 * hh) * 2), qf[s], sa);
      float tmax = -INFINITY;
#pragma unroll
      for (int j = 0; j < 16; ++j) {
        if (tt * 32 + crow(j, hh) >= nsel) sa[j] = -INFINITY;
        tmax = fmaxf(tmax, sa[j]);
      }
      tmax = xhalf_max(tmax);
      const float cand = tmax * sc;
      if (__any(cand > mrun + 8.f)) {
        const float mnew = fmaxf(mrun, cand);
        const float alpha = __builtin_amdgcn_exp2f(mrun - mnew);
        mrun = mnew;
        lrun *= alpha;
#pragma unroll
        for (int i = 0; i < 4; ++i)
#pragma unroll
          for (int j = 0; j < 16; ++j) O[i][j] *= alpha;
      }
      float psum = 0.f;
#pragma unroll
      for (int j = 0; j < 16; ++j) { const float pv = __builtin_amdgcn_exp2f(sa[j] * sc - mrun); sa[j] = pv; psum += pv; }
      lrun += psum;
#pragma unroll
      for (int s2 = 0; s2 < 2; ++s2) {
        const bf16x8 pp = pack8(sa, s2);
        bf16x8 vf[4];
        trfrag4<272>(tile, 16 * s2, ln, vf);
#pragma unroll
        for (int mt = 0; mt < 4; ++mt) O[mt] = mfma32(vf[mt], pp, O[mt]);
      }
      __builtin_amdgcn_fence(__ATOMIC_ACQ_REL, "wavefront");
    }
#undef GGATHER1
#undef GGATHER
#undef GSTORE1
    const float ltot = xhalf_sum(lrun);
    const float inv = 1.f / ltot;
    if (c31 < 8 && rep2 == DUP_DSA2 - 1) {
      u16* orow = QX + tq * LDQ + c31 * 128;
#pragma unroll
      for (int mt = 0; mt < 4; ++mt)
#pragma unroll
        for (int i4 = 0; i4 < 4; ++i4) {
          uint2 o;
          o.x = pack2(O[mt][4 * i4] * inv, O[mt][4 * i4 + 1] * inv);
          o.y = pack2(O[mt][4 * i4 + 2] * inv, O[mt][4 * i4 + 3] * inv);
          *(uint2*)(orow + 32 * mt + 8 * i4 + 4 * hh) = o;
        }
    }
  }
  __syncthreads();
}

DI void phase_prep(const Params& p, int l, char* smem) {
  if (EN_C) {
    int rt, ct;
    for (int it = 0; next_tile(it, 128, 6, 32, 2, rt, ct); ++it) qx_tile(p, l, rt, ct, smem);
  }
  const int n_gdn = EN_B ? 1024 : 0, n_kp = EN_C ? 512 : 0;
  for (int t = lbid(); t < n_gdn + n_kp; t += lgdim()) {
    if (t < n_gdn) gdn_prep_item(p, l, t, smem);
    else dsa_kprep_item(p, l, t - n_gdn);
  }
}

DI int xcc_id() { return (int)(__builtin_amdgcn_s_getreg((3 << 11) | 20) & 0x7u); }

DI void phase_mixers(const Params& p, int l, char* smem) {
  __shared__ int s_item;
  const int x0 = xcc_id();
  int xs = x0;
  for (;;) {
    __syncthreads();
    {
      int qi = l * 8 + xs;
      asm volatile("" : "+s"(qi));
      if (ltid() == 0) s_item = (int)atomicAdd(p.CNT() + qi, 1u);
    }
    __syncthreads();
    const int it = s_item;
    const int n_gdn = EN_B ? 1 : 0;
    if (it >= n_gdn + 256) {
      xs = (xs + 1) & 7;
      if (xs == x0) break;
      continue;
    }
    const int x = xs;
    if (it < n_gdn) {
#pragma unroll 1
      for (int rep = 0; rep < DUP_GDN; ++rep) gdn_rec_item(p, l, x, smem, rep == DUP_GDN - 1);
    }
    else {
      const int j = it - n_gdn, k = j >> 1;
      if ((j & 1) == 0) { if (EN_A) diff_item(p, l, 127 - k, x, smem); }
      else { if (EN_C) dsa_item(p, l, 511 - (k * 4 + (x >> 1)), x & 1, smem); }
    }
  }
}

DI void run_phase(const Params& p, int ph, char* smem) {
  if (ph == 0) { phase0(p, smem); return; }
  const int l = (ph - 1) / 9, s = (ph - 1) % 9;
  switch (s) {
    case 0: phase_inproj(p, l, smem); break;
    case 1: phase_prep(p, l, smem); break;
    case 2: phase_mixers(p, l, smem); break;
    case 3: phase_merge(p, l, smem); break;
    case 4: phase_resgemm(p, p.MERGED(), LDX, p.wo(l), KP1024, 1024, smem); break;
    case 5: ln_phase(p.out, p.ln1_g + l * 1024, p.ln1_b + l * 1024, p.XB(), nullptr); break;
    case 6: phase_ff1(p, l, smem); break;
    case 7: phase_resgemm(p, p.P(), LDH, p.wf2(l), KP4096, 4096, smem); break;
    case 8: ln_phase(p.out, p.ln2_g + l * 1024, p.ln2_b + l * 1024, (l == 1) ? nullptr : p.XB(), (l == 1) ? p.out : nullptr); break;
  }
}

constexpr int N_PHASES = 19;


DI u32 xb_ld(u32* p) { return __hip_atomic_load(p, __ATOMIC_RELAXED, __HIP_MEMORY_SCOPE_AGENT); }
DI u32 xb_add(u32* p, u32 v) { return __hip_atomic_fetch_add(p, v, __ATOMIC_RELAXED, __HIP_MEMORY_SCOPE_AGENT); }
DI void fast_sync(u32* bar, int x, const volatile int* st) {
  asm volatile("s_waitcnt vmcnt(0)" ::: "memory");
  __syncthreads();
  if (ltid() == 0) {
    __builtin_amdgcn_s_waitcnt(0);
    const u32 nloc = (u32)st[0], nx = (u32)st[1];
    const u32 old = xb_add(bar + 32 * (8 + x), 1u);
    const u32 gen = old / nloc;
    if (old + 1u == (gen + 1u) * nloc) {
      __builtin_amdgcn_fence(__ATOMIC_RELEASE, "agent");
      asm volatile("s_waitcnt vmcnt(0)" ::: "memory");
      const u32 og = xb_add(bar + 32 * 24, 1u);
      const u32 tg = og / nx;
      if (og + 1u == (tg + 1u) * nx) xb_add(bar + 32 * 25, 1u);
      else { while (xb_ld(bar + 32 * 25) == tg) __builtin_amdgcn_s_sleep(1); }
      __builtin_amdgcn_fence(__ATOMIC_ACQUIRE, "agent");
      xb_add(bar + 32 * (16 + x), 1u);
      asm volatile("s_waitcnt vmcnt(0)" ::: "memory");
    } else {
      while (xb_ld(bar + 32 * (16 + x)) == gen) __builtin_amdgcn_s_sleep(1);
      __builtin_amdgcn_fence(__ATOMIC_ACQUIRE, "agent");
      asm volatile("s_waitcnt vmcnt(0)" ::: "memory");
    }
  }
  __syncthreads();
}
#if COOP
DI void gsync() { cg::this_grid().sync(); }
__global__ void __launch_bounds__(512, 1) mega_kernel(Params p, int ph_begin, int ph_end) {
  __shared__ __attribute__((aligned(16))) char smem[SMEM_BYTES];
  __shared__ int xb_st[2];
  const int myx = xcc_id();
  if (ltid() == 0) (void)xb_add(p.BAR() + 32 * myx, 1u);
  for (int r = 0; r < REP0; ++r) { phase0(p, smem); cg::this_grid().sync(); }
  if (ltid() == 0) {
    int mine = 0, cnt = 0;
    for (int j = 0; j < 8; ++j) { const int c = (int)xb_ld(p.BAR() + 32 * j); cnt += (c > 0) ? 1 : 0; mine = (j == myx) ? c : mine; }
    xb_st[0] = mine > 0 ? mine : 1;
    xb_st[1] = cnt > 0 ? cnt : 1;
  }
  __syncthreads();
#define gsync() fast_sync(p.BAR(), myx, xb_st)
#pragma unroll 1
  for (int l = 0; l < 2; ++l) {
    for (int r = 0; r < REP1; ++r) { phase_inproj(p, l, smem); gsync(); }
    phase_prep(p, l, smem);
    gsync();
    phase_mixers(p, l, smem);
    gsync();
    for (int r = 0; r < REP2; ++r) { phase_merge(p, l, smem); gsync(); }
    for (int r = 0; r < REP3; ++r) { phase_resgemm(p, p.MERGED(), LDX, p.wo(l), KP1024, 1024, smem); gsync(); }
    for (int r = 0; r < REP4; ++r) { ln_phase(p.out, p.ln1_g + l * 1024, p.ln1_b + l * 1024, p.XB(), nullptr); gsync(); }
    for (int r = 0; r < REP5; ++r) { phase_ff1(p, l, smem); gsync(); }
    for (int r = 0; r < REP6; ++r) { phase_resgemm(p, p.P(), LDH, p.wf2(l), KP4096, 4096, smem); gsync(); }
    ln_phase(p.out, p.ln2_g + l * 1024, p.ln2_b + l * 1024, (l == 1) ? nullptr : p.XB(), (l == 1) ? p.out : nullptr);
    if (l == 0) gsync();
  }
}
#undef gsync
#else
__global__ void __launch_bounds__(512, 1) mega_kernel(Params p, int ph_begin, int ph_end) {
  __shared__ __attribute__((aligned(16))) char smem[SMEM_BYTES];
  for (int ph = ph_begin; ph < ph_end; ++ph) run_phase(p, ph, smem);
}
#endif

extern "C" void kernel_launch(void* const* d_in, const int* in_sizes, int n_in, void* d_out, int out_size,
                              void* d_ws, size_t ws_size, hipStream_t stream) {
  static int grid_blocks = 0;
  if (!grid_blocks) {
    int dev = 0, cus = 0, per_cu = 0;
    hipGetDevice(&dev);
    hipDeviceGetAttribute(&cus, hipDeviceAttributeMultiprocessorCount, dev);
    hipOccupancyMaxActiveBlocksPerMultiprocessor(&per_cu, mega_kernel, NTHR, 0);
    if (per_cu < 1) per_cu = 1;
    if (per_cu > 1) per_cu = 1;
    grid_blocks = cus * per_cu;
  }
  Params p{};
  const float** pf = (const float**)&p;
  for (int i = 0; i < 27; ++i) pf[i] = (const float*)d_in[i];
  p.out = (float*)d_out;
  p.ws = (char*)d_ws;
  if (WS_NEED > ws_size) { fprintf(stderr, "workspace too small: need %zu have %zu\n", (size_t)WS_NEED, ws_size); return; }
#if COOP
  hipMemsetAsync(p.ws + O_BAR, 0, 4096, stream);
  int b = 0, e = N_PHASES;
  void* args[] = {&p, &b, &e};
  hipError_t err = hipLaunchCooperativeKernel((void*)mega_kernel, dim3(grid_blocks), dim3(NTHR), args, 0, stream);
  if (err != hipSuccess) fprintf(stderr, "cooperative launch failed: %s (grid %d)\n", hipGetErrorString(err), grid_blocks);
#else
  for (int ph = 0; ph < N_PHASES; ++ph) mega_kernel<<<grid_blocks, NTHR, 0, stream>>>(p, ph, ph + 1);
#endif
}
```

```cpp
#include <hip/hip_runtime.h>
#include <hip/hip_cooperative_groups.h>
#include <cstdio>
namespace cg = cooperative_groups;

#ifndef COOP
#define COOP 1
#endif
#ifndef REP0
#define REP0 1
#define REP1 1
#define REP2 1
#define REP3 1
#define REP4 1
#define REP5 1
#define REP6 1
#endif
#ifndef DUP_GDN
#define DUP_GDN 1
#endif
#ifndef DUP_DIFF
#define DUP_DIFF 1
#endif
#ifndef DUP_DSA1
#define DUP_DSA1 1
#endif
#ifndef DUP_DSA2
#define DUP_DSA2 1
#endif
#ifndef EN_A
#define EN_A 1
#endif
#ifndef EN_B
#define EN_B 1
#endif
#ifndef EN_C
#define EN_C 1
#endif

typedef unsigned short u16;
typedef unsigned int u32;
typedef unsigned long long u64;
using bf16x8 = __attribute__((ext_vector_type(8))) short;
using s16x4 = __attribute__((ext_vector_type(4))) short;
using f32x4 = __attribute__((ext_vector_type(4))) float;
using f32x16 = __attribute__((ext_vector_type(16))) float;
#define DI __device__ __forceinline__

constexpr int NT = 32768, T = 16384, PC = 4048;
constexpr int AQ = 0, AK = 512, AV = 1024, BQ = 1536, BK_ = 2048, BV = 2560, BZ = 3072, BA = 3584, BB = 3588,
              CQ = 3592, CKVc = 3848, CKI = 3976, CWI = 4040, GATES = 4048;
constexpr float EPS = 1e-6f;
constexpr float DN_ALPHA = 1.41421356237f;
constexpr int NTHR = 512;
constexpr int SMEM_BYTES = 153600 + 512;

constexpr size_t al256(size_t x) { return (x + 255) & ~(size_t)255; }
constexpr int LDX = 1088, LDH = 4160, LDQ = 1600;
constexpr int KP1024 = 1088, KP512 = 576, KP256 = 320, KP4096 = 4160;
constexpr size_t SZ_WIN = al256((size_t)7120 * KP1024 * 2), SZ_WQX = al256((size_t)1536 * KP256 * 2), SZ_WBR = al256((size_t)1024 * KP512 * 2),
                 SZ_WBRC = al256((size_t)1024 * KP1024 * 2), SZ_WO = al256((size_t)1024 * KP1024 * 2), SZ_WF1 = al256((size_t)4096 * KP1024 * 2), SZ_WF2 = al256((size_t)1024 * KP4096 * 2);
constexpr size_t O_WIN = 0, O_WQX = O_WIN + SZ_WIN, O_WBRA = O_WQX + SZ_WQX, O_WBRB = O_WBRA + SZ_WBR, O_WBRC = O_WBRB + SZ_WBR,
                 O_WO = O_WBRC + SZ_WBRC, O_WF1 = O_WO + SZ_WO, O_WF2 = O_WF1 + SZ_WF1, LAYER_W = O_WF2 + SZ_WF2;
constexpr size_t O_P = 2 * LAYER_W, O_XB = O_P + (size_t)NT * LDH * 2, O_M = O_XB + (size_t)NT * LDX * 2;
constexpr size_t O_KDT = O_M, O_ATT = O_KDT + 33554432, O_HALO = O_ATT + 16777216, O_KIDX = O_HALO + 4718592, O_CKV = O_KIDX + 4194304,
                 O_MEND = O_CKV + 8388608 + 4194304;
constexpr size_t O_WIDX = O_MEND, O_GL = O_WIDX + (size_t)NT * 8 * 4, O_LAM = O_GL + 8192, O_CNT = O_LAM + 256, O_BAR = O_CNT + 256, WS_NEED = O_BAR + 4096;
static_assert(O_MEND - O_M >= (size_t)NT * LDX * 2, "merged alias");

struct Params {
  const float *x, *w_in, *b_gate, *a_lambda, *a_subln_g, *b_conv_w, *b_a_log, *b_dt_bias, *b_norm_g,
      *c_q_norm_g, *c_kv_norm_g, *c_kidx_g, *c_kidx_b, *c_w_uq, *c_w_qidx, *c_w_uk, *c_w_uv,
      *w_branch_a, *w_branch_b, *w_branch_c, *w_o, *ln1_g, *ln1_b, *w_ff1, *w_ff2, *ln2_g, *ln2_b;
  float* out;
  char* ws;
  __device__ __forceinline__ u16* win(int l) const { return (u16*)(ws + l * LAYER_W + O_WIN); }
  __device__ __forceinline__ u16* wqx(int l) const { return (u16*)(ws + l * LAYER_W + O_WQX); }
  __device__ __forceinline__ u16* wbra(int l) const { return (u16*)(ws + l * LAYER_W + O_WBRA); }
  __device__ __forceinline__ u16* wbrb(int l) const { return (u16*)(ws + l * LAYER_W + O_WBRB); }
  __device__ __forceinline__ u16* wbrc(int l) const { return (u16*)(ws + l * LAYER_W + O_WBRC); }
  __device__ __forceinline__ u16* wo(int l) const { return (u16*)(ws + l * LAYER_W + O_WO); }
  __device__ __forceinline__ u16* wf1(int l) const { return (u16*)(ws + l * LAYER_W + O_WF1); }
  __device__ __forceinline__ u16* wf2(int l) const { return (u16*)(ws + l * LAYER_W + O_WF2); }
  __device__ __forceinline__ u16* P() const { return (u16*)(ws + O_P); }
  __device__ __forceinline__ u16* XB() const { return (u16*)(ws + O_XB); }
  __device__ __forceinline__ u16* KDT() const { return (u16*)(ws + O_KDT); }
  __device__ __forceinline__ u16* ATT() const { return (u16*)(ws + O_ATT); }
  __device__ __forceinline__ u16* HALO() const { return (u16*)(ws + O_HALO); }
  __device__ __forceinline__ u16* KIDX() const { return (u16*)(ws + O_KIDX); }
  __device__ __forceinline__ u16* CKV() const { return (u16*)(ws + O_CKV); }
  __device__ __forceinline__ u16* MERGED() const { return (u16*)(ws + O_M); }
  __device__ __forceinline__ float* WIDX() const { return (float*)(ws + O_WIDX); }
  __device__ __forceinline__ float* GL() const { return (float*)(ws + O_GL); }
  __device__ __forceinline__ float* LAM() const { return (float*)(ws + O_LAM); }
  __device__ __forceinline__ u32* CNT() const { return (u32*)(ws + O_CNT); }
  __device__ __forceinline__ u32* BAR() const { return (u32*)(ws + O_BAR); }
};

DI int lbid() { int b = blockIdx.x; asm volatile("" : "+s"(b)); return b; }
DI int lgdim() { int b = gridDim.x; asm volatile("" : "+s"(b)); return b; }
DI int ltid() { int t = threadIdx.x; asm volatile("" : "+v"(t)); return t; }
DI u16 f2bf(float x) { return __builtin_bit_cast(u16, (__bf16)x); }
DI float bf2f(u16 h) { return __uint_as_float(((u32)h) << 16); }
DI u32 pack2(float a, float b) {
  typedef __bf16 bf16v2_ __attribute__((ext_vector_type(2)));
  const bf16v2_ v = {(__bf16)a, (__bf16)b};
  return __builtin_bit_cast(u32, v);
}
DI float bflo(u32 v) { return __uint_as_float(v << 16); }
DI float bfhi(u32 v) { return __uint_as_float(v & 0xffff0000u); }
DI f32x4 mfma16(bf16x8 a, bf16x8 b, f32x4 c) { return __builtin_amdgcn_mfma_f32_16x16x32_bf16(a, b, c, 0, 0, 0); }
DI f32x16 mfma32(bf16x8 a, bf16x8 b, f32x16 c) { return __builtin_amdgcn_mfma_f32_32x32x16_bf16(a, b, c, 0, 0, 0); }
DI int crow(int i, int hh) { return (i & 3) + 8 * (i >> 2) + 4 * hh; }
DI float sigmoidf_(float x) { return 1.f / (1.f + __expf(-x)); }
DI float siluf_(float x) { return x / (1.f + __expf(-x)); }
DI float xhalf_max(float x) {
  const u32 u = __float_as_uint(x);
  const auto r = __builtin_amdgcn_permlane32_swap(u, u, false, false);
  return fmaxf(__uint_as_float(r[0]), __uint_as_float(r[1]));
}
DI float xhalf_sum(float x) {
  const u32 u = __float_as_uint(x);
  const auto r = __builtin_amdgcn_permlane32_swap(u, u, false, false);
  return __uint_as_float(r[0]) + __uint_as_float(r[1]);
}
DI u32 lane_lt_cnt(u64 m) { return __builtin_amdgcn_mbcnt_hi((u32)(m >> 32), __builtin_amdgcn_mbcnt_lo((u32)m, 0)); }

DI bf16x8 pack8(const f32x16& x, int s) {
  typedef __bf16 bf16v8_ __attribute__((ext_vector_type(8)));
  bf16v8_ v;
#pragma unroll
  for (int j = 0; j < 8; ++j) v[j] = (__bf16)x[8 * s + j];
  return __builtin_bit_cast(bf16x8, v);
}
DI bf16x8 afrag_perm(const char* base, int row, int stride, int kbase, int hh) {
  const char* pr = base + row * stride + (kbase + 4 * hh) * 2;
  s16x4 lo = *(const s16x4*)pr;
  s16x4 hi = *(const s16x4*)(pr + 16);
  return __builtin_shufflevector(lo, hi, 0, 1, 2, 3, 4, 5, 6, 7);
}
DI bf16x8 trfrag(const char* img, int stride, int krow0, int col0, int ln) {
  const int hh = ln >> 5, chalf = (ln >> 4) & 1, q4 = (ln & 15) >> 2, p4 = ln & 3;
  u32 a = (u32)(size_t)(img + (krow0 + 4 * hh + q4) * stride + (col0 + 16 * chalf + 4 * p4) * 2);
  s16x4 lo, hi;
  asm volatile("ds_read_b64_tr_b16 %0, %2\n\tds_read_b64_tr_b16 %1, %3\n\ts_waitcnt lgkmcnt(0)"
               : "=&v"(lo), "=&v"(hi) : "v"(a), "v"(a + 8 * stride) : "memory");
  return __builtin_shufflevector(lo, hi, 0, 1, 2, 3, 4, 5, 6, 7);
}

template <int STRIDE>
DI void trfrag4(const char* img, int krow0, int ln, bf16x8 (&f)[4]) {
  const int hh = ln >> 5, chalf = (ln >> 4) & 1, q4 = (ln & 15) >> 2, p4 = ln & 3;
  const u32 a = (u32)(size_t)(img + (krow0 + 4 * hh + q4) * STRIDE + (16 * chalf + 4 * p4) * 2);
  s16x4 l0, h0, l1, h1, l2, h2, l3, h3;
  asm volatile(
      "ds_read_b64_tr_b16 %0, %8\n\tds_read_b64_tr_b16 %1, %8 offset:%9\n\t"
      "ds_read_b64_tr_b16 %2, %8 offset:64\n\tds_read_b64_tr_b16 %3, %8 offset:%10\n\t"
      "ds_read_b64_tr_b16 %4, %8 offset:128\n\tds_read_b64_tr_b16 %5, %8 offset:%11\n\t"
      "ds_read_b64_tr_b16 %6, %8 offset:192\n\tds_read_b64_tr_b16 %7, %8 offset:%12\n\t"
      "s_waitcnt lgkmcnt(0)"
      : "=&v"(l0), "=&v"(h0), "=&v"(l1), "=&v"(h1), "=&v"(l2), "=&v"(h2), "=&v"(l3), "=&v"(h3)
      : "v"(a), "i"(8 * STRIDE), "i"(8 * STRIDE + 64), "i"(8 * STRIDE + 128), "i"(8 * STRIDE + 192)
      : "memory");
  f[0] = __builtin_shufflevector(l0, h0, 0, 1, 2, 3, 4, 5, 6, 7);
  f[1] = __builtin_shufflevector(l1, h1, 0, 1, 2, 3, 4, 5, 6, 7);
  f[2] = __builtin_shufflevector(l2, h2, 0, 1, 2, 3, 4, 5, 6, 7);
  f[3] = __builtin_shufflevector(l3, h3, 0, 1, 2, 3, 4, 5, 6, 7);
}

template <int MT, int NT>
DI void gemm_core(const u16* __restrict__ A, int lda, const u16* __restrict__ B, int ldb, int K,
                  f32x4 (&acc)[MT][NT], char* smem) {
  constexpr int BM = 64 * MT, BN = 32 * NT;
  constexpr int ASZ = BM * 128, BSZ = BN * 128, BUF = ASZ + BSZ;
  constexpr int NA = BM / 64, NB = BN / 64;
  const int tid = ltid(), l = tid & 63, w = tid >> 6, wm = w >> 1, wn = w & 1;
  const int fr = l & 15, fq = l >> 4;
  uint4 ra0, ra1, ra2, ra3, rb0, rb1, rb2, rb3;
  const int nk = K >> 6;
  const int srow = tid >> 3, sch = tid & 7;
  const int ssw = sch ^ ((srow >> 1) & 7);
  const int fsw = (fr >> 1) & 7;
#define GL1(i, kt)                                                                                        \
  if (NA > i) ra##i = *(const uint4*)(A + (size_t)(srow + 64 * i) * lda + (kt) * 64 + sch * 8);           \
  if (NB > i) rb##i = *(const uint4*)(B + (size_t)(srow + 64 * i) * ldb + (kt) * 64 + sch * 8);
#define GLOAD(kt) { GL1(0, kt) GL1(1, kt) GL1(2, kt) GL1(3, kt) }
#define SS1(i)                                                                   \
  if (NA > i) *(uint4*)(as_ + (srow + 64 * i) * 128 + ssw * 16) = ra##i;         \
  if (NB > i) *(uint4*)(bs_ + (srow + 64 * i) * 128 + ssw * 16) = rb##i;
#define SSTORE(buf)                              \
  {                                              \
    char* as_ = smem + (buf) * BUF;              \
    char* bs_ = as_ + ASZ;                       \
    SS1(0) SS1(1) SS1(2) SS1(3)                  \
  }
  GLOAD(0);
  SSTORE(0);
  GLOAD(((1 < nk) ? 1 : 0));
#pragma unroll 1
  for (int kt = 0; kt < nk; ++kt) {
    __syncthreads();
    SSTORE((kt + 1) & 1);
    { const int kn_ = (kt + 2 < nk) ? kt + 2 : nk - 1; GLOAD(kn_); }
    const char* as = smem + (kt & 1) * BUF;
    const char* bs = as + ASZ;
#pragma unroll
    for (int kk = 0; kk < 2; ++kk) {
      bf16x8 xf[MT], wf[NT];
#pragma unroll
      for (int mi = 0; mi < MT; ++mi)
        xf[mi] = *(const bf16x8*)(as + (wm * (MT * 16) + mi * 16 + fr) * 128 + (((kk * 4 + fq) ^ fsw) * 16));
#pragma unroll
      for (int ni = 0; ni < NT; ++ni)
        wf[ni] = *(const bf16x8*)(bs + (wn * (NT * 16) + ni * 16 + fr) * 128 + (((kk * 4 + fq) ^ fsw) * 16));
      __builtin_amdgcn_s_setprio(1);
#pragma unroll
      for (int mi = 0; mi < MT; ++mi)
#pragma unroll
        for (int ni = 0; ni < NT; ++ni) acc[mi][ni] = mfma16(wf[ni], xf[mi], acc[mi][ni]);
      __builtin_amdgcn_s_setprio(0);
    }
  }
  __syncthreads();
#undef GLOAD
#undef SSTORE
#undef GL1
#undef SS1
}
template <int MT, int NT>
DI void zero_acc(f32x4 (&acc)[MT][NT]) {
#pragma unroll
  for (int i = 0; i < MT; ++i)
#pragma unroll
    for (int j = 0; j < NT; ++j) acc[i][j] = f32x4{0.f, 0.f, 0.f, 0.f};
}


DI bool next_tile(int it, int RT, int CT, int PR, int PCc, int& rt, int& ct) {
  const int bid = lbid(), x = bid & 7, j = bid >> 3, J = lgdim() >> 3;
  const int u = j + it * J;
  const int pcols = CT / PCc, npatch = (RT / PR) * pcols;
  const int pid = (u >> 6) * 8 + x;
  if (pid >= npatch) return false;
  const int w = u & 63, pr = pid / pcols, pc = pid - pr * pcols;
  rt = pr * PR + w / PCc;
  ct = pc * PCc + w % PCc;
  return true;
}
DI void transpose_job(const float* __restrict__ src, int K, int N, u16* __restrict__ dst, int ldd, const float* kscale, char* smem) {
  float(*tile)[65] = (float(*)[65])smem;
  const int ntn = (N + 63) >> 6, ntk = K >> 6, tid = ltid();
  for (int t = lbid(); t < ntn * ntk; t += lgdim()) {
    const int tk = t / ntn, tn = t % ntn, k0 = tk * 64, n0 = tn * 64;
    {
      const int n = tid & 63, kb = tid >> 6;
      for (int i = 0; i < 8; ++i) {
        const int k = kb + 8 * i;
        float v = (n0 + n < N) ? src[(size_t)(k0 + k) * N + n0 + n] : 0.f;
        if (kscale) v *= kscale[k0 + k];
        tile[k][n] = v;
      }
    }
    __syncthreads();
    {
      const int n = tid >> 3, kc = tid & 7;
      if (n0 + n < N) {
        uint4 o;
        o.x = pack2(tile[kc * 8 + 0][n], tile[kc * 8 + 1][n]); o.y = pack2(tile[kc * 8 + 2][n], tile[kc * 8 + 3][n]);
        o.z = pack2(tile[kc * 8 + 4][n], tile[kc * 8 + 5][n]); o.w = pack2(tile[kc * 8 + 6][n], tile[kc * 8 + 7][n]);
        *(uint4*)(dst + (size_t)(n0 + n) * ldd + k0 + kc * 8) = o;
      }
    }
    __syncthreads();
  }
}

DI void phase0(const Params& p, char* smem) {
  const size_t gtid = (size_t)lbid() * NTHR + ltid(), gsz = (size_t)lgdim() * NTHR;
  for (int l = 0; l < 2; ++l) {
    transpose_job(p.w_in + (size_t)l * 1024 * 7120, 1024, 7120, p.win(l), KP1024, nullptr, smem);
    transpose_job(p.w_branch_a + (size_t)l * 512 * 1024, 512, 1024, p.wbra(l), KP512, nullptr, smem);
    transpose_job(p.w_branch_b + (size_t)l * 512 * 1024, 512, 1024, p.wbrb(l), KP512, nullptr, smem);
    transpose_job(p.w_o + (size_t)l * 1024 * 1024, 1024, 1024, p.wo(l), KP1024, nullptr, smem);
    transpose_job(p.w_ff1 + (size_t)l * 1024 * 4096, 1024, 4096, p.wf1(l), KP1024, nullptr, smem);
    transpose_job(p.w_ff2 + (size_t)l * 4096 * 1024, 4096, 1024, p.wf2(l), KP4096, nullptr, smem);
    transpose_job(p.c_w_qidx + (size_t)l * 256 * 512, 256, 512, p.wqx(l) + 1024 * KP256, KP256, p.c_q_norm_g + l * 256, smem);
    {
      const float* uq = p.c_w_uq + (size_t)l * 256 * 512;
      const float* uk = p.c_w_uk + (size_t)l * 128 * 512;
      const float* g = p.c_q_norm_g + l * 256;
      for (size_t e = gtid; e < 1024 * 256; e += gsz) {
        const int n = (int)(e >> 8), k = (int)(e & 255), h = n >> 7, r2 = n & 127;
        const float4* a = (const float4*)(uq + (k * 8 + h) * 64);
        const float4* b = (const float4*)(uk + (r2 * 8 + h) * 64);
        float s = 0.f;
        for (int d = 0; d < 16; ++d) { float4 x = a[d], y = b[d]; s += x.x * y.x + x.y * y.y + x.z * y.z + x.w * y.w; }
        p.wqx(l)[(size_t)n * KP256 + k] = f2bf(s * g[k]);
      }
    }
    {
      const float* uv = p.c_w_uv + (size_t)l * 128 * 512;
      const float* bc = p.w_branch_c + (size_t)l * 512 * 1024;
      for (size_t e = gtid; e < 1024 * 256; e += gsz) {
        const int k = (int)(e >> 8), n4 = (int)(e & 255) * 4, h = k >> 7, r = k & 127;
        const float* a = uv + (r * 8 + h) * 64;
        const float* b = bc + (size_t)(h * 64) * 1024 + n4;
        float4 acc4 = float4{0.f, 0.f, 0.f, 0.f};
#pragma unroll 8
        for (int d = 0; d < 64; ++d) {
          const float4 v = *(const float4*)(b + (size_t)d * 1024);
          const float ad = a[d];
          acc4.x += ad * v.x; acc4.y += ad * v.y; acc4.z += ad * v.z; acc4.w += ad * v.w;
        }
        u16* dst = p.wbrc(l) + (size_t)n4 * KP1024 + k;
        dst[0] = f2bf(acc4.x); dst[KP1024] = f2bf(acc4.y); dst[2 * KP1024] = f2bf(acc4.z); dst[3 * KP1024] = f2bf(acc4.w);
      }
    }
  }
  for (size_t e = gtid; e < (size_t)NT * 1024 / 8; e += gsz) {
    const float4 a = ((const float4*)p.x)[2 * e], b = ((const float4*)p.x)[2 * e + 1];
    uint4 o;
    o.x = pack2(a.x, a.y); o.y = pack2(a.z, a.w); o.z = pack2(b.x, b.y); o.w = pack2(b.z, b.w);
    *(uint4*)(p.XB() + (e >> 7) * LDX + (e & 127) * 8) = o;
  }
  if (gtid < 2) {
    const int l = (int)gtid;
    const float* lp = p.a_lambda + l * 256;
    float s1 = 0.f, s2 = 0.f;
    for (int i = 0; i < 64; ++i) { s1 += lp[i] * lp[64 + i]; s2 += lp[128 + i] * lp[192 + i]; }
    const float lam_init = 0.8f - 0.6f * expf(-0.3f * l);
    p.LAM()[l] = expf(s1) - expf(s2) + lam_init;
    p.LAM()[2 + l] = lam_init;
    for (int i = 0; i < 8; ++i) p.CNT()[l * 8 + i] = 0;
  }
}

DI void ln_phase(const float* S, const float* __restrict__ g, const float* __restrict__ b, u16* XBo, float* fout) {
  const int l = ltid() & 63;
  const int wave = lbid() * 8 + (ltid() >> 6), nw = lgdim() * 8;
  for (int row = wave; row < NT; row += nw) {
    float4 v[4];
    float s = 0.f;
#pragma unroll
    for (int i = 0; i < 4; ++i) { v[i] = *(const float4*)(S + (size_t)row * 1024 + i * 256 + l * 4); s += v[i].x + v[i].y + v[i].z + v[i].w; }
#pragma unroll
    for (int o = 32; o; o >>= 1) s += __shfl_xor(s, o);
    const float mu = s * (1.f / 1024.f);
    float q = 0.f;
#pragma unroll
    for (int i = 0; i < 4; ++i) { float a = v[i].x - mu, bb = v[i].y - mu, c = v[i].z - mu, d = v[i].w - mu; q += a * a + bb * bb + c * c + d * d; }
#pragma unroll
    for (int o = 32; o; o >>= 1) q += __shfl_xor(q, o);
    const float rs = rsqrtf(q * (1.f / 1024.f) + EPS);
#pragma unroll
    for (int i = 0; i < 4; ++i) {
      const int c = i * 256 + l * 4;
      const float4 gg = *(const float4*)(g + c), bb = *(const float4*)(b + c);
      float4 y;
      y.x = (v[i].x - mu) * rs * gg.x + bb.x; y.y = (v[i].y - mu) * rs * gg.y + bb.y;
      y.z = (v[i].z - mu) * rs * gg.z + bb.z; y.w = (v[i].w - mu) * rs * gg.w + bb.w;
      if (fout) *(float4*)(fout + (size_t)row * 1024 + c) = y;
      if (XBo) { uint2 o; o.x = pack2(y.x, y.y); o.y = pack2(y.z, y.w); *(uint2*)(XBo + (size_t)row * LDX + c) = o; }
    }
  }
}

#define EPI_LOOP(MT_, NT_)                                                \
  const int l_ = ltid() & 63, w_ = ltid() >> 6;                           \
  const int wm_ = w_ >> 1, wn_ = w_ & 1, fr_ = l_ & 15, fq_ = l_ >> 4;    \
  _Pragma("unroll") for (int mi = 0; mi < MT_; ++mi)                      \
  _Pragma("unroll") for (int ni = 0; ni < NT_; ++ni)

DI void phase_inproj(const Params& p, int l, char* smem) {
  int rt, ct;
  for (int it = 0; next_tile(it, 128, 16, 8, 8, rt, ct); ++it) {
    const int r0 = rt * 256, c0 = ct * 256;
    f32x4 acc[4][8];
    zero_acc<4, 8>(acc);
    gemm_core<4, 8>(p.XB() + (size_t)r0 * LDX, LDX, p.win(l) + (size_t)c0 * KP1024, KP1024, 1024, acc, smem);
    EPI_LOOP(4, 8) {
      const int row = r0 + wm_ * 64 + mi * 16 + fr_, col = c0 + wn_ * 128 + ni * 16 + fq_ * 4;
      if (col < PC) {
        uint2 o;
        o.x = pack2(acc[mi][ni][0], acc[mi][ni][1]); o.y = pack2(acc[mi][ni][2], acc[mi][ni][3]);
        *(uint2*)(p.P() + (size_t)row * PC + col) = o;
        if (col >= BQ && col < BZ && (row & 63) >= 61)
          *(uint2*)(p.HALO() + ((size_t)(row >> 6) * 3 + ((row & 63) - 61)) * 1536 + (col - BQ)) = o;
      }
    }
  }
}

DI void qx_tile(const Params& p, int l, int rt, int ct, char* smem) {
  const int r0 = rt * 256, c0 = ct * 256;
  float* rsv = (float*)(smem + 147456);
  {
    const int row = ltid() >> 1, half = ltid() & 1;
    const uint4* src = (const uint4*)(p.P() + (size_t)(r0 + row) * PC + CQ + half * 128);
    float ss = 0.f;
    for (int i = 0; i < 16; ++i) {
      uint4 v = src[i];
      float a;
      a = bflo(v.x); ss += a * a; a = bfhi(v.x); ss += a * a; a = bflo(v.y); ss += a * a; a = bfhi(v.y); ss += a * a;
      a = bflo(v.z); ss += a * a; a = bfhi(v.z); ss += a * a; a = bflo(v.w); ss += a * a; a = bfhi(v.w); ss += a * a;
    }
    ss += __shfl_xor(ss, 1);
    if (!half) rsv[row] = rsqrtf(ss * (1.f / 256.f) + EPS);
  }
  f32x4 acc[4][8];
  zero_acc<4, 8>(acc);
  gemm_core<4, 8>(p.P() + (size_t)r0 * PC + CQ, PC, p.wqx(l) + (size_t)c0 * KP256, KP256, 256, acc, smem);
  u16* QX = (u16*)p.out;
  EPI_LOOP(4, 8) {
    const int rl = wm_ * 64 + mi * 16 + fr_, col = c0 + wn_ * 128 + ni * 16 + fq_ * 4;
    const float rs = rsv[rl];
    uint2 o;
    o.x = pack2(acc[mi][ni][0] * rs, acc[mi][ni][1] * rs); o.y = pack2(acc[mi][ni][2] * rs, acc[mi][ni][3] * rs);
    *(uint2*)(QX + (size_t)(r0 + rl) * LDQ + col) = o;
  }
  __syncthreads();
}

DI void phase_merge(const Params& p, int l, char* smem) {
  const u16* QX = (const u16*)p.out;
  int rt, ct;
  for (int it = 0; next_tile(it, 128, 8, 8, 8, rt, ct); ++it) {
    const int r0 = rt * 256, c0 = ct * 128;
    bool first = true;
#pragma unroll 1
    for (int j = 0; j < 3; ++j) {
      if ((j == 0 && !EN_A) || (j == 1 && !EN_B) || (j == 2 && !EN_C)) continue;
      const u16* Ab; const u16* Wb; int lda, K;
      int ldw;
      if (j == 0) { Ab = p.P() + (size_t)r0 * PC + AQ; lda = PC; Wb = p.wbra(l) + (size_t)c0 * KP512; K = 512; ldw = KP512; }
      else if (j == 1) { Ab = p.P() + (size_t)r0 * PC + BZ; lda = PC; Wb = p.wbrb(l) + (size_t)c0 * KP512; K = 512; ldw = KP512; }
      else { Ab = QX + (size_t)r0 * LDQ; lda = LDQ; Wb = p.wbrc(l) + (size_t)c0 * KP1024; K = 1024; ldw = KP1024; }
      f32x4 g[4][4];
      zero_acc<4, 4>(g);
      gemm_core<4, 4>(p.XB() + (size_t)r0 * LDX, LDX, p.win(l) + (size_t)(GATES + j * 1024 + c0) * KP1024, KP1024, 1024, g, smem);
      const float* bg = p.b_gate + l * 3072 + j * 1024;
      {
        EPI_LOOP(4, 4) {
          const int col = c0 + wn_ * 64 + ni * 16 + fq_ * 4;
          const float4 bb = *(const float4*)(bg + col);
          g[mi][ni][0] = sigmoidf_(g[mi][ni][0] + bb.x);
          g[mi][ni][1] = sigmoidf_(g[mi][ni][1] + bb.y);
          g[mi][ni][2] = sigmoidf_(g[mi][ni][2] + bb.z);
          g[mi][ni][3] = sigmoidf_(g[mi][ni][3] + bb.w);
        }
      }
      f32x4 br[4][4];
      zero_acc<4, 4>(br);
      gemm_core<4, 4>(Ab, lda, Wb, ldw, K, br, smem);
      {
        EPI_LOOP(4, 4) {
          const int row = r0 + wm_ * 64 + mi * 16 + fr_, col = c0 + wn_ * 64 + ni * 16 + fq_ * 4;
          u16* mp = p.MERGED() + (size_t)row * LDX + col;
          float a0 = g[mi][ni][0] * br[mi][ni][0], a1 = g[mi][ni][1] * br[mi][ni][1];
          float a2 = g[mi][ni][2] * br[mi][ni][2], a3 = g[mi][ni][3] * br[mi][ni][3];
          if (!first) {
            const uint2 old = *(const uint2*)mp;
            a0 += bflo(old.x); a1 += bfhi(old.x); a2 += bflo(old.y); a3 += bfhi(old.y);
          }
          uint2 o;
          o.x = pack2(a0, a1); o.y = pack2(a2, a3);
          *(uint2*)mp = o;
        }
      }
      first = false;
    }
  }
}

DI void phase_resgemm(const Params& p, const u16* A, int lda, const u16* W, int ldw, int K, char* smem) {
  int rt, ct;
  for (int it = 0; next_tile(it, 128, 4, 16, 4, rt, ct); ++it) {
    const int r0 = rt * 256, c0 = ct * 256;
    f32x4 acc[4][8];
    zero_acc<4, 8>(acc);
    gemm_core<4, 8>(A + (size_t)r0 * lda, lda, W + (size_t)c0 * ldw, ldw, K, acc, smem);
    EPI_LOOP(4, 8) {
      const int row = r0 + wm_ * 64 + mi * 16 + fr_, col = c0 + wn_ * 128 + ni * 16 + fq_ * 4;
      const uint2 xb = *(const uint2*)(p.XB() + (size_t)row * LDX + col);
      float4 o;
      o.x = DN_ALPHA * bflo(xb.x) + acc[mi][ni][0]; o.y = DN_ALPHA * bfhi(xb.x) + acc[mi][ni][1];
      o.z = DN_ALPHA * bflo(xb.y) + acc[mi][ni][2]; o.w = DN_ALPHA * bfhi(xb.y) + acc[mi][ni][3];
      *(float4*)(p.out + (size_t)row * 1024 + col) = o;
    }
  }
}

DI void phase_ff1(const Params& p, int l, char* smem) {
  int rt, ct;
  for (int it = 0; next_tile(it, 128, 16, 8, 8, rt, ct); ++it) {
    const int r0 = rt * 256, c0 = ct * 256;
    f32x4 acc[4][8];
    zero_acc<4, 8>(acc);
    gemm_core<4, 8>(p.XB() + (size_t)r0 * LDX, LDX, p.wf1(l) + (size_t)c0 * KP1024, KP1024, 1024, acc, smem);
    EPI_LOOP(4, 8) {
      const int row = r0 + wm_ * 64 + mi * 16 + fr_, col = c0 + wn_ * 128 + ni * 16 + fq_ * 4;
      float a0 = fmaxf(acc[mi][ni][0], 0.f), a1 = fmaxf(acc[mi][ni][1], 0.f), a2 = fmaxf(acc[mi][ni][2], 0.f), a3 = fmaxf(acc[mi][ni][3], 0.f);
      uint2 o;
      o.x = pack2(a0 * a0, a1 * a1); o.y = pack2(a2 * a2, a3 * a3);
      *(uint2*)(p.P() + (size_t)row * LDH + col) = o;
    }
  }
}

DI void dsa_kprep_item(const Params& p, int l, int it) {
  const int ln = ltid() & 63, w = ltid() >> 6;
  const float g0 = p.c_kv_norm_g[l * 128 + 2 * ln], g1 = p.c_kv_norm_g[l * 128 + 2 * ln + 1];
  const float kg = p.c_kidx_g[l * 64 + ln], kb = p.c_kidx_b[l * 64 + ln];
  for (int i = 0; i < 8; ++i) {
    const size_t tok = (size_t)it * 64 + w * 8 + i;
    const u16* pr = p.P() + tok * PC;
    const u32 v = *(const u32*)(pr + CKVc + 2 * ln);
    const float a = bflo(v), b = bfhi(v);
    float ss = a * a + b * b;
#pragma unroll
    for (int o = 32; o; o >>= 1) ss += __shfl_xor(ss, o);
    const float rs = rsqrtf(ss * (1.f / 128.f) + EPS);
    *(u32*)(p.CKV() + tok * 128 + 2 * ln) = pack2(a * rs * g0, b * rs * g1);
    const float k = bf2f(pr[CKI + ln]);
    float s = k;
#pragma unroll
    for (int o = 32; o; o >>= 1) s += __shfl_xor(s, o);
    const float mu = s * (1.f / 64.f);
    float q = (k - mu) * (k - mu);
#pragma unroll
    for (int o = 32; o; o >>= 1) q += __shfl_xor(q, o);
    p.KIDX()[tok * 64 + ln] = f2bf((k - mu) * rsqrtf(q * (1.f / 64.f) + EPS) * kg + kb);
    if (ln < 8) p.WIDX()[tok * 8 + ln] = bf2f(pr[CWI + ln]) * 0.04419417382f;
  }
}

DI void gdn_prep_item(const Params& p, int l, int it, char* smem0) {
  const int half_ = ltid() >> 8;
  const int cidx = it >> 1, h = (it & 1) * 2 + half_, n = cidx & 255;
  const size_t t0g = (size_t)cidx * 64;
  char* smem = smem0 + half_ * 69632;
  const int tid = ltid() & 255, ln = tid & 63, w = tid >> 6;
  char* qs = smem;
  char* ks = smem + 17408;
  char* vs = smem + 2 * 17408;
  float* Lm = (float*)(smem + 3 * 17408);
  float* gcs = Lm + 4096;
  float* bts = gcs + 64;
  float* egs = bts + 64;
  u16* proj = p.P();
  {
    const int c = tid & 127, rh = tid >> 7;
    uint4 st[12];
#pragma unroll
    for (int part = 0; part < 3; ++part)
#pragma unroll
      for (int i = 0; i < 4; ++i) {
        const int piece = tid + 256 * i, row = piece >> 4, ch = piece & 15;
        st[part * 4 + i] = *(const uint4*)(proj + (t0g + row) * PC + BQ + part * 512 + h * 128 + ch * 8);
      }
    float hx[9];
#pragma unroll
    for (int i = 0; i < 9; ++i) hx[i] = 0.f;
    if (rh == 0 && n != 0) {
#pragma unroll
      for (int part = 0; part < 3; ++part) {
        const u16* hp = p.HALO() + ((size_t)(cidx - 1) * 3) * 1536 + part * 512 + h * 128 + c;
        hx[part * 3 + 0] = bf2f(hp[0]); hx[part * 3 + 1] = bf2f(hp[1536]); hx[part * 3 + 2] = bf2f(hp[2 * 1536]);
      }
    }
#pragma unroll
    for (int part = 0; part < 3; ++part)
#pragma unroll
      for (int i = 0; i < 4; ++i) {
        const int piece = tid + 256 * i, row = piece >> 4, ch = piece & 15;
        char* dst = (part == 0 ? qs : (part == 1 ? ks : vs));
        *(uint4*)(dst + row * 272 + ch * 16) = st[part * 4 + i];
      }
    __syncthreads();
    if (rh == 1) {
#pragma unroll
      for (int part = 0; part < 3; ++part) {
        const char* src = (part == 0 ? qs : (part == 1 ? ks : vs));
        hx[part * 3 + 0] = bf2f(*(const u16*)(src + 29 * 272 + c * 2));
        hx[part * 3 + 1] = bf2f(*(const u16*)(src + 30 * 272 + c * 2));
        hx[part * 3 + 2] = bf2f(*(const u16*)(src + 31 * 272 + c * 2));
      }
    }
    __syncthreads();
#pragma unroll
    for (int part = 0; part < 3; ++part) {
      const int wch = part * 512 + h * 128 + c;
      const float* cw = p.b_conv_w + (size_t)l * 4 * 1536 + wch;
      const float w0 = cw[0], w1 = cw[1536], w2 = cw[2 * 1536], w3 = cw[3 * 1536];
      float xm3 = hx[part * 3 + 0], xm2 = hx[part * 3 + 1], xm1 = hx[part * 3 + 2];
      char* dst = (part == 0 ? qs : (part == 1 ? ks : vs));
#pragma unroll 8
      for (int i = 0; i < 32; ++i) {
        const int r = rh * 32 + i;
        u16* px = (u16*)(dst + r * 272 + c * 2);
        const float x = bf2f(*px);
        const float y = w0 * xm3 + w1 * xm2 + w2 * xm1 + w3 * x;
        xm3 = xm2; xm2 = xm1; xm1 = x;
        *px = f2bf(siluf_(y));
      }
    }
  }
  if (w == 0) {
    const float a = bf2f(proj[(t0g + ln) * PC + BA + h]) + p.b_dt_bias[l * 4 + h];
    const float ea = __expf(a);
    const float sp = (a > 20.f) ? a : ((ea < 0.01f) ? ea * (1.f - ea * (0.5f - ea * 0.333333333f)) : __logf(1.f + ea));
    float g = -__expf(p.b_a_log[l * 4 + h]) * sp;
#pragma unroll
    for (int o = 1; o < 64; o <<= 1) { float t = __shfl_up(g, o); if (ln >= o) g += t; }
    gcs[ln] = g;
    egs[ln] = __expf(g);
    bts[ln] = sigmoidf_(bf2f(proj[(t0g + ln) * PC + BB + h]));
  }
  __syncthreads();
  {
    const int row = tid >> 2, qr = tid & 3;
#pragma unroll
    for (int part = 0; part < 2; ++part) {
      char* base = (part == 0 ? qs : ks) + row * 272 + qr * 64;
      uint4 v[4];
      float ss = 0.f;
#pragma unroll
      for (int i = 0; i < 4; ++i) {
        v[i] = *(uint4*)(base + i * 16);
        float a;
        a = bflo(v[i].x); ss += a * a; a = bfhi(v[i].x); ss += a * a; a = bflo(v[i].y); ss += a * a; a = bfhi(v[i].y); ss += a * a;
        a = bflo(v[i].z); ss += a * a; a = bfhi(v[i].z); ss += a * a; a = bflo(v[i].w); ss += a * a; a = bfhi(v[i].w); ss += a * a;
      }
      ss += __shfl_xor(ss, 1);
      ss += __shfl_xor(ss, 2);
      const float rs = rsqrtf(ss + EPS) * (part == 0 ? 0.08838834764f : 1.f);
#pragma unroll
      for (int i = 0; i < 4; ++i) {
        uint4 o;
        o.x = pack2(bflo(v[i].x) * rs, bfhi(v[i].x) * rs); o.y = pack2(bflo(v[i].y) * rs, bfhi(v[i].y) * rs);
        o.z = pack2(bflo(v[i].z) * rs, bfhi(v[i].z) * rs); o.w = pack2(bflo(v[i].w) * rs, bfhi(v[i].w) * rs);
        *(uint4*)(base + i * 16) = o;
      }
    }
  }
  __syncthreads();
  {
    const int fr = ln & 15, fq = ln >> 4;
    f32x4 kk[4], qk[4];
#pragma unroll
    for (int nt = 0; nt < 4; ++nt) { kk[nt] = f32x4{0, 0, 0, 0}; qk[nt] = f32x4{0, 0, 0, 0}; }
#pragma unroll
    for (int s = 0; s < 4; ++s) {
      const bf16x8 ak = *(const bf16x8*)(ks + (16 * w + fr) * 272 + (32 * s + 8 * fq) * 2);
      const bf16x8 aq = *(const bf16x8*)(qs + (16 * w + fr) * 272 + (32 * s + 8 * fq) * 2);
#pragma unroll
      for (int nt = 0; nt < 4; ++nt) {
        const bf16x8 bk = *(const bf16x8*)(ks + (16 * nt + fr) * 272 + (32 * s + 8 * fq) * 2);
        kk[nt] = mfma16(ak, bk, kk[nt]);
        qk[nt] = mfma16(aq, bk, qk[nt]);
      }
    }
#pragma unroll
    for (int nt = 0; nt < 4; ++nt)
#pragma unroll
      for (int jj = 0; jj < 4; ++jj) {
        const int i = 16 * w + 4 * fq + jj, j = 16 * nt + fr;
        const float dec = (i >= j) ? __expf(gcs[i] - gcs[j]) : 0.f;
        Lm[i * 64 + j] = (i > j) ? bts[i] * kk[nt][jj] * dec : 0.f;
        p.ATT()[(t0g + i) * 256 + h * 64 + j] = f2bf((i >= j) ? qk[nt][jj] * dec : 0.f);
      }
  }
  __syncthreads();
  {
    const int c = tid;
    const bool isu = c < 128;
    const char* src = isu ? (vs + c * 2) : (ks + (c - 128) * 2);
    const float wsel = isu ? 0.f : 1.f;
    float x[64];
#pragma unroll
    for (int i = 0; i < 64; ++i) {
      float a = bf2f(*(const u16*)(src + i * 272)) * bts[i] * fmaf(egs[i] - 1.f, wsel, 1.f);
      const float* Lr = Lm + i * 64;
#pragma unroll
      for (int j = 0; j < i; ++j) a -= Lr[j] * x[j];
      x[i] = a;
      asm volatile("" ::: "memory");
    }
    if (isu) {
      u32 pk[32];
#pragma unroll
      for (int pos = 0; pos < 64; pos += 2) {
        const int hh = pos >> 5, Tt = (pos >> 4) & 1, ii = pos & 15;
        const int r0 = 32 * Tt + (ii & 3) + 8 * (ii >> 2) + 4 * hh;
        const int i1 = ii + 1;
        const int r1 = 32 * Tt + (i1 & 3) + 8 * (i1 >> 2) + 4 * hh;
        pk[pos >> 1] = pack2(x[r0], x[r1]);
      }
      char* dst = (char*)proj + ((t0g + (c >> 1)) * PC + BV + h * 128) * 2 + (c & 1) * 128;
#pragma unroll
      for (int i = 0; i < 8; ++i) *(uint4*)(dst + i * 16) = uint4{pk[4 * i], pk[4 * i + 1], pk[4 * i + 2], pk[4 * i + 3]};
    } else {
#pragma unroll
      for (int i = 0; i < 64; ++i) proj[(t0g + i) * PC + BK_ + h * 128 + (c - 128)] = f2bf(x[i]);
    }
  }
  {
    const float glast = gcs[63];
#pragma unroll
    for (int i = 0; i < 4; ++i) {
      const int piece = tid + 256 * i, row = piece >> 4, ch = piece & 15;
      const uint4 v = *(const uint4*)(qs + row * 272 + ch * 16);
      const float e = egs[row];
      uint4 o;
      o.x = pack2(bflo(v.x) * e, bfhi(v.x) * e); o.y = pack2(bflo(v.y) * e, bfhi(v.y) * e);
      o.z = pack2(bflo(v.z) * e, bfhi(v.z) * e); o.w = pack2(bflo(v.w) * e, bfhi(v.w) * e);
      *(uint4*)(proj + (t0g + row) * PC + BQ + h * 128 + ch * 8) = o;
    }
    const int d = tid & 127, half = tid >> 7;
    u32 pk[16];
#pragma unroll
    for (int i = 0; i < 16; ++i) {
      const int r0 = half * 32 + 2 * i;
      const float a = bf2f(*(const u16*)(ks + r0 * 272 + d * 2)) * __expf(glast - gcs[r0]);
      const float b = bf2f(*(const u16*)(ks + (r0 + 1) * 272 + d * 2)) * __expf(glast - gcs[r0 + 1]);
      pk[i] = pack2(a, b);
    }
    u16* dst = p.KDT() + (((size_t)cidx * 4 + h) * 128 + d) * 64 + half * 32;
#pragma unroll
    for (int i = 0; i < 4; ++i) *(uint4*)(dst + i * 8) = uint4{pk[4 * i], pk[4 * i + 1], pk[4 * i + 2], pk[4 * i + 3]};
    if (tid == 0) p.GL()[cidx * 4 + h] = egs[63];
  }
  __syncthreads();
}

DI void gdn_rec_item(const Params& p, int l, int bh, char* smem, bool wr) {
  const int b = bh >> 2, h = bh & 3;
  const int tid = ltid(), ln = tid & 63, w = tid >> 6, hh = ln >> 5, c31 = ln & 31;
  const bool is_comp = w < 4;
  constexpr int BUFB = 59904;
  float* Ot = (float*)(smem + 2 * BUFB);
  u16* proj = p.P();
  const float* ng = p.b_norm_g + l * 128;
  const int lt = tid & 255;
#define LD_AQ(i, n_)                                                                                      \
  {                                                                                                       \
    const size_t t0g_ = ((size_t)b * 256 + (n_)) * 64;                                                    \
    const int piece = ltv + 256 * i, row = piece >> 4, ch = piece & 15;                                   \
    la##i = *(const uint4*)(proj + (t0g_ + row) * PC + BK_ + h * 128 + ch * 8);                           \
    lq##i = *(const uint4*)(proj + (t0g_ + row) * PC + BQ + h * 128 + ch * 8);                            \
  }
#define LD_K(i, n_)                                                                                       \
  {                                                                                                       \
    const int piece = ltv + 256 * i, row2 = piece >> 3, ch2 = piece & 7;                                  \
    lk##i = *(const uint4*)(p.KDT() + ((((size_t)b * 256 + (n_)) * 4 + h) * 128 + row2) * 64 + ch2 * 8);  \
  }
#define LD_T(i, n_)                                                                                       \
  {                                                                                                       \
    const size_t t0g_ = ((size_t)b * 256 + (n_)) * 64;                                                    \
    const int piece = ltv + 256 * i, row = piece >> 3, ch = piece & 7;                                     \
    lt##i = *(const uint4*)(p.ATT() + (t0g_ + row) * 256 + h * 64 + ch * 8);                              \
  }
#define LD_R1(n_) { LD_AQ(0, n_) LD_AQ(1, n_) LD_AQ(2, n_) LD_AQ(3, n_) }
#define LD_R2(n_) { LD_K(0, n_) LD_K(1, n_) LD_K(2, n_) LD_K(3, n_) LD_T(0, n_) LD_T(1, n_) }
#define ST_AQ(i, buf_)                                                                                    \
  {                                                                                                       \
    char* Wm_ = smem + (buf_) * BUFB; char* Qd_ = Wm_ + 16896;                                            \
    const int piece = ltv + 256 * i, row = piece >> 4, ch = piece & 15;                                   \
    *(uint2*)(Wm_ + row * 264 + ch * 16) = uint2{la##i.x, la##i.y}; *(uint2*)(Wm_ + row * 264 + ch * 16 + 8) = uint2{la##i.z, la##i.w}; \
    *(uint2*)(Qd_ + row * 264 + ch * 16) = uint2{lq##i.x, lq##i.y}; *(uint2*)(Qd_ + row * 264 + ch * 16 + 8) = uint2{lq##i.z, lq##i.w}; \
  }
#define ST_K(i, buf_)                                                                                     \
  {                                                                                                       \
    char* Kt_ = smem + (buf_) * BUFB + 2 * 16896;                                                         \
    const int piece = ltv + 256 * i, row2 = piece >> 3, ch2 = piece & 7;                                  \
    *(uint2*)(Kt_ + row2 * 136 + ch2 * 16) = uint2{lk##i.x, lk##i.y}; *(uint2*)(Kt_ + row2 * 136 + ch2 * 16 + 8) = uint2{lk##i.z, lk##i.w}; \
  }
#define ST_T(i, buf_)                                                                                     \
  {                                                                                                       \
    char* At_ = smem + (buf_) * BUFB + 2 * 16896 + 17408;                                                 \
    const int piece = ltv + 256 * i, row = piece >> 3, ch = piece & 7;                                     \
    *(uint2*)(At_ + row * 136 + ch * 16) = uint2{lt##i.x, lt##i.y}; *(uint2*)(At_ + row * 136 + ch * 16 + 8) = uint2{lt##i.z, lt##i.w}; \
  }
#define ST_R1(buf_) { ST_AQ(0, buf_) ST_AQ(1, buf_) ST_AQ(2, buf_) ST_AQ(3, buf_) }
#define ST_R2(buf_) { ST_K(0, buf_) ST_K(1, buf_) ST_K(2, buf_) ST_K(3, buf_) ST_T(0, buf_) ST_T(1, buf_) }
#define LD_Z(n_)                                                                                          \
  {                                                                                                       \
    const u16* zp_ = proj + (((size_t)b * 256 + (n_)) * 64 + nrow) * PC + BZ + h * 128 + nqr * 32;        \
    lz0 = *(const uint4*)(zp_); lz1 = *(const uint4*)(zp_ + 8); lz2 = *(const uint4*)(zp_ + 16); lz3 = *(const uint4*)(zp_ + 24); \
  }
  f32x16 S[4];
#pragma unroll
  for (int i = 0; i < 4; ++i)
#pragma unroll
    for (int j = 0; j < 16; ++j) S[i][j] = 0.f;
  const int e = 32 * w + c31;
  uint4 un0, un1, un2, un3;
  float gln = 0.f;
#define LD_U(n_)                                                                                          \
  {                                                                                                       \
    const uint4* up_ = (const uint4*)((const char*)proj + ((((size_t)b * 256 + (n_)) * 64 + (e >> 1)) * PC + BV + h * 128) * 2 + (e & 1) * 128 + hh * 64); \
    un0 = up_[0]; un1 = up_[1]; un2 = up_[2]; un3 = up_[3];                                               \
    gln = p.GL()[((size_t)b * 256 + (n_)) * 4 + h];                                                       \
  }
  if (!is_comp) {
    const int ltv = lt;
    uint4 la0, la1, la2, la3, lq0, lq1, lq2, lq3, lk0, lk1, lk2, lk3, lt0, lt1;
    LD_R1(0) LD_R2(0)
    ST_R1(0) ST_R2(0)
  } else {
    LD_U(0)
  }
  for (int n = 0; n < 256; ++n) {
    f32x16 o[2];
    __syncthreads();
    if (is_comp) {
      int lnv = ln;
      asm volatile("" : "+v"(lnv));
      const int hh = lnv >> 5, c31 = lnv & 31;
      const char* Wm = smem + (n & 1) * BUFB;
      const char* Qd = Wm + 16896;
      const char* Kt = Wm + 2 * 16896;
      const char* At = Kt + 17408;
      f32x16 ws[2];
#pragma unroll
      for (int i = 0; i < 2; ++i)
#pragma unroll
        for (int j = 0; j < 16; ++j) { ws[i][j] = 0.f; o[i][j] = 0.f; }
#pragma unroll
      for (int Tt = 0; Tt < 4; ++Tt)
#pragma unroll
        for (int s = 0; s < 2; ++s) {
          const int kb = 32 * Tt + 16 * s;
          const bf16x8 sps = pack8(S[Tt], s);
#pragma unroll
          for (int Tc = 0; Tc < 2; ++Tc) {
            ws[Tc] = mfma32(afrag_perm(Wm, 32 * Tc + c31, 264, kb, hh), sps, ws[Tc]);
            o[Tc] = mfma32(afrag_perm(Qd, 32 * Tc + c31, 264, kb, hh), sps, o[Tc]);
          }
        }
      f32x16 vn[2];
      vn[0][0] = bflo(un0.x) - ws[0][0]; vn[0][1] = bfhi(un0.x) - ws[0][1]; vn[0][2] = bflo(un0.y) - ws[0][2]; vn[0][3] = bfhi(un0.y) - ws[0][3];
      vn[0][4] = bflo(un0.z) - ws[0][4]; vn[0][5] = bfhi(un0.z) - ws[0][5]; vn[0][6] = bflo(un0.w) - ws[0][6]; vn[0][7] = bfhi(un0.w) - ws[0][7];
      vn[0][8] = bflo(un1.x) - ws[0][8]; vn[0][9] = bfhi(un1.x) - ws[0][9]; vn[0][10] = bflo(un1.y) - ws[0][10]; vn[0][11] = bfhi(un1.y) - ws[0][11];
      vn[0][12] = bflo(un1.z) - ws[0][12]; vn[0][13] = bfhi(un1.z) - ws[0][13]; vn[0][14] = bflo(un1.w) - ws[0][14]; vn[0][15] = bfhi(un1.w) - ws[0][15];
      vn[1][0] = bflo(un2.x) - ws[1][0]; vn[1][1] = bfhi(un2.x) - ws[1][1]; vn[1][2] = bflo(un2.y) - ws[1][2]; vn[1][3] = bfhi(un2.y) - ws[1][3];
      vn[1][4] = bflo(un2.z) - ws[1][4]; vn[1][5] = bfhi(un2.z) - ws[1][5]; vn[1][6] = bflo(un2.w) - ws[1][6]; vn[1][7] = bfhi(un2.w) - ws[1][7];
      vn[1][8] = bflo(un3.x) - ws[1][8]; vn[1][9] = bfhi(un3.x) - ws[1][9]; vn[1][10] = bflo(un3.y) - ws[1][10]; vn[1][11] = bfhi(un3.y) - ws[1][11];
      vn[1][12] = bflo(un3.z) - ws[1][12]; vn[1][13] = bfhi(un3.z) - ws[1][13]; vn[1][14] = bflo(un3.w) - ws[1][14]; vn[1][15] = bfhi(un3.w) - ws[1][15];
      const float gl = gln;
      if (n + 1 < 256) LD_U(n + 1)
      bf16x8 vp[2][2];
#pragma unroll
      for (int Tc = 0; Tc < 2; ++Tc) { vp[Tc][0] = pack8(vn[Tc], 0); vp[Tc][1] = pack8(vn[Tc], 1); }
#pragma unroll
      for (int s = 0; s < 2; ++s) {
        o[0] = mfma32(afrag_perm(At, c31, 136, 16 * s, hh), vp[0][s], o[0]);
        o[1] = mfma32(afrag_perm(At, 32 + c31, 136, 16 * s, hh), vp[0][s], o[1]);
        o[1] = mfma32(afrag_perm(At, 32 + c31, 136, 32 + 16 * s, hh), vp[1][s], o[1]);
      }
#pragma unroll
      for (int Tt = 0; Tt < 4; ++Tt)
#pragma unroll
        for (int j = 0; j < 16; ++j) S[Tt][j] *= gl;
#pragma unroll
      for (int Tc = 0; Tc < 2; ++Tc)
#pragma unroll
        for (int s = 0; s < 2; ++s)
#pragma unroll
          for (int Tt = 0; Tt < 4; ++Tt)
            S[Tt] = mfma32(afrag_perm(Kt, 32 * Tt + c31, 136, 32 * Tc + 16 * s, hh), vp[Tc][s], S[Tt]);
    } else {
      int ltv = lt;
      asm volatile("" : "+v"(ltv));
      const int nrow = ltv >> 2, nqr = ltv & 3;
      const int nn = (n + 1 < 256) ? n + 1 : 255;
      {
        uint4 la0, la1, la2, la3, lq0, lq1, lq2, lq3;
        LD_R1(nn)
        ST_R1((n + 1) & 1)
      }
      uint4 lz0, lz1, lz2, lz3;
      {
        uint4 lk0, lk1, lk2, lk3, lt0, lt1;
        LD_R2(nn)
        const int nz = (n > 0) ? n - 1 : 0;
        LD_Z(nz)
        ST_R2((n + 1) & 1)
      }
      if (n > 0) {
        const float* orow = Ot + nrow * 132 + nqr * 32;
        float ss = 0.f;
#pragma unroll
        for (int i = 0; i < 8; ++i) {
          const float4 v = *(const float4*)(orow + 4 * i);
          ss += v.x * v.x + v.y * v.y + v.z * v.z + v.w * v.w;
        }
        ss += __shfl_xor(ss, 1);
        ss += __shfl_xor(ss, 2);
        const float rs = rsqrtf(ss * (1.f / 128.f) + EPS);
        u16* zp = proj + (((size_t)b * 256 + (n - 1)) * 64 + nrow) * PC + BZ + h * 128 + nqr * 32;
        const float* gg = ng + nqr * 32;
#define GN1(i, Z)                                                                                          \
        {                                                                                                  \
          const float4 oa = *(const float4*)(orow + 8 * i), ob = *(const float4*)(orow + 8 * i + 4);       \
          uint4 r;                                                                                         \
          r.x = pack2(oa.x * rs * gg[8 * i + 0] * siluf_(bflo(Z.x)), oa.y * rs * gg[8 * i + 1] * siluf_(bfhi(Z.x))); \
          r.y = pack2(oa.z * rs * gg[8 * i + 2] * siluf_(bflo(Z.y)), oa.w * rs * gg[8 * i + 3] * siluf_(bfhi(Z.y))); \
          r.z = pack2(ob.x * rs * gg[8 * i + 4] * siluf_(bflo(Z.z)), ob.y * rs * gg[8 * i + 5] * siluf_(bfhi(Z.z))); \
          r.w = pack2(ob.z * rs * gg[8 * i + 6] * siluf_(bflo(Z.w)), ob.w * rs * gg[8 * i + 7] * siluf_(bfhi(Z.w))); \
          if (wr) *(uint4*)(zp + 8 * i) = r;                                                               \
        }
        GN1(0, lz0) GN1(1, lz1) GN1(2, lz2) GN1(3, lz3)
      }
    }
    __syncthreads();
    if (is_comp) {
#pragma unroll
      for (int Tc = 0; Tc < 2; ++Tc)
#pragma unroll
        for (int j = 0; j < 16; ++j) Ot[(32 * Tc + crow(j, hh)) * 132 + e] = o[Tc][j];
    }
  }
  __syncthreads();
  if (!is_comp) {
    const int n = 256;
    const int nrow = lt >> 2, nqr = lt & 3;
    uint4 lz0, lz1, lz2, lz3;
    LD_Z(255)
    const float* orow = Ot + nrow * 132 + nqr * 32;
    float ss = 0.f;
#pragma unroll
    for (int i = 0; i < 8; ++i) {
      const float4 v = *(const float4*)(orow + 4 * i);
      ss += v.x * v.x + v.y * v.y + v.z * v.z + v.w * v.w;
    }
    ss += __shfl_xor(ss, 1);
    ss += __shfl_xor(ss, 2);
    const float rs = rsqrtf(ss * (1.f / 128.f) + EPS);
    u16* zp = proj + (((size_t)b * 256 + (n - 1)) * 64 + nrow) * PC + BZ + h * 128 + nqr * 32;
    const float* gg = ng + nqr * 32;
    GN1(0, lz0) GN1(1, lz1) GN1(2, lz2) GN1(3, lz3)
  }
#undef GN1
#undef LD_AQ
#undef LD_K
#undef LD_R1
#undef LD_R2
#undef LD_T
#undef ST_AQ
#undef ST_K
#undef ST_R1
#undef ST_R2
#undef ST_T
#undef LD_Z
#undef LD_U
  __syncthreads();
}

DI void diff_item(const Params& p, int l, int qt, int bh, char* smem) {
  const int b = bh >> 2, h = bh & 3;
  const int tid = ltid(), ln = tid & 63, w = tid >> 6, hh = ln >> 5, c31 = ln & 31;
  const int st = w & 3, c = w >> 2;
  const size_t tokbase = (size_t)b * T;
  const int qb = qt * 128 + 32 * st + c31;
  u16* proj = p.P();
  bf16x8 qf[4];
  {
    const u16* qrow = proj + (tokbase + qb) * PC + AQ + h * 128 + c * 64 + 8 * hh;
#pragma unroll
    for (int s = 0; s < 4; ++s) qf[s] = *(const bf16x8*)(qrow + 16 * s);
  }
  f32x16 O[4];
  float mrun, lrun;
  const float sc = 0.125f * 1.44269504089f;
  char* Ks = smem;
  char* Vs = smem + 17408;
  uint4 rk0, rk1, rv0, rv1;
  const int srow = tid >> 4, sch = tid & 15;
#define DLOAD1(i, kt)                                                                \
  {                                                                                  \
    const u16* base = proj + (tokbase + (kt) * 64 + srow + 32 * i) * PC + h * 128 + sch * 8; \
    rk##i = *(const uint4*)(base + AK);                                              \
    rv##i = *(const uint4*)(base + AV);                                              \
  }
#define DLOAD(kt) { DLOAD1(0, kt) DLOAD1(1, kt) }
#define DSTORE1(i)                                                \
  *(uint4*)(Ks + (srow + 32 * i) * 272 + sch * 16) = rk##i;       \
  *(uint4*)(Vs + (srow + 32 * i) * 320 + sch * 16) = rv##i;
  const int nkt = 2 * qt + 2;
#pragma unroll 1
  for (int rep = 0; rep < DUP_DIFF; ++rep) {
#pragma unroll
  for (int i = 0; i < 4; ++i)
#pragma unroll
    for (int j = 0; j < 16; ++j) O[i][j] = 0.f;
  mrun = -INFINITY; lrun = 0.f;
  DLOAD(0);
  for (int kt = 0; kt < nkt; ++kt) {
    __syncthreads();
    DSTORE1(0) DSTORE1(1)
    __syncthreads();
    if (kt + 1 < nkt) { DLOAD(kt + 1); }
    if (kt * 64 > qt * 128 + 32 * st + 31) continue;
    f32x16 sa[2];
#pragma unroll
    for (int k2 = 0; k2 < 2; ++k2) {
#pragma unroll
      for (int j = 0; j < 16; ++j) sa[k2][j] = 0.f;
#pragma unroll
      for (int s = 0; s < 4; ++s)
        sa[k2] = mfma32(*(const bf16x8*)(Ks + (32 * k2 + c31) * 272 + (c * 64 + 16 * s + 8 * hh) * 2), qf[s], sa[k2]);
    }
    if (kt >= 2 * qt) {
#pragma unroll
      for (int k2 = 0; k2 < 2; ++k2)
#pragma unroll
        for (int j = 0; j < 16; ++j)
          if (kt * 64 + 32 * k2 + crow(j, hh) > qb) sa[k2][j] = -INFINITY;
    }
    float tmax = sa[0][0];
#pragma unroll
    for (int k2 = 0; k2 < 2; ++k2)
#pragma unroll
      for (int j = 0; j < 16; ++j) tmax = fmaxf(tmax, sa[k2][j]);
    tmax = xhalf_max(tmax);
    const float cand = tmax * sc;
    if (__any(cand > mrun + 8.f)) {
      const float mnew = fmaxf(mrun, cand);
      const float alpha = __builtin_amdgcn_exp2f(mrun - mnew);
      mrun = mnew;
      lrun *= alpha;
#pragma unroll
      for (int i = 0; i < 4; ++i)
#pragma unroll
        for (int j = 0; j < 16; ++j) O[i][j] *= alpha;
    }
    float psum = 0.f;
#pragma unroll
    for (int k2 = 0; k2 < 2; ++k2)
#pragma unroll
      for (int j = 0; j < 16; ++j) { const float pv = __builtin_amdgcn_exp2f(sa[k2][j] * sc - mrun); sa[k2][j] = pv; psum += pv; }
    lrun += psum;
#pragma unroll
    for (int k2 = 0; k2 < 2; ++k2)
#pragma unroll
      for (int s2 = 0; s2 < 2; ++s2) {
        const bf16x8 pp = pack8(sa[k2], s2);
        bf16x8 vf[4];
        trfrag4<320>(Vs, 32 * k2 + 16 * s2, ln, vf);
#pragma unroll
        for (int mt = 0; mt < 4; ++mt) O[mt] = mfma32(vf[mt], pp, O[mt]);
      }
  }
  }
#undef DLOAD
#undef DLOAD1
#undef DSTORE1
  __syncthreads();
  const float ltot = xhalf_sum(lrun);
  const float inv = 1.f / ltot;
  float* xch = (float*)smem + st * 32 * 132;
  if (c == 1) {
#pragma unroll
    for (int mt = 0; mt < 4; ++mt)
#pragma unroll
      for (int i4 = 0; i4 < 4; ++i4)
        *(float4*)(xch + c31 * 132 + 32 * mt + 8 * i4 + 4 * hh) =
            float4{O[mt][4 * i4] * inv, O[mt][4 * i4 + 1] * inv, O[mt][4 * i4 + 2] * inv, O[mt][4 * i4 + 3] * inv};
  }
  __syncthreads();
  if (c == 0) {
    const float lam = p.LAM()[l], oml = 1.f - p.LAM()[2 + l];
    float ss = 0.f;
#pragma unroll
    for (int mt = 0; mt < 4; ++mt)
#pragma unroll
      for (int i4 = 0; i4 < 4; ++i4) {
        const float4 o1 = *(const float4*)(xch + c31 * 132 + 32 * mt + 8 * i4 + 4 * hh);
        float d;
        d = O[mt][4 * i4] * inv - lam * o1.x; O[mt][4 * i4] = d; ss += d * d;
        d = O[mt][4 * i4 + 1] * inv - lam * o1.y; O[mt][4 * i4 + 1] = d; ss += d * d;
        d = O[mt][4 * i4 + 2] * inv - lam * o1.z; O[mt][4 * i4 + 2] = d; ss += d * d;
        d = O[mt][4 * i4 + 3] * inv - lam * o1.w; O[mt][4 * i4 + 3] = d; ss += d * d;
      }
    ss = xhalf_sum(ss);
    const float rs = rsqrtf(ss * (1.f / 128.f) + EPS) * oml;
    const float* sg = p.a_subln_g + l * 128;
    int qb_e = qb;
    asm volatile("" : "+v"(qb_e));
    u16* orow = proj + (tokbase + qb_e) * PC + AQ + h * 128;
#pragma unroll
    for (int mt = 0; mt < 4; ++mt)
#pragma unroll
      for (int i4 = 0; i4 < 4; ++i4) {
        const int dv = 32 * mt + 8 * i4 + 4 * hh;
        const float4 gg = *(const float4*)(sg + dv);
        uint2 o;
        o.x = pack2(O[mt][4 * i4] * rs * gg.x, O[mt][4 * i4 + 1] * rs * gg.y);
        o.y = pack2(O[mt][4 * i4 + 2] * rs * gg.z, O[mt][4 * i4 + 3] * rs * gg.w);
        *(uint2*)(orow + dv) = o;
      }
  }
  __syncthreads();
}

DI u32 mono_key(float f) { u32 u = __float_as_uint(f); return (u & 0x80000000u) ? ~u : (u | 0x80000000u); }

constexpr int DCAP = 640;
DI u32 dsa_prune(u32* ck, u16* ci, int cnt, u32 tau_old, bool exact, int ln, int& newcnt) {
  u32 kv[10];
  u16 iv[10];
  u32 mx = 0u;
#pragma unroll
  for (int j = 0; j < 10; ++j) {
    const int pos = ln + 64 * j;
    const bool vd = pos < cnt;
    kv[j] = vd ? ck[pos] : 0u;
    iv[j] = vd ? ci[pos] : (u16)0;
    mx = max(mx, kv[j]);
  }
#pragma unroll
  for (int o = 32; o; o >>= 1) mx = max(mx, (u32)__shfl_xor((int)mx, o));
  u32 L = tau_old + 1u, H = mx + 1u;
  int curL = cnt;
  while ((exact || curL > 384) && (H - L) > 1u) {
    const u32 mid = L + ((H - L) >> 1);
    int c = 0;
#pragma unroll
    for (int j = 0; j < 10; ++j) c += __popcll(__ballot(kv[j] >= mid));
    if (c >= 256) { L = mid; curL = c; } else H = mid;
  }
  int ngt = 0;
#pragma unroll
  for (int j = 0; j < 10; ++j) ngt += __popcll(__ballot(kv[j] > L));
  const int target = (!exact && curL <= 384) ? curL : 256;
  const int need = target - ngt;
  int run_gt = 0, run_eq = 0;
#pragma unroll
  for (int j = 0; j < 10; ++j) {
    const bool gt = kv[j] > L, eq = (kv[j] == L);
    const u64 mg = __ballot(gt), me = __ballot(eq);
    const int pg = run_gt + (int)lane_lt_cnt(mg), pe = run_eq + (int)lane_lt_cnt(me);
    if (gt) { ck[pg] = kv[j]; ci[pg] = iv[j]; }
    else if (eq && pe < need) { ck[ngt + pe] = kv[j]; ci[ngt + pe] = iv[j]; }
    run_gt += __popcll(mg);
    run_eq += __popcll(me);
  }
  newcnt = target;
  return L;
}

DI void dsa_item(const Params& p, int l, int tile32, int b, char* smem) {
  const int tid = ltid(), ln = tid & 63, w = tid >> 6, hh = ln >> 5, c31 = ln & 31;
  const int t0 = tile32 * 32 + 4 * w;
  const size_t tokbase = (size_t)b * T;
  u16* QX = (u16*)p.out;
  char* wl = smem + w * 17408;
  u32* ckey = (u32*)wl;
  u16* cidx = (u16*)(wl + 10240);
  u16* ifin = (u16*)(wl + 15360);
  char* tile = wl;
  int cnt0 = 0, cnt1 = 0, cnt2 = 0, cnt3 = 0;
  {
    bf16x8 qa[4];
    {
      const int r = c31, ql = 2 * ((r >> 2) & 1) + (r & 1), hd = ((r & 3) >> 1) + 2 * (r >> 3);
      const u16* qrow = QX + (tokbase + t0 + ql) * LDQ + 1024 + hd * 64 + 8 * hh;
#pragma unroll
      for (int s = 0; s < 4; ++s) qa[s] = *(const bf16x8*)(qrow + 16 * s);
    }
    typedef float f32x2 __attribute__((ext_vector_type(2)));
    f32x2 wq2[8];
    {
      const float4* wi = (const float4*)(p.WIDX() + (tokbase + t0 + 2 * hh) * 8);
      const float4 a0 = wi[0], a1 = wi[1], b0 = wi[2], b1 = wi[3];
      wq2[0] = f32x2{a0.x, b0.x}; wq2[1] = f32x2{a0.y, b0.y}; wq2[2] = f32x2{a0.z, b0.z}; wq2[3] = f32x2{a0.w, b0.w};
      wq2[4] = f32x2{a1.x, b1.x}; wq2[5] = f32x2{a1.y, b1.y}; wq2[6] = f32x2{a1.z, b1.z}; wq2[7] = f32x2{a1.w, b1.w};
    }
    const int qpos0 = t0 + 2 * hh;
    const int nkt = ((t0 + 3) >> 5) + 1;
    const u32 lmask = (1u << c31) - 1u;
#pragma unroll 1
    for (int rep = 0; rep < DUP_DSA1; ++rep) {
    cnt0 = cnt1 = cnt2 = cnt3 = 0;
    u32 tau0 = 0u, tau1 = 0u, tau2 = 0u, tau3 = 0u;
    bf16x8 kn[4][4];
    {
#pragma unroll
      for (int t = 0; t < 4; ++t) {
        const u16* krow = p.KIDX() + (tokbase + t * 32 + c31) * 64 + 8 * hh;
#pragma unroll
        for (int s = 0; s < 4; ++s) kn[t][s] = *(const bf16x8*)(krow + 16 * s);
      }
    }
    const int ngrp = (nkt + 3) >> 2;
    for (int g = 0; g <= ngrp; ++g) {
      const int lim = (g < ngrp) ? (DCAP - 128) : 256;
      for (;;) {
        const int q = (cnt0 > lim) ? 0 : (cnt1 > lim) ? 1 : (cnt2 > lim) ? 2 : (cnt3 > lim) ? 3 : -1;
        if (q < 0) break;
        const int c = (q == 0) ? cnt0 : (q == 1) ? cnt1 : (q == 2) ? cnt2 : cnt3;
        const u32 to = (q == 0) ? tau0 : (q == 1) ? tau1 : (q == 2) ? tau2 : tau3;
        int nc;
        const u32 t = dsa_prune(ckey + q * DCAP, cidx + q * DCAP, c, to, g == ngrp, ln, nc);
        if (q == 0) { cnt0 = nc; tau0 = t; } else if (q == 1) { cnt1 = nc; tau1 = t; }
        else if (q == 2) { cnt2 = nc; tau2 = t; } else { cnt3 = nc; tau3 = t; }
      }
      if (g == ngrp) break;
      bf16x8 kc[4][4];
#pragma unroll
      for (int t = 0; t < 4; ++t)
#pragma unroll
        for (int s = 0; s < 4; ++s) kc[t][s] = kn[t][s];
      if (g + 1 < ngrp) {
#pragma unroll
        for (int t = 0; t < 4; ++t) {
          const u16* krow = p.KIDX() + (tokbase + (g + 1) * 128 + t * 32 + c31) * 64 + 8 * hh;
#pragma unroll
          for (int s = 0; s < 4; ++s) kn[t][s] = *(const bf16x8*)(krow + 16 * s);
        }
      }
      const u32 tauA = hh ? tau2 : tau0, tauB = hh ? tau3 : tau1;
#pragma unroll
      for (int t = 0; t < 4; ++t) {
        const int key = (g * 4 + t) * 32 + c31;
        f32x16 acc;
#pragma unroll
        for (int j = 0; j < 16; ++j) acc[j] = 0.f;
#pragma unroll
        for (int s = 0; s < 4; ++s) acc = mfma32(qa[s], kc[t][s], acc);
        f32x2 ss2 = f32x2{0.f, 0.f};
#pragma unroll
        for (int hq = 0; hq < 8; ++hq) {
          const f32x2 rr = f32x2{__builtin_amdgcn_fmed3f(acc[2 * hq], 0.f, 3.0e38f), __builtin_amdgcn_fmed3f(acc[2 * hq + 1], 0.f, 3.0e38f)};
          ss2 = __builtin_elementwise_fma(wq2[hq], rr, ss2);
        }
        const float s0 = ss2.x, s1 = ss2.y;
        const u32 k0 = mono_key(s0), k1 = mono_key(s1);
        const bool c0 = (key <= qpos0) && (k0 > tauA), c1 = (key <= qpos0 + 1) && (k1 > tauB);
        const u64 m0 = __ballot(c0), m1 = __ballot(c1);
        if (m0 | m1) {
          const u32 h0 = hh ? (u32)(m0 >> 32) : (u32)m0, h1 = hh ? (u32)(m1 >> 32) : (u32)m1;
          const int pA = (hh ? cnt2 : cnt0) + __popc(h0 & lmask), pB = (hh ? cnt3 : cnt1) + __popc(h1 & lmask);
          if (c0) { ckey[(2 * hh) * DCAP + pA] = k0; cidx[(2 * hh) * DCAP + pA] = (u16)key; }
          if (c1) { ckey[(2 * hh + 1) * DCAP + pB] = k1; cidx[(2 * hh + 1) * DCAP + pB] = (u16)key; }
          cnt0 += __popc((u32)m0); cnt2 += __popc((u32)(m0 >> 32));
          cnt1 += __popc((u32)m1); cnt3 += __popc((u32)(m1 >> 32));
        }
      }
    }
#pragma unroll
    for (int qq = 0; qq < 4; ++qq) {
      const int cq = (qq == 0) ? cnt0 : (qq == 1) ? cnt1 : (qq == 2) ? cnt2 : cnt3;
#pragma unroll
      for (int j = 0; j < 4; ++j) {
        const int pos = ln + 64 * j;
        ifin[qq * 256 + pos] = (pos < cq) ? cidx[qq * DCAP + pos] : (u16)0;
      }
    }
    }
  }
  const float sc = 0.125f * 1.44269504089f;
#pragma unroll 1
  for (int rep2 = 0; rep2 < DUP_DSA2; ++rep2)
#pragma unroll 1
  for (int qq = 0; qq < 4; ++qq) {
    const int nsel = (qq == 0) ? cnt0 : (qq == 1) ? cnt1 : (qq == 2) ? cnt2 : cnt3;
    const size_t tq = tokbase + t0 + qq;
    bf16x8 qf[8];
    {
      const u16* qab = QX + tq * LDQ + (c31 & 7) * 128 + 8 * hh;
#pragma unroll
      for (int s = 0; s < 8; ++s) qf[s] = *(const bf16x8*)(qab + 16 * s);
    }
    f32x16 O[4];
#pragma unroll
    for (int i = 0; i < 4; ++i)
#pragma unroll
      for (int j = 0; j < 16; ++j) O[i][j] = 0.f;
    float mrun = -INFINITY, lrun = 0.f;
    const int ntile = (nsel + 31) >> 5;
    uint4 gr0, gr1, gr2, gr3, gr4, gr5, gr6, gr7;
#define GGATHER1(i, tt_)                                                                     \
    {                                                                                        \
      const int piece = ln + 64 * i, row = piece >> 4, ch = piece & 15;                      \
      const int idx = ifin[qq * 256 + (tt_) * 32 + row];                                     \
      gr##i = *(const uint4*)(p.CKV() + (tokbase + idx) * 128 + ch * 8);                     \
    }
#define GGATHER(tt_) { GGATHER1(0, tt_) GGATHER1(1, tt_) GGATHER1(2, tt_) GGATHER1(3, tt_) GGATHER1(4, tt_) GGATHER1(5, tt_) GGATHER1(6, tt_) GGATHER1(7, tt_) }
#define GSTORE1(i) { const int piece = ln + 64 * i, row = piece >> 4, ch = piece & 15; *(uint4*)(tile + row * 272 + ch * 16) = gr##i; }
    if (ntile > 0) GGATHER(0)
    for (int tt = 0; tt < ntile; ++tt) {
      GSTORE1(0) GSTORE1(1) GSTORE1(2) GSTORE1(3) GSTORE1(4) GSTORE1(5) GSTORE1(6) GSTORE1(7)
      if (tt + 1 < ntile) GGATHER(tt + 1)
      __builtin_amdgcn_fence(__ATOMIC_RELEASE, "wavefront");
      f32x16 sa;
#pragma unroll
      for (int j = 0; j < 16; ++j) sa[j] = 0.f;
#pragma unroll
      for (int s = 0; s < 8; ++s) sa = mfma32(*(const bf16x8*)(tile + c31 * 272 + (16 * s + 8 * hh) * 2), qf[s], sa);
      float tmax = -INFINITY;
#pragma unroll
      for (int j = 0; j < 16; ++j) {
        if (tt * 32 + crow(j, hh) >= nsel) sa[j] = -INFINITY;
        tmax = fmaxf(tmax, sa[j]);
      }
      tmax = xhalf_max(tmax);
      const float cand = tmax * sc;
      if (__any(cand > mrun + 8.f)) {
        const float mnew = fmaxf(mrun, cand);
        const float alpha = __builtin_amdgcn_exp2f(mrun - mnew);
        mrun = mnew;
        lrun *= alpha;
#pragma unroll
        for (int i = 0; i < 4; ++i)
#pragma unroll
          for (int j = 0; j < 16; ++j) O[i][j] *= alpha;
      }
      float psum = 0.f;
#pragma unroll
      for (int j = 0; j < 16; ++j) { const float pv = __builtin_amdgcn_exp2f(sa[j] * sc - mrun); sa[j] = pv; psum += pv; }
      lrun += psum;
#pragma unroll
      for (int s2 = 0; s2 < 2; ++s2) {
        const bf16x8 pp = pack8(sa, s2);
        bf16x8 vf[4];
        trfrag4<272>(tile, 16 * s2, ln, vf);
#pragma unroll
        for (int mt = 0; mt < 4; ++mt) O[mt] = mfma32(vf[mt], pp, O[mt]);
      }
      __builtin_amdgcn_fence(__ATOMIC_ACQ_REL, "wavefront");
    }
#undef GGATHER1
#undef GGATHER
#undef GSTORE1
    const float ltot = xhalf_sum(lrun);
    const float inv = 1.f / ltot;
    if (c31 < 8 && rep2 == DUP_DSA2 - 1) {
      u16* orow = QX + tq * LDQ + c31 * 128;
#pragma unroll
      for (int mt = 0; mt < 4; ++mt)
#pragma unroll
        for (int i4 = 0; i4 < 4; ++i4) {
          uint2 o;
          o.x = pack2(O[mt][4 * i4] * inv, O[mt][4 * i4 + 1] * inv);
          o.y = pack2(O[mt][4 * i4 + 2] * inv, O[mt][4 * i4 + 3] * inv);
          *(uint2*)(orow + 32 * mt + 8 * i4 + 4 * hh) = o;
        }
    }
  }
  __syncthreads();
}

DI void phase_prep(const Params& p, int l, char* smem) {
  if (EN_C) {
    int rt, ct;
    for (int it = 0; next_tile(it, 128, 6, 32, 2, rt, ct); ++it) qx_tile(p, l, rt, ct, smem);
  }
  const int n_gdn = EN_B ? 1024 : 0, n_kp = EN_C ? 512 : 0;
  for (int t = lbid(); t < n_gdn + n_kp; t += lgdim()) {
    if (t < n_gdn) gdn_prep_item(p, l, t, smem);
    else dsa_kprep_item(p, l, t - n_gdn);
  }
}

DI int xcc_id() { return (int)(__builtin_amdgcn_s_getreg((3 << 11) | 20) & 0x7u); }

DI void phase_mixers(const Params& p, int l, char* smem) {
  __shared__ int s_item;
  const int x0 = xcc_id();
  int xs = x0;
  for (;;) {
    __syncthreads();
    {
      int qi = l * 8 + xs;
      asm volatile("" : "+s"(qi));
      if (ltid() == 0) s_item = (int)atomicAdd(p.CNT() + qi, 1u);
    }
    __syncthreads();
    const int it = s_item;
    const int n_gdn = EN_B ? 1 : 0;
    if (it >= n_gdn + 256) {
      xs = (xs + 1) & 7;
      if (xs == x0) break;
      continue;
    }
    const int x = xs;
    if (it < n_gdn) {
#pragma unroll 1
      for (int rep = 0; rep < DUP_GDN; ++rep) gdn_rec_item(p, l, x, smem, rep == DUP_GDN - 1);
    }
    else {
      const int j = it - n_gdn, k = j >> 1;
      if ((j & 1) == 0) { if (EN_A) diff_item(p, l, 127 - k, x, smem); }
      else { if (EN_C) dsa_item(p, l, 511 - (k * 4 + (x >> 1)), x & 1, smem); }
    }
  }
}

DI void run_phase(const Params& p, int ph, char* smem) {
  if (ph == 0) { phase0(p, smem); return; }
  const int l = (ph - 1) / 9, s = (ph - 1) % 9;
  switch (s) {
    case 0: phase_inproj(p, l, smem); break;
    case 1: phase_prep(p, l, smem); break;
    case 2: phase_mixers(p, l, smem); break;
    case 3: phase_merge(p, l, smem); break;
    case 4: phase_resgemm(p, p.MERGED(), LDX, p.wo(l), KP1024, 1024, smem); break;
    case 5: ln_phase(p.out, p.ln1_g + l * 1024, p.ln1_b + l * 1024, p.XB(), nullptr); break;
    case 6: phase_ff1(p, l, smem); break;
    case 7: phase_resgemm(p, p.P(), LDH, p.wf2(l), KP4096, 4096, smem); break;
    case 8: ln_phase(p.out, p.ln2_g + l * 1024, p.ln2_b + l * 1024, (l == 1) ? nullptr : p.XB(), (l == 1) ? p.out : nullptr); break;
  }
}

constexpr int N_PHASES = 19;


DI u32 xb_ld(u32* p) { return __hip_atomic_load(p, __ATOMIC_RELAXED, __HIP_MEMORY_SCOPE_AGENT); }
DI u32 xb_add(u32* p, u32 v) { return __hip_atomic_fetch_add(p, v, __ATOMIC_RELAXED, __HIP_MEMORY_SCOPE_AGENT); }
DI void fast_sync(u32* bar, int x, const volatile int* st) {
  asm volatile("s_waitcnt vmcnt(0)" ::: "memory");
  __syncthreads();
  if (ltid() == 0) {
    __builtin_amdgcn_s_waitcnt(0);
    const u32 nloc = (u32)st[0], nx = (u32)st[1];
    const u32 old = xb_add(bar + 32 * (8 + x), 1u);
    const u32 gen = old / nloc;
    if (old + 1u == (gen + 1u) * nloc) {
      __builtin_amdgcn_fence(__ATOMIC_RELEASE, "agent");
      asm volatile("s_waitcnt vmcnt(0)" ::: "memory");
      const u32 og = xb_add(bar + 32 * 24, 1u);
      const u32 tg = og / nx;
      if (og + 1u == (tg + 1u) * nx) xb_add(bar + 32 * 25, 1u);
      else { while (xb_ld(bar + 32 * 25) == tg) __builtin_amdgcn_s_sleep(1); }
      __builtin_amdgcn_fence(__ATOMIC_ACQUIRE, "agent");
      xb_add(bar + 32 * (16 + x), 1u);
      asm volatile("s_waitcnt vmcnt(0)" ::: "memory");
    } else {
      while (xb_ld(bar + 32 * (16 + x)) == gen) __builtin_amdgcn_s_sleep(1);
      __builtin_amdgcn_fence(__ATOMIC_ACQUIRE, "agent");
      asm volatile("s_waitcnt vmcnt(0)" ::: "memory");
    }
  }
  __syncthreads();
}
#if COOP
DI void gsync() { cg::this_grid().sync(); }
__global__ void __launch_bounds__(512, 1) mega_kernel(Params p, int ph_begin, int ph_end) {
  __shared__ __attribute__((aligned(16))) char smem[SMEM_BYTES];
  __shared__ int xb_st[2];
  const int myx = xcc_id();
  if (ltid() == 0) (void)xb_add(p.BAR() + 32 * myx, 1u);
  for (int r = 0; r < REP0; ++r) { phase0(p, smem); cg::this_grid().sync(); }
  if (ltid() == 0) {
    int mine = 0, cnt = 0;
    for (int j = 0; j < 8; ++j) { const int c = (int)xb_ld(p.BAR() + 32 * j); cnt += (c > 0) ? 1 : 0; mine = (j == myx) ? c : mine; }
    xb_st[0] = mine > 0 ? mine : 1;
    xb_st[1] = cnt > 0 ? cnt : 1;
  }
  __syncthreads();
#define gsync() fast_sync(p.BAR(), myx, xb_st)
#pragma unroll 1
  for (int l = 0; l < 2; ++l) {
    for (int r = 0; r < REP1; ++r) { phase_inproj(p, l, smem); gsync(); }
    phase_prep(p, l, smem);
    gsync();
    phase_mixers(p, l, smem);
    gsync();
    for (int r = 0; r < REP2; ++r) { phase_merge(p, l, smem); gsync(); }
    for (int r = 0; r < REP3; ++r) { phase_resgemm(p, p.MERGED(), LDX, p.wo(l), KP1024, 1024, smem); gsync(); }
    for (int r = 0; r < REP4; ++r) { ln_phase(p.out, p.ln1_g + l * 1024, p.ln1_b + l * 1024, p.XB(), nullptr); gsync(); }
    for (int r = 0; r < REP5; ++r) { phase_ff1(p, l, smem); gsync(); }
    for (int r = 0; r < REP6; ++r) { phase_resgemm(p, p.P(), LDH, p.wf2(l), KP4096, 4096, smem); gsync(); }
    ln_phase(p.out, p.ln2_g + l * 1024, p.ln2_b + l * 1024, (l == 1) ? nullptr : p.XB(), (l == 1) ? p.out : nullptr);
    if (l == 0) gsync();
  }
}
#undef gsync
#else
__global__ void __launch_bounds__(512, 1) mega_kernel(Params p, int ph_begin, int ph_end) {
  __shared__ __attribute__((aligned(16))) char smem[SMEM_BYTES];
  for (int ph = ph_begin; ph < ph_end; ++ph) run_phase(p, ph, smem);
}
#endif

extern "C" void kernel_launch(void* const* d_in, const int* in_sizes, int n_in, void* d_out, int out_size,
                              void* d_ws, size_t ws_size, hipStream_t stream) {
  static int grid_blocks = 0;
  if (!grid_blocks) {
    int dev = 0, cus = 0, per_cu = 0;
    hipGetDevice(&dev);
    hipDeviceGetAttribute(&cus, hipDeviceAttributeMultiprocessorCount, dev);
    hipOccupancyMaxActiveBlocksPerMultiprocessor(&per_cu, mega_kernel, NTHR, 0);
    if (per_cu < 1) per_cu = 1;
    if (per_cu > 1) per_cu = 1;
    grid_blocks = cus * per_cu;
  }
  Params p{};
  const float** pf = (const float**)&p;
  for (int i = 0; i < 27; ++i) pf[i] = (const float*)d_in[i];
  p.out = (float*)d_out;
  p.ws = (char*)d_ws;
  if (WS_NEED > ws_size) { fprintf(stderr, "workspace too small: need %zu have %zu\n", (size_t)WS_NEED, ws_size); return; }
#if COOP
  hipMemsetAsync(p.ws + O_BAR, 0, 4096, stream);
  int b = 0, e = N_PHASES;
  void* args[] = {&p, &b, &e};
  hipError_t err = hipLaunchCooperativeKernel((void*)mega_kernel, dim3(grid_blocks), dim3(NTHR), args, 0, stream);
  if (err != hipSuccess) fprintf(stderr, "cooperative launch failed: %s (grid %d)\n", hipGetErrorString(err), grid_blocks);
#else
  for (int ph = 0; ph < N_PHASES; ++ph) mega_kernel<<<grid_blocks, NTHR, 0, stream>>>(p, ph, ph + 1);
#endif
}
```

```cpp
#include <hip/hip_runtime.h>
#include <hip/hip_cooperative_groups.h>
#include <cstdio>
namespace cg = cooperative_groups;

#ifndef COOP
#define COOP 1
#endif
#ifndef REP0
#define REP0 1
#define REP1 1
#define REP2 1
#define REP3 1
#define REP4 1
#define REP5 1
#define REP6 1
#endif
#ifndef DUP_GDN
#define DUP_GDN 1
#endif
#ifndef DUP_DIFF
#define DUP_DIFF 1
#endif
#ifndef DUP_DSA1
#define DUP_DSA1 1
#endif
#ifndef DUP_DSA2
#define DUP_DSA2 1
#endif
#ifndef EN_A
#define EN_A 1
#endif
#ifndef EN_B
#define EN_B 1
#endif
#ifndef EN_C
#define EN_C 1
#endif

typedef unsigned short u16;
typedef unsigned int u32;
typedef unsigned long long u64;
using bf16x8 = __attribute__((ext_vector_type(8))) short;
using s16x4 = __attribute__((ext_vector_type(4))) short;
using f32x4 = __attribute__((ext_vector_type(4))) float;
using f32x16 = __attribute__((ext_vector_type(16))) float;
#define DI __device__ __forceinline__

constexpr int NT = 32768, T = 16384, PC = 4048;
constexpr int AQ = 0, AK = 512, AV = 1024, BQ = 1536, BK_ = 2048, BV = 2560, BZ = 3072, BA = 3584, BB = 3588,
              CQ = 3592, CKVc = 3848, CKI = 3976, CWI = 4040, GATES = 4048;
constexpr float EPS = 1e-6f;
constexpr float DN_ALPHA = 1.41421356237f;
constexpr int NTHR = 512;
constexpr int SMEM_BYTES = 153600 + 512;

constexpr size_t al256(size_t x) { return (x + 255) & ~(size_t)255; }
constexpr int LDX = 1088, LDH = 4160, LDQ = 1600;
constexpr int KP1024 = 1088, KP512 = 576, KP256 = 320, KP4096 = 4160;
constexpr size_t SZ_WIN = al256((size_t)7120 * KP1024 * 2), SZ_WQX = al256((size_t)1536 * KP256 * 2), SZ_WBR = al256((size_t)1024 * KP512 * 2),
                 SZ_WBRC = al256((size_t)1024 * KP1024 * 2), SZ_WO = al256((size_t)1024 * KP1024 * 2), SZ_WF1 = al256((size_t)4096 * KP1024 * 2), SZ_WF2 = al256((size_t)1024 * KP4096 * 2);
constexpr size_t O_WIN = 0, O_WQX = O_WIN + SZ_WIN, O_WBRA = O_WQX + SZ_WQX, O_WBRB = O_WBRA + SZ_WBR, O_WBRC = O_WBRB + SZ_WBR,
                 O_WO = O_WBRC + SZ_WBRC, O_WF1 = O_WO + SZ_WO, O_WF2 = O_WF1 + SZ_WF1, LAYER_W = O_WF2 + SZ_WF2;
constexpr size_t O_P = 2 * LAYER_W, O_XB = O_P + (size_t)NT * LDH * 2, O_M = O_XB + (size_t)NT * LDX * 2;
constexpr size_t O_KDT = O_M, O_ATT = O_KDT + 33554432, O_HALO = O_ATT + 16777216, O_KIDX = O_HALO + 4718592, O_CKV = O_KIDX + 4194304,
                 O_MEND = O_CKV + 8388608 + 4194304;
constexpr size_t O_WIDX = O_MEND, O_GL = O_WIDX + (size_t)NT * 8 * 4, O_LAM = O_GL + 8192, O_CNT = O_LAM + 256, O_BAR = O_CNT + 256, WS_NEED = O_BAR + 4096;
static_assert(O_MEND - O_M >= (size_t)NT * LDX * 2, "merged alias");

struct Params {
  const float *x, *w_in, *b_gate, *a_lambda, *a_subln_g, *b_conv_w, *b_a_log, *b_dt_bias, *b_norm_g,
      *c_q_norm_g, *c_kv_norm_g, *c_kidx_g, *c_kidx_b, *c_w_uq, *c_w_qidx, *c_w_uk, *c_w_uv,
      *w_branch_a, *w_branch_b, *w_branch_c, *w_o, *ln1_g, *ln1_b, *w_ff1, *w_ff2, *ln2_g, *ln2_b;
  float* out;
  char* ws;
  __device__ __forceinline__ u16* win(int l) const { return (u16*)(ws + l * LAYER_W + O_WIN); }
  __device__ __forceinline__ u16* wqx(int l) const { return (u16*)(ws + l * LAYER_W + O_WQX); }
  __device__ __forceinline__ u16* wbra(int l) const { return (u16*)(ws + l * LAYER_W + O_WBRA); }
  __device__ __forceinline__ u16* wbrb(int l) const { return (u16*)(ws + l * LAYER_W + O_WBRB); }
  __device__ __forceinline__ u16* wbrc(int l) const { return (u16*)(ws + l * LAYER_W + O_WBRC); }
  __device__ __forceinline__ u16* wo(int l) const { return (u16*)(ws + l * LAYER_W + O_WO); }
  __device__ __forceinline__ u16* wf1(int l) const { return (u16*)(ws + l * LAYER_W + O_WF1); }
  __device__ __forceinline__ u16* wf2(int l) const { return (u16*)(ws + l * LAYER_W + O_WF2); }
  __device__ __forceinline__ u16* P() const { return (u16*)(ws + O_P); }
  __device__ __forceinline__ u16* XB() const { return (u16*)(ws + O_XB); }
  __device__ __forceinline__ u16* KDT() const { return (u16*)(ws + O_KDT); }
  __device__ __forceinline__ u16* ATT() const { return (u16*)(ws + O_ATT); }
  __device__ __forceinline__ u16* HALO() const { return (u16*)(ws + O_HALO); }
  __device__ __forceinline__ u16* KIDX() const { return (u16*)(ws + O_KIDX); }
  __device__ __forceinline__ u16* CKV() const { return (u16*)(ws + O_CKV); }
  __device__ __forceinline__ u16* MERGED() const { return (u16*)(ws + O_M); }
  __device__ __forceinline__ float* WIDX() const { return (float*)(ws + O_WIDX); }
  __device__ __forceinline__ float* GL() const { return (float*)(ws + O_GL); }
  __device__ __forceinline__ float* LAM() const { return (float*)(ws + O_LAM); }
  __device__ __forceinline__ u32* CNT() const { return (u32*)(ws + O_CNT); }
  __device__ __forceinline__ u32* BAR() const { return (u32*)(ws + O_BAR); }
};

DI int lbid() { int b = blockIdx.x; asm volatile("" : "+s"(b)); return b; }
DI int lgdim() { int b = gridDim.x; asm volatile("" : "+s"(b)); return b; }
DI int ltid() { int t = threadIdx.x; asm volatile("" : "+v"(t)); return t; }
DI u16 f2bf(float x) { return __builtin_bit_cast(u16, (__bf16)x); }
DI float bf2f(u16 h) { return __uint_as_float(((u32)h) << 16); }
DI u32 pack2(float a, float b) {
  typedef __bf16 bf16v2_ __attribute__((ext_vector_type(2)));
  const bf16v2_ v = {(__bf16)a, (__bf16)b};
  return __builtin_bit_cast(u32, v);
}
DI float bflo(u32 v) { return __uint_as_float(v << 16); }
DI float bfhi(u32 v) { return __uint_as_float(v & 0xffff0000u); }
DI f32x4 mfma16(bf16x8 a, bf16x8 b, f32x4 c) { return __builtin_amdgcn_mfma_f32_16x16x32_bf16(a, b, c, 0, 0, 0); }
DI f32x16 mfma32(bf16x8 a, bf16x8 b, f32x16 c) { return __builtin_amdgcn_mfma_f32_32x32x16_bf16(a, b, c, 0, 0, 0); }
DI int crow(int i, int hh) { return (i & 3) + 8 * (i >> 2) + 4 * hh; }
DI float sigmoidf_(float x) { return 1.f / (1.f + __expf(-x)); }
DI float siluf_(float x) { return x / (1.f + __expf(-x)); }
DI float xhalf_max(float x) {
  const u32 u = __float_as_uint(x);
  const auto r = __builtin_amdgcn_permlane32_swap(u, u, false, false);
  return fmaxf(__uint_as_float(r[0]), __uint_as_float(r[1]));
}
DI float xhalf_sum(float x) {
  const u32 u = __float_as_uint(x);
  const auto r = __builtin_amdgcn_permlane32_swap(u, u, false, false);
  return __uint_as_float(r[0]) + __uint_as_float(r[1]);
}
DI u32 lane_lt_cnt(u64 m) { return __builtin_amdgcn_mbcnt_hi((u32)(m >> 32), __builtin_amdgcn_mbcnt_lo((u32)m, 0)); }

DI bf16x8 pack8(const f32x16& x, int s) {
  typedef __bf16 bf16v8_ __attribute__((ext_vector_type(8)));
  bf16v8_ v;
#pragma unroll
  for (int j = 0; j < 8; ++j) v[j] = (__bf16)x[8 * s + j];
  return __builtin_bit_cast(bf16x8, v);
}
DI bf16x8 afrag_perm(const char* base, int row, int stride, int kbase, int hh) {
  const char* pr = base + row * stride + (kbase + 4 * hh) * 2;
  s16x4 lo = *(const s16x4*)pr;
  s16x4 hi = *(const s16x4*)(pr + 16);
  return __builtin_shufflevector(lo, hi, 0, 1, 2, 3, 4, 5, 6, 7);
}
DI bf16x8 trfrag(const char* img, int stride, int krow0, int col0, int ln) {
  const int hh = ln >> 5, chalf = (ln >> 4) & 1, q4 = (ln & 15) >> 2, p4 = ln & 3;
  u32 a = (u32)(size_t)(img + (krow0 + 4 * hh + q4) * stride + (col0 + 16 * chalf + 4 * p4) * 2);
  s16x4 lo, hi;
  asm volatile("ds_read_b64_tr_b16 %0, %2\n\tds_read_b64_tr_b16 %1, %3\n\ts_waitcnt lgkmcnt(0)"
               : "=&v"(lo), "=&v"(hi) : "v"(a), "v"(a + 8 * stride) : "memory");
  return __builtin_shufflevector(lo, hi, 0, 1, 2, 3, 4, 5, 6, 7);
}

template <int STRIDE>
DI void trfrag4(const char* img, int krow0, int ln, bf16x8 (&f)[4]) {
  typedef __attribute__((address_space(3))) s16x4 lds_s16x4;
  const int hh = ln >> 5, chalf = (ln >> 4) & 1, q4 = (ln & 15) >> 2, p4 = ln & 3;
  const char* a = img + (krow0 + 4 * hh + q4) * STRIDE + (16 * chalf + 4 * p4) * 2;
#pragma unroll
  for (int mt = 0; mt < 4; ++mt) {
    const s16x4 lo = __builtin_amdgcn_ds_read_tr16_b64_v4i16((lds_s16x4*)(a + 64 * mt));
    const s16x4 hi = __builtin_amdgcn_ds_read_tr16_b64_v4i16((lds_s16x4*)(a + 8 * STRIDE + 64 * mt));
    f[mt] = __builtin_shufflevector(lo, hi, 0, 1, 2, 3, 4, 5, 6, 7);
  }
}

template <int MT, int NT>
DI void gemm_core(const u16* __restrict__ A, int lda, const u16* __restrict__ B, int ldb, int K,
                  f32x4 (&acc)[MT][NT], char* smem) {
  constexpr int BM = 64 * MT, BN = 32 * NT;
  constexpr int ASZ = BM * 128, BSZ = BN * 128, BUF = ASZ + BSZ;
  constexpr int NA = BM / 64, NB = BN / 64;
  const int tid = ltid(), l = tid & 63, w = tid >> 6, wm = w >> 1, wn = w & 1;
  const int fr = l & 15, fq = l >> 4;
  uint4 ra0, ra1, ra2, ra3, rb0, rb1, rb2, rb3;
  const int nk = K >> 6;
  const int srow = tid >> 3, sch = tid & 7;
  const int ssw = sch ^ ((srow >> 1) & 7);
  const int fsw = (fr >> 1) & 7;
#define GL1(i, kt)                                                                                        \
  if (NA > i) ra##i = *(const uint4*)(A + (size_t)(srow + 64 * i) * lda + (kt) * 64 + sch * 8);           \
  if (NB > i) rb##i = *(const uint4*)(B + (size_t)(srow + 64 * i) * ldb + (kt) * 64 + sch * 8);
#define GLOAD(kt) { GL1(0, kt) GL1(1, kt) GL1(2, kt) GL1(3, kt) }
#define SS1(i)                                                                   \
  if (NA > i) *(uint4*)(as_ + (srow + 64 * i) * 128 + ssw * 16) = ra##i;         \
  if (NB > i) *(uint4*)(bs_ + (srow + 64 * i) * 128 + ssw * 16) = rb##i;
#define SSTORE(buf)                              \
  {                                              \
    char* as_ = smem + (buf) * BUF;              \
    char* bs_ = as_ + ASZ;                       \
    SS1(0) SS1(1) SS1(2) SS1(3)                  \
  }
  GLOAD(0);
  SSTORE(0);
  GLOAD(((1 < nk) ? 1 : 0));
#pragma unroll 1
  for (int kt = 0; kt < nk; ++kt) {
    __syncthreads();
    SSTORE((kt + 1) & 1);
    { const int kn_ = (kt + 2 < nk) ? kt + 2 : nk - 1; GLOAD(kn_); }
    const char* as = smem + (kt & 1) * BUF;
    const char* bs = as + ASZ;
#pragma unroll
    for (int kk = 0; kk < 2; ++kk) {
      bf16x8 xf[MT], wf[NT];
#pragma unroll
      for (int mi = 0; mi < MT; ++mi)
        xf[mi] = *(const bf16x8*)(as + (wm * (MT * 16) + mi * 16 + fr) * 128 + (((kk * 4 + fq) ^ fsw) * 16));
#pragma unroll
      for (int ni = 0; ni < NT; ++ni)
        wf[ni] = *(const bf16x8*)(bs + (wn * (NT * 16) + ni * 16 + fr) * 128 + (((kk * 4 + fq) ^ fsw) * 16));
      __builtin_amdgcn_s_setprio(1);
#pragma unroll
      for (int mi = 0; mi < MT; ++mi)
#pragma unroll
        for (int ni = 0; ni < NT; ++ni) acc[mi][ni] = mfma16(wf[ni], xf[mi], acc[mi][ni]);
      __builtin_amdgcn_s_setprio(0);
    }
  }
  __syncthreads();
#undef GLOAD
#undef SSTORE
#undef GL1
#undef SS1
}
template <int MT, int NT>
DI void zero_acc(f32x4 (&acc)[MT][NT]) {
#pragma unroll
  for (int i = 0; i < MT; ++i)
#pragma unroll
    for (int j = 0; j < NT; ++j) acc[i][j] = f32x4{0.f, 0.f, 0.f, 0.f};
}


DI bool next_tile(int it, int RT, int CT, int PR, int PCc, int& rt, int& ct) {
  const int bid = lbid(), x = bid & 7, j = bid >> 3, J = lgdim() >> 3;
  const int u = j + it * J;
  const int pcols = CT / PCc, npatch = (RT / PR) * pcols;
  const int pid = (u >> 6) * 8 + x;
  if (pid >= npatch) return false;
  const int w = u & 63, pr = pid / pcols, pc = pid - pr * pcols;
  rt = pr * PR + w / PCc;
  ct = pc * PCc + w % PCc;
  return true;
}
DI void transpose_job(const float* __restrict__ src, int K, int N, u16* __restrict__ dst, int ldd, const float* kscale, char* smem) {
  float(*tile)[65] = (float(*)[65])smem;
  const int ntn = (N + 63) >> 6, ntk = K >> 6, tid = ltid();
  for (int t = lbid(); t < ntn * ntk; t += lgdim()) {
    const int tk = t / ntn, tn = t % ntn, k0 = tk * 64, n0 = tn * 64;
    {
      const int n = tid & 63, kb = tid >> 6;
      for (int i = 0; i < 8; ++i) {
        const int k = kb + 8 * i;
        float v = (n0 + n < N) ? src[(size_t)(k0 + k) * N + n0 + n] : 0.f;
        if (kscale) v *= kscale[k0 + k];
        tile[k][n] = v;
      }
    }
    __syncthreads();
    {
      const int n = tid >> 3, kc = tid & 7;
      if (n0 + n < N) {
        uint4 o;
        o.x = pack2(tile[kc * 8 + 0][n], tile[kc * 8 + 1][n]); o.y = pack2(tile[kc * 8 + 2][n], tile[kc * 8 + 3][n]);
        o.z = pack2(tile[kc * 8 + 4][n], tile[kc * 8 + 5][n]); o.w = pack2(tile[kc * 8 + 6][n], tile[kc * 8 + 7][n]);
        *(uint4*)(dst + (size_t)(n0 + n) * ldd + k0 + kc * 8) = o;
      }
    }
    __syncthreads();
  }
}

DI void phase0(const Params& p, char* smem) {
  const size_t gtid = (size_t)lbid() * NTHR + ltid(), gsz = (size_t)lgdim() * NTHR;
  for (int l = 0; l < 2; ++l) {
    transpose_job(p.w_in + (size_t)l * 1024 * 7120, 1024, 7120, p.win(l), KP1024, nullptr, smem);
    transpose_job(p.w_branch_a + (size_t)l * 512 * 1024, 512, 1024, p.wbra(l), KP512, nullptr, smem);
    transpose_job(p.w_branch_b + (size_t)l * 512 * 1024, 512, 1024, p.wbrb(l), KP512, nullptr, smem);
    transpose_job(p.w_o + (size_t)l * 1024 * 1024, 1024, 1024, p.wo(l), KP1024, nullptr, smem);
    transpose_job(p.w_ff1 + (size_t)l * 1024 * 4096, 1024, 4096, p.wf1(l), KP1024, nullptr, smem);
    transpose_job(p.w_ff2 + (size_t)l * 4096 * 1024, 4096, 1024, p.wf2(l), KP4096, nullptr, smem);
    transpose_job(p.c_w_qidx + (size_t)l * 256 * 512, 256, 512, p.wqx(l) + 1024 * KP256, KP256, p.c_q_norm_g + l * 256, smem);
    {
      const float* uq = p.c_w_uq + (size_t)l * 256 * 512;
      const float* uk = p.c_w_uk + (size_t)l * 128 * 512;
      const float* g = p.c_q_norm_g + l * 256;
      for (size_t e = gtid; e < 1024 * 256; e += gsz) {
        const int n = (int)(e >> 8), k = (int)(e & 255), h = n >> 7, r2 = n & 127;
        const float4* a = (const float4*)(uq + (k * 8 + h) * 64);
        const float4* b = (const float4*)(uk + (r2 * 8 + h) * 64);
        float s = 0.f;
        for (int d = 0; d < 16; ++d) { float4 x = a[d], y = b[d]; s += x.x * y.x + x.y * y.y + x.z * y.z + x.w * y.w; }
        p.wqx(l)[(size_t)n * KP256 + k] = f2bf(s * g[k]);
      }
    }
    {
      const float* uv = p.c_w_uv + (size_t)l * 128 * 512;
      const float* bc = p.w_branch_c + (size_t)l * 512 * 1024;
      for (size_t e = gtid; e < 1024 * 256; e += gsz) {
        const int k = (int)(e >> 8), n4 = (int)(e & 255) * 4, h = k >> 7, r = k & 127;
        const float* a = uv + (r * 8 + h) * 64;
        const float* b = bc + (size_t)(h * 64) * 1024 + n4;
        float4 acc4 = float4{0.f, 0.f, 0.f, 0.f};
#pragma unroll 8
        for (int d = 0; d < 64; ++d) {
          const float4 v = *(const float4*)(b + (size_t)d * 1024);
          const float ad = a[d];
          acc4.x += ad * v.x; acc4.y += ad * v.y; acc4.z += ad * v.z; acc4.w += ad * v.w;
        }
        u16* dst = p.wbrc(l) + (size_t)n4 * KP1024 + k;
        dst[0] = f2bf(acc4.x); dst[KP1024] = f2bf(acc4.y); dst[2 * KP1024] = f2bf(acc4.z); dst[3 * KP1024] = f2bf(acc4.w);
      }
    }
  }
  for (size_t e = gtid; e < (size_t)NT * 1024 / 8; e += gsz) {
    const float4 a = ((const float4*)p.x)[2 * e], b = ((const float4*)p.x)[2 * e + 1];
    uint4 o;
    o.x = pack2(a.x, a.y); o.y = pack2(a.z, a.w); o.z = pack2(b.x, b.y); o.w = pack2(b.z, b.w);
    *(uint4*)(p.XB() + (e >> 7) * LDX + (e & 127) * 8) = o;
  }
  if (gtid < 2) {
    const int l = (int)gtid;
    const float* lp = p.a_lambda + l * 256;
    float s1 = 0.f, s2 = 0.f;
    for (int i = 0; i < 64; ++i) { s1 += lp[i] * lp[64 + i]; s2 += lp[128 + i] * lp[192 + i]; }
    const float lam_init = 0.8f - 0.6f * expf(-0.3f * l);
    p.LAM()[l] = expf(s1) - expf(s2) + lam_init;
    p.LAM()[2 + l] = lam_init;
    for (int i = 0; i < 8; ++i) p.CNT()[l * 8 + i] = 0;
  }
}

DI void ln_phase(const float* S, const float* __restrict__ g, const float* __restrict__ b, u16* XBo, float* fout) {
  const int l = ltid() & 63;
  const int wave = lbid() * 8 + (ltid() >> 6), nw = lgdim() * 8;
  for (int row = wave; row < NT; row += nw) {
    float4 v[4];
    float s = 0.f;
#pragma unroll
    for (int i = 0; i < 4; ++i) { v[i] = *(const float4*)(S + (size_t)row * 1024 + i * 256 + l * 4); s += v[i].x + v[i].y + v[i].z + v[i].w; }
#pragma unroll
    for (int o = 32; o; o >>= 1) s += __shfl_xor(s, o);
    const float mu = s * (1.f / 1024.f);
    float q = 0.f;
#pragma unroll
    for (int i = 0; i < 4; ++i) { float a = v[i].x - mu, bb = v[i].y - mu, c = v[i].z - mu, d = v[i].w - mu; q += a * a + bb * bb + c * c + d * d; }
#pragma unroll
    for (int o = 32; o; o >>= 1) q += __shfl_xor(q, o);
    const float rs = rsqrtf(q * (1.f / 1024.f) + EPS);
#pragma unroll
    for (int i = 0; i < 4; ++i) {
      const int c = i * 256 + l * 4;
      const float4 gg = *(const float4*)(g + c), bb = *(const float4*)(b + c);
      float4 y;
      y.x = (v[i].x - mu) * rs * gg.x + bb.x; y.y = (v[i].y - mu) * rs * gg.y + bb.y;
      y.z = (v[i].z - mu) * rs * gg.z + bb.z; y.w = (v[i].w - mu) * rs * gg.w + bb.w;
      if (fout) *(float4*)(fout + (size_t)row * 1024 + c) = y;
      if (XBo) { uint2 o; o.x = pack2(y.x, y.y); o.y = pack2(y.z, y.w); *(uint2*)(XBo + (size_t)row * LDX + c) = o; }
    }
  }
}

#define EPI_LOOP(MT_, NT_)                                                \
  const int l_ = ltid() & 63, w_ = ltid() >> 6;                           \
  const int wm_ = w_ >> 1, wn_ = w_ & 1, fr_ = l_ & 15, fq_ = l_ >> 4;    \
  _Pragma("unroll") for (int mi = 0; mi < MT_; ++mi)                      \
  _Pragma("unroll") for (int ni = 0; ni < NT_; ++ni)

DI void phase_inproj(const Params& p, int l, char* smem) {
  int rt, ct;
  for (int it = 0; next_tile(it, 128, 16, 8, 8, rt, ct); ++it) {
    const int r0 = rt * 256, c0 = ct * 256;
    f32x4 acc[4][8];
    zero_acc<4, 8>(acc);
    gemm_core<4, 8>(p.XB() + (size_t)r0 * LDX, LDX, p.win(l) + (size_t)c0 * KP1024, KP1024, 1024, acc, smem);
    EPI_LOOP(4, 8) {
      const int row = r0 + wm_ * 64 + mi * 16 + fr_, col = c0 + wn_ * 128 + ni * 16 + fq_ * 4;
      if (col < PC) {
        uint2 o;
        o.x = pack2(acc[mi][ni][0], acc[mi][ni][1]); o.y = pack2(acc[mi][ni][2], acc[mi][ni][3]);
        *(uint2*)(p.P() + (size_t)row * PC + col) = o;
        if (col >= BQ && col < BZ && (row & 63) >= 61)
          *(uint2*)(p.HALO() + ((size_t)(row >> 6) * 3 + ((row & 63) - 61)) * 1536 + (col - BQ)) = o;
      }
    }
  }
}

DI void qx_tile(const Params& p, int l, int rt, int ct, char* smem) {
  const int r0 = rt * 256, c0 = ct * 256;
  float* rsv = (float*)(smem + 147456);
  {
    const int row = ltid() >> 1, half = ltid() & 1;
    const uint4* src = (const uint4*)(p.P() + (size_t)(r0 + row) * PC + CQ + half * 128);
    float ss = 0.f;
    for (int i = 0; i < 16; ++i) {
      uint4 v = src[i];
      float a;
      a = bflo(v.x); ss += a * a; a = bfhi(v.x); ss += a * a; a = bflo(v.y); ss += a * a; a = bfhi(v.y); ss += a * a;
      a = bflo(v.z); ss += a * a; a = bfhi(v.z); ss += a * a; a = bflo(v.w); ss += a * a; a = bfhi(v.w); ss += a * a;
    }
    ss += __shfl_xor(ss, 1);
    if (!half) rsv[row] = rsqrtf(ss * (1.f / 256.f) + EPS);
  }
  f32x4 acc[4][8];
  zero_acc<4, 8>(acc);
  gemm_core<4, 8>(p.P() + (size_t)r0 * PC + CQ, PC, p.wqx(l) + (size_t)c0 * KP256, KP256, 256, acc, smem);
  u16* QX = (u16*)p.out;
  EPI_LOOP(4, 8) {
    const int rl = wm_ * 64 + mi * 16 + fr_, col = c0 + wn_ * 128 + ni * 16 + fq_ * 4;
    const float rs = rsv[rl];
    uint2 o;
    o.x = pack2(acc[mi][ni][0] * rs, acc[mi][ni][1] * rs); o.y = pack2(acc[mi][ni][2] * rs, acc[mi][ni][3] * rs);
    *(uint2*)(QX + (size_t)(r0 + rl) * LDQ + col) = o;
  }
  __syncthreads();
}

DI void phase_merge(const Params& p, int l, char* smem) {
  const u16* QX = (const u16*)p.out;
  int rt, ct;
  for (int it = 0; next_tile(it, 128, 8, 8, 8, rt, ct); ++it) {
    const int r0 = rt * 256, c0 = ct * 128;
    bool first = true;
#pragma unroll 1
    for (int j = 0; j < 3; ++j) {
      if ((j == 0 && !EN_A) || (j == 1 && !EN_B) || (j == 2 && !EN_C)) continue;
      const u16* Ab; const u16* Wb; int lda, K;
      int ldw;
      if (j == 0) { Ab = p.P() + (size_t)r0 * PC + AQ; lda = PC; Wb = p.wbra(l) + (size_t)c0 * KP512; K = 512; ldw = KP512; }
      else if (j == 1) { Ab = p.P() + (size_t)r0 * PC + BZ; lda = PC; Wb = p.wbrb(l) + (size_t)c0 * KP512; K = 512; ldw = KP512; }
      else { Ab = QX + (size_t)r0 * LDQ; lda = LDQ; Wb = p.wbrc(l) + (size_t)c0 * KP1024; K = 1024; ldw = KP1024; }
      f32x4 g[4][4];
      zero_acc<4, 4>(g);
      gemm_core<4, 4>(p.XB() + (size_t)r0 * LDX, LDX, p.win(l) + (size_t)(GATES + j * 1024 + c0) * KP1024, KP1024, 1024, g, smem);
      const float* bg = p.b_gate + l * 3072 + j * 1024;
      {
        EPI_LOOP(4, 4) {
          const int col = c0 + wn_ * 64 + ni * 16 + fq_ * 4;
          const float4 bb = *(const float4*)(bg + col);
          g[mi][ni][0] = sigmoidf_(g[mi][ni][0] + bb.x);
          g[mi][ni][1] = sigmoidf_(g[mi][ni][1] + bb.y);
          g[mi][ni][2] = sigmoidf_(g[mi][ni][2] + bb.z);
          g[mi][ni][3] = sigmoidf_(g[mi][ni][3] + bb.w);
        }
      }
      f32x4 br[4][4];
      zero_acc<4, 4>(br);
      gemm_core<4, 4>(Ab, lda, Wb, ldw, K, br, smem);
      {
        EPI_LOOP(4, 4) {
          const int row = r0 + wm_ * 64 + mi * 16 + fr_, col = c0 + wn_ * 64 + ni * 16 + fq_ * 4;
          u16* mp = p.MERGED() + (size_t)row * LDX + col;
          float a0 = g[mi][ni][0] * br[mi][ni][0], a1 = g[mi][ni][1] * br[mi][ni][1];
          float a2 = g[mi][ni][2] * br[mi][ni][2], a3 = g[mi][ni][3] * br[mi][ni][3];
          if (!first) {
            const uint2 old = *(const uint2*)mp;
            a0 += bflo(old.x); a1 += bfhi(old.x); a2 += bflo(old.y); a3 += bfhi(old.y);
          }
          uint2 o;
          o.x = pack2(a0, a1); o.y = pack2(a2, a3);
          *(uint2*)mp = o;
        }
      }
      first = false;
    }
  }
}

DI void phase_resgemm(const Params& p, const u16* A, int lda, const u16* W, int ldw, int K, char* smem) {
  int rt, ct;
  for (int it = 0; next_tile(it, 128, 4, 16, 4, rt, ct); ++it) {
    const int r0 = rt * 256, c0 = ct * 256;
    f32x4 acc[4][8];
    zero_acc<4, 8>(acc);
    gemm_core<4, 8>(A + (size_t)r0 * lda, lda, W + (size_t)c0 * ldw, ldw, K, acc, smem);
    EPI_LOOP(4, 8) {
      const int row = r0 + wm_ * 64 + mi * 16 + fr_, col = c0 + wn_ * 128 + ni * 16 + fq_ * 4;
      const uint2 xb = *(const uint2*)(p.XB() + (size_t)row * LDX + col);
      float4 o;
      o.x = DN_ALPHA * bflo(xb.x) + acc[mi][ni][0]; o.y = DN_ALPHA * bfhi(xb.x) + acc[mi][ni][1];
      o.z = DN_ALPHA * bflo(xb.y) + acc[mi][ni][2]; o.w = DN_ALPHA * bfhi(xb.y) + acc[mi][ni][3];
      *(float4*)(p.out + (size_t)row * 1024 + col) = o;
    }
  }
}

DI void phase_ff1(const Params& p, int l, char* smem) {
  int rt, ct;
  for (int it = 0; next_tile(it, 128, 16, 8, 8, rt, ct); ++it) {
    const int r0 = rt * 256, c0 = ct * 256;
    f32x4 acc[4][8];
    zero_acc<4, 8>(acc);
    gemm_core<4, 8>(p.XB() + (size_t)r0 * LDX, LDX, p.wf1(l) + (size_t)c0 * KP1024, KP1024, 1024, acc, smem);
    EPI_LOOP(4, 8) {
      const int row = r0 + wm_ * 64 + mi * 16 + fr_, col = c0 + wn_ * 128 + ni * 16 + fq_ * 4;
      float a0 = fmaxf(acc[mi][ni][0], 0.f), a1 = fmaxf(acc[mi][ni][1], 0.f), a2 = fmaxf(acc[mi][ni][2], 0.f), a3 = fmaxf(acc[mi][ni][3], 0.f);
      uint2 o;
      o.x = pack2(a0 * a0, a1 * a1); o.y = pack2(a2 * a2, a3 * a3);
      *(uint2*)(p.P() + (size_t)row * LDH + col) = o;
    }
  }
}

DI void dsa_kprep_item(const Params& p, int l, int it) {
  const int ln = ltid() & 63, w = ltid() >> 6;
  const float g0 = p.c_kv_norm_g[l * 128 + 2 * ln], g1 = p.c_kv_norm_g[l * 128 + 2 * ln + 1];
  const float kg = p.c_kidx_g[l * 64 + ln], kb = p.c_kidx_b[l * 64 + ln];
  for (int i = 0; i < 8; ++i) {
    const size_t tok = (size_t)it * 64 + w * 8 + i;
    const u16* pr = p.P() + tok * PC;
    const u32 v = *(const u32*)(pr + CKVc + 2 * ln);
    const float a = bflo(v), b = bfhi(v);
    float ss = a * a + b * b;
#pragma unroll
    for (int o = 32; o; o >>= 1) ss += __shfl_xor(ss, o);
    const float rs = rsqrtf(ss * (1.f / 128.f) + EPS);
    *(u32*)(p.CKV() + tok * 128 + 2 * ln) = pack2(a * rs * g0, b * rs * g1);
    const float k = bf2f(pr[CKI + ln]);
    float s = k;
#pragma unroll
    for (int o = 32; o; o >>= 1) s += __shfl_xor(s, o);
    const float mu = s * (1.f / 64.f);
    float q = (k - mu) * (k - mu);
#pragma unroll
    for (int o = 32; o; o >>= 1) q += __shfl_xor(q, o);
    p.KIDX()[tok * 64 + ln] = f2bf((k - mu) * rsqrtf(q * (1.f / 64.f) + EPS) * kg + kb);
    if (ln < 8) p.WIDX()[tok * 8 + ln] = bf2f(pr[CWI + ln]) * 0.04419417382f;
  }
}

DI void gdn_prep_item(const Params& p, int l, int it, char* smem0) {
  const int half_ = ltid() >> 8;
  const int cidx = it >> 1, h = (it & 1) * 2 + half_, n = cidx & 255;
  const size_t t0g = (size_t)cidx * 64;
  char* smem = smem0 + half_ * 69632;
  const int tid = ltid() & 255, ln = tid & 63, w = tid >> 6;
  char* qs = smem;
  char* ks = smem + 17408;
  char* vs = smem + 2 * 17408;
  float* Lm = (float*)(smem + 3 * 17408);
  float* gcs = Lm + 4096;
  float* bts = gcs + 64;
  float* egs = bts + 64;
  u16* proj = p.P();
  {
    const int c = tid & 127, rh = tid >> 7;
    uint4 st[12];
#pragma unroll
    for (int part = 0; part < 3; ++part)
#pragma unroll
      for (int i = 0; i < 4; ++i) {
        const int piece = tid + 256 * i, row = piece >> 4, ch = piece & 15;
        st[part * 4 + i] = *(const uint4*)(proj + (t0g + row) * PC + BQ + part * 512 + h * 128 + ch * 8);
      }
    float hx[9];
#pragma unroll
    for (int i = 0; i < 9; ++i) hx[i] = 0.f;
    if (rh == 0 && n != 0) {
#pragma unroll
      for (int part = 0; part < 3; ++part) {
        const u16* hp = p.HALO() + ((size_t)(cidx - 1) * 3) * 1536 + part * 512 + h * 128 + c;
        hx[part * 3 + 0] = bf2f(hp[0]); hx[part * 3 + 1] = bf2f(hp[1536]); hx[part * 3 + 2] = bf2f(hp[2 * 1536]);
      }
    }
#pragma unroll
    for (int part = 0; part < 3; ++part)
#pragma unroll
      for (int i = 0; i < 4; ++i) {
        const int piece = tid + 256 * i, row = piece >> 4, ch = piece & 15;
        char* dst = (part == 0 ? qs : (part == 1 ? ks : vs));
        *(uint4*)(dst + row * 272 + ch * 16) = st[part * 4 + i];
      }
    __syncthreads();
    if (rh == 1) {
#pragma unroll
      for (int part = 0; part < 3; ++part) {
        const char* src = (part == 0 ? qs : (part == 1 ? ks : vs));
        hx[part * 3 + 0] = bf2f(*(const u16*)(src + 29 * 272 + c * 2));
        hx[part * 3 + 1] = bf2f(*(const u16*)(src + 30 * 272 + c * 2));
        hx[part * 3 + 2] = bf2f(*(const u16*)(src + 31 * 272 + c * 2));
      }
    }
    __syncthreads();
#pragma unroll
    for (int part = 0; part < 3; ++part) {
      const int wch = part * 512 + h * 128 + c;
      const float* cw = p.b_conv_w + (size_t)l * 4 * 1536 + wch;
      const float w0 = cw[0], w1 = cw[1536], w2 = cw[2 * 1536], w3 = cw[3 * 1536];
      float xm3 = hx[part * 3 + 0], xm2 = hx[part * 3 + 1], xm1 = hx[part * 3 + 2];
      char* dst = (part == 0 ? qs : (part == 1 ? ks : vs));
#pragma unroll 8
      for (int i = 0; i < 32; ++i) {
        const int r = rh * 32 + i;
        u16* px = (u16*)(dst + r * 272 + c * 2);
        const float x = bf2f(*px);
        const float y = w0 * xm3 + w1 * xm2 + w2 * xm1 + w3 * x;
        xm3 = xm2; xm2 = xm1; xm1 = x;
        *px = f2bf(siluf_(y));
      }
    }
  }
  if (w == 0) {
    const float a = bf2f(proj[(t0g + ln) * PC + BA + h]) + p.b_dt_bias[l * 4 + h];
    const float ea = __expf(a);
    const float sp = (a > 20.f) ? a : ((ea < 0.01f) ? ea * (1.f - ea * (0.5f - ea * 0.333333333f)) : __logf(1.f + ea));
    float g = -__expf(p.b_a_log[l * 4 + h]) * sp;
#pragma unroll
    for (int o = 1; o < 64; o <<= 1) { float t = __shfl_up(g, o); if (ln >= o) g += t; }
    gcs[ln] = g;
    egs[ln] = __expf(g);
    bts[ln] = sigmoidf_(bf2f(proj[(t0g + ln) * PC + BB + h]));
  }
  __syncthreads();
  {
    const int row = tid >> 2, qr = tid & 3;
#pragma unroll
    for (int part = 0; part < 2; ++part) {
      char* base = (part == 0 ? qs : ks) + row * 272 + qr * 64;
      uint4 v[4];
      float ss = 0.f;
#pragma unroll
      for (int i = 0; i < 4; ++i) {
        v[i] = *(uint4*)(base + i * 16);
        float a;
        a = bflo(v[i].x); ss += a * a; a = bfhi(v[i].x); ss += a * a; a = bflo(v[i].y); ss += a * a; a = bfhi(v[i].y); ss += a * a;
        a = bflo(v[i].z); ss += a * a; a = bfhi(v[i].z); ss += a * a; a = bflo(v[i].w); ss += a * a; a = bfhi(v[i].w); ss += a * a;
      }
      ss += __shfl_xor(ss, 1);
      ss += __shfl_xor(ss, 2);
      const float rs = rsqrtf(ss + EPS) * (part == 0 ? 0.08838834764f : 1.f);
#pragma unroll
      for (int i = 0; i < 4; ++i) {
        uint4 o;
        o.x = pack2(bflo(v[i].x) * rs, bfhi(v[i].x) * rs); o.y = pack2(bflo(v[i].y) * rs, bfhi(v[i].y) * rs);
        o.z = pack2(bflo(v[i].z) * rs, bfhi(v[i].z) * rs); o.w = pack2(bflo(v[i].w) * rs, bfhi(v[i].w) * rs);
        *(uint4*)(base + i * 16) = o;
      }
    }
  }
  __syncthreads();
  {
    const int fr = ln & 15, fq = ln >> 4;
    f32x4 kk[4], qk[4];
#pragma unroll
    for (int nt = 0; nt < 4; ++nt) { kk[nt] = f32x4{0, 0, 0, 0}; qk[nt] = f32x4{0, 0, 0, 0}; }
#pragma unroll
    for (int s = 0; s < 4; ++s) {
      const bf16x8 ak = *(const bf16x8*)(ks + (16 * w + fr) * 272 + (32 * s + 8 * fq) * 2);
      const bf16x8 aq = *(const bf16x8*)(qs + (16 * w + fr) * 272 + (32 * s + 8 * fq) * 2);
#pragma unroll
      for (int nt = 0; nt < 4; ++nt) {
        const bf16x8 bk = *(const bf16x8*)(ks + (16 * nt + fr) * 272 + (32 * s + 8 * fq) * 2);
        kk[nt] = mfma16(ak, bk, kk[nt]);
        qk[nt] = mfma16(aq, bk, qk[nt]);
      }
    }
#pragma unroll
    for (int nt = 0; nt < 4; ++nt)
#pragma unroll
      for (int jj = 0; jj < 4; ++jj) {
        const int i = 16 * w + 4 * fq + jj, j = 16 * nt + fr;
        const float dec = (i >= j) ? __expf(gcs[i] - gcs[j]) : 0.f;
        Lm[i * 64 + j] = (i > j) ? bts[i] * kk[nt][jj] * dec : 0.f;
        p.ATT()[(t0g + i) * 256 + h * 64 + j] = f2bf((i >= j) ? qk[nt][jj] * dec : 0.f);
      }
  }
  __syncthreads();
  {
    const int c = tid;
    const bool isu = c < 128;
    const char* src = isu ? (vs + c * 2) : (ks + (c - 128) * 2);
    const float wsel = isu ? 0.f : 1.f;
    float x[64];
#pragma unroll
    for (int i = 0; i < 64; ++i) {
      float a = bf2f(*(const u16*)(src + i * 272)) * bts[i] * fmaf(egs[i] - 1.f, wsel, 1.f);
      const float* Lr = Lm + i * 64;
#pragma unroll
      for (int j = 0; j < i; ++j) a -= Lr[j] * x[j];
      x[i] = a;
      asm volatile("" ::: "memory");
    }
    if (isu) {
      u32 pk[32];
#pragma unroll
      for (int pos = 0; pos < 64; pos += 2) {
        const int hh = pos >> 5, Tt = (pos >> 4) & 1, ii = pos & 15;
        const int r0 = 32 * Tt + (ii & 3) + 8 * (ii >> 2) + 4 * hh;
        const int i1 = ii + 1;
        const int r1 = 32 * Tt + (i1 & 3) + 8 * (i1 >> 2) + 4 * hh;
        pk[pos >> 1] = pack2(x[r0], x[r1]);
      }
      char* dst = (char*)proj + ((t0g + (c >> 1)) * PC + BV + h * 128) * 2 + (c & 1) * 128;
#pragma unroll
      for (int i = 0; i < 8; ++i) *(uint4*)(dst + i * 16) = uint4{pk[4 * i], pk[4 * i + 1], pk[4 * i + 2], pk[4 * i + 3]};
    } else {
#pragma unroll
      for (int i = 0; i < 64; ++i) proj[(t0g + i) * PC + BK_ + h * 128 + (c - 128)] = f2bf(x[i]);
    }
  }
  {
    const float glast = gcs[63];
#pragma unroll
    for (int i = 0; i < 4; ++i) {
      const int piece = tid + 256 * i, row = piece >> 4, ch = piece & 15;
      const uint4 v = *(const uint4*)(qs + row * 272 + ch * 16);
      const float e = egs[row];
      uint4 o;
      o.x = pack2(bflo(v.x) * e, bfhi(v.x) * e); o.y = pack2(bflo(v.y) * e, bfhi(v.y) * e);
      o.z = pack2(bflo(v.z) * e, bfhi(v.z) * e); o.w = pack2(bflo(v.w) * e, bfhi(v.w) * e);
      *(uint4*)(proj + (t0g + row) * PC + BQ + h * 128 + ch * 8) = o;
    }
    const int d = tid & 127, half = tid >> 7;
    u32 pk[16];
#pragma unroll
    for (int i = 0; i < 16; ++i) {
      const int r0 = half * 32 + 2 * i;
      const float a = bf2f(*(const u16*)(ks + r0 * 272 + d * 2)) * __expf(glast - gcs[r0]);
      const float b = bf2f(*(const u16*)(ks + (r0 + 1) * 272 + d * 2)) * __expf(glast - gcs[r0 + 1]);
      pk[i] = pack2(a, b);
    }
    u16* dst = p.KDT() + (((size_t)cidx * 4 + h) * 128 + d) * 64 + half * 32;
#pragma unroll
    for (int i = 0; i < 4; ++i) *(uint4*)(dst + i * 8) = uint4{pk[4 * i], pk[4 * i + 1], pk[4 * i + 2], pk[4 * i + 3]};
    if (tid == 0) p.GL()[cidx * 4 + h] = egs[63];
  }
  __syncthreads();
}

DI void gdn_rec_item(const Params& p, int l, int bh, char* smem, bool wr) {
  const int b = bh >> 2, h = bh & 3;
  const int tid = ltid(), ln = tid & 63, w = tid >> 6, hh = ln >> 5, c31 = ln & 31;
  const bool is_comp = w < 4;
  constexpr int BUFB = 59904;
  float* Ot = (float*)(smem + 2 * BUFB);
  u16* proj = p.P();
  const float* ng = p.b_norm_g + l * 128;
  const int lt = tid & 255;
#define LD_AQ(i, n_)                                                                                      \
  {                                                                                                       \
    const size_t t0g_ = ((size_t)b * 256 + (n_)) * 64;                                                    \
    const int piece = ltv + 256 * i, row = piece >> 4, ch = piece & 15;                                   \
    la##i = *(const uint4*)(proj + (t0g_ + row) * PC + BK_ + h * 128 + ch * 8);                           \
    lq##i = *(const uint4*)(proj + (t0g_ + row) * PC + BQ + h * 128 + ch * 8);                            \
  }
#define LD_K(i, n_)                                                                                       \
  {                                                                                                       \
    const int piece = ltv + 256 * i, row2 = piece >> 3, ch2 = piece & 7;                                  \
    lk##i = *(const uint4*)(p.KDT() + ((((size_t)b * 256 + (n_)) * 4 + h) * 128 + row2) * 64 + ch2 * 8);  \
  }
#define LD_T(i, n_)                                                                                       \
  {                                                                                                       \
    const size_t t0g_ = ((size_t)b * 256 + (n_)) * 64;                                                    \
    const int piece = ltv + 256 * i, row = piece >> 3, ch = piece & 7;                                     \
    lt##i = *(const uint4*)(p.ATT() + (t0g_ + row) * 256 + h * 64 + ch * 8);                              \
  }
#define LD_R1(n_) { LD_AQ(0, n_) LD_AQ(1, n_) LD_AQ(2, n_) LD_AQ(3, n_) }
#define LD_R2(n_) { LD_K(0, n_) LD_K(1, n_) LD_K(2, n_) LD_K(3, n_) LD_T(0, n_) LD_T(1, n_) }
#define ST_AQ(i, buf_)                                                                                    \
  {                                                                                                       \
    char* Wm_ = smem + (buf_) * BUFB; char* Qd_ = Wm_ + 16896;                                            \
    const int piece = ltv + 256 * i, row = piece >> 4, ch = piece & 15;                                   \
    *(uint2*)(Wm_ + row * 264 + ch * 16) = uint2{la##i.x, la##i.y}; *(uint2*)(Wm_ + row * 264 + ch * 16 + 8) = uint2{la##i.z, la##i.w}; \
    *(uint2*)(Qd_ + row * 264 + ch * 16) = uint2{lq##i.x, lq##i.y}; *(uint2*)(Qd_ + row * 264 + ch * 16 + 8) = uint2{lq##i.z, lq##i.w}; \
  }
#define ST_K(i, buf_)                                                                                     \
  {                                                                                                       \
    char* Kt_ = smem + (buf_) * BUFB + 2 * 16896;                                                         \
    const int piece = ltv + 256 * i, row2 = piece >> 3, ch2 = piece & 7;                                  \
    *(uint2*)(Kt_ + row2 * 136 + ch2 * 16) = uint2{lk##i.x, lk##i.y}; *(uint2*)(Kt_ + row2 * 136 + ch2 * 16 + 8) = uint2{lk##i.z, lk##i.w}; \
  }
#define ST_T(i, buf_)                                                                                     \
  {                                                                                                       \
    char* At_ = smem + (buf_) * BUFB + 2 * 16896 + 17408;                                                 \
    const int piece = ltv + 256 * i, row = piece >> 3, ch = piece & 7;                                     \
    *(uint2*)(At_ + row * 136 + ch * 16) = uint2{lt##i.x, lt##i.y}; *(uint2*)(At_ + row * 136 + ch * 16 + 8) = uint2{lt##i.z, lt##i.w}; \
  }
#define ST_R1(buf_) { ST_AQ(0, buf_) ST_AQ(1, buf_) ST_AQ(2, buf_) ST_AQ(3, buf_) }
#define ST_R2(buf_) { ST_K(0, buf_) ST_K(1, buf_) ST_K(2, buf_) ST_K(3, buf_) ST_T(0, buf_) ST_T(1, buf_) }
#define LD_Z(n_)                                                                                          \
  {                                                                                                       \
    const u16* zp_ = proj + (((size_t)b * 256 + (n_)) * 64 + nrow) * PC + BZ + h * 128 + nqr * 32;        \
    lz0 = *(const uint4*)(zp_); lz1 = *(const uint4*)(zp_ + 8); lz2 = *(const uint4*)(zp_ + 16); lz3 = *(const uint4*)(zp_ + 24); \
  }
  f32x16 S[4];
#pragma unroll
  for (int i = 0; i < 4; ++i)
#pragma unroll
    for (int j = 0; j < 16; ++j) S[i][j] = 0.f;
  const int e = 32 * w + c31;
  uint4 un0, un1, un2, un3;
  float gln = 0.f;
#define LD_U(n_)                                                                                          \
  {                                                                                                       \
    const uint4* up_ = (const uint4*)((const char*)proj + ((((size_t)b * 256 + (n_)) * 64 + (e >> 1)) * PC + BV + h * 128) * 2 + (e & 1) * 128 + hh * 64); \
    un0 = up_[0]; un1 = up_[1]; un2 = up_[2]; un3 = up_[3];                                               \
    gln = p.GL()[((size_t)b * 256 + (n_)) * 4 + h];                                                       \
  }
  if (!is_comp) {
    const int ltv = lt;
    uint4 la0, la1, la2, la3, lq0, lq1, lq2, lq3, lk0, lk1, lk2, lk3, lt0, lt1;
    LD_R1(0) LD_R2(0)
    ST_R1(0) ST_R2(0)
  } else {
    LD_U(0)
  }
  for (int n = 0; n < 256; ++n) {
    f32x16 o[2];
    __syncthreads();
    if (is_comp) {
      int lnv = ln;
      asm volatile("" : "+v"(lnv));
      const int hh = lnv >> 5, c31 = lnv & 31;
      const char* Wm = smem + (n & 1) * BUFB;
      const char* Qd = Wm + 16896;
      const char* Kt = Wm + 2 * 16896;
      const char* At = Kt + 17408;
      f32x16 ws[2];
#pragma unroll
      for (int i = 0; i < 2; ++i)
#pragma unroll
        for (int j = 0; j < 16; ++j) { ws[i][j] = 0.f; o[i][j] = 0.f; }
#pragma unroll
      for (int Tt = 0; Tt < 4; ++Tt)
#pragma unroll
        for (int s = 0; s < 2; ++s) {
          const int kb = 32 * Tt + 16 * s;
          const bf16x8 sps = pack8(S[Tt], s);
#pragma unroll
          for (int Tc = 0; Tc < 2; ++Tc) {
            ws[Tc] = mfma32(afrag_perm(Wm, 32 * Tc + c31, 264, kb, hh), sps, ws[Tc]);
            o[Tc] = mfma32(afrag_perm(Qd, 32 * Tc + c31, 264, kb, hh), sps, o[Tc]);
          }
        }
      f32x16 vn[2];
      vn[0][0] = bflo(un0.x) - ws[0][0]; vn[0][1] = bfhi(un0.x) - ws[0][1]; vn[0][2] = bflo(un0.y) - ws[0][2]; vn[0][3] = bfhi(un0.y) - ws[0][3];
      vn[0][4] = bflo(un0.z) - ws[0][4]; vn[0][5] = bfhi(un0.z) - ws[0][5]; vn[0][6] = bflo(un0.w) - ws[0][6]; vn[0][7] = bfhi(un0.w) - ws[0][7];
      vn[0][8] = bflo(un1.x) - ws[0][8]; vn[0][9] = bfhi(un1.x) - ws[0][9]; vn[0][10] = bflo(un1.y) - ws[0][10]; vn[0][11] = bfhi(un1.y) - ws[0][11];
      vn[0][12] = bflo(un1.z) - ws[0][12]; vn[0][13] = bfhi(un1.z) - ws[0][13]; vn[0][14] = bflo(un1.w) - ws[0][14]; vn[0][15] = bfhi(un1.w) - ws[0][15];
      vn[1][0] = bflo(un2.x) - ws[1][0]; vn[1][1] = bfhi(un2.x) - ws[1][1]; vn[1][2] = bflo(un2.y) - ws[1][2]; vn[1][3] = bfhi(un2.y) - ws[1][3];
      vn[1][4] = bflo(un2.z) - ws[1][4]; vn[1][5] = bfhi(un2.z) - ws[1][5]; vn[1][6] = bflo(un2.w) - ws[1][6]; vn[1][7] = bfhi(un2.w) - ws[1][7];
      vn[1][8] = bflo(un3.x) - ws[1][8]; vn[1][9] = bfhi(un3.x) - ws[1][9]; vn[1][10] = bflo(un3.y) - ws[1][10]; vn[1][11] = bfhi(un3.y) - ws[1][11];
      vn[1][12] = bflo(un3.z) - ws[1][12]; vn[1][13] = bfhi(un3.z) - ws[1][13]; vn[1][14] = bflo(un3.w) - ws[1][14]; vn[1][15] = bfhi(un3.w) - ws[1][15];
      const float gl = gln;
      if (n + 1 < 256) LD_U(n + 1)
      bf16x8 vp[2][2];
#pragma unroll
      for (int Tc = 0; Tc < 2; ++Tc) { vp[Tc][0] = pack8(vn[Tc], 0); vp[Tc][1] = pack8(vn[Tc], 1); }
#pragma unroll
      for (int s = 0; s < 2; ++s) {
        o[0] = mfma32(afrag_perm(At, c31, 136, 16 * s, hh), vp[0][s], o[0]);
        o[1] = mfma32(afrag_perm(At, 32 + c31, 136, 16 * s, hh), vp[0][s], o[1]);
        o[1] = mfma32(afrag_perm(At, 32 + c31, 136, 32 + 16 * s, hh), vp[1][s], o[1]);
      }
#pragma unroll
      for (int Tt = 0; Tt < 4; ++Tt)
#pragma unroll
        for (int j = 0; j < 16; ++j) S[Tt][j] *= gl;
#pragma unroll
      for (int Tc = 0; Tc < 2; ++Tc)
#pragma unroll
        for (int s = 0; s < 2; ++s)
#pragma unroll
          for (int Tt = 0; Tt < 4; ++Tt)
            S[Tt] = mfma32(afrag_perm(Kt, 32 * Tt + c31, 136, 32 * Tc + 16 * s, hh), vp[Tc][s], S[Tt]);
    } else {
      int ltv = lt;
      asm volatile("" : "+v"(ltv));
      const int nrow = ltv >> 2, nqr = ltv & 3;
      const int nn = (n + 1 < 256) ? n + 1 : 255;
      {
        uint4 la0, la1, la2, la3, lq0, lq1, lq2, lq3;
        LD_R1(nn)
        ST_R1((n + 1) & 1)
      }
      uint4 lz0, lz1, lz2, lz3;
      {
        uint4 lk0, lk1, lk2, lk3, lt0, lt1;
        LD_R2(nn)
        const int nz = (n > 0) ? n - 1 : 0;
        LD_Z(nz)
        ST_R2((n + 1) & 1)
      }
      if (n > 0) {
        const float* orow = Ot + nrow * 132 + nqr * 32;
        float ss = 0.f;
#pragma unroll
        for (int i = 0; i < 8; ++i) {
          const float4 v = *(const float4*)(orow + 4 * i);
          ss += v.x * v.x + v.y * v.y + v.z * v.z + v.w * v.w;
        }
        ss += __shfl_xor(ss, 1);
        ss += __shfl_xor(ss, 2);
        const float rs = rsqrtf(ss * (1.f / 128.f) + EPS);
        u16* zp = proj + (((size_t)b * 256 + (n - 1)) * 64 + nrow) * PC + BZ + h * 128 + nqr * 32;
        const float* gg = ng + nqr * 32;
#define GN1(i, Z)                                                                                          \
        {                                                                                                  \
          const float4 oa = *(const float4*)(orow + 8 * i), ob = *(const float4*)(orow + 8 * i + 4);       \
          uint4 r;                                                                                         \
          r.x = pack2(oa.x * rs * gg[8 * i + 0] * siluf_(bflo(Z.x)), oa.y * rs * gg[8 * i + 1] * siluf_(bfhi(Z.x))); \
          r.y = pack2(oa.z * rs * gg[8 * i + 2] * siluf_(bflo(Z.y)), oa.w * rs * gg[8 * i + 3] * siluf_(bfhi(Z.y))); \
          r.z = pack2(ob.x * rs * gg[8 * i + 4] * siluf_(bflo(Z.z)), ob.y * rs * gg[8 * i + 5] * siluf_(bfhi(Z.z))); \
          r.w = pack2(ob.z * rs * gg[8 * i + 6] * siluf_(bflo(Z.w)), ob.w * rs * gg[8 * i + 7] * siluf_(bfhi(Z.w))); \
          if (wr) *(uint4*)(zp + 8 * i) = r;                                                               \
        }
        GN1(0, lz0) GN1(1, lz1) GN1(2, lz2) GN1(3, lz3)
      }
    }
    __syncthreads();
    if (is_comp) {
#pragma unroll
      for (int Tc = 0; Tc < 2; ++Tc)
#pragma unroll
        for (int j = 0; j < 16; ++j) Ot[(32 * Tc + crow(j, hh)) * 132 + e] = o[Tc][j];
    }
  }
  __syncthreads();
  if (!is_comp) {
    const int n = 256;
    const int nrow = lt >> 2, nqr = lt & 3;
    uint4 lz0, lz1, lz2, lz3;
    LD_Z(255)
    const float* orow = Ot + nrow * 132 + nqr * 32;
    float ss = 0.f;
#pragma unroll
    for (int i = 0; i < 8; ++i) {
      const float4 v = *(const float4*)(orow + 4 * i);
      ss += v.x * v.x + v.y * v.y + v.z * v.z + v.w * v.w;
    }
    ss += __shfl_xor(ss, 1);
    ss += __shfl_xor(ss, 2);
    const float rs = rsqrtf(ss * (1.f / 128.f) + EPS);
    u16* zp = proj + (((size_t)b * 256 + (n - 1)) * 64 + nrow) * PC + BZ + h * 128 + nqr * 32;
    const float* gg = ng + nqr * 32;
    GN1(0, lz0) GN1(1, lz1) GN1(2, lz2) GN1(3, lz3)
  }
#undef GN1
#undef LD_AQ
#undef LD_K
#undef LD_R1
#undef LD_R2
#undef LD_T
#undef ST_AQ
#undef ST_K
#undef ST_R1
#undef ST_R2
#undef ST_T
#undef LD_Z
#undef LD_U
  __syncthreads();
}

DI void diff_item(const Params& p, int l, int qt, int bh, char* smem) {
  const int b = bh >> 2, h = bh & 3;
  const int tid = ltid(), ln = tid & 63, w = tid >> 6, hh = ln >> 5, c31 = ln & 31;
  const int st = w & 3, c = w >> 2;
  const size_t tokbase = (size_t)b * T;
  const int qb = qt * 128 + 32 * st + c31;
  u16* proj = p.P();
  bf16x8 qf[4];
  {
    const u16* qrow = proj + (tokbase + qb) * PC + AQ + h * 128 + c * 64 + 8 * hh;
#pragma unroll
    for (int s = 0; s < 4; ++s) qf[s] = *(const bf16x8*)(qrow + 16 * s);
  }
  f32x16 O[4];
  float mrun, lrun;
  f32x16 Lacc;
  bf16x8 onesf;
  {
    const short o1 = (c31 == 0) ? (short)0x3F80 : (short)0;
    onesf = bf16x8{o1, o1, o1, o1, o1, o1, o1, o1};
  }
  const float sc = 0.125f * 1.44269504089f;
  char* Ks = smem;
  char* Vs = smem + 17408;
  uint4 rk0, rk1, rv0, rv1;
  const int srow = tid >> 4, sch = tid & 15;
#define DLOAD1(i, kt)                                                                \
  {                                                                                  \
    const u16* base = proj + (tokbase + (kt) * 64 + srow + 32 * i) * PC + h * 128 + sch * 8; \
    rk##i = *(const uint4*)(base + AK);                                              \
    rv##i = *(const uint4*)(base + AV);                                              \
  }
#define DLOAD(kt) { DLOAD1(0, kt) DLOAD1(1, kt) }
#define DSTORE1(i)                                                \
  *(uint4*)(Ks + (srow + 32 * i) * 272 + sch * 16) = rk##i;       \
  *(uint4*)(Vs + (srow + 32 * i) * 320 + sch * 16) = rv##i;
  const int nkt = 2 * qt + 2;
#pragma unroll 1
  for (int rep = 0; rep < DUP_DIFF; ++rep) {
#pragma unroll
  for (int i = 0; i < 4; ++i)
#pragma unroll
    for (int j = 0; j < 16; ++j) O[i][j] = 0.f;
  mrun = -INFINITY; lrun = 0.f;
#pragma unroll
  for (int j = 0; j < 16; ++j) Lacc[j] = 0.f;
  DLOAD(0);
  for (int kt = 0; kt < nkt; ++kt) {
    __syncthreads();
    DSTORE1(0) DSTORE1(1)
    __syncthreads();
    if (kt + 1 < nkt) { DLOAD(kt + 1); }
    if (kt * 64 > qt * 128 + 32 * st + 31) continue;
    f32x16 sa[2];
#pragma unroll
    for (int k2 = 0; k2 < 2; ++k2) {
#pragma unroll
      for (int j = 0; j < 16; ++j) sa[k2][j] = 0.f;
#pragma unroll
      for (int s = 0; s < 4; ++s)
        sa[k2] = mfma32(*(const bf16x8*)(Ks + (32 * k2 + c31) * 272 + (c * 64 + 16 * s + 8 * hh) * 2), qf[s], sa[k2]);
    }
    if (kt >= 2 * qt) {
#pragma unroll
      for (int k2 = 0; k2 < 2; ++k2)
#pragma unroll
        for (int j = 0; j < 16; ++j)
          if (kt * 64 + 32 * k2 + crow(j, hh) > qb) sa[k2][j] = -INFINITY;
    }
    float tmax = sa[0][0];
#pragma unroll
    for (int k2 = 0; k2 < 2; ++k2)
#pragma unroll
      for (int j = 0; j < 16; ++j) tmax = fmaxf(tmax, sa[k2][j]);
    tmax = xhalf_max(tmax);
    const float cand = tmax * sc;
    if (__any(cand > mrun + 8.f)) {
      const float mnew = fmaxf(mrun, cand);
      const float alpha = __builtin_amdgcn_exp2f(mrun - mnew);
      mrun = mnew;
#pragma unroll
      for (int j = 0; j < 16; ++j) Lacc[j] *= alpha;
#pragma unroll
      for (int i = 0; i < 4; ++i)
#pragma unroll
        for (int j = 0; j < 16; ++j) O[i][j] *= alpha;
    }
#pragma unroll
    for (int k2 = 0; k2 < 2; ++k2)
#pragma unroll
      for (int j = 0; j < 16; ++j) sa[k2][j] = __builtin_amdgcn_exp2f(sa[k2][j] * sc - mrun);
#pragma unroll
    for (int k2 = 0; k2 < 2; ++k2)
#pragma unroll
      for (int s2 = 0; s2 < 2; ++s2) {
        const bf16x8 pp = pack8(sa[k2], s2);
        bf16x8 vf[4];
        trfrag4<320>(Vs, 32 * k2 + 16 * s2, ln, vf);
#pragma unroll
        for (int mt = 0; mt < 4; ++mt) O[mt] = mfma32(vf[mt], pp, O[mt]);
        Lacc = mfma32(onesf, pp, Lacc);
      }
  }
  }
#undef DLOAD
#undef DLOAD1
#undef DSTORE1
  __syncthreads();
  lrun = Lacc[0];
  const float ltot = xhalf_sum(lrun);
  const float inv = 1.f / ltot;
  float* xch = (float*)smem + st * 32 * 132;
  if (c == 1) {
#pragma unroll
    for (int mt = 0; mt < 4; ++mt)
#pragma unroll
      for (int i4 = 0; i4 < 4; ++i4)
        *(float4*)(xch + c31 * 132 + 32 * mt + 8 * i4 + 4 * hh) =
            float4{O[mt][4 * i4] * inv, O[mt][4 * i4 + 1] * inv, O[mt][4 * i4 + 2] * inv, O[mt][4 * i4 + 3] * inv};
  }
  __syncthreads();
  if (c == 0) {
    const float lam = p.LAM()[l], oml = 1.f - p.LAM()[2 + l];
    float ss = 0.f;
#pragma unroll
    for (int mt = 0; mt < 4; ++mt)
#pragma unroll
      for (int i4 = 0; i4 < 4; ++i4) {
        const float4 o1 = *(const float4*)(xch + c31 * 132 + 32 * mt + 8 * i4 + 4 * hh);
        float d;
        d = O[mt][4 * i4] * inv - lam * o1.x; O[mt][4 * i4] = d; ss += d * d;
        d = O[mt][4 * i4 + 1] * inv - lam * o1.y; O[mt][4 * i4 + 1] = d; ss += d * d;
        d = O[mt][4 * i4 + 2] * inv - lam * o1.z; O[mt][4 * i4 + 2] = d; ss += d * d;
        d = O[mt][4 * i4 + 3] * inv - lam * o1.w; O[mt][4 * i4 + 3] = d; ss += d * d;
      }
    ss = xhalf_sum(ss);
    const float rs = rsqrtf(ss * (1.f / 128.f) + EPS) * oml;
    const float* sg = p.a_subln_g + l * 128;
    int qb_e = qb;
    asm volatile("" : "+v"(qb_e));
    u16* orow = proj + (tokbase + qb_e) * PC + AQ + h * 128;
#pragma unroll
    for (int mt = 0; mt < 4; ++mt)
#pragma unroll
      for (int i4 = 0; i4 < 4; ++i4) {
        const int dv = 32 * mt + 8 * i4 + 4 * hh;
        const float4 gg = *(const float4*)(sg + dv);
        uint2 o;
        o.x = pack2(O[mt][4 * i4] * rs * gg.x, O[mt][4 * i4 + 1] * rs * gg.y);
        o.y = pack2(O[mt][4 * i4 + 2] * rs * gg.z, O[mt][4 * i4 + 3] * rs * gg.w);
        *(uint2*)(orow + dv) = o;
      }
  }
  __syncthreads();
}

DI u32 mono_key(float f) { u32 u = __float_as_uint(f); return (u & 0x80000000u) ? ~u : (u | 0x80000000u); }

constexpr int DCAP = 640;
DI u32 dsa_prune(u32* ck, u16* ci, int cnt, u32 tau_old, bool exact, int ln, int& newcnt) {
  u32 kv[10];
  u16 iv[10];
  u32 mx = 0u;
#pragma unroll
  for (int j = 0; j < 10; ++j) {
    const int pos = ln + 64 * j;
    const bool vd = pos < cnt;
    kv[j] = vd ? ck[pos] : 0u;
    iv[j] = vd ? ci[pos] : (u16)0;
    mx = max(mx, kv[j]);
  }
#pragma unroll
  for (int o = 32; o; o >>= 1) mx = max(mx, (u32)__shfl_xor((int)mx, o));
  u32 L = tau_old + 1u, H = mx + 1u;
  int curL = cnt;
  while ((exact || curL > 384) && (H - L) > 1u) {
    const u32 mid = L + ((H - L) >> 1);
    int c = 0;
#pragma unroll
    for (int j = 0; j < 10; ++j) c += __popcll(__ballot(kv[j] >= mid));
    if (c >= 256) { L = mid; curL = c; } else H = mid;
  }
  int ngt = 0;
#pragma unroll
  for (int j = 0; j < 10; ++j) ngt += __popcll(__ballot(kv[j] > L));
  const int target = (!exact && curL <= 384) ? curL : 256;
  const int need = target - ngt;
  int run_gt = 0, run_eq = 0;
#pragma unroll
  for (int j = 0; j < 10; ++j) {
    const bool gt = kv[j] > L, eq = (kv[j] == L);
    const u64 mg = __ballot(gt), me = __ballot(eq);
    const int pg = run_gt + (int)lane_lt_cnt(mg), pe = run_eq + (int)lane_lt_cnt(me);
    if (gt) { ck[pg] = kv[j]; ci[pg] = iv[j]; }
    else if (eq && pe < need) { ck[ngt + pe] = kv[j]; ci[ngt + pe] = iv[j]; }
    run_gt += __popcll(mg);
    run_eq += __popcll(me);
  }
  newcnt = target;
  return L;
}

DI void dsa_item(const Params& p, int l, int tile32, int b, char* smem) {
  const int tid = ltid(), ln = tid & 63, w = tid >> 6, hh = ln >> 5, c31 = ln & 31;
  const int t0 = tile32 * 32 + 4 * w;
  const size_t tokbase = (size_t)b * T;
  u16* QX = (u16*)p.out;
  char* wl = smem + w * 17408;
  u32* ckey = (u32*)wl;
  u16* cidx = (u16*)(wl + 10240);
  u16* ifin = (u16*)(wl + 15360);
  char* tile = wl;
  int cnt0 = 0, cnt1 = 0, cnt2 = 0, cnt3 = 0;
  {
    bf16x8 qa[4];
    {
      const int r = c31, ql = 2 * ((r >> 2) & 1) + (r & 1), hd = ((r & 3) >> 1) + 2 * (r >> 3);
      const u16* qrow = QX + (tokbase + t0 + ql) * LDQ + 1024 + hd * 64 + 8 * hh;
#pragma unroll
      for (int s = 0; s < 4; ++s) qa[s] = *(const bf16x8*)(qrow + 16 * s);
    }
    typedef float f32x2 __attribute__((ext_vector_type(2)));
    f32x2 wq2[8];
    {
      const float4* wi = (const float4*)(p.WIDX() + (tokbase + t0 + 2 * hh) * 8);
      const float4 a0 = wi[0], a1 = wi[1], b0 = wi[2], b1 = wi[3];
      wq2[0] = f32x2{a0.x, b0.x}; wq2[1] = f32x2{a0.y, b0.y}; wq2[2] = f32x2{a0.z, b0.z}; wq2[3] = f32x2{a0.w, b0.w};
      wq2[4] = f32x2{a1.x, b1.x}; wq2[5] = f32x2{a1.y, b1.y}; wq2[6] = f32x2{a1.z, b1.z}; wq2[7] = f32x2{a1.w, b1.w};
    }
    const int qpos0 = t0 + 2 * hh;
    const int nkt = ((t0 + 3) >> 5) + 1;
    const u32 lmask = (1u << c31) - 1u;
#pragma unroll 1
    for (int rep = 0; rep < DUP_DSA1; ++rep) {
    cnt0 = cnt1 = cnt2 = cnt3 = 0;
    u32 tau0 = 0u, tau1 = 0u, tau2 = 0u, tau3 = 0u;
    bf16x8 kn[4][4];
    {
#pragma unroll
      for (int t = 0; t < 4; ++t) {
        const u16* krow = p.KIDX() + (tokbase + t * 32 + c31) * 64 + 8 * hh;
#pragma unroll
        for (int s = 0; s < 4; ++s) kn[t][s] = *(const bf16x8*)(krow + 16 * s);
      }
    }
    const int ngrp = (nkt + 3) >> 2;
    for (int g = 0; g <= ngrp; ++g) {
      const int lim = (g < ngrp) ? (DCAP - 128) : 256;
      for (;;) {
        const int q = (cnt0 > lim) ? 0 : (cnt1 > lim) ? 1 : (cnt2 > lim) ? 2 : (cnt3 > lim) ? 3 : -1;
        if (q < 0) break;
        const int c = (q == 0) ? cnt0 : (q == 1) ? cnt1 : (q == 2) ? cnt2 : cnt3;
        const u32 to = (q == 0) ? tau0 : (q == 1) ? tau1 : (q == 2) ? tau2 : tau3;
        int nc;
        const u32 t = dsa_prune(ckey + q * DCAP, cidx + q * DCAP, c, to, g == ngrp, ln, nc);
        if (q == 0) { cnt0 = nc; tau0 = t; } else if (q == 1) { cnt1 = nc; tau1 = t; }
        else if (q == 2) { cnt2 = nc; tau2 = t; } else { cnt3 = nc; tau3 = t; }
      }
      if (g == ngrp) break;
      bf16x8 kc[4][4];
#pragma unroll
      for (int t = 0; t < 4; ++t)
#pragma unroll
        for (int s = 0; s < 4; ++s) kc[t][s] = kn[t][s];
      if (g + 1 < ngrp) {
#pragma unroll
        for (int t = 0; t < 4; ++t) {
          const u16* krow = p.KIDX() + (tokbase + (g + 1) * 128 + t * 32 + c31) * 64 + 8 * hh;
#pragma unroll
          for (int s = 0; s < 4; ++s) kn[t][s] = *(const bf16x8*)(krow + 16 * s);
        }
      }
      const u32 tauA = hh ? tau2 : tau0, tauB = hh ? tau3 : tau1;
#pragma unroll
      for (int t = 0; t < 4; ++t) {
        const int key = (g * 4 + t) * 32 + c31;
        f32x16 acc;
#pragma unroll
        for (int j = 0; j < 16; ++j) acc[j] = 0.f;
#pragma unroll
        for (int s = 0; s < 4; ++s) acc = mfma32(qa[s], kc[t][s], acc);
        f32x2 ss2 = f32x2{0.f, 0.f};
#pragma unroll
        for (int hq = 0; hq < 8; ++hq) {
          const f32x2 rr = f32x2{__builtin_amdgcn_fmed3f(acc[2 * hq], 0.f, 3.0e38f), __builtin_amdgcn_fmed3f(acc[2 * hq + 1], 0.f, 3.0e38f)};
          ss2 = __builtin_elementwise_fma(wq2[hq], rr, ss2);
        }
        const float s0 = ss2.x, s1 = ss2.y;
        const u32 k0 = mono_key(s0), k1 = mono_key(s1);
        const bool c0 = (key <= qpos0) && (k0 > tauA), c1 = (key <= qpos0 + 1) && (k1 > tauB);
        const u64 m0 = __ballot(c0), m1 = __ballot(c1);
        if (m0 | m1) {
          const u32 h0 = hh ? (u32)(m0 >> 32) : (u32)m0, h1 = hh ? (u32)(m1 >> 32) : (u32)m1;
          const int pA = (hh ? cnt2 : cnt0) + __popc(h0 & lmask), pB = (hh ? cnt3 : cnt1) + __popc(h1 & lmask);
          if (c0) { ckey[(2 * hh) * DCAP + pA] = k0; cidx[(2 * hh) * DCAP + pA] = (u16)key; }
          if (c1) { ckey[(2 * hh + 1) * DCAP + pB] = k1; cidx[(2 * hh + 1) * DCAP + pB] = (u16)key; }
          cnt0 += __popc((u32)m0); cnt2 += __popc((u32)(m0 >> 32));
          cnt1 += __popc((u32)m1); cnt3 += __popc((u32)(m1 >> 32));
        }
      }
    }
#pragma unroll
    for (int qq = 0; qq < 4; ++qq) {
      const int cq = (qq == 0) ? cnt0 : (qq == 1) ? cnt1 : (qq == 2) ? cnt2 : cnt3;
#pragma unroll
      for (int j = 0; j < 4; ++j) {
        const int pos = ln + 64 * j;
        ifin[qq * 256 + pos] = (pos < cq) ? cidx[qq * DCAP + pos] : (u16)0;
      }
    }
    }
  }
  const float sc = 0.125f * 1.44269504089f;
#pragma unroll 1
  for (int rep2 = 0; rep2 < DUP_DSA2; ++rep2)
#pragma unroll 1
  for (int qq = 0; qq < 4; ++qq) {
    const int nsel = (qq == 0) ? cnt0 : (qq == 1) ? cnt1 : (qq == 2) ? cnt2 : cnt3;
    const size_t tq = tokbase + t0 + qq;
    bf16x8 qf[8];
    {
      const u16* qab = QX + tq * LDQ + (c31 & 7) * 128 + 8 * hh;
#pragma unroll
      for (int s = 0; s < 8; ++s) qf[s] = *(const bf16x8*)(qab + 16 * s);
    }
    f32x16 O[4];
#pragma unroll
    for (int i = 0; i < 4; ++i)
#pragma unroll
      for (int j = 0; j < 16; ++j) O[i][j] = 0.f;
    float mrun = -INFINITY, lrun = 0.f;
    const int ntile = (nsel + 31) >> 5;
    uint4 gr0, gr1, gr2, gr3, gr4, gr5, gr6, gr7;
#define GGATHER1(i, tt_)                                                                     \
    {                                                                                        \
      const int piece = ln + 64 * i, row = piece >> 4, ch = piece & 15;                      \
      const int idx = ifin[qq * 256 + (tt_) * 32 + row];                                     \
      gr##i = *(const uint4*)(p.CKV() + (tokbase + idx) * 128 + ch * 8);                     \
    }
#define GGATHER(tt_) { GGATHER1(0, tt_) GGATHER1(1, tt_) GGATHER1(2, tt_) GGATHER1(3, tt_) GGATHER1(4, tt_) GGATHER1(5, tt_) GGATHER1(6, tt_) GGATHER1(7, tt_) }
#define GSTORE1(i) { const int piece = ln + 64 * i, row = piece >> 4, ch = piece & 15; *(uint4*)(tile + row * 272 + ch * 16) = gr##i; }
    if (ntile > 0) GGATHER(0)
    for (int tt = 0; tt < ntile; ++tt) {
      GSTORE1(0) GSTORE1(1) GSTORE1(2) GSTORE1(3) GSTORE1(4) GSTORE1(5) GSTORE1(6) GSTORE1(7)
      if (tt + 1 < ntile) GGATHER(tt + 1)
      __builtin_amdgcn_fence(__ATOMIC_RELEASE, "wavefront");
      f32x16 sa;
#pragma unroll
      for (int j = 0; j < 16; ++j) sa[j] = 0.f;
#pragma unroll
      for (int s = 0; s < 8; ++s) sa = mfma32(*(const bf16x8*)(tile + c31 * 272 + (16 * s + 8 * hh) * 2), qf[s], sa);
      float tmax = -INFINITY;
#pragma unroll
      for (int j = 0; j < 16; ++j) {
        if (tt * 32 + crow(j, hh) >= nsel) sa[j] = -INFINITY;
        tmax = fmaxf(tmax, sa[j]);
      }
      tmax = xhalf_max(tmax);
      const float cand = tmax * sc;
      if (__any(cand > mrun + 8.f)) {
        const float mnew = fmaxf(mrun, cand);
        const float alpha = __builtin_amdgcn_exp2f(mrun - mnew);
        mrun = mnew;
        lrun *= alpha;
#pragma unroll
        for (int i = 0; i < 4; ++i)
#pragma unroll
          for (int j = 0; j < 16; ++j) O[i][j] *= alpha;
      }
      float psum = 0.f;
#pragma unroll
      for (int j = 0; j < 16; ++j) { const float pv = __builtin_amdgcn_exp2f(sa[j] * sc - mrun); sa[j] = pv; psum += pv; }
      lrun += psum;
#pragma unroll
      for (int s2 = 0; s2 < 2; ++s2) {
        const bf16x8 pp = pack8(sa, s2);
        bf16x8 vf[4];
        trfrag4<272>(tile, 16 * s2, ln, vf);
#pragma unroll
        for (int mt = 0; mt < 4; ++mt) O[mt] = mfma32(vf[mt], pp, O[mt]);
      }
      __builtin_amdgcn_fence(__ATOMIC_ACQ_REL, "wavefront");
    }
#undef GGATHER1
#undef GGATHER
#undef GSTORE1
    const float ltot = xhalf_sum(lrun);
    const float inv = 1.f / ltot;
    if (c31 < 8 && rep2 == DUP_DSA2 - 1) {
      u16* orow = QX + tq * LDQ + c31 * 128;
#pragma unroll
      for (int mt = 0; mt < 4; ++mt)
#pragma unroll
        for (int i4 = 0; i4 < 4; ++i4) {
          uint2 o;
          o.x = pack2(O[mt][4 * i4] * inv, O[mt][4 * i4 + 1] * inv);
          o.y = pack2(O[mt][4 * i4 + 2] * inv, O[mt][4 * i4 + 3] * inv);
          *(uint2*)(orow + 32 * mt + 8 * i4 + 4 * hh) = o;
        }
    }
  }
  __syncthreads();
}

DI void phase_prep(const Params& p, int l, char* smem) {
  if (EN_C) {
    int rt, ct;
    for (int it = 0; next_tile(it, 128, 6, 32, 2, rt, ct); ++it) qx_tile(p, l, rt, ct, smem);
  }
  const int n_gdn = EN_B ? 1024 : 0, n_kp = EN_C ? 512 : 0;
  for (int t = lbid(); t < n_gdn + n_kp; t += lgdim()) {
    if (t < n_gdn) gdn_prep_item(p, l, t, smem);
    else dsa_kprep_item(p, l, t - n_gdn);
  }
}

DI int xcc_id() { return (int)(__builtin_amdgcn_s_getreg((3 << 11) | 20) & 0x7u); }

DI void phase_mixers(const Params& p, int l, char* smem) {
  __shared__ int s_item;
  const int x0 = xcc_id();
  int xs = x0;
  for (;;) {
    __syncthreads();
    {
      int qi = l * 8 + xs;
      asm volatile("" : "+s"(qi));
      if (ltid() == 0) s_item = (int)atomicAdd(p.CNT() + qi, 1u);
    }
    __syncthreads();
    const int it = s_item;
    const int n_gdn = EN_B ? 1 : 0;
    if (it >= n_gdn + 256) {
      xs = (xs + 1) & 7;
      if (xs == x0) break;
      continue;
    }
    const int x = xs;
    if (it < n_gdn) {
#pragma unroll 1
      for (int rep = 0; rep < DUP_GDN; ++rep) gdn_rec_item(p, l, x, smem, rep == DUP_GDN - 1);
    }
    else {
      const int j = it - n_gdn, k = j >> 1;
      if ((j & 1) == 0) { if (EN_A) diff_item(p, l, 127 - k, x, smem); }
      else { if (EN_C) dsa_item(p, l, 511 - (k * 4 + (x >> 1)), x & 1, smem); }
    }
  }
}

DI void run_phase(const Params& p, int ph, char* smem) {
  if (ph == 0) { phase0(p, smem); return; }
  const int l = (ph - 1) / 9, s = (ph - 1) % 9;
  switch (s) {
    case 0: phase_inproj(p, l, smem); break;
    case 1: phase_prep(p, l, smem); break;
    case 2: phase_mixers(p, l, smem); break;
    case 3: phase_merge(p, l, smem); break;
    case 4: phase_resgemm(p, p.MERGED(), LDX, p.wo(l), KP1024, 1024, smem); break;
    case 5: ln_phase(p.out, p.ln1_g + l * 1024, p.ln1_b + l * 1024, p.XB(), nullptr); break;
    case 6: phase_ff1(p, l, smem); break;
    case 7: phase_resgemm(p, p.P(), LDH, p.wf2(l), KP4096, 4096, smem); break;
    case 8: ln_phase(p.out, p.ln2_g + l * 1024, p.ln2_b + l * 1024, (l == 1) ? nullptr : p.XB(), (l == 1) ? p.out : nullptr); break;
  }
}

constexpr int N_PHASES = 19;


DI u32 xb_ld(u32* p) { return __hip_atomic_load(p, __ATOMIC_RELAXED, __HIP_MEMORY_SCOPE_AGENT); }
DI u32 xb_add(u32* p, u32 v) { return __hip_atomic_fetch_add(p, v, __ATOMIC_RELAXED, __HIP_MEMORY_SCOPE_AGENT); }
DI void fast_sync(u32* bar, int x, const volatile int* st) {
  asm volatile("s_waitcnt vmcnt(0)" ::: "memory");
  __syncthreads();
  if (ltid() == 0) {
    __builtin_amdgcn_s_waitcnt(0);
    const u32 nloc = (u32)st[0], nx = (u32)st[1];
    const u32 old = xb_add(bar + 32 * (8 + x), 1u);
    const u32 gen = old / nloc;
    if (old + 1u == (gen + 1u) * nloc) {
      __builtin_amdgcn_fence(__ATOMIC_RELEASE, "agent");
      asm volatile("s_waitcnt vmcnt(0)" ::: "memory");
      const u32 og = xb_add(bar + 32 * 24, 1u);
      const u32 tg = og / nx;
      if (og + 1u == (tg + 1u) * nx) xb_add(bar + 32 * 25, 1u);
      else { while (xb_ld(bar + 32 * 25) == tg) __builtin_amdgcn_s_sleep(1); }
      __builtin_amdgcn_fence(__ATOMIC_ACQUIRE, "agent");
      xb_add(bar + 32 * (16 + x), 1u);
      asm volatile("s_waitcnt vmcnt(0)" ::: "memory");
    } else {
      while (xb_ld(bar + 32 * (16 + x)) == gen) __builtin_amdgcn_s_sleep(1);
      __builtin_amdgcn_fence(__ATOMIC_ACQUIRE, "agent");
      asm volatile("s_waitcnt vmcnt(0)" ::: "memory");
    }
  }
  __syncthreads();
}
#if COOP
DI void gsync() { cg::this_grid().sync(); }
__global__ void __launch_bounds__(512, 1) mega_kernel(Params p, int ph_begin, int ph_end) {
  __shared__ __attribute__((aligned(16))) char smem[SMEM_BYTES];
  __shared__ int xb_st[2];
  const int myx = xcc_id();
  if (ltid() == 0) (void)xb_add(p.BAR() + 32 * myx, 1u);
  for (int r = 0; r < REP0; ++r) { phase0(p, smem); cg::this_grid().sync(); }
  if (ltid() == 0) {
    int mine = 0, cnt = 0;
    for (int j = 0; j < 8; ++j) { const int c = (int)xb_ld(p.BAR() + 32 * j); cnt += (c > 0) ? 1 : 0; mine = (j == myx) ? c : mine; }
    xb_st[0] = mine > 0 ? mine : 1;
    xb_st[1] = cnt > 0 ? cnt : 1;
  }
  __syncthreads();
#define gsync() fast_sync(p.BAR(), myx, xb_st)
#pragma unroll 1
  for (int l = 0; l < 2; ++l) {
    for (int r = 0; r < REP1; ++r) { phase_inproj(p, l, smem); gsync(); }
    phase_prep(p, l, smem);
    gsync();
    phase_mixers(p, l, smem);
    gsync();
    for (int r = 0; r < REP2; ++r) { phase_merge(p, l, smem); gsync(); }
    for (int r = 0; r < REP3; ++r) { phase_resgemm(p, p.MERGED(), LDX, p.wo(l), KP1024, 1024, smem); gsync(); }
    for (int r = 0; r < REP4; ++r) { ln_phase(p.out, p.ln1_g + l * 1024, p.ln1_b + l * 1024, p.XB(), nullptr); gsync(); }
    for (int r = 0; r < REP5; ++r) { phase_ff1(p, l, smem); gsync(); }
    for (int r = 0; r < REP6; ++r) { phase_resgemm(p, p.P(), LDH, p.wf2(l), KP4096, 4096, smem); gsync(); }
    ln_phase(p.out, p.ln2_g + l * 1024, p.ln2_b + l * 1024, (l == 1) ? nullptr : p.XB(), (l == 1) ? p.out : nullptr);
    if (l == 0) gsync();
  }
}
#undef gsync
#else
__global__ void __launch_bounds__(512, 1) mega_kernel(Params p, int ph_begin, int ph_end) {
  __shared__ __attribute__((aligned(16))) char smem[SMEM_BYTES];
  for (int ph = ph_begin; ph < ph_end; ++ph) run_phase(p, ph, smem);
}
#endif

extern "C" void kernel_launch(void* const* d_in, const int* in_sizes, int n_in, void* d_out, int out_size,
                              void* d_ws, size_t ws_size, hipStream_t stream) {
  static int grid_blocks = 0;
  if (!grid_blocks) {
    int dev = 0, cus = 0, per_cu = 0;
    hipGetDevice(&dev);
    hipDeviceGetAttribute(&cus, hipDeviceAttributeMultiprocessorCount, dev);
    hipOccupancyMaxActiveBlocksPerMultiprocessor(&per_cu, mega_kernel, NTHR, 0);
    if (per_cu < 1) per_cu = 1;
    if (per_cu > 1) per_cu = 1;
    grid_blocks = cus * per_cu;
  }
  Params p{};
  const float** pf = (const float**)&p;
  for (int i = 0; i < 27; ++i) pf[i] = (const float*)d_in[i];
  p.out = (float*)d_out;
  p.ws = (char*)d_ws;
  if (WS_NEED > ws_size) { fprintf(stderr, "workspace too small: need %zu have %zu\n", (size_t)WS_NEED, ws_size); return; }
#if COOP
  hipMemsetAsync(p.ws + O_BAR, 0, 4096, stream);
  int b = 0, e = N_PHASES;
  void* args[] = {&p, &b, &e};
  hipError_t err = hipLaunchCooperativeKernel((void*)mega_kernel, dim3(grid_blocks), dim3(NTHR), args, 0, stream);
  if (err != hipSuccess) fprintf(stderr, "cooperative launch failed: %s (grid %d)\n", hipGetErrorString(err), grid_blocks);
#else
  for (int ph = 0; ph < N_PHASES; ++ph) mega_kernel<<<grid_blocks, NTHR, 0, stream>>>(p, ph, ph + 1);
#endif
}
```

```cpp
#include <hip/hip_runtime.h>
#include <hip/hip_cooperative_groups.h>
#include <cstdio>
namespace cg = cooperative_groups;

#ifndef COOP
#define COOP 1
#endif
#ifndef REP0
#define REP0 1
#define REP1 1
#define REP2 1
#define REP3 1
#define REP4 1
#define REP5 1
#define REP6 1
#endif
#ifndef DUP_GDN
#define DUP_GDN 1
#endif
#ifndef DUP_DIFF
#define DUP_DIFF 1
#endif
#ifndef DUP_DSA1
#define DUP_DSA1 1
#endif
#ifndef DUP_DSA2
#define DUP_DSA2 1
#endif
#ifndef EN_A
#define EN_A 1
#endif
#ifndef EN_B
#define EN_B 1
#endif
#ifndef EN_C
#define EN_C 1
#endif

typedef unsigned short u16;
typedef unsigned int u32;
typedef unsigned long long u64;
using bf16x8 = __attribute__((ext_vector_type(8))) short;
using s16x4 = __attribute__((ext_vector_type(4))) short;
using f32x4 = __attribute__((ext_vector_type(4))) float;
using f32x16 = __attribute__((ext_vector_type(16))) float;
#define DI __device__ __forceinline__

constexpr int NT = 32768, T = 16384, PC = 4048;
constexpr int AQ = 0, AK = 512, AV = 1024, BQ = 1536, BK_ = 2048, BV = 2560, BZ = 3072, BA = 3584, BB = 3588,
              CQ = 3592, CKVc = 3848, CKI = 3976, CWI = 4040, GATES = 4048;
constexpr float EPS = 1e-6f;
constexpr float DN_ALPHA = 1.41421356237f;
constexpr int NTHR = 512;
constexpr int SMEM_BYTES = 153600 + 512;

constexpr size_t al256(size_t x) { return (x + 255) & ~(size_t)255; }
constexpr int LDX = 1088, LDH = 4160, LDQ = 1600;
constexpr int KP1024 = 1088, KP512 = 576, KP256 = 320, KP4096 = 4160;
constexpr size_t SZ_WIN = al256((size_t)7120 * KP1024 * 2), SZ_WQX = al256((size_t)1536 * KP256 * 2), SZ_WBR = al256((size_t)1024 * KP512 * 2),
                 SZ_WBRC = al256((size_t)1024 * KP1024 * 2), SZ_WO = al256((size_t)1024 * KP1024 * 2), SZ_WF1 = al256((size_t)4096 * KP1024 * 2), SZ_WF2 = al256((size_t)1024 * KP4096 * 2);
constexpr size_t O_WIN = 0, O_WQX = O_WIN + SZ_WIN, O_WBRA = O_WQX + SZ_WQX, O_WBRB = O_WBRA + SZ_WBR, O_WBRC = O_WBRB + SZ_WBR,
                 O_WO = O_WBRC + SZ_WBRC, O_WF1 = O_WO + SZ_WO, O_WF2 = O_WF1 + SZ_WF1, LAYER_W = O_WF2 + SZ_WF2;
constexpr size_t O_P = 2 * LAYER_W, O_XB = O_P + (size_t)NT * LDH * 2, O_M = O_XB + (size_t)NT * LDX * 2;
constexpr size_t O_KDT = O_M, O_ATT = O_KDT + 33554432, O_HALO = O_ATT + 16777216, O_KIDX = O_HALO + 4718592, O_CKV = O_KIDX + 4194304,
                 O_MEND = O_CKV + 8388608 + 4194304;
constexpr size_t O_WIDX = O_MEND, O_GL = O_WIDX + (size_t)NT * 8 * 4, O_LAM = O_GL + 8192, O_CNT = O_LAM + 256, O_BAR = O_CNT + 256, WS_NEED = O_BAR + 4096;
static_assert(O_MEND - O_M >= (size_t)NT * LDX * 2, "merged alias");

struct Params {
  const float *x, *w_in, *b_gate, *a_lambda, *a_subln_g, *b_conv_w, *b_a_log, *b_dt_bias, *b_norm_g,
      *c_q_norm_g, *c_kv_norm_g, *c_kidx_g, *c_kidx_b, *c_w_uq, *c_w_qidx, *c_w_uk, *c_w_uv,
      *w_branch_a, *w_branch_b, *w_branch_c, *w_o, *ln1_g, *ln1_b, *w_ff1, *w_ff2, *ln2_g, *ln2_b;
  float* out;
  char* ws;
  __device__ __forceinline__ u16* win(int l) const { return (u16*)(ws + l * LAYER_W + O_WIN); }
  __device__ __forceinline__ u16* wqx(int l) const { return (u16*)(ws + l * LAYER_W + O_WQX); }
  __device__ __forceinline__ u16* wbra(int l) const { return (u16*)(ws + l * LAYER_W + O_WBRA); }
  __device__ __forceinline__ u16* wbrb(int l) const { return (u16*)(ws + l * LAYER_W + O_WBRB); }
  __device__ __forceinline__ u16* wbrc(int l) const { return (u16*)(ws + l * LAYER_W + O_WBRC); }
  __device__ __forceinline__ u16* wo(int l) const { return (u16*)(ws + l * LAYER_W + O_WO); }
  __device__ __forceinline__ u16* wf1(int l) const { return (u16*)(ws + l * LAYER_W + O_WF1); }
  __device__ __forceinline__ u16* wf2(int l) const { return (u16*)(ws + l * LAYER_W + O_WF2); }
  __device__ __forceinline__ u16* P() const { return (u16*)(ws + O_P); }
  __device__ __forceinline__ u16* XB() const { return (u16*)(ws + O_XB); }
  __device__ __forceinline__ u16* KDT() const { return (u16*)(ws + O_KDT); }
  __device__ __forceinline__ u16* ATT() const { return (u16*)(ws + O_ATT); }
  __device__ __forceinline__ u16* HALO() const { return (u16*)(ws + O_HALO); }
  __device__ __forceinline__ u16* KIDX() const { return (u16*)(ws + O_KIDX); }
  __device__ __forceinline__ u16* CKV() const { return (u16*)(ws + O_CKV); }
  __device__ __forceinline__ u16* MERGED() const { return (u16*)(ws + O_M); }
  __device__ __forceinline__ float* WIDX() const { return (float*)(ws + O_WIDX); }
  __device__ __forceinline__ float* GL() const { return (float*)(ws + O_GL); }
  __device__ __forceinline__ float* LAM() const { return (float*)(ws + O_LAM); }
  __device__ __forceinline__ u32* CNT() const { return (u32*)(ws + O_CNT); }
  __device__ __forceinline__ u32* BAR() const { return (u32*)(ws + O_BAR); }
};

DI int lbid() { int b = blockIdx.x; asm volatile("" : "+s"(b)); return b; }
DI int lgdim() { int b = gridDim.x; asm volatile("" : "+s"(b)); return b; }
DI int ltid() { int t = threadIdx.x; asm volatile("" : "+v"(t)); return t; }
DI u16 f2bf(float x) { return __builtin_bit_cast(u16, (__bf16)x); }
DI float bf2f(u16 h) { return __uint_as_float(((u32)h) << 16); }
DI u32 pack2(float a, float b) {
  typedef __bf16 bf16v2_ __attribute__((ext_vector_type(2)));
  const bf16v2_ v = {(__bf16)a, (__bf16)b};
  return __builtin_bit_cast(u32, v);
}
DI float bflo(u32 v) { return __uint_as_float(v << 16); }
DI float bfhi(u32 v) { return __uint_as_float(v & 0xffff0000u); }
DI f32x4 mfma16(bf16x8 a, bf16x8 b, f32x4 c) { return __builtin_amdgcn_mfma_f32_16x16x32_bf16(a, b, c, 0, 0, 0); }
DI f32x16 mfma32(bf16x8 a, bf16x8 b, f32x16 c) { return __builtin_amdgcn_mfma_f32_32x32x16_bf16(a, b, c, 0, 0, 0); }
DI int crow(int i, int hh) { return (i & 3) + 8 * (i >> 2) + 4 * hh; }
DI float sigmoidf_(float x) { return 1.f / (1.f + __expf(-x)); }
DI float siluf_(float x) { return x / (1.f + __expf(-x)); }
DI float xhalf_max(float x) {
  const u32 u = __float_as_uint(x);
  const auto r = __builtin_amdgcn_permlane32_swap(u, u, false, false);
  return fmaxf(__uint_as_float(r[0]), __uint_as_float(r[1]));
}
DI float xhalf_sum(float x) {
  const u32 u = __float_as_uint(x);
  const auto r = __builtin_amdgcn_permlane32_swap(u, u, false, false);
  return __uint_as_float(r[0]) + __uint_as_float(r[1]);
}
DI u32 lane_lt_cnt(u64 m) { return __builtin_amdgcn_mbcnt_hi((u32)(m >> 32), __builtin_amdgcn_mbcnt_lo((u32)m, 0)); }

DI bf16x8 pack8(const f32x16& x, int s) {
  typedef __bf16 bf16v8_ __attribute__((ext_vector_type(8)));
  bf16v8_ v;
#pragma unroll
  for (int j = 0; j < 8; ++j) v[j] = (__bf16)x[8 * s + j];
  return __builtin_bit_cast(bf16x8, v);
}
DI bf16x8 afrag_perm(const char* base, int row, int stride, int kbase, int hh) {
  const char* pr = base + row * stride + (kbase + 4 * hh) * 2;
  s16x4 lo = *(const s16x4*)pr;
  s16x4 hi = *(const s16x4*)(pr + 16);
  return __builtin_shufflevector(lo, hi, 0, 1, 2, 3, 4, 5, 6, 7);
}
DI bf16x8 trfrag(const char* img, int stride, int krow0, int col0, int ln) {
  const int hh = ln >> 5, chalf = (ln >> 4) & 1, q4 = (ln & 15) >> 2, p4 = ln & 3;
  u32 a = (u32)(size_t)(img + (krow0 + 4 * hh + q4) * stride + (col0 + 16 * chalf + 4 * p4) * 2);
  s16x4 lo, hi;
  asm volatile("ds_read_b64_tr_b16 %0, %2\n\tds_read_b64_tr_b16 %1, %3\n\ts_waitcnt lgkmcnt(0)"
               : "=&v"(lo), "=&v"(hi) : "v"(a), "v"(a + 8 * stride) : "memory");
  return __builtin_shufflevector(lo, hi, 0, 1, 2, 3, 4, 5, 6, 7);
}

template <int STRIDE>
DI void trfrag4(const char* img, int krow0, int ln, bf16x8 (&f)[4]) {
  typedef __attribute__((address_space(3))) s16x4 lds_s16x4;
  const int hh = ln >> 5, chalf = (ln >> 4) & 1, q4 = (ln & 15) >> 2, p4 = ln & 3;
  const char* a = img + (krow0 + 4 * hh + q4) * STRIDE + (16 * chalf + 4 * p4) * 2;
#pragma unroll
  for (int mt = 0; mt < 4; ++mt) {
    const s16x4 lo = __builtin_amdgcn_ds_read_tr16_b64_v4i16((lds_s16x4*)(a + 64 * mt));
    const s16x4 hi = __builtin_amdgcn_ds_read_tr16_b64_v4i16((lds_s16x4*)(a + 8 * STRIDE + 64 * mt));
    f[mt] = __builtin_shufflevector(lo, hi, 0, 1, 2, 3, 4, 5, 6, 7);
  }
}

template <int MT, int NT>
DI void gemm_core(const u16* __restrict__ A, int lda, const u16* __restrict__ B, int ldb, int K,
                  f32x4 (&acc)[MT][NT], char* smem) {
  constexpr int BM = 64 * MT, BN = 32 * NT;
  constexpr int ASZ = BM * 128, BSZ = BN * 128, BUF = ASZ + BSZ;
  constexpr int NA = BM / 64, NB = BN / 64;
  const int tid = ltid(), l = tid & 63, w = tid >> 6, wm = w >> 1, wn = w & 1;
  const int fr = l & 15, fq = l >> 4;
  uint4 ra0, ra1, ra2, ra3, rb0, rb1, rb2, rb3;
  const int nk = K >> 6;
  const int srow = tid >> 3, sch = tid & 7;
  const int ssw = sch ^ ((srow >> 1) & 7);
  const int fsw = (fr >> 1) & 7;
#define GL1(i, kt)                                                                                        \
  if (NA > i) ra##i = *(const uint4*)(A + (size_t)(srow + 64 * i) * lda + (kt) * 64 + sch * 8);           \
  if (NB > i) rb##i = *(const uint4*)(B + (size_t)(srow + 64 * i) * ldb + (kt) * 64 + sch * 8);
#define GLOAD(kt) { GL1(0, kt) GL1(1, kt) GL1(2, kt) GL1(3, kt) }
#define SS1(i)                                                                   \
  if (NA > i) *(uint4*)(as_ + (srow + 64 * i) * 128 + ssw * 16) = ra##i;         \
  if (NB > i) *(uint4*)(bs_ + (srow + 64 * i) * 128 + ssw * 16) = rb##i;
#define SSTORE(buf)                              \
  {                                              \
    char* as_ = smem + (buf) * BUF;              \
    char* bs_ = as_ + ASZ;                       \
    SS1(0) SS1(1) SS1(2) SS1(3)                  \
  }
  GLOAD(0);
  SSTORE(0);
  GLOAD(((1 < nk) ? 1 : 0));
#pragma unroll 1
  for (int kt = 0; kt < nk; ++kt) {
    __syncthreads();
    SSTORE((kt + 1) & 1);
    { const int kn_ = (kt + 2 < nk) ? kt + 2 : nk - 1; GLOAD(kn_); }
    const char* as = smem + (kt & 1) * BUF;
    const char* bs = as + ASZ;
#pragma unroll
    for (int kk = 0; kk < 2; ++kk) {
      bf16x8 xf[MT], wf[NT];
#pragma unroll
      for (int mi = 0; mi < MT; ++mi)
        xf[mi] = *(const bf16x8*)(as + (wm * (MT * 16) + mi * 16 + fr) * 128 + (((kk * 4 + fq) ^ fsw) * 16));
#pragma unroll
      for (int ni = 0; ni < NT; ++ni)
        wf[ni] = *(const bf16x8*)(bs + (wn * (NT * 16) + ni * 16 + fr) * 128 + (((kk * 4 + fq) ^ fsw) * 16));
      __builtin_amdgcn_s_setprio(1);
#pragma unroll
      for (int mi = 0; mi < MT; ++mi)
#pragma unroll
        for (int ni = 0; ni < NT; ++ni) acc[mi][ni] = mfma16(wf[ni], xf[mi], acc[mi][ni]);
      __builtin_amdgcn_s_setprio(0);
    }
  }
  __syncthreads();
#undef GLOAD
#undef SSTORE
#undef GL1
#undef SS1
}
template <int MT, int NT>
DI void zero_acc(f32x4 (&acc)[MT][NT]) {
#pragma unroll
  for (int i = 0; i < MT; ++i)
#pragma unroll
    for (int j = 0; j < NT; ++j) acc[i][j] = f32x4{0.f, 0.f, 0.f, 0.f};
}


DI bool next_tile(int it, int RT, int CT, int PR, int PCc, int& rt, int& ct) {
  const int bid = lbid(), x = bid & 7, j = bid >> 3, J = lgdim() >> 3;
  const int u = j + it * J;
  const int pcols = CT / PCc, npatch = (RT / PR) * pcols;
  const int pid = (u >> 6) * 8 + x;
  if (pid >= npatch) return false;
  const int w = u & 63, pr = pid / pcols, pc = pid - pr * pcols;
  rt = pr * PR + w / PCc;
  ct = pc * PCc + w % PCc;
  return true;
}
DI void transpose_job(const float* __restrict__ src, int K, int N, u16* __restrict__ dst, int ldd, const float* kscale, char* smem) {
  float(*tile)[65] = (float(*)[65])smem;
  const int ntn = (N + 63) >> 6, ntk = K >> 6, tid = ltid();
  for (int t = lbid(); t < ntn * ntk; t += lgdim()) {
    const int tk = t / ntn, tn = t % ntn, k0 = tk * 64, n0 = tn * 64;
    {
      const int n = tid & 63, kb = tid >> 6;
      for (int i = 0; i < 8; ++i) {
        const int k = kb + 8 * i;
        float v = (n0 + n < N) ? src[(size_t)(k0 + k) * N + n0 + n] : 0.f;
        if (kscale) v *= kscale[k0 + k];
        tile[k][n] = v;
      }
    }
    __syncthreads();
    {
      const int n = tid >> 3, kc = tid & 7;
      if (n0 + n < N) {
        uint4 o;
        o.x = pack2(tile[kc * 8 + 0][n], tile[kc * 8 + 1][n]); o.y = pack2(tile[kc * 8 + 2][n], tile[kc * 8 + 3][n]);
        o.z = pack2(tile[kc * 8 + 4][n], tile[kc * 8 + 5][n]); o.w = pack2(tile[kc * 8 + 6][n], tile[kc * 8 + 7][n]);
        *(uint4*)(dst + (size_t)(n0 + n) * ldd + k0 + kc * 8) = o;
      }
    }
    __syncthreads();
  }
}

DI void phase0(const Params& p, char* smem) {
  const size_t gtid = (size_t)lbid() * NTHR + ltid(), gsz = (size_t)lgdim() * NTHR;
  for (int l = 0; l < 2; ++l) {
    transpose_job(p.w_in + (size_t)l * 1024 * 7120, 1024, 7120, p.win(l), KP1024, nullptr, smem);
    transpose_job(p.w_branch_a + (size_t)l * 512 * 1024, 512, 1024, p.wbra(l), KP512, nullptr, smem);
    transpose_job(p.w_branch_b + (size_t)l * 512 * 1024, 512, 1024, p.wbrb(l), KP512, nullptr, smem);
    transpose_job(p.w_o + (size_t)l * 1024 * 1024, 1024, 1024, p.wo(l), KP1024, nullptr, smem);
    transpose_job(p.w_ff1 + (size_t)l * 1024 * 4096, 1024, 4096, p.wf1(l), KP1024, nullptr, smem);
    transpose_job(p.w_ff2 + (size_t)l * 4096 * 1024, 4096, 1024, p.wf2(l), KP4096, nullptr, smem);
    transpose_job(p.c_w_qidx + (size_t)l * 256 * 512, 256, 512, p.wqx(l) + 1024 * KP256, KP256, p.c_q_norm_g + l * 256, smem);
    {
      const float* uq = p.c_w_uq + (size_t)l * 256 * 512;
      const float* uk = p.c_w_uk + (size_t)l * 128 * 512;
      const float* g = p.c_q_norm_g + l * 256;
      for (size_t e = gtid; e < 1024 * 256; e += gsz) {
        const int n = (int)(e >> 8), k = (int)(e & 255), h = n >> 7, r2 = n & 127;
        const float4* a = (const float4*)(uq + (k * 8 + h) * 64);
        const float4* b = (const float4*)(uk + (r2 * 8 + h) * 64);
        float s = 0.f;
        for (int d = 0; d < 16; ++d) { float4 x = a[d], y = b[d]; s += x.x * y.x + x.y * y.y + x.z * y.z + x.w * y.w; }
        p.wqx(l)[(size_t)n * KP256 + k] = f2bf(s * g[k]);
      }
    }
    {
      const float* uv = p.c_w_uv + (size_t)l * 128 * 512;
      const float* bc = p.w_branch_c + (size_t)l * 512 * 1024;
      for (size_t e = gtid; e < 1024 * 256; e += gsz) {
        const int k = (int)(e >> 8), n4 = (int)(e & 255) * 4, h = k >> 7, r = k & 127;
        const float* a = uv + (r * 8 + h) * 64;
        const float* b = bc + (size_t)(h * 64) * 1024 + n4;
        float4 acc4 = float4{0.f, 0.f, 0.f, 0.f};
#pragma unroll 8
        for (int d = 0; d < 64; ++d) {
          const float4 v = *(const float4*)(b + (size_t)d * 1024);
          const float ad = a[d];
          acc4.x += ad * v.x; acc4.y += ad * v.y; acc4.z += ad * v.z; acc4.w += ad * v.w;
        }
        u16* dst = p.wbrc(l) + (size_t)n4 * KP1024 + k;
        dst[0] = f2bf(acc4.x); dst[KP1024] = f2bf(acc4.y); dst[2 * KP1024] = f2bf(acc4.z); dst[3 * KP1024] = f2bf(acc4.w);
      }
    }
  }
  for (size_t e = gtid; e < (size_t)NT * 1024 / 8; e += gsz) {
    const float4 a = ((const float4*)p.x)[2 * e], b = ((const float4*)p.x)[2 * e + 1];
    uint4 o;
    o.x = pack2(a.x, a.y); o.y = pack2(a.z, a.w); o.z = pack2(b.x, b.y); o.w = pack2(b.z, b.w);
    *(uint4*)(p.XB() + (e >> 7) * LDX + (e & 127) * 8) = o;
  }
  if (gtid < 2) {
    const int l = (int)gtid;
    const float* lp = p.a_lambda + l * 256;
    float s1 = 0.f, s2 = 0.f;
    for (int i = 0; i < 64; ++i) { s1 += lp[i] * lp[64 + i]; s2 += lp[128 + i] * lp[192 + i]; }
    const float lam_init = 0.8f - 0.6f * expf(-0.3f * l);
    p.LAM()[l] = expf(s1) - expf(s2) + lam_init;
    p.LAM()[2 + l] = lam_init;
    for (int i = 0; i < 8; ++i) p.CNT()[l * 8 + i] = 0;
  }
}

DI void ln_phase(const float* S, const float* __restrict__ g, const float* __restrict__ b, u16* XBo, float* fout) {
  const int l = ltid() & 63;
  const int wave = lbid() * 8 + (ltid() >> 6), nw = lgdim() * 8;
  for (int row = wave; row < NT; row += nw) {
    float4 v[4];
    float s = 0.f;
#pragma unroll
    for (int i = 0; i < 4; ++i) { v[i] = *(const float4*)(S + (size_t)row * 1024 + i * 256 + l * 4); s += v[i].x + v[i].y + v[i].z + v[i].w; }
#pragma unroll
    for (int o = 32; o; o >>= 1) s += __shfl_xor(s, o);
    const float mu = s * (1.f / 1024.f);
    float q = 0.f;
#pragma unroll
    for (int i = 0; i < 4; ++i) { float a = v[i].x - mu, bb = v[i].y - mu, c = v[i].z - mu, d = v[i].w - mu; q += a * a + bb * bb + c * c + d * d; }
#pragma unroll
    for (int o = 32; o; o >>= 1) q += __shfl_xor(q, o);
    const float rs = rsqrtf(q * (1.f / 1024.f) + EPS);
#pragma unroll
    for (int i = 0; i < 4; ++i) {
      const int c = i * 256 + l * 4;
      const float4 gg = *(const float4*)(g + c), bb = *(const float4*)(b + c);
      float4 y;
      y.x = (v[i].x - mu) * rs * gg.x + bb.x; y.y = (v[i].y - mu) * rs * gg.y + bb.y;
      y.z = (v[i].z - mu) * rs * gg.z + bb.z; y.w = (v[i].w - mu) * rs * gg.w + bb.w;
      if (fout) *(float4*)(fout + (size_t)row * 1024 + c) = y;
      if (XBo) { uint2 o; o.x = pack2(y.x, y.y); o.y = pack2(y.z, y.w); *(uint2*)(XBo + (size_t)row * LDX + c) = o; }
    }
  }
}

#define EPI_LOOP(MT_, NT_)                                                \
  const int l_ = ltid() & 63, w_ = ltid() >> 6;                           \
  const int wm_ = w_ >> 1, wn_ = w_ & 1, fr_ = l_ & 15, fq_ = l_ >> 4;    \
  _Pragma("unroll") for (int mi = 0; mi < MT_; ++mi)                      \
  _Pragma("unroll") for (int ni = 0; ni < NT_; ++ni)

DI void phase_inproj(const Params& p, int l, char* smem) {
  int rt, ct;
  for (int it = 0; next_tile(it, 128, 16, 8, 8, rt, ct); ++it) {
    const int r0 = rt * 256, c0 = ct * 256;
    f32x4 acc[4][8];
    zero_acc<4, 8>(acc);
    gemm_core<4, 8>(p.XB() + (size_t)r0 * LDX, LDX, p.win(l) + (size_t)c0 * KP1024, KP1024, 1024, acc, smem);
    EPI_LOOP(4, 8) {
      const int row = r0 + wm_ * 64 + mi * 16 + fr_, col = c0 + wn_ * 128 + ni * 16 + fq_ * 4;
      if (col < PC) {
        uint2 o;
        o.x = pack2(acc[mi][ni][0], acc[mi][ni][1]); o.y = pack2(acc[mi][ni][2], acc[mi][ni][3]);
        *(uint2*)(p.P() + (size_t)row * PC + col) = o;
        if (col >= BQ && col < BZ && (row & 63) >= 61)
          *(uint2*)(p.HALO() + ((size_t)(row >> 6) * 3 + ((row & 63) - 61)) * 1536 + (col - BQ)) = o;
      }
    }
  }
}

DI void qx_tile(const Params& p, int l, int rt, int ct, char* smem) {
  const int r0 = rt * 256, c0 = ct * 256;
  float* rsv = (float*)(smem + 147456);
  {
    const int row = ltid() >> 1, half = ltid() & 1;
    const uint4* src = (const uint4*)(p.P() + (size_t)(r0 + row) * PC + CQ + half * 128);
    float ss = 0.f;
    for (int i = 0; i < 16; ++i) {
      uint4 v = src[i];
      float a;
      a = bflo(v.x); ss += a * a; a = bfhi(v.x); ss += a * a; a = bflo(v.y); ss += a * a; a = bfhi(v.y); ss += a * a;
      a = bflo(v.z); ss += a * a; a = bfhi(v.z); ss += a * a; a = bflo(v.w); ss += a * a; a = bfhi(v.w); ss += a * a;
    }
    ss += __shfl_xor(ss, 1);
    if (!half) rsv[row] = rsqrtf(ss * (1.f / 256.f) + EPS);
  }
  f32x4 acc[4][8];
  zero_acc<4, 8>(acc);
  gemm_core<4, 8>(p.P() + (size_t)r0 * PC + CQ, PC, p.wqx(l) + (size_t)c0 * KP256, KP256, 256, acc, smem);
  u16* QX = (u16*)p.out;
  EPI_LOOP(4, 8) {
    const int rl = wm_ * 64 + mi * 16 + fr_, col = c0 + wn_ * 128 + ni * 16 + fq_ * 4;
    const float rs = rsv[rl];
    uint2 o;
    o.x = pack2(acc[mi][ni][0] * rs, acc[mi][ni][1] * rs); o.y = pack2(acc[mi][ni][2] * rs, acc[mi][ni][3] * rs);
    *(uint2*)(QX + (size_t)(r0 + rl) * LDQ + col) = o;
  }
  __syncthreads();
}

DI void phase_merge(const Params& p, int l, char* smem) {
  const u16* QX = (const u16*)p.out;
  int rt, ct;
  for (int it = 0; next_tile(it, 128, 8, 8, 8, rt, ct); ++it) {
    const int r0 = rt * 256, c0 = ct * 128;
    bool first = true;
#pragma unroll 1
    for (int j = 0; j < 3; ++j) {
      if ((j == 0 && !EN_A) || (j == 1 && !EN_B) || (j == 2 && !EN_C)) continue;
      const u16* Ab; const u16* Wb; int lda, K;
      int ldw;
      if (j == 0) { Ab = p.P() + (size_t)r0 * PC + AQ; lda = PC; Wb = p.wbra(l) + (size_t)c0 * KP512; K = 512; ldw = KP512; }
      else if (j == 1) { Ab = p.P() + (size_t)r0 * PC + BZ; lda = PC; Wb = p.wbrb(l) + (size_t)c0 * KP512; K = 512; ldw = KP512; }
      else { Ab = QX + (size_t)r0 * LDQ; lda = LDQ; Wb = p.wbrc(l) + (size_t)c0 * KP1024; K = 1024; ldw = KP1024; }
      f32x4 g[4][4];
      zero_acc<4, 4>(g);
      gemm_core<4, 4>(p.XB() + (size_t)r0 * LDX, LDX, p.win(l) + (size_t)(GATES + j * 1024 + c0) * KP1024, KP1024, 1024, g, smem);
      const float* bg = p.b_gate + l * 3072 + j * 1024;
      {
        EPI_LOOP(4, 4) {
          const int col = c0 + wn_ * 64 + ni * 16 + fq_ * 4;
          const float4 bb = *(const float4*)(bg + col);
          g[mi][ni][0] = sigmoidf_(g[mi][ni][0] + bb.x);
          g[mi][ni][1] = sigmoidf_(g[mi][ni][1] + bb.y);
          g[mi][ni][2] = sigmoidf_(g[mi][ni][2] + bb.z);
          g[mi][ni][3] = sigmoidf_(g[mi][ni][3] + bb.w);
        }
      }
      f32x4 br[4][4];
      zero_acc<4, 4>(br);
      gemm_core<4, 4>(Ab, lda, Wb, ldw, K, br, smem);
      {
        EPI_LOOP(4, 4) {
          const int row = r0 + wm_ * 64 + mi * 16 + fr_, col = c0 + wn_ * 64 + ni * 16 + fq_ * 4;
          u16* mp = p.MERGED() + (size_t)row * LDX + col;
          float a0 = g[mi][ni][0] * br[mi][ni][0], a1 = g[mi][ni][1] * br[mi][ni][1];
          float a2 = g[mi][ni][2] * br[mi][ni][2], a3 = g[mi][ni][3] * br[mi][ni][3];
          if (!first) {
            const uint2 old = *(const uint2*)mp;
            a0 += bflo(old.x); a1 += bfhi(old.x); a2 += bflo(old.y); a3 += bfhi(old.y);
          }
          uint2 o;
          o.x = pack2(a0, a1); o.y = pack2(a2, a3);
          *(uint2*)mp = o;
        }
      }
      first = false;
    }
  }
}

DI void phase_resgemm(const Params& p, const u16* A, int lda, const u16* W, int ldw, int K, char* smem) {
  int rt, ct;
  for (int it = 0; next_tile(it, 128, 4, 16, 4, rt, ct); ++it) {
    const int r0 = rt * 256, c0 = ct * 256;
    f32x4 acc[4][8];
    zero_acc<4, 8>(acc);
    gemm_core<4, 8>(A + (size_t)r0 * lda, lda, W + (size_t)c0 * ldw, ldw, K, acc, smem);
    EPI_LOOP(4, 8) {
      const int row = r0 + wm_ * 64 + mi * 16 + fr_, col = c0 + wn_ * 128 + ni * 16 + fq_ * 4;
      const uint2 xb = *(const uint2*)(p.XB() + (size_t)row * LDX + col);
      float4 o;
      o.x = DN_ALPHA * bflo(xb.x) + acc[mi][ni][0]; o.y = DN_ALPHA * bfhi(xb.x) + acc[mi][ni][1];
      o.z = DN_ALPHA * bflo(xb.y) + acc[mi][ni][2]; o.w = DN_ALPHA * bfhi(xb.y) + acc[mi][ni][3];
      *(float4*)(p.out + (size_t)row * 1024 + col) = o;
    }
  }
}

DI void phase_ff1(const Params& p, int l, char* smem) {
  int rt, ct;
  for (int it = 0; next_tile(it, 128, 16, 8, 8, rt, ct); ++it) {
    const int r0 = rt * 256, c0 = ct * 256;
    f32x4 acc[4][8];
    zero_acc<4, 8>(acc);
    gemm_core<4, 8>(p.XB() + (size_t)r0 * LDX, LDX, p.wf1(l) + (size_t)c0 * KP1024, KP1024, 1024, acc, smem);
    EPI_LOOP(4, 8) {
      const int row = r0 + wm_ * 64 + mi * 16 + fr_, col = c0 + wn_ * 128 + ni * 16 + fq_ * 4;
      float a0 = fmaxf(acc[mi][ni][0], 0.f), a1 = fmaxf(acc[mi][ni][1], 0.f), a2 = fmaxf(acc[mi][ni][2], 0.f), a3 = fmaxf(acc[mi][ni][3], 0.f);
      uint2 o;
      o.x = pack2(a0 * a0, a1 * a1); o.y = pack2(a2 * a2, a3 * a3);
      *(uint2*)(p.P() + (size_t)row * LDH + col) = o;
    }
  }
}

DI void dsa_kprep_item(const Params& p, int l, int it) {
  const int ln = ltid() & 63, w = ltid() >> 6;
  const float g0 = p.c_kv_norm_g[l * 128 + 2 * ln], g1 = p.c_kv_norm_g[l * 128 + 2 * ln + 1];
  const float kg = p.c_kidx_g[l * 64 + ln], kb = p.c_kidx_b[l * 64 + ln];
  for (int i = 0; i < 8; ++i) {
    const size_t tok = (size_t)it * 64 + w * 8 + i;
    const u16* pr = p.P() + tok * PC;
    const u32 v = *(const u32*)(pr + CKVc + 2 * ln);
    const float a = bflo(v), b = bfhi(v);
    float ss = a * a + b * b;
#pragma unroll
    for (int o = 32; o; o >>= 1) ss += __shfl_xor(ss, o);
    const float rs = rsqrtf(ss * (1.f / 128.f) + EPS);
    *(u32*)(p.CKV() + tok * 128 + 2 * ln) = pack2(a * rs * g0, b * rs * g1);
    const float k = bf2f(pr[CKI + ln]);
    float s = k;
#pragma unroll
    for (int o = 32; o; o >>= 1) s += __shfl_xor(s, o);
    const float mu = s * (1.f / 64.f);
    float q = (k - mu) * (k - mu);
#pragma unroll
    for (int o = 32; o; o >>= 1) q += __shfl_xor(q, o);
    p.KIDX()[tok * 64 + ln] = f2bf((k - mu) * rsqrtf(q * (1.f / 64.f) + EPS) * kg + kb);
    if (ln < 8) p.WIDX()[tok * 8 + ln] = bf2f(pr[CWI + ln]) * 0.04419417382f;
  }
}

DI void gdn_prep_item(const Params& p, int l, int it, char* smem0) {
  const int half_ = ltid() >> 8;
  const int cidx = it >> 1, h = (it & 1) * 2 + half_, n = cidx & 255;
  const size_t t0g = (size_t)cidx * 64;
  char* smem = smem0 + half_ * 69632;
  const int tid = ltid() & 255, ln = tid & 63, w = tid >> 6;
  char* qs = smem;
  char* ks = smem + 17408;
  char* vs = smem + 2 * 17408;
  float* Lm = (float*)(smem + 3 * 17408);
  float* gcs = Lm + 4096;
  float* bts = gcs + 64;
  float* egs = bts + 64;
  u16* proj = p.P();
  {
    const int c = tid & 127, rh = tid >> 7;
    uint4 st[12];
#pragma unroll
    for (int part = 0; part < 3; ++part)
#pragma unroll
      for (int i = 0; i < 4; ++i) {
        const int piece = tid + 256 * i, row = piece >> 4, ch = piece & 15;
        st[part * 4 + i] = *(const uint4*)(proj + (t0g + row) * PC + BQ + part * 512 + h * 128 + ch * 8);
      }
    float hx[9];
#pragma unroll
    for (int i = 0; i < 9; ++i) hx[i] = 0.f;
    if (rh == 0 && n != 0) {
#pragma unroll
      for (int part = 0; part < 3; ++part) {
        const u16* hp = p.HALO() + ((size_t)(cidx - 1) * 3) * 1536 + part * 512 + h * 128 + c;
        hx[part * 3 + 0] = bf2f(hp[0]); hx[part * 3 + 1] = bf2f(hp[1536]); hx[part * 3 + 2] = bf2f(hp[2 * 1536]);
      }
    }
#pragma unroll
    for (int part = 0; part < 3; ++part)
#pragma unroll
      for (int i = 0; i < 4; ++i) {
        const int piece = tid + 256 * i, row = piece >> 4, ch = piece & 15;
        char* dst = (part == 0 ? qs : (part == 1 ? ks : vs));
        *(uint4*)(dst + row * 272 + ch * 16) = st[part * 4 + i];
      }
    __syncthreads();
    if (rh == 1) {
#pragma unroll
      for (int part = 0; part < 3; ++part) {
        const char* src = (part == 0 ? qs : (part == 1 ? ks : vs));
        hx[part * 3 + 0] = bf2f(*(const u16*)(src + 29 * 272 + c * 2));
        hx[part * 3 + 1] = bf2f(*(const u16*)(src + 30 * 272 + c * 2));
        hx[part * 3 + 2] = bf2f(*(const u16*)(src + 31 * 272 + c * 2));
      }
    }
    __syncthreads();
#pragma unroll
    for (int part = 0; part < 3; ++part) {
      const int wch = part * 512 + h * 128 + c;
      const float* cw = p.b_conv_w + (size_t)l * 4 * 1536 + wch;
      const float w0 = cw[0], w1 = cw[1536], w2 = cw[2 * 1536], w3 = cw[3 * 1536];
      float xm3 = hx[part * 3 + 0], xm2 = hx[part * 3 + 1], xm1 = hx[part * 3 + 2];
      char* dst = (part == 0 ? qs : (part == 1 ? ks : vs));
#pragma unroll 8
      for (int i = 0; i < 32; ++i) {
        const int r = rh * 32 + i;
        u16* px = (u16*)(dst + r * 272 + c * 2);
        const float x = bf2f(*px);
        const float y = w0 * xm3 + w1 * xm2 + w2 * xm1 + w3 * x;
        xm3 = xm2; xm2 = xm1; xm1 = x;
        *px = f2bf(siluf_(y));
      }
    }
  }
  if (w == 0) {
    const float a = bf2f(proj[(t0g + ln) * PC + BA + h]) + p.b_dt_bias[l * 4 + h];
    const float ea = __expf(a);
    const float sp = (a > 20.f) ? a : ((ea < 0.01f) ? ea * (1.f - ea * (0.5f - ea * 0.333333333f)) : __logf(1.f + ea));
    float g = -__expf(p.b_a_log[l * 4 + h]) * sp;
#pragma unroll
    for (int o = 1; o < 64; o <<= 1) { float t = __shfl_up(g, o); if (ln >= o) g += t; }
    gcs[ln] = g;
    egs[ln] = __expf(g);
    bts[ln] = sigmoidf_(bf2f(proj[(t0g + ln) * PC + BB + h]));
  }
  __syncthreads();
  {
    const int row = tid >> 2, qr = tid & 3;
#pragma unroll
    for (int part = 0; part < 2; ++part) {
      char* base = (part == 0 ? qs : ks) + row * 272 + qr * 64;
      uint4 v[4];
      float ss = 0.f;
#pragma unroll
      for (int i = 0; i < 4; ++i) {
        v[i] = *(uint4*)(base + i * 16);
        float a;
        a = bflo(v[i].x); ss += a * a; a = bfhi(v[i].x); ss += a * a; a = bflo(v[i].y); ss += a * a; a = bfhi(v[i].y); ss += a * a;
        a = bflo(v[i].z); ss += a * a; a = bfhi(v[i].z); ss += a * a; a = bflo(v[i].w); ss += a * a; a = bfhi(v[i].w); ss += a * a;
      }
      ss += __shfl_xor(ss, 1);
      ss += __shfl_xor(ss, 2);
      const float rs = rsqrtf(ss + EPS) * (part == 0 ? 0.08838834764f : 1.f);
#pragma unroll
      for (int i = 0; i < 4; ++i) {
        uint4 o;
        o.x = pack2(bflo(v[i].x) * rs, bfhi(v[i].x) * rs); o.y = pack2(bflo(v[i].y) * rs, bfhi(v[i].y) * rs);
        o.z = pack2(bflo(v[i].z) * rs, bfhi(v[i].z) * rs); o.w = pack2(bflo(v[i].w) * rs, bfhi(v[i].w) * rs);
        *(uint4*)(base + i * 16) = o;
      }
    }
  }
  __syncthreads();
  {
    const int fr = ln & 15, fq = ln >> 4;
    f32x4 kk[4], qk[4];
#pragma unroll
    for (int nt = 0; nt < 4; ++nt) { kk[nt] = f32x4{0, 0, 0, 0}; qk[nt] = f32x4{0, 0, 0, 0}; }
#pragma unroll
    for (int s = 0; s < 4; ++s) {
      const bf16x8 ak = *(const bf16x8*)(ks + (16 * w + fr) * 272 + (32 * s + 8 * fq) * 2);
      const bf16x8 aq = *(const bf16x8*)(qs + (16 * w + fr) * 272 + (32 * s + 8 * fq) * 2);
#pragma unroll
      for (int nt = 0; nt < 4; ++nt) {
        const bf16x8 bk = *(const bf16x8*)(ks + (16 * nt + fr) * 272 + (32 * s + 8 * fq) * 2);
        kk[nt] = mfma16(ak, bk, kk[nt]);
        qk[nt] = mfma16(aq, bk, qk[nt]);
      }
    }
#pragma unroll
    for (int nt = 0; nt < 4; ++nt)
#pragma unroll
      for (int jj = 0; jj < 4; ++jj) {
        const int i = 16 * w + 4 * fq + jj, j = 16 * nt + fr;
        const float dec = (i >= j) ? __expf(gcs[i] - gcs[j]) : 0.f;
        Lm[i * 64 + j] = (i > j) ? bts[i] * kk[nt][jj] * dec : 0.f;
        p.ATT()[(t0g + i) * 256 + h * 64 + j] = f2bf((i >= j) ? qk[nt][jj] * dec : 0.f);
      }
  }
  __syncthreads();
  {
    const int c = tid;
    const bool isu = c < 128;
    const char* src = isu ? (vs + c * 2) : (ks + (c - 128) * 2);
    const float wsel = isu ? 0.f : 1.f;
    float x[64];
#pragma unroll
    for (int i = 0; i < 64; ++i) {
      float a = bf2f(*(const u16*)(src + i * 272)) * bts[i] * fmaf(egs[i] - 1.f, wsel, 1.f);
      const float* Lr = Lm + i * 64;
#pragma unroll
      for (int j = 0; j < i; ++j) a -= Lr[j] * x[j];
      x[i] = a;
      asm volatile("" ::: "memory");
    }
    if (isu) {
      u32 pk[32];
#pragma unroll
      for (int pos = 0; pos < 64; pos += 2) {
        const int hh = pos >> 5, Tt = (pos >> 4) & 1, ii = pos & 15;
        const int r0 = 32 * Tt + (ii & 3) + 8 * (ii >> 2) + 4 * hh;
        const int i1 = ii + 1;
        const int r1 = 32 * Tt + (i1 & 3) + 8 * (i1 >> 2) + 4 * hh;
        pk[pos >> 1] = pack2(x[r0], x[r1]);
      }
      char* dst = (char*)proj + ((t0g + (c >> 1)) * PC + BV + h * 128) * 2 + (c & 1) * 128;
#pragma unroll
      for (int i = 0; i < 8; ++i) *(uint4*)(dst + i * 16) = uint4{pk[4 * i], pk[4 * i + 1], pk[4 * i + 2], pk[4 * i + 3]};
    } else {
#pragma unroll
      for (int i = 0; i < 64; ++i) proj[(t0g + i) * PC + BK_ + h * 128 + (c - 128)] = f2bf(x[i]);
    }
  }
  {
    const float glast = gcs[63];
#pragma unroll
    for (int i = 0; i < 4; ++i) {
      const int piece = tid + 256 * i, row = piece >> 4, ch = piece & 15;
      const uint4 v = *(const uint4*)(qs + row * 272 + ch * 16);
      const float e = egs[row];
      uint4 o;
      o.x = pack2(bflo(v.x) * e, bfhi(v.x) * e); o.y = pack2(bflo(v.y) * e, bfhi(v.y) * e);
      o.z = pack2(bflo(v.z) * e, bfhi(v.z) * e); o.w = pack2(bflo(v.w) * e, bfhi(v.w) * e);
      *(uint4*)(proj + (t0g + row) * PC + BQ + h * 128 + ch * 8) = o;
    }
    const int d = tid & 127, half = tid >> 7;
    u32 pk[16];
#pragma unroll
    for (int i = 0; i < 16; ++i) {
      const int r0 = half * 32 + 2 * i;
      const float a = bf2f(*(const u16*)(ks + r0 * 272 + d * 2)) * __expf(glast - gcs[r0]);
      const float b = bf2f(*(const u16*)(ks + (r0 + 1) * 272 + d * 2)) * __expf(glast - gcs[r0 + 1]);
      pk[i] = pack2(a, b);
    }
    u16* dst = p.KDT() + (((size_t)cidx * 4 + h) * 128 + d) * 64 + half * 32;
#pragma unroll
    for (int i = 0; i < 4; ++i) *(uint4*)(dst + i * 8) = uint4{pk[4 * i], pk[4 * i + 1], pk[4 * i + 2], pk[4 * i + 3]};
    if (tid == 0) p.GL()[cidx * 4 + h] = egs[63];
  }
  __syncthreads();
}

DI void gdn_rec_item(const Params& p, int l, int bh, char* smem, bool wr) {
  const int b = bh >> 2, h = bh & 3;
  const int tid = ltid(), ln = tid & 63, w = tid >> 6, hh = ln >> 5, c31 = ln & 31;
  const bool is_comp = w < 4;
  constexpr int BUFB = 59904;
  float* Ot = (float*)(smem + 2 * BUFB);
  u16* proj = p.P();
  const float* ng = p.b_norm_g + l * 128;
  const int lt = tid & 255;
#define LD_AQ(i, n_)                                                                                      \
  {                                                                                                       \
    const size_t t0g_ = ((size_t)b * 256 + (n_)) * 64;                                                    \
    const int piece = ltv + 256 * i, row = piece >> 4, ch = piece & 15;                                   \
    la##i = *(const uint4*)(proj + (t0g_ + row) * PC + BK_ + h * 128 + ch * 8);                           \
    lq##i = *(const uint4*)(proj + (t0g_ + row) * PC + BQ + h * 128 + ch * 8);                            \
  }
#define LD_K(i, n_)                                                                                       \
  {                                                                                                       \
    const int piece = ltv + 256 * i, row2 = piece >> 3, ch2 = piece & 7;                                  \
    lk##i = *(const uint4*)(p.KDT() + ((((size_t)b * 256 + (n_)) * 4 + h) * 128 + row2) * 64 + ch2 * 8);  \
  }
#define LD_T(i, n_)                                                                                       \
  {                                                                                                       \
    const size_t t0g_ = ((size_t)b * 256 + (n_)) * 64;                                                    \
    const int piece = ltv + 256 * i, row = piece >> 3, ch = piece & 7;                                     \
    lt##i = *(const uint4*)(p.ATT() + (t0g_ + row) * 256 + h * 64 + ch * 8);                              \
  }
#define LD_R1(n_) { LD_AQ(0, n_) LD_AQ(1, n_) LD_AQ(2, n_) LD_AQ(3, n_) }
#define LD_R2(n_) { LD_K(0, n_) LD_K(1, n_) LD_K(2, n_) LD_K(3, n_) LD_T(0, n_) LD_T(1, n_) }
#define ST_AQ(i, buf_)                                                                                    \
  {                                                                                                       \
    char* Wm_ = smem + (buf_) * BUFB; char* Qd_ = Wm_ + 16896;                                            \
    const int piece = ltv + 256 * i, row = piece >> 4, ch = piece & 15;                                   \
    *(uint2*)(Wm_ + row * 264 + ch * 16) = uint2{la##i.x, la##i.y}; *(uint2*)(Wm_ + row * 264 + ch * 16 + 8) = uint2{la##i.z, la##i.w}; \
    *(uint2*)(Qd_ + row * 264 + ch * 16) = uint2{lq##i.x, lq##i.y}; *(uint2*)(Qd_ + row * 264 + ch * 16 + 8) = uint2{lq##i.z, lq##i.w}; \
  }
#define ST_K(i, buf_)                                                                                     \
  {                                                                                                       \
    char* Kt_ = smem + (buf_) * BUFB + 2 * 16896;                                                         \
    const int piece = ltv + 256 * i, row2 = piece >> 3, ch2 = piece & 7;                                  \
    *(uint2*)(Kt_ + row2 * 136 + ch2 * 16) = uint2{lk##i.x, lk##i.y}; *(uint2*)(Kt_ + row2 * 136 + ch2 * 16 + 8) = uint2{lk##i.z, lk##i.w}; \
  }
#define ST_T(i, buf_)                                                                                     \
  {                                                                                                       \
    char* At_ = smem + (buf_) * BUFB + 2 * 16896 + 17408;                                                 \
    const int piece = ltv + 256 * i, row = piece >> 3, ch = piece & 7;                                     \
    *(uint2*)(At_ + row * 136 + ch * 16) = uint2{lt##i.x, lt##i.y}; *(uint2*)(At_ + row * 136 + ch * 16 + 8) = uint2{lt##i.z, lt##i.w}; \
  }
#define ST_R1(buf_) { ST_AQ(0, buf_) ST_AQ(1, buf_) ST_AQ(2, buf_) ST_AQ(3, buf_) }
#define ST_R2(buf_) { ST_K(0, buf_) ST_K(1, buf_) ST_K(2, buf_) ST_K(3, buf_) ST_T(0, buf_) ST_T(1, buf_) }
#define LD_Z(n_)                                                                                          \
  {                                                                                                       \
    const u16* zp_ = proj + (((size_t)b * 256 + (n_)) * 64 + nrow) * PC + BZ + h * 128 + nqr * 32;        \
    lz0 = *(const uint4*)(zp_); lz1 = *(const uint4*)(zp_ + 8); lz2 = *(const uint4*)(zp_ + 16); lz3 = *(const uint4*)(zp_ + 24); \
  }
  f32x16 S[4];
#pragma unroll
  for (int i = 0; i < 4; ++i)
#pragma unroll
    for (int j = 0; j < 16; ++j) S[i][j] = 0.f;
  const int e = 32 * w + c31;
  uint4 un0, un1, un2, un3;
  float gln = 0.f;
#define LD_U(n_)                                                                                          \
  {                                                                                                       \
    const uint4* up_ = (const uint4*)((const char*)proj + ((((size_t)b * 256 + (n_)) * 64 + (e >> 1)) * PC + BV + h * 128) * 2 + (e & 1) * 128 + hh * 64); \
    un0 = up_[0]; un1 = up_[1]; un2 = up_[2]; un3 = up_[3];                                               \
    gln = p.GL()[((size_t)b * 256 + (n_)) * 4 + h];                                                       \
  }
  if (!is_comp) {
    const int ltv = lt;
    uint4 la0, la1, la2, la3, lq0, lq1, lq2, lq3, lk0, lk1, lk2, lk3, lt0, lt1;
    LD_R1(0) LD_R2(0)
    ST_R1(0) ST_R2(0)
  } else {
    LD_U(0)
  }
  for (int n = 0; n < 256; ++n) {
    f32x16 o[2];
    __syncthreads();
    if (is_comp) {
      int lnv = ln;
      asm volatile("" : "+v"(lnv));
      const int hh = lnv >> 5, c31 = lnv & 31;
      const char* Wm = smem + (n & 1) * BUFB;
      const char* Qd = Wm + 16896;
      const char* Kt = Wm + 2 * 16896;
      const char* At = Kt + 17408;
      f32x16 ws[2];
#pragma unroll
      for (int i = 0; i < 2; ++i)
#pragma unroll
        for (int j = 0; j < 16; ++j) { ws[i][j] = 0.f; o[i][j] = 0.f; }
#pragma unroll
      for (int Tt = 0; Tt < 4; ++Tt)
#pragma unroll
        for (int s = 0; s < 2; ++s) {
          const int kb = 32 * Tt + 16 * s;
          const bf16x8 sps = pack8(S[Tt], s);
#pragma unroll
          for (int Tc = 0; Tc < 2; ++Tc) {
            ws[Tc] = mfma32(afrag_perm(Wm, 32 * Tc + c31, 264, kb, hh), sps, ws[Tc]);
            o[Tc] = mfma32(afrag_perm(Qd, 32 * Tc + c31, 264, kb, hh), sps, o[Tc]);
          }
        }
      f32x16 vn[2];
      vn[0][0] = bflo(un0.x) - ws[0][0]; vn[0][1] = bfhi(un0.x) - ws[0][1]; vn[0][2] = bflo(un0.y) - ws[0][2]; vn[0][3] = bfhi(un0.y) - ws[0][3];
      vn[0][4] = bflo(un0.z) - ws[0][4]; vn[0][5] = bfhi(un0.z) - ws[0][5]; vn[0][6] = bflo(un0.w) - ws[0][6]; vn[0][7] = bfhi(un0.w) - ws[0][7];
      vn[0][8] = bflo(un1.x) - ws[0][8]; vn[0][9] = bfhi(un1.x) - ws[0][9]; vn[0][10] = bflo(un1.y) - ws[0][10]; vn[0][11] = bfhi(un1.y) - ws[0][11];
      vn[0][12] = bflo(un1.z) - ws[0][12]; vn[0][13] = bfhi(un1.z) - ws[0][13]; vn[0][14] = bflo(un1.w) - ws[0][14]; vn[0][15] = bfhi(un1.w) - ws[0][15];
      vn[1][0] = bflo(un2.x) - ws[1][0]; vn[1][1] = bfhi(un2.x) - ws[1][1]; vn[1][2] = bflo(un2.y) - ws[1][2]; vn[1][3] = bfhi(un2.y) - ws[1][3];
      vn[1][4] = bflo(un2.z) - ws[1][4]; vn[1][5] = bfhi(un2.z) - ws[1][5]; vn[1][6] = bflo(un2.w) - ws[1][6]; vn[1][7] = bfhi(un2.w) - ws[1][7];
      vn[1][8] = bflo(un3.x) - ws[1][8]; vn[1][9] = bfhi(un3.x) - ws[1][9]; vn[1][10] = bflo(un3.y) - ws[1][10]; vn[1][11] = bfhi(un3.y) - ws[1][11];
      vn[1][12] = bflo(un3.z) - ws[1][12]; vn[1][13] = bfhi(un3.z) - ws[1][13]; vn[1][14] = bflo(un3.w) - ws[1][14]; vn[1][15] = bfhi(un3.w) - ws[1][15];
      const float gl = gln;
      if (n + 1 < 256) LD_U(n + 1)
      bf16x8 vp[2][2];
#pragma unroll
      for (int Tc = 0; Tc < 2; ++Tc) { vp[Tc][0] = pack8(vn[Tc], 0); vp[Tc][1] = pack8(vn[Tc], 1); }
#pragma unroll
      for (int s = 0; s < 2; ++s) {
        o[0] = mfma32(afrag_perm(At, c31, 136, 16 * s, hh), vp[0][s], o[0]);
        o[1] = mfma32(afrag_perm(At, 32 + c31, 136, 16 * s, hh), vp[0][s], o[1]);
        o[1] = mfma32(afrag_perm(At, 32 + c31, 136, 32 + 16 * s, hh), vp[1][s], o[1]);
      }
#pragma unroll
      for (int Tt = 0; Tt < 4; ++Tt)
#pragma unroll
        for (int j = 0; j < 16; ++j) S[Tt][j] *= gl;
#pragma unroll
      for (int Tc = 0; Tc < 2; ++Tc)
#pragma unroll
        for (int s = 0; s < 2; ++s)
#pragma unroll
          for (int Tt = 0; Tt < 4; ++Tt)
            S[Tt] = mfma32(afrag_perm(Kt, 32 * Tt + c31, 136, 32 * Tc + 16 * s, hh), vp[Tc][s], S[Tt]);
    } else {
      int ltv = lt;
      asm volatile("" : "+v"(ltv));
      const int nrow = ltv >> 2, nqr = ltv & 3;
      const int nn = (n + 1 < 256) ? n + 1 : 255;
      {
        uint4 la0, la1, la2, la3, lq0, lq1, lq2, lq3;
        LD_R1(nn)
        ST_R1((n + 1) & 1)
      }
      uint4 lz0, lz1, lz2, lz3;
      {
        uint4 lk0, lk1, lk2, lk3, lt0, lt1;
        LD_R2(nn)
        const int nz = (n > 0) ? n - 1 : 0;
        LD_Z(nz)
        ST_R2((n + 1) & 1)
      }
      if (n > 0) {
        const float* orow = Ot + nrow * 132 + nqr * 32;
        float ss = 0.f;
#pragma unroll
        for (int i = 0; i < 8; ++i) {
          const float4 v = *(const float4*)(orow + 4 * i);
          ss += v.x * v.x + v.y * v.y + v.z * v.z + v.w * v.w;
        }
        ss += __shfl_xor(ss, 1);
        ss += __shfl_xor(ss, 2);
        const float rs = rsqrtf(ss * (1.f / 128.f) + EPS);
        u16* zp = proj + (((size_t)b * 256 + (n - 1)) * 64 + nrow) * PC + BZ + h * 128 + nqr * 32;
        const float* gg = ng + nqr * 32;
#define GN1(i, Z)                                                                                          \
        {                                                                                                  \
          const float4 oa = *(const float4*)(orow + 8 * i), ob = *(const float4*)(orow + 8 * i + 4);       \
          uint4 r;                                                                                         \
          r.x = pack2(oa.x * rs * gg[8 * i + 0] * siluf_(bflo(Z.x)), oa.y * rs * gg[8 * i + 1] * siluf_(bfhi(Z.x))); \
          r.y = pack2(oa.z * rs * gg[8 * i + 2] * siluf_(bflo(Z.y)), oa.w * rs * gg[8 * i + 3] * siluf_(bfhi(Z.y))); \
          r.z = pack2(ob.x * rs * gg[8 * i + 4] * siluf_(bflo(Z.z)), ob.y * rs * gg[8 * i + 5] * siluf_(bfhi(Z.z))); \
          r.w = pack2(ob.z * rs * gg[8 * i + 6] * siluf_(bflo(Z.w)), ob.w * rs * gg[8 * i + 7] * siluf_(bfhi(Z.w))); \
          if (wr) *(uint4*)(zp + 8 * i) = r;                                                               \
        }
        GN1(0, lz0) GN1(1, lz1) GN1(2, lz2) GN1(3, lz3)
      }
    }
    __syncthreads();
    if (is_comp) {
#pragma unroll
      for (int Tc = 0; Tc < 2; ++Tc)
#pragma unroll
        for (int j = 0; j < 16; ++j) Ot[(32 * Tc + crow(j, hh)) * 132 + e] = o[Tc][j];
    }
  }
  __syncthreads();
  if (!is_comp) {
    const int n = 256;
    const int nrow = lt >> 2, nqr = lt & 3;
    uint4 lz0, lz1, lz2, lz3;
    LD_Z(255)
    const float* orow = Ot + nrow * 132 + nqr * 32;
    float ss = 0.f;
#pragma unroll
    for (int i = 0; i < 8; ++i) {
      const float4 v = *(const float4*)(orow + 4 * i);
      ss += v.x * v.x + v.y * v.y + v.z * v.z + v.w * v.w;
    }
    ss += __shfl_xor(ss, 1);
    ss += __shfl_xor(ss, 2);
    const float rs = rsqrtf(ss * (1.f / 128.f) + EPS);
    u16* zp = proj + (((size_t)b * 256 + (n - 1)) * 64 + nrow) * PC + BZ + h * 128 + nqr * 32;
    const float* gg = ng + nqr * 32;
    GN1(0, lz0) GN1(1, lz1) GN1(2, lz2) GN1(3, lz3)
  }
#undef GN1
#undef LD_AQ
#undef LD_K
#undef LD_R1
#undef LD_R2
#undef LD_T
#undef ST_AQ
#undef ST_K
#undef ST_R1
#undef ST_R2
#undef ST_T
#undef LD_Z
#undef LD_U
  __syncthreads();
}

DI void diff_item(const Params& p, int l, int qt, int bh, char* smem) {
  const int b = bh >> 2, h = bh & 3;
  const int tid = ltid(), ln = tid & 63, w = tid >> 6, hh = ln >> 5, c31 = ln & 31;
  const int st = w & 3, c = w >> 2;
  const size_t tokbase = (size_t)b * T;
  const int qb = qt * 128 + 32 * st + c31;
  u16* proj = p.P();
  bf16x8 qf[4];
  {
    const u16* qrow = proj + (tokbase + qb) * PC + AQ + h * 128 + c * 64 + 8 * hh;
#pragma unroll
    for (int s = 0; s < 4; ++s) {
      const bf16x8 q = *(const bf16x8*)(qrow + 16 * s);
      typedef __bf16 bf16v8q_ __attribute__((ext_vector_type(8)));
      bf16v8q_ v;
#pragma unroll
      for (int j = 0; j < 8; ++j) v[j] = (__bf16)(bf2f((u16)q[j]) * (0.125f * 1.44269504089f));
      qf[s] = __builtin_bit_cast(bf16x8, v);
    }
  }
  f32x16 O[4];
  float mrun, lrun;
  f32x16 Lacc;
  bf16x8 onesf;
  {
    const short o1 = (c31 == 0) ? (short)0x3F80 : (short)0;
    onesf = bf16x8{o1, o1, o1, o1, o1, o1, o1, o1};
  }
  const bf16x8 onesK = (hh == 0) ? bf16x8{(short)0x3F80, 0, 0, 0, 0, 0, 0, 0} : bf16x8{0, 0, 0, 0, 0, 0, 0, 0};
  bf16x8 mfrag = bf16x8{0, 0, 0, 0, 0, 0, 0, 0};
  const float sc = 0.125f * 1.44269504089f;
  char* Ks = smem;
  char* Vs = smem + 17408;
  uint4 rk0, rk1, rv0, rv1;
  const int srow = tid >> 4, sch = tid & 15;
#define DLOAD1(i, kt)                                                                \
  {                                                                                  \
    const u16* base = proj + (tokbase + (kt) * 64 + srow + 32 * i) * PC + h * 128 + sch * 8; \
    rk##i = *(const uint4*)(base + AK);                                              \
    rv##i = *(const uint4*)(base + AV);                                              \
  }
#define DLOAD(kt) { DLOAD1(0, kt) DLOAD1(1, kt) }
#define DSTORE1(i)                                                \
  *(uint4*)(Ks + (srow + 32 * i) * 272 + sch * 16) = rk##i;       \
  *(uint4*)(Vs + (srow + 32 * i) * 320 + sch * 16) = rv##i;
  const int nkt = 2 * qt + 2;
#pragma unroll 1
  for (int rep = 0; rep < DUP_DIFF; ++rep) {
#pragma unroll
  for (int i = 0; i < 4; ++i)
#pragma unroll
    for (int j = 0; j < 16; ++j) O[i][j] = 0.f;
  mrun = 0.f; lrun = 0.f;
  mfrag = bf16x8{0, 0, 0, 0, 0, 0, 0, 0};
#pragma unroll
  for (int j = 0; j < 16; ++j) Lacc[j] = 0.f;
  DLOAD(0);
  for (int kt = 0; kt < nkt; ++kt) {
    __syncthreads();
    DSTORE1(0) DSTORE1(1)
    __syncthreads();
    if (kt + 1 < nkt) { DLOAD(kt + 1); }
    if (kt * 64 > qt * 128 + 32 * st + 31) continue;
    f32x16 sa[2];
#pragma unroll
    for (int k2 = 0; k2 < 2; ++k2) {
#pragma unroll
      for (int j = 0; j < 16; ++j) sa[k2][j] = 0.f;
#pragma unroll
      for (int s = 0; s < 4; ++s)
        sa[k2] = mfma32(*(const bf16x8*)(Ks + (32 * k2 + c31) * 272 + (c * 64 + 16 * s + 8 * hh) * 2), qf[s], sa[k2]);
      sa[k2] = mfma32(onesK, mfrag, sa[k2]);
    }
    if (kt >= 2 * qt) {
#pragma unroll
      for (int k2 = 0; k2 < 2; ++k2)
#pragma unroll
        for (int j = 0; j < 16; ++j)
          if (kt * 64 + 32 * k2 + crow(j, hh) > qb) sa[k2][j] = -INFINITY;
    }
    float tmax = sa[0][0];
#pragma unroll
    for (int k2 = 0; k2 < 2; ++k2)
#pragma unroll
      for (int j = 0; j < 16; ++j) tmax = fmaxf(tmax, sa[k2][j]);
    tmax = xhalf_max(tmax);
    if (__any(tmax > 8.f)) {
      const float mnew = bf2f(f2bf(mrun + fmaxf(tmax, 0.f)));
      const float delta = mnew - mrun;
      const float alpha = __builtin_amdgcn_exp2f(-delta);
      mrun = mnew;
      {
        const short mb = (hh == 0) ? (short)f2bf(-mnew) : (short)0;
        mfrag = bf16x8{mb, 0, 0, 0, 0, 0, 0, 0};
      }
#pragma unroll
      for (int k2 = 0; k2 < 2; ++k2)
#pragma unroll
        for (int j = 0; j < 16; ++j) sa[k2][j] -= delta;
#pragma unroll
      for (int j = 0; j < 16; ++j) Lacc[j] *= alpha;
#pragma unroll
      for (int i = 0; i < 4; ++i)
#pragma unroll
        for (int j = 0; j < 16; ++j) O[i][j] *= alpha;
    }
#pragma unroll
    for (int k2 = 0; k2 < 2; ++k2)
#pragma unroll
      for (int j = 0; j < 16; ++j) sa[k2][j] = __builtin_amdgcn_exp2f(sa[k2][j]);
#pragma unroll
    for (int k2 = 0; k2 < 2; ++k2)
#pragma unroll
      for (int s2 = 0; s2 < 2; ++s2) {
        const bf16x8 pp = pack8(sa[k2], s2);
        bf16x8 vf[4];
        trfrag4<320>(Vs, 32 * k2 + 16 * s2, ln, vf);
#pragma unroll
        for (int mt = 0; mt < 4; ++mt) O[mt] = mfma32(vf[mt], pp, O[mt]);
        Lacc = mfma32(onesf, pp, Lacc);
      }
  }
  }
#undef DLOAD
#undef DLOAD1
#undef DSTORE1
  __syncthreads();
  lrun = Lacc[0];
  const float ltot = xhalf_sum(lrun);
  const float inv = 1.f / ltot;
  float* xch = (float*)smem + st * 32 * 132;
  if (c == 1) {
#pragma unroll
    for (int mt = 0; mt < 4; ++mt)
#pragma unroll
      for (int i4 = 0; i4 < 4; ++i4)
        *(float4*)(xch + c31 * 132 + 32 * mt + 8 * i4 + 4 * hh) =
            float4{O[mt][4 * i4] * inv, O[mt][4 * i4 + 1] * inv, O[mt][4 * i4 + 2] * inv, O[mt][4 * i4 + 3] * inv};
  }
  __syncthreads();
  if (c == 0) {
    const float lam = p.LAM()[l], oml = 1.f - p.LAM()[2 + l];
    float ss = 0.f;
#pragma unroll
    for (int mt = 0; mt < 4; ++mt)
#pragma unroll
      for (int i4 = 0; i4 < 4; ++i4) {
        const float4 o1 = *(const float4*)(xch + c31 * 132 + 32 * mt + 8 * i4 + 4 * hh);
        float d;
        d = O[mt][4 * i4] * inv - lam * o1.x; O[mt][4 * i4] = d; ss += d * d;
        d = O[mt][4 * i4 + 1] * inv - lam * o1.y; O[mt][4 * i4 + 1] = d; ss += d * d;
        d = O[mt][4 * i4 + 2] * inv - lam * o1.z; O[mt][4 * i4 + 2] = d; ss += d * d;
        d = O[mt][4 * i4 + 3] * inv - lam * o1.w; O[mt][4 * i4 + 3] = d; ss += d * d;
      }
    ss = xhalf_sum(ss);
    const float rs = rsqrtf(ss * (1.f / 128.f) + EPS) * oml;
    const float* sg = p.a_subln_g + l * 128;
    int qb_e = qb;
    asm volatile("" : "+v"(qb_e));
    u16* orow = proj + (tokbase + qb_e) * PC + AQ + h * 128;
#pragma unroll
    for (int mt = 0; mt < 4; ++mt)
#pragma unroll
      for (int i4 = 0; i4 < 4; ++i4) {
        const int dv = 32 * mt + 8 * i4 + 4 * hh;
        const float4 gg = *(const float4*)(sg + dv);
        uint2 o;
        o.x = pack2(O[mt][4 * i4] * rs * gg.x, O[mt][4 * i4 + 1] * rs * gg.y);
        o.y = pack2(O[mt][4 * i4 + 2] * rs * gg.z, O[mt][4 * i4 + 3] * rs * gg.w);
        *(uint2*)(orow + dv) = o;
      }
  }
  __syncthreads();
}

DI u32 mono_key(float f) { u32 u = __float_as_uint(f); return (u & 0x80000000u) ? ~u : (u | 0x80000000u); }

constexpr int DCAP = 640;
DI u32 dsa_prune(u32* ck, u16* ci, int cnt, u32 tau_old, bool exact, int ln, int& newcnt) {
  u32 kv[10];
  u16 iv[10];
  u32 mx = 0u;
#pragma unroll
  for (int j = 0; j < 10; ++j) {
    const int pos = ln + 64 * j;
    const bool vd = pos < cnt;
    kv[j] = vd ? ck[pos] : 0u;
    iv[j] = vd ? ci[pos] : (u16)0;
    mx = max(mx, kv[j]);
  }
#pragma unroll
  for (int o = 32; o; o >>= 1) mx = max(mx, (u32)__shfl_xor((int)mx, o));
  u32 L = tau_old + 1u, H = mx + 1u;
  int curL = cnt;
  while ((exact || curL > 384) && (H - L) > 1u) {
    const u32 mid = L + ((H - L) >> 1);
    int c = 0;
#pragma unroll
    for (int j = 0; j < 10; ++j) c += __popcll(__ballot(kv[j] >= mid));
    if (c >= 256) { L = mid; curL = c; } else H = mid;
  }
  int ngt = 0;
#pragma unroll
  for (int j = 0; j < 10; ++j) ngt += __popcll(__ballot(kv[j] > L));
  const int target = (!exact && curL <= 384) ? curL : 256;
  const int need = target - ngt;
  int run_gt = 0, run_eq = 0;
#pragma unroll
  for (int j = 0; j < 10; ++j) {
    const bool gt = kv[j] > L, eq = (kv[j] == L);
    const u64 mg = __ballot(gt), me = __ballot(eq);
    const int pg = run_gt + (int)lane_lt_cnt(mg), pe = run_eq + (int)lane_lt_cnt(me);
    if (gt) { ck[pg] = kv[j]; ci[pg] = iv[j]; }
    else if (eq && pe < need) { ck[ngt + pe] = kv[j]; ci[ngt + pe] = iv[j]; }
    run_gt += __popcll(mg);
    run_eq += __popcll(me);
  }
  newcnt = target;
  return L;
}

DI void dsa_item(const Params& p, int l, int tile32, int b, char* smem) {
  const int tid = ltid(), ln = tid & 63, w = tid >> 6, hh = ln >> 5, c31 = ln & 31;
  const int t0 = tile32 * 32 + 4 * w;
  const size_t tokbase = (size_t)b * T;
  u16* QX = (u16*)p.out;
  char* wl = smem + w * 17408;
  u32* ckey = (u32*)wl;
  u16* cidx = (u16*)(wl + 10240);
  u16* ifin = (u16*)(wl + 15360);
  char* tile = wl;
  int cnt0 = 0, cnt1 = 0, cnt2 = 0, cnt3 = 0;
  {
    bf16x8 qa[4];
    {
      const int r = c31, ql = 2 * ((r >> 2) & 1) + (r & 1), hd = ((r & 3) >> 1) + 2 * (r >> 3);
      const u16* qrow = QX + (tokbase + t0 + ql) * LDQ + 1024 + hd * 64 + 8 * hh;
#pragma unroll
      for (int s = 0; s < 4; ++s) qa[s] = *(const bf16x8*)(qrow + 16 * s);
    }
    typedef float f32x2 __attribute__((ext_vector_type(2)));
    f32x2 wq2[8];
    {
      const float4* wi = (const float4*)(p.WIDX() + (tokbase + t0 + 2 * hh) * 8);
      const float4 a0 = wi[0], a1 = wi[1], b0 = wi[2], b1 = wi[3];
      wq2[0] = f32x2{a0.x, b0.x}; wq2[1] = f32x2{a0.y, b0.y}; wq2[2] = f32x2{a0.z, b0.z}; wq2[3] = f32x2{a0.w, b0.w};
      wq2[4] = f32x2{a1.x, b1.x}; wq2[5] = f32x2{a1.y, b1.y}; wq2[6] = f32x2{a1.z, b1.z}; wq2[7] = f32x2{a1.w, b1.w};
    }
    const int qpos0 = t0 + 2 * hh;
    const int nkt = ((t0 + 3) >> 5) + 1;
    const u32 lmask = (1u << c31) - 1u;
#pragma unroll 1
    for (int rep = 0; rep < DUP_DSA1; ++rep) {
    cnt0 = cnt1 = cnt2 = cnt3 = 0;
    u32 tau0 = 0u, tau1 = 0u, tau2 = 0u, tau3 = 0u;
    bf16x8 kn[4][4];
    {
#pragma unroll
      for (int t = 0; t < 4; ++t) {
        const u16* krow = p.KIDX() + (tokbase + t * 32 + c31) * 64 + 8 * hh;
#pragma unroll
        for (int s = 0; s < 4; ++s) kn[t][s] = *(const bf16x8*)(krow + 16 * s);
      }
    }
    const int ngrp = (nkt + 3) >> 2;
    for (int g = 0; g <= ngrp; ++g) {
      const int lim = (g < ngrp) ? (DCAP - 128) : 256;
      for (;;) {
        const int q = (cnt0 > lim) ? 0 : (cnt1 > lim) ? 1 : (cnt2 > lim) ? 2 : (cnt3 > lim) ? 3 : -1;
        if (q < 0) break;
        const int c = (q == 0) ? cnt0 : (q == 1) ? cnt1 : (q == 2) ? cnt2 : cnt3;
        const u32 to = (q == 0) ? tau0 : (q == 1) ? tau1 : (q == 2) ? tau2 : tau3;
        int nc;
        const u32 t = dsa_prune(ckey + q * DCAP, cidx + q * DCAP, c, to, g == ngrp, ln, nc);
        if (q == 0) { cnt0 = nc; tau0 = t; } else if (q == 1) { cnt1 = nc; tau1 = t; }
        else if (q == 2) { cnt2 = nc; tau2 = t; } else { cnt3 = nc; tau3 = t; }
      }
      if (g == ngrp) break;
      bf16x8 kc[4][4];
#pragma unroll
      for (int t = 0; t < 4; ++t)
#pragma unroll
        for (int s = 0; s < 4; ++s) kc[t][s] = kn[t][s];
      if (g + 1 < ngrp) {
#pragma unroll
        for (int t = 0; t < 4; ++t) {
          const u16* krow = p.KIDX() + (tokbase + (g + 1) * 128 + t * 32 + c31) * 64 + 8 * hh;
#pragma unroll
          for (int s = 0; s < 4; ++s) kn[t][s] = *(const bf16x8*)(krow + 16 * s);
        }
      }
      const u32 tauA = hh ? tau2 : tau0, tauB = hh ? tau3 : tau1;
#pragma unroll
      for (int t = 0; t < 4; ++t) {
        const int key = (g * 4 + t) * 32 + c31;
        f32x16 acc;
#pragma unroll
        for (int j = 0; j < 16; ++j) acc[j] = 0.f;
#pragma unroll
        for (int s = 0; s < 4; ++s) acc = mfma32(qa[s], kc[t][s], acc);
        f32x2 ss2 = f32x2{0.f, 0.f};
#pragma unroll
        for (int hq = 0; hq < 8; ++hq) {
          const f32x2 rr = f32x2{__builtin_amdgcn_fmed3f(acc[2 * hq], 0.f, 3.0e38f), __builtin_amdgcn_fmed3f(acc[2 * hq + 1], 0.f, 3.0e38f)};
          ss2 = __builtin_elementwise_fma(wq2[hq], rr, ss2);
        }
        const float s0 = ss2.x, s1 = ss2.y;
        const u32 k0 = mono_key(s0), k1 = mono_key(s1);
        const bool c0 = (key <= qpos0) && (k0 > tauA), c1 = (key <= qpos0 + 1) && (k1 > tauB);
        const u64 m0 = __ballot(c0), m1 = __ballot(c1);
        if (m0 | m1) {
          const u32 h0 = hh ? (u32)(m0 >> 32) : (u32)m0, h1 = hh ? (u32)(m1 >> 32) : (u32)m1;
          const int pA = (hh ? cnt2 : cnt0) + __popc(h0 & lmask), pB = (hh ? cnt3 : cnt1) + __popc(h1 & lmask);
          if (c0) { ckey[(2 * hh) * DCAP + pA] = k0; cidx[(2 * hh) * DCAP + pA] = (u16)key; }
          if (c1) { ckey[(2 * hh + 1) * DCAP + pB] = k1; cidx[(2 * hh + 1) * DCAP + pB] = (u16)key; }
          cnt0 += __popc((u32)m0); cnt2 += __popc((u32)(m0 >> 32));
          cnt1 += __popc((u32)m1); cnt3 += __popc((u32)(m1 >> 32));
        }
      }
    }
#pragma unroll
    for (int qq = 0; qq < 4; ++qq) {
      const int cq = (qq == 0) ? cnt0 : (qq == 1) ? cnt1 : (qq == 2) ? cnt2 : cnt3;
#pragma unroll
      for (int j = 0; j < 4; ++j) {
        const int pos = ln + 64 * j;
        ifin[qq * 256 + pos] = (pos < cq) ? cidx[qq * DCAP + pos] : (u16)0;
      }
    }
    }
  }
  const float sc = 0.125f * 1.44269504089f;
#pragma unroll 1
  for (int rep2 = 0; rep2 < DUP_DSA2; ++rep2)
#pragma unroll 1
  for (int qq = 0; qq < 4; ++qq) {
    const int nsel = (qq == 0) ? cnt0 : (qq == 1) ? cnt1 : (qq == 2) ? cnt2 : cnt3;
    const size_t tq = tokbase + t0 + qq;
    bf16x8 qf[8];
    {
      const u16* qab = QX + tq * LDQ + (c31 & 7) * 128 + 8 * hh;
#pragma unroll
      for (int s = 0; s < 8; ++s) qf[s] = *(const bf16x8*)(qab + 16 * s);
    }
    f32x16 O[4];
#pragma unroll
    for (int i = 0; i < 4; ++i)
#pragma unroll
      for (int j = 0; j < 16; ++j) O[i][j] = 0.f;
    float mrun = -INFINITY, lrun = 0.f;
    const int ntile = (nsel + 31) >> 5;
    uint4 gr0, gr1, gr2, gr3, gr4, gr5, gr6, gr7;
#define GGATHER1(i, tt_)                                                                     \
    {                                                                                        \
      const int piece = ln + 64 * i, row = piece >> 4, ch = piece & 15;                      \
      const int idx = ifin[qq * 256 + (tt_) * 32 + row];                                     \
      gr##i = *(const uint4*)(p.CKV() + (tokbase + idx) * 128 + ch * 8);                     \
    }
#define GGATHER(tt_) { GGATHER1(0, tt_) GGATHER1(1, tt_) GGATHER1(2, tt_) GGATHER1(3, tt_) GGATHER1(4, tt_) GGATHER1(5, tt_) GGATHER1(6, tt_) GGATHER1(7, tt_) }
#define GSTORE1(i) { const int piece = ln + 64 * i, row = piece >> 4, ch = piece & 15; *(uint4*)(tile + row * 272 + ch * 16) = gr##i; }
    if (ntile > 0) GGATHER(0)
    for (int tt = 0; tt < ntile; ++tt) {
      GSTORE1(0) GSTORE1(1) GSTORE1(2) GSTORE1(3) GSTORE1(4) GSTORE1(5) GSTORE1(6) GSTORE1(7)
      if (tt + 1 < ntile) GGATHER(tt + 1)
      __builtin_amdgcn_fence(__ATOMIC_RELEASE, "wavefront");
      f32x16 sa;
#pragma unroll
      for (int j = 0; j < 16; ++j) sa[j] = 0.f;
#pragma unroll
      for (int s = 0; s < 8; ++s) sa = mfma32(*(const bf16x8*)(tile + c31 * 272 + (16 * s + 8 * hh) * 2), qf[s], sa);
      float tmax = -INFINITY;
#pragma unroll
      for (int j = 0; j < 16; ++j) {
        if (tt * 32 + crow(j, hh) >= nsel) sa[j] = -INFINITY;
        tmax = fmaxf(tmax, sa[j]);
      }
      tmax = xhalf_max(tmax);
      const float cand = tmax * sc;
      if (__any(cand > mrun + 8.f)) {
        const float mnew = fmaxf(mrun, cand);
        const float alpha = __builtin_amdgcn_exp2f(mrun - mnew);
        mrun = mnew;
        lrun *= alpha;
#pragma unroll
        for (int i = 0; i < 4; ++i)
#pragma unroll
          for (int j = 0; j < 16; ++j) O[i][j] *= alpha;
      }
      float psum = 0.f;
#pragma unroll
      for (int j = 0; j < 16; ++j) { const float pv = __builtin_amdgcn_exp2f(sa[j] * sc - mrun); sa[j] = pv; psum += pv; }
      lrun += psum;
#pragma unroll
      for (int s2 = 0; s2 < 2; ++s2) {
        const bf16x8 pp = pack8(sa, s2);
        bf16x8 vf[4];
        trfrag4<272>(tile, 16 * s2, ln, vf);
#pragma unroll
        for (int mt = 0; mt < 4; ++mt) O[mt] = mfma32(vf[mt], pp, O[mt]);
      }
      __builtin_amdgcn_fence(__ATOMIC_ACQ_REL, "wavefront");
    }
#undef GGATHER1
#undef GGATHER
#undef GSTORE1
    const float ltot = xhalf_sum(lrun);
    const float inv = 1.f / ltot;
    if (c31 < 8 && rep2 == DUP_DSA2 - 1) {
      u16* orow = QX + tq * LDQ + c31 * 128;
#pragma unroll
      for (int mt = 0; mt < 4; ++mt)
#pragma unroll
        for (int i4 = 0; i4 < 4; ++i4) {
          uint2 o;
          o.x = pack2(O[mt][4 * i4] * inv, O[mt][4 * i4 + 1] * inv);
          o.y = pack2(O[mt][4 * i4 + 2] * inv, O[mt][4 * i4 + 3] * inv);
          *(uint2*)(orow + 32 * mt + 8 * i4 + 4 * hh) = o;
        }
    }
  }
  __syncthreads();
}

DI void phase_prep(const Params& p, int l, char* smem) {
  if (EN_C) {
    int rt, ct;
    for (int it = 0; next_tile(it, 128, 6, 32, 2, rt, ct); ++it) qx_tile(p, l, rt, ct, smem);
  }
  const int n_gdn = EN_B ? 1024 : 0, n_kp = EN_C ? 512 : 0;
  for (int t = lbid(); t < n_gdn + n_kp; t += lgdim()) {
    if (t < n_gdn) gdn_prep_item(p, l, t, smem);
    else dsa_kprep_item(p, l, t - n_gdn);
  }
}

DI int xcc_id() { return (int)(__builtin_amdgcn_s_getreg((3 << 11) | 20) & 0x7u); }

DI void phase_mixers(const Params& p, int l, char* smem) {
  __shared__ int s_item;
  const int x0 = xcc_id();
  int xs = x0;
  for (;;) {
    __syncthreads();
    {
      int qi = l * 8 + xs;
      asm volatile("" : "+s"(qi));
      if (ltid() == 0) s_item = (int)atomicAdd(p.CNT() + qi, 1u);
    }
    __syncthreads();
    const int it = s_item;
    const int n_gdn = EN_B ? 1 : 0;
    if (it >= n_gdn + 256) {
      xs = (xs + 1) & 7;
      if (xs == x0) break;
      continue;
    }
    const int x = xs;
    if (it < n_gdn) {
#pragma unroll 1
      for (int rep = 0; rep < DUP_GDN; ++rep) gdn_rec_item(p, l, x, smem, rep == DUP_GDN - 1);
    }
    else {
      const int j = it - n_gdn, k = j >> 1;
      if ((j & 1) == 0) { if (EN_A) diff_item(p, l, 127 - k, x, smem); }
      else { if (EN_C) dsa_item(p, l, 511 - (k * 4 + (x >> 1)), x & 1, smem); }
    }
  }
}

DI void run_phase(const Params& p, int ph, char* smem) {
  if (ph == 0) { phase0(p, smem); return; }
  const int l = (ph - 1) / 9, s = (ph - 1) % 9;
  switch (s) {
    case 0: phase_inproj(p, l, smem); break;
    case 1: phase_prep(p, l, smem); break;
    case 2: phase_mixers(p, l, smem); break;
    case 3: phase_merge(p, l, smem); break;
    case 4: phase_resgemm(p, p.MERGED(), LDX, p.wo(l), KP1024, 1024, smem); break;
    case 5: ln_phase(p.out, p.ln1_g + l * 1024, p.ln1_b + l * 1024, p.XB(), nullptr); break;
    case 6: phase_ff1(p, l, smem); break;
    case 7: phase_resgemm(p, p.P(), LDH, p.wf2(l), KP4096, 4096, smem); break;
    case 8: ln_phase(p.out, p.ln2_g + l * 1024, p.ln2_b + l * 1024, (l == 1) ? nullptr : p.XB(), (l == 1) ? p.out : nullptr); break;
  }
}

constexpr int N_PHASES = 19;


DI u32 xb_ld(u32* p) { return __hip_atomic_load(p, __ATOMIC_RELAXED, __HIP_MEMORY_SCOPE_AGENT); }
DI u32 xb_add(u32* p, u32 v) { return __hip_atomic_fetch_add(p, v, __ATOMIC_RELAXED, __HIP_MEMORY_SCOPE_AGENT); }
DI void fast_sync(u32* bar, int x, const volatile int* st) {
  asm volatile("s_waitcnt vmcnt(0)" ::: "memory");
  __syncthreads();
  if (ltid() == 0) {
    __builtin_amdgcn_s_waitcnt(0);
    const u32 nloc = (u32)st[0], nx = (u32)st[1];
    const u32 old = xb_add(bar + 32 * (8 + x), 1u);
    const u32 gen = old / nloc;
    if (old + 1u == (gen + 1u) * nloc) {
      __builtin_amdgcn_fence(__ATOMIC_RELEASE, "agent");
      asm volatile("s_waitcnt vmcnt(0)" ::: "memory");
      const u32 og = xb_add(bar + 32 * 24, 1u);
      const u32 tg = og / nx;
      if (og + 1u == (tg + 1u) * nx) xb_add(bar + 32 * 25, 1u);
      else { while (xb_ld(bar + 32 * 25) == tg) __builtin_amdgcn_s_sleep(1); }
      __builtin_amdgcn_fence(__ATOMIC_ACQUIRE, "agent");
      xb_add(bar + 32 * (16 + x), 1u);
      asm volatile("s_waitcnt vmcnt(0)" ::: "memory");
    } else {
      while (xb_ld(bar + 32 * (16 + x)) == gen) __builtin_amdgcn_s_sleep(1);
      __builtin_amdgcn_fence(__ATOMIC_ACQUIRE, "agent");
      asm volatile("s_waitcnt vmcnt(0)" ::: "memory");
    }
  }
  __syncthreads();
}
#if COOP
DI void gsync() { cg::this_grid().sync(); }
__global__ void __launch_bounds__(512, 1) mega_kernel(Params p, int ph_begin, int ph_end) {
  __shared__ __attribute__((aligned(16))) char smem[SMEM_BYTES];
  __shared__ int xb_st[2];
  const int myx = xcc_id();
  if (ltid() == 0) (void)xb_add(p.BAR() + 32 * myx, 1u);
  for (int r = 0; r < REP0; ++r) { phase0(p, smem); cg::this_grid().sync(); }
  if (ltid() == 0) {
    int mine = 0, cnt = 0;
    for (int j = 0; j < 8; ++j) { const int c = (int)xb_ld(p.BAR() + 32 * j); cnt += (c > 0) ? 1 : 0; mine = (j == myx) ? c : mine; }
    xb_st[0] = mine > 0 ? mine : 1;
    xb_st[1] = cnt > 0 ? cnt : 1;
  }
  __syncthreads();
#define gsync() fast_sync(p.BAR(), myx, xb_st)
#pragma unroll 1
  for (int l = 0; l < 2; ++l) {
    for (int r = 0; r < REP1; ++r) { phase_inproj(p, l, smem); gsync(); }
    phase_prep(p, l, smem);
    gsync();
    phase_mixers(p, l, smem);
    gsync();
    for (int r = 0; r < REP2; ++r) { phase_merge(p, l, smem); gsync(); }
    for (int r = 0; r < REP3; ++r) { phase_resgemm(p, p.MERGED(), LDX, p.wo(l), KP1024, 1024, smem); gsync(); }
    for (int r = 0; r < REP4; ++r) { ln_phase(p.out, p.ln1_g + l * 1024, p.ln1_b + l * 1024, p.XB(), nullptr); gsync(); }
    for (int r = 0; r < REP5; ++r) { phase_ff1(p, l, smem); gsync(); }
    for (int r = 0; r < REP6; ++r) { phase_resgemm(p, p.P(), LDH, p.wf2(l), KP4096, 4096, smem); gsync(); }
    ln_phase(p.out, p.ln2_g + l * 1024, p.ln2_b + l * 1024, (l == 1) ? nullptr : p.XB(), (l == 1) ? p.out : nullptr);
    if (l == 0) gsync();
  }
}
#undef gsync
#else
__global__ void __launch_bounds__(512, 1) mega_kernel(Params p, int ph_begin, int ph_end) {
  __shared__ __attribute__((aligned(16))) char smem[SMEM_BYTES];
  for (int ph = ph_begin; ph < ph_end; ++ph) run_phase(p, ph, smem);
}
#endif

extern "C" void kernel_launch(void* const* d_in, const int* in_sizes, int n_in, void* d_out, int out_size,
                              void* d_ws, size_t ws_size, hipStream_t stream) {
  static int grid_blocks = 0;
  if (!grid_blocks) {
    int dev = 0, cus = 0, per_cu = 0;
    hipGetDevice(&dev);
    hipDeviceGetAttribute(&cus, hipDeviceAttributeMultiprocessorCount, dev);
    hipOccupancyMaxActiveBlocksPerMultiprocessor(&per_cu, mega_kernel, NTHR, 0);
    if (per_cu < 1) per_cu = 1;
    if (per_cu > 1) per_cu = 1;
    grid_blocks = cus * per_cu;
  }
  Params p{};
  const float** pf = (const float**)&p;
  for (int i = 0; i < 27; ++i) pf[i] = (const float*)d_in[i];
  p.out = (float*)d_out;
  p.ws = (char*)d_ws;
  if (WS_NEED > ws_size) { fprintf(stderr, "workspace too small: need %zu have %zu\n", (size_t)WS_NEED, ws_size); return; }
#if COOP
  hipMemsetAsync(p.ws + O_BAR, 0, 4096, stream);
  int b = 0, e = N_PHASES;
  void* args[] = {&p, &b, &e};
  hipError_t err = hipLaunchCooperativeKernel((void*)mega_kernel, dim3(grid_blocks), dim3(NTHR), args, 0, stream);
  if (err != hipSuccess) fprintf(stderr, "cooperative launch failed: %s (grid %d)\n", hipGetErrorString(err), grid_blocks);
#else
  for (int ph = 0; ph < N_PHASES; ++ph) mega_kernel<<<grid_blocks, NTHR, 0, stream>>>(p, ph, ph + 1);
#endif
}
```
